# Optimizing an MI355X kernel written in HIP

```python
import jax, jax.numpy as jnp
from jax import lax
import numpy as np

D_MODEL = 1024
BATCH = 4
SEQ = 4096
DEPTH = 4

LRU_WIDTH = 512
LRU_BLOCKS = 8
LRU_BLOCK = LRU_WIDTH // LRU_BLOCKS
CONV_WIDTH = 4
LRU_C = 8.0
MLA_HEADS = 4
QK_NOPE = 128
QK_ROPE = 64
QK_HEAD = QK_NOPE + QK_ROPE
V_HEAD = 128
Q_LORA = 768
KV_LORA = 256
MLA_WIDTH = MLA_HEADS * V_HEAD
MIX_WIDTH = LRU_WIDTH + MLA_WIDTH
IN_WIDTH = 2 * LRU_WIDTH + Q_LORA + KV_LORA + QK_ROPE
ROPE_BASE = 10000.0
Q_BLOCK = 128
N_EXPERTS = 16
N_GROUPS = 4
EXPERTS_PER_GROUP = N_EXPERTS // N_GROUPS
TOP_K = 2
D_EXPERT = 512
MOE_BLOCK = 128
DN_ALPHA = (2 * DEPTH) ** 0.25
DN_BETA = (8 * DEPTH) ** -0.25
EPS = 1e-6

kernel_name = 'hybrid_rglru_mla_moe_deepnorm'


def layer_norm(x, g, b):
    xf = x.astype(jnp.float32)
    mu = jnp.mean(xf, axis=-1, keepdims=True)
    var = jnp.mean(jnp.square(xf - mu), axis=-1, keepdims=True)
    return ((xf - mu) * lax.rsqrt(var + EPS) * g.astype(jnp.float32) + b.astype(jnp.float32)).astype(x.dtype)


def rms_norm(x, g):
    xf = x.astype(jnp.float32)
    ms = jnp.mean(xf * xf, axis=-1, keepdims=True)
    return (xf * lax.rsqrt(ms + EPS) * g.astype(jnp.float32)).astype(x.dtype)


def rope(x, pos):
    half = QK_ROPE // 2
    inv = ROPE_BASE ** (-jnp.arange(half, dtype=jnp.float32) / half)
    ang = pos.astype(jnp.float32)[:, None] * inv[None, :]
    cos = jnp.cos(ang)[None, :, None, :]
    sin = jnp.sin(ang)[None, :, None, :]
    xf = x.astype(jnp.float32)
    x1, x2 = xf[..., :half], xf[..., half:]
    return jnp.concatenate([x1 * cos - x2 * sin, x1 * sin + x2 * cos], axis=-1).astype(x.dtype)


def rg_lru_group(u, gate_in, conv_w, conv_b, w_rgate, b_rgate, w_igate, b_igate, lru_lambda):
    bsz, seq, _ = u.shape
    xc = lax.conv_general_dilated(u, conv_w[:, None, :], window_strides=(1,),
                                  padding=[(CONV_WIDTH - 1, 0)],
                                  dimension_numbers=('NWC', 'WIO', 'NWC'),
                                  feature_group_count=LRU_WIDTH) + conv_b
    xb = xc.reshape(bsz, seq, LRU_BLOCKS, LRU_BLOCK)
    r = jax.nn.sigmoid(jnp.einsum('bsnc,ncd->bsnd', xb, w_rgate) + b_rgate).reshape(bsz, seq, LRU_WIDTH)
    i = jax.nn.sigmoid(jnp.einsum('bsnc,ncd->bsnd', xb, w_igate) + b_igate).reshape(bsz, seq, LRU_WIDTH)
    log_a = (-LRU_C * r.astype(jnp.float32)) * jax.nn.softplus(-lru_lambda.astype(jnp.float32))
    a = jnp.exp(log_a)
    drive = jnp.sqrt(-jnp.expm1(2.0 * log_a)) * (i * xc).astype(jnp.float32)

    def combine(left, right):
        a1, b1 = left
        a2, b2 = right
        return a1 * a2, a2 * b1 + b2

    _, h = lax.associative_scan(combine, (a, drive), axis=1)
    return h.astype(u.dtype) * jax.nn.gelu(gate_in)


def causal_block_attention(q, k, v):
    bsz, seq, nh, dk = q.shape
    nb = seq // Q_BLOCK
    qb = q.reshape(bsz, nb, Q_BLOCK, nh, dk).transpose(1, 0, 2, 3, 4)
    k_pos = jnp.arange(seq)

    def one_block(args):
        qi, bi = args
        s = jnp.einsum('bqhd,bkhd->bhqk', qi, k, preferred_element_type=jnp.float32)
        q_pos = bi * Q_BLOCK + jnp.arange(Q_BLOCK)
        s = jnp.where(k_pos[None, :] <= q_pos[:, None], s, -jnp.inf)
        p = jax.nn.softmax(s, axis=-1)
        return jnp.einsum('bhqk,bkhd->bqhd', p.astype(v.dtype), v)

    out = lax.map(one_block, (qb, jnp.arange(nb)))
    return out.transpose(1, 0, 2, 3, 4).reshape(bsz, seq, nh * V_HEAD)


def mla_group(q_lat, kv_lat, k_rope_raw, q_norm_g, w_q_up, kv_norm_g, w_kv_up, pos):
    bsz, seq, _ = q_lat.shape
    q = jnp.einsum('bsr,rhd->bshd', rms_norm(q_lat, q_norm_g), w_q_up)
    q = jnp.concatenate([q[..., :QK_NOPE], rope(q[..., QK_NOPE:], pos)], axis=-1)
    kv = jnp.einsum('bsr,rhd->bshd', rms_norm(kv_lat, kv_norm_g), w_kv_up)
    k_nope, v = kv[..., :QK_NOPE], kv[..., QK_NOPE:]
    k_pe = rope(k_rope_raw[:, :, None, :], pos)
    k = jnp.concatenate([k_nope, jnp.broadcast_to(k_pe, (bsz, seq, MLA_HEADS, QK_ROPE))], axis=-1)
    return causal_block_attention(q * (QK_HEAD ** -0.5), k, v)


def route(x2, router_w, router_bias):
    n_tok = x2.shape[0]
    s = jax.nn.sigmoid(jnp.einsum('nd,de->ne', x2, router_w, preferred_element_type=jnp.float32))
    s_sel = (s + router_bias.astype(jnp.float32)).reshape(n_tok, N_GROUPS, EXPERTS_PER_GROUP)
    grp_score = jnp.sum(lax.top_k(s_sel, 2)[0], axis=-1)
    best_g = jnp.argmax(grp_score, axis=-1)
    _, local = lax.top_k(s_sel[jnp.arange(n_tok), best_g], TOP_K)
    expert_idx = best_g[:, None] * EXPERTS_PER_GROUP + local
    w = jnp.take_along_axis(s, expert_idx, axis=1)
    return expert_idx, w / jnp.sum(w, axis=-1, keepdims=True)


def moe_ffn(x2, router_w, router_bias, w_exp_gate, w_exp_up, w_exp_down):
    n_tok, d = x2.shape
    n_asg = n_tok * TOP_K
    expert_idx, gates = route(x2, router_w, router_bias)
    flat_e = expert_idx.reshape(-1)
    order = jnp.argsort(flat_e)
    sorted_e = flat_e[order]
    tok = order // TOP_K
    counts = jnp.bincount(flat_e, length=N_EXPERTS)
    padded = (counts + MOE_BLOCK - 1) // MOE_BLOCK * MOE_BLOCK
    pad_end = jnp.cumsum(padded)
    pad_start = pad_end - padded
    start = jnp.cumsum(counts) - counts
    dest = pad_start[sorted_e] + (jnp.arange(n_asg) - start[sorted_e])
    n_blocks = -(-n_asg // MOE_BLOCK) + N_EXPERTS
    buf = jnp.zeros((n_blocks * MOE_BLOCK, d), x2.dtype).at[dest].set(x2[tok])
    block_expert = jnp.minimum(jnp.searchsorted(pad_end, jnp.arange(n_blocks) * MOE_BLOCK, side='right'),
                               N_EXPERTS - 1)

    def expert_block(args):
        xb, e = args
        hb = jax.nn.silu(xb @ w_exp_gate[e]) * (xb @ w_exp_up[e])
        return hb @ w_exp_down[e]

    yb = lax.map(expert_block, (buf.reshape(n_blocks, MOE_BLOCK, d), block_expert))
    y_sorted = yb.reshape(n_blocks * MOE_BLOCK, d)[dest]
    g_sorted = gates.reshape(-1)[order].astype(x2.dtype)
    return jax.ops.segment_sum(y_sorted * g_sorted[:, None], tok, num_segments=n_tok)


def hybrid_layer(x, w_in, conv_w, conv_b, w_rgate, b_rgate, w_igate, b_igate, lru_lambda,
                 q_norm_g, w_q_up, kv_norm_g, w_kv_up, out_norm_g, w_out, ln1_g, ln1_b,
                 router_w, router_bias, w_exp_gate, w_exp_up, w_exp_down, ln2_g, ln2_b):
    bsz, seq, d = x.shape
    pos = jnp.arange(seq)
    z = jnp.einsum('bsd,dc->bsc', x, w_in)
    o1 = LRU_WIDTH
    o2 = 2 * LRU_WIDTH
    o3 = o2 + Q_LORA
    o4 = o3 + KV_LORA
    u, gate_in, q_lat, kv_lat, k_rope_raw = jnp.split(z, [o1, o2, o3, o4], axis=-1)
    lru_out = rg_lru_group(u, gate_in, conv_w, conv_b, w_rgate, b_rgate, w_igate, b_igate, lru_lambda)
    mla_out = mla_group(q_lat, kv_lat, k_rope_raw, q_norm_g, w_q_up, kv_norm_g, w_kv_up, pos)
    mix = jnp.concatenate([rms_norm(lru_out, out_norm_g[:LRU_WIDTH]),
                           rms_norm(mla_out, out_norm_g[LRU_WIDTH:])], axis=-1)
    h = jnp.einsum('bsc,cd->bsd', mix, w_out)
    x = layer_norm(DN_ALPHA * x + h, ln1_g, ln1_b)
    f = moe_ffn(x.reshape(bsz * seq, d), router_w, router_bias, w_exp_gate, w_exp_up, w_exp_down)
    return layer_norm(DN_ALPHA * x + f.reshape(bsz, seq, d), ln2_g, ln2_b)


def setup_inputs(seed: int = 0) -> dict:
    key = jax.random.key(seed)
    ks = jax.random.split(key, 24)
    L, D = DEPTH, D_MODEL
    nrm = lambda k, shape, scale: jax.random.normal(k, shape, jnp.float32) * scale
    x = jax.random.normal(ks[0], (BATCH, SEQ, D), jnp.float32)
    w_in = nrm(ks[1], (L, D, IN_WIDTH), D ** -0.5)
    conv_w = nrm(ks[2], (L, CONV_WIDTH, LRU_WIDTH), CONV_WIDTH ** -0.5)
    conv_b = nrm(ks[3], (L, LRU_WIDTH), 0.02)
    w_rgate = nrm(ks[4], (L, LRU_BLOCKS, LRU_BLOCK, LRU_BLOCK), LRU_BLOCK ** -0.5)
    b_rgate = nrm(ks[5], (L, LRU_BLOCKS, LRU_BLOCK), 0.02)
    w_igate = nrm(ks[6], (L, LRU_BLOCKS, LRU_BLOCK, LRU_BLOCK), LRU_BLOCK ** -0.5)
    b_igate = nrm(ks[7], (L, LRU_BLOCKS, LRU_BLOCK), 0.02)
    a0 = jax.random.uniform(ks[8], (L, LRU_WIDTH), jnp.float32, 0.9, 0.999)
    lru_lambda = jnp.log(a0) - jnp.log1p(-a0)
    q_norm_g = 1.0 + nrm(ks[9], (L, Q_LORA), 0.02)
    w_q_up = nrm(ks[10], (L, Q_LORA, MLA_HEADS, QK_HEAD), Q_LORA ** -0.5)
    kv_norm_g = 1.0 + nrm(ks[11], (L, KV_LORA), 0.02)
    kv_scale = jnp.concatenate([jnp.ones((QK_NOPE,), jnp.float32), jnp.full((V_HEAD,), DN_BETA, jnp.float32)])
    w_kv_up = nrm(ks[12], (L, KV_LORA, MLA_HEADS, QK_NOPE + V_HEAD), KV_LORA ** -0.5) * kv_scale
    out_norm_g = 1.0 + nrm(ks[13], (L, MIX_WIDTH), 0.02)
    w_out = nrm(ks[14], (L, MIX_WIDTH, D), MIX_WIDTH ** -0.5 * DN_BETA)
    ln1_g = 1.0 + nrm(ks[15], (L, D), 0.02)
    ln1_b = nrm(ks[16], (L, D), 0.02)
    router_w = nrm(ks[17], (D, N_EXPERTS), D ** -0.5)
    router_bias = nrm(ks[18], (N_EXPERTS,), 0.01)
    w_exp_gate = nrm(ks[19], (L, N_EXPERTS, D, D_EXPERT), D ** -0.5)
    w_exp_up = nrm(ks[20], (L, N_EXPERTS, D, D_EXPERT), D ** -0.5)
    w_exp_down = nrm(ks[21], (L, N_EXPERTS, D_EXPERT, D), D_EXPERT ** -0.5 * DN_BETA)
    ln2_g = 1.0 + nrm(ks[22], (L, D), 0.02)
    ln2_b = nrm(ks[23], (L, D), 0.02)
    return {'x': x, 'w_in': w_in, 'conv_w': conv_w, 'conv_b': conv_b,
            'w_rgate': w_rgate, 'b_rgate': b_rgate, 'w_igate': w_igate, 'b_igate': b_igate,
            'lru_lambda': lru_lambda, 'q_norm_g': q_norm_g, 'w_q_up': w_q_up,
            'kv_norm_g': kv_norm_g, 'w_kv_up': w_kv_up, 'out_norm_g': out_norm_g, 'w_out': w_out,
            'ln1_g': ln1_g, 'ln1_b': ln1_b, 'router_w': router_w, 'router_bias': router_bias,
            'w_exp_gate': w_exp_gate, 'w_exp_up': w_exp_up, 'w_exp_down': w_exp_down,
            'ln2_g': ln2_g, 'ln2_b': ln2_b}


def reference(x, w_in, conv_w, conv_b, w_rgate, b_rgate, w_igate, b_igate, lru_lambda,
              q_norm_g, w_q_up, kv_norm_g, w_kv_up, out_norm_g, w_out, ln1_g, ln1_b,
              router_w, router_bias, w_exp_gate, w_exp_up, w_exp_down, ln2_g, ln2_b):
    for l in range(DEPTH):
        x = hybrid_layer(x, w_in[l], conv_w[l], conv_b[l], w_rgate[l], b_rgate[l], w_igate[l], b_igate[l],
                         lru_lambda[l], q_norm_g[l], w_q_up[l], kv_norm_g[l], w_kv_up[l], out_norm_g[l],
                         w_out[l], ln1_g[l], ln1_b[l], router_w, router_bias,
                         w_exp_gate[l], w_exp_up[l], w_exp_down[l], ln2_g[l], ln2_b[l])
    return x
```

```cpp
#include <hip/hip_runtime.h>
#include <cstdint>
#include <cstdio>

namespace cfg {
constexpr int D = 1024, B = 4, S = 4096, NT = B * S, L = 4;
constexpr int LW = 512, NBLK = 8, BLK = 64;
constexpr int H = 4, QNOPE = 128, QROPE = 64, QH = 192, VH = 128, QL = 768, KVL = 256;
constexpr int INW = 2112;
constexpr int NE = 16, DE = 512;
constexpr float ALPHA = 1.681792830507429f, EPS = 1e-6f;
}
using namespace cfg;

#ifndef MODE
#define MODE 1
#endif
#if MODE == 0
namespace ref {

__device__ __forceinline__ float wave_sum(float v) {
#pragma unroll
    for (int o = 1; o < 64; o <<= 1) v += __shfl_xor(v, o);
    return v;
}
__device__ __forceinline__ float wave_max(float v) {
#pragma unroll
    for (int o = 1; o < 64; o <<= 1) v = fmaxf(v, __shfl_xor(v, o));
    return v;
}
#define BF16_EMU 1
__device__ __forceinline__ float rb(float f) {
#if BF16_EMU
    unsigned u = __float_as_uint(f); u = (u + 0x7fffu + ((u >> 16) & 1u)) & 0xffff0000u; return __uint_as_float(u);
#else
    return f;
#endif
}
__device__ __forceinline__ float sigmoidf_(float x) { return 1.f / (1.f + expf(-x)); }
__device__ __forceinline__ float gelu_tanh(float x) { return 0.5f * x * (1.f + tanhf(0.7978845608028654f * (x + 0.044715f * x * x * x))); }

template <bool RO> __global__ __launch_bounds__(256) void gemm(const float* __restrict__ A, int lda, const float* __restrict__ Bm, int ldb, float* __restrict__ C, int ldc, int K) {
    __shared__ float As[16][68];
    __shared__ float Bs[16][68];
    const int tid = threadIdx.x, tx = tid & 15, ty = tid >> 4;
    const int m0 = blockIdx.y * 64, n0 = blockIdx.x * 64;
    float acc[4][4];
#pragma unroll
    for (int i = 0; i < 4; ++i)
#pragma unroll
        for (int j = 0; j < 4; ++j) acc[i][j] = 0.f;
    for (int k0 = 0; k0 < K; k0 += 16) {
#pragma unroll
        for (int it = 0; it < 4; ++it) { const int i = tid + it * 256; const int m = i >> 4, k = i & 15; As[k][m] = rb(A[(size_t)(m0 + m) * lda + k0 + k]); }
#pragma unroll
        for (int it = 0; it < 4; ++it) { const int i = tid + it * 256; const int k = i >> 6, n = i & 63; Bs[k][n] = rb(Bm[(size_t)(k0 + k) * ldb + n0 + n]); }
        __syncthreads();
#pragma unroll
        for (int k = 0; k < 16; ++k) {
            float a[4], b[4];
#pragma unroll
            for (int i = 0; i < 4; ++i) { a[i] = As[k][ty * 4 + i]; b[i] = Bs[k][tx * 4 + i]; }
#pragma unroll
            for (int i = 0; i < 4; ++i)
#pragma unroll
                for (int j = 0; j < 4; ++j) acc[i][j] = fmaf(a[i], b[j], acc[i][j]);
        }
        __syncthreads();
    }
#pragma unroll
    for (int i = 0; i < 4; ++i)
#pragma unroll
        for (int j = 0; j < 4; ++j) C[(size_t)(m0 + ty * 4 + i) * ldc + n0 + tx * 4 + j] = RO ? rb(acc[i][j]) : acc[i][j];
}

__global__ __launch_bounds__(256) void rmsnorm(float* X, int ld, int off, int n, const float* __restrict__ g) {
    const int row = blockIdx.x * 4 + (threadIdx.x >> 6), lane = threadIdx.x & 63;
    float* x = X + (size_t)row * ld + off;
    float s = 0.f;
    for (int i = lane; i < n; i += 64) { const float v = x[i]; s += v * v; }
    s = wave_sum(s);
    const float r = rsqrtf(s / (float)n + EPS);
    for (int i = lane; i < n; i += 64) x[i] = x[i] * r * g[i];
}

__global__ __launch_bounds__(256) void lru_gates(const float* __restrict__ Z, const float* __restrict__ conv_w, const float* __restrict__ conv_b,
                                                 const float* __restrict__ wr, const float* __restrict__ br, const float* __restrict__ wi, const float* __restrict__ bi,
                                                 const float* __restrict__ lam, float* __restrict__ Aout, float* __restrict__ Dout) {
    const int idx = blockIdx.x * 256 + threadIdx.x;
    const int tok = idx >> 9, ch = idx & 511, n = ch >> 6, d = ch & 63, s = tok & (S - 1);
    float accr = br[ch], acci = bi[ch], xc_own = 0.f;
    for (int c = 0; c < 64; ++c) {
        const int cc = n * 64 + c;
        float xc = conv_b[cc];
#pragma unroll
        for (int w = 0; w < 4; ++w) { const int sp = s + w - 3; if (sp >= 0) xc = fmaf(Z[(size_t)(tok + w - 3) * INW + cc], conv_w[w * LW + cc], xc); }
        accr = fmaf(xc, wr[(size_t)cc * 64 + d], accr);
        acci = fmaf(xc, wi[(size_t)cc * 64 + d], acci);
        if (c == d) xc_own = xc;
    }
    const float r = sigmoidf_(accr), ig = sigmoidf_(acci);
    const float sp = log1pf(expf(-lam[ch]));
    const float log_a = -8.0f * r * sp;
    Aout[idx] = expf(log_a);
    Dout[idx] = sqrtf(-expm1f(2.0f * log_a)) * (ig * xc_own);
}

__global__ __launch_bounds__(256) void lru_scan(const float* __restrict__ Ain, const float* __restrict__ Din, const float* __restrict__ Z, float* __restrict__ MIX) {
    const int idx = blockIdx.x * 256 + threadIdx.x;
    const int b = idx >> 9, ch = idx & 511;
    float h = 0.f;
    for (int s0 = 0; s0 < S; s0 += 8) {
        float a[8], d[8], g[8];
#pragma unroll
        for (int j = 0; j < 8; ++j) { const size_t t = (size_t)b * S + s0 + j; a[j] = Ain[t * LW + ch]; d[j] = Din[t * LW + ch]; g[j] = Z[t * INW + LW + ch]; }
#pragma unroll
        for (int j = 0; j < 8; ++j) { h = fmaf(a[j], h, d[j]); const size_t t = (size_t)b * S + s0 + j; MIX[t * D + ch] = h * gelu_tanh(g[j]); }
    }
}

__global__ __launch_bounds__(256) void q_post(float* Q) {
    const int idx = blockIdx.x * 256 + threadIdx.x;
    const int j = idx % 96, th = idx / 96, h = th & 3, tok = th >> 2, s = tok & (S - 1);
    float* q = Q + (size_t)tok * QL + h * QH;
    const float sc = 0.07216878364870322f;
    if (j < 64) { q[j] *= sc; q[j + 64] *= sc; }
    else {
        const int i = j - 64;
        const float inv = powf(10000.0f, -(float)i / 32.0f);
        const float ang = (float)s * inv;
        const float c = cosf(ang), sn = sinf(ang);
        const float x1 = q[128 + i], x2 = q[160 + i];
        q[128 + i] = (x1 * c - x2 * sn) * sc; q[160 + i] = (x1 * sn + x2 * c) * sc;
    }
}
__global__ __launch_bounds__(256) void kpe_rope(const float* __restrict__ Z, float* __restrict__ KPE) {
    const int idx = blockIdx.x * 256 + threadIdx.x;
    const int i = idx & 31, tok = idx >> 5, s = tok & (S - 1);
    const float inv = powf(10000.0f, -(float)i / 32.0f);
    const float ang = (float)s * inv;
    const float c = cosf(ang), sn = sinf(ang);
    const float x1 = Z[(size_t)tok * INW + 2048 + i], x2 = Z[(size_t)tok * INW + 2048 + 32 + i];
    KPE[(size_t)tok * 64 + i] = x1 * c - x2 * sn; KPE[(size_t)tok * 64 + 32 + i] = x1 * sn + x2 * c;
}

__global__ __launch_bounds__(64) void attention(const float* __restrict__ Q, const float* __restrict__ KV, const float* __restrict__ KPE, float* __restrict__ MIX) {
    extern __shared__ __attribute__((aligned(16))) float dyn_lds[];
    float (*sc)[S] = (float (*)[S])dyn_lds;
    float (*qs)[QH] = (float (*)[QH])(dyn_lds + 4 * S);
    const int lane = threadIdx.x;
    const int blk = blockIdx.x;
    const int qb = blk % (S / 4), bh = blk / (S / 4), h = bh & 3, b = bh >> 2;
    const int q0 = qb * 4;
    for (int i = lane; i < 4 * QH; i += 64) { const int r = i / QH, d = i % QH; qs[r][d] = rb(Q[(size_t)(b * S + q0 + r) * QL + h * QH + d]); }
    __syncthreads();
    const int nk = q0 + 4;
    for (int j = lane; j < nk; j += 64) {
        const float* kn = KV + (size_t)(b * S + j) * 1024 + h * 256;
        const float* kp = KPE + (size_t)(b * S + j) * 64;
        float d0 = 0.f, d1 = 0.f, d2 = 0.f, d3 = 0.f;
        for (int d = 0; d < 128; d += 4) {
            float4 kv = *(const float4*)(kn + d); kv.x = rb(kv.x); kv.y = rb(kv.y); kv.z = rb(kv.z); kv.w = rb(kv.w);
            d0 += kv.x * qs[0][d] + kv.y * qs[0][d + 1] + kv.z * qs[0][d + 2] + kv.w * qs[0][d + 3];
            d1 += kv.x * qs[1][d] + kv.y * qs[1][d + 1] + kv.z * qs[1][d + 2] + kv.w * qs[1][d + 3];
            d2 += kv.x * qs[2][d] + kv.y * qs[2][d + 1] + kv.z * qs[2][d + 2] + kv.w * qs[2][d + 3];
            d3 += kv.x * qs[3][d] + kv.y * qs[3][d + 1] + kv.z * qs[3][d + 2] + kv.w * qs[3][d + 3];
        }
        for (int d = 0; d < 64; d += 4) {
            float4 kv = *(const float4*)(kp + d); kv.x = rb(kv.x); kv.y = rb(kv.y); kv.z = rb(kv.z); kv.w = rb(kv.w);
            d0 += kv.x * qs[0][128 + d] + kv.y * qs[0][129 + d] + kv.z * qs[0][130 + d] + kv.w * qs[0][131 + d];
            d1 += kv.x * qs[1][128 + d] + kv.y * qs[1][129 + d] + kv.z * qs[1][130 + d] + kv.w * qs[1][131 + d];
            d2 += kv.x * qs[2][128 + d] + kv.y * qs[2][129 + d] + kv.z * qs[2][130 + d] + kv.w * qs[2][131 + d];
            d3 += kv.x * qs[3][128 + d] + kv.y * qs[3][129 + d] + kv.z * qs[3][130 + d] + kv.w * qs[3][131 + d];
        }
        const float NEG = -INFINITY;
        sc[0][j] = (j <= q0 + 0) ? d0 : NEG; sc[1][j] = (j <= q0 + 1) ? d1 : NEG; sc[2][j] = (j <= q0 + 2) ? d2 : NEG; sc[3][j] = (j <= q0 + 3) ? d3 : NEG;
    }
    __syncthreads();
    float inv_l[4];
#pragma unroll
    for (int r = 0; r < 4; ++r) {
        float m = -INFINITY;
        for (int j = lane; j < nk; j += 64) m = fmaxf(m, sc[r][j]);
        m = wave_max(m);
        float l = 0.f;
        for (int j = lane; j < nk; j += 64) { const float p = expf(sc[r][j] - m); sc[r][j] = rb(p); l += p; }
        l = wave_sum(l);
        inv_l[r] = 1.f / l;
    }
    __syncthreads();
    float o[4][2];
#pragma unroll
    for (int r = 0; r < 4; ++r) { o[r][0] = 0.f; o[r][1] = 0.f; }
    for (int j = 0; j < nk; ++j) {
        const float* v = KV + (size_t)(b * S + j) * 1024 + h * 256 + 128;
        const float v0 = rb(v[lane]), v1 = rb(v[lane + 64]);
#pragma unroll
        for (int r = 0; r < 4; ++r) { const float p = sc[r][j]; o[r][0] = fmaf(p, v0, o[r][0]); o[r][1] = fmaf(p, v1, o[r][1]); }
    }
#pragma unroll
    for (int r = 0; r < 4; ++r) {
        float* out = MIX + (size_t)(b * S + q0 + r) * D + 512 + h * 128;
        out[lane] = o[r][0] * inv_l[r]; out[lane + 64] = o[r][1] * inv_l[r];
    }
}

__global__ __launch_bounds__(256) void ln_res(const float* Xin, const float* __restrict__ Y, float* Xout, const float* __restrict__ g, const float* __restrict__ bta) {
    const int row = blockIdx.x * 4 + (threadIdx.x >> 6), lane = threadIdx.x & 63;
    float v[16]; float s = 0.f;
#pragma unroll
    for (int j = 0; j < 16; ++j) { const int c = lane + 64 * j; v[j] = ALPHA * Xin[(size_t)row * D + c] + Y[(size_t)row * D + c]; s += v[j]; }
    const float mu = wave_sum(s) * (1.f / D);
    float q = 0.f;
#pragma unroll
    for (int j = 0; j < 16; ++j) { v[j] -= mu; q += v[j] * v[j]; }
    const float r = rsqrtf(wave_sum(q) * (1.f / D) + EPS);
#pragma unroll
    for (int j = 0; j < 16; ++j) { const int c = lane + 64 * j; Xout[(size_t)row * D + c] = v[j] * r * g[c] + bta[c]; }
}
__global__ __launch_bounds__(256) void ln_moe(float* X, const float* __restrict__ YE, const float* __restrict__ GATE, const float* __restrict__ g, const float* __restrict__ bta) {
    const int row = blockIdx.x * 4 + (threadIdx.x >> 6), lane = threadIdx.x & 63;
    const float g0 = GATE[row * 2], g1 = GATE[row * 2 + 1];
    float v[16]; float s = 0.f;
#pragma unroll
    for (int j = 0; j < 16; ++j) { const int c = lane + 64 * j; v[j] = ALPHA * X[(size_t)row * D + c] + g0 * YE[(size_t)(2 * row) * D + c] + g1 * YE[(size_t)(2 * row + 1) * D + c]; s += v[j]; }
    const float mu = wave_sum(s) * (1.f / D);
    float q = 0.f;
#pragma unroll
    for (int j = 0; j < 16; ++j) { v[j] -= mu; q += v[j] * v[j]; }
    const float r = rsqrtf(wave_sum(q) * (1.f / D) + EPS);
#pragma unroll
    for (int j = 0; j < 16; ++j) { const int c = lane + 64 * j; X[(size_t)row * D + c] = v[j] * r * g[c] + bta[c]; }
}

__global__ __launch_bounds__(256) void router(const float* __restrict__ X, const float* __restrict__ RW, const float* __restrict__ RB, float* __restrict__ GATE, int* CNT, int* LIST) {
    const int tok = blockIdx.x * 4 + (threadIdx.x >> 6), lane = threadIdx.x & 63;
    float acc[16];
#pragma unroll
    for (int e = 0; e < 16; ++e) acc[e] = 0.f;
    for (int j = 0; j < 16; ++j) {
        const int i = lane + 64 * j;
        const float x = X[(size_t)tok * D + i];
        const float4* w = (const float4*)(RW + (size_t)i * 16);
        const float4 w0 = w[0], w1 = w[1], w2 = w[2], w3 = w[3];
        acc[0] = fmaf(x, w0.x, acc[0]); acc[1] = fmaf(x, w0.y, acc[1]); acc[2] = fmaf(x, w0.z, acc[2]); acc[3] = fmaf(x, w0.w, acc[3]);
        acc[4] = fmaf(x, w1.x, acc[4]); acc[5] = fmaf(x, w1.y, acc[5]); acc[6] = fmaf(x, w1.z, acc[6]); acc[7] = fmaf(x, w1.w, acc[7]);
        acc[8] = fmaf(x, w2.x, acc[8]); acc[9] = fmaf(x, w2.y, acc[9]); acc[10] = fmaf(x, w2.z, acc[10]); acc[11] = fmaf(x, w2.w, acc[11]);
        acc[12] = fmaf(x, w3.x, acc[12]); acc[13] = fmaf(x, w3.y, acc[13]); acc[14] = fmaf(x, w3.z, acc[14]); acc[15] = fmaf(x, w3.w, acc[15]);
    }
    float sg[16], ss[16];
#pragma unroll
    for (int e = 0; e < 16; ++e) { sg[e] = sigmoidf_(wave_sum(acc[e])); ss[e] = sg[e] + RB[e]; }
    int best_g = 0; float best = -INFINITY;
#pragma unroll
    for (int gI = 0; gI < 4; ++gI) {
        float m1 = -INFINITY, m2 = -INFINITY;
#pragma unroll
        for (int k = 0; k < 4; ++k) { const float v = ss[gI * 4 + k]; if (v > m1) { m2 = m1; m1 = v; } else if (v > m2) { m2 = v; } }
        const float gs = m1 + m2;
        if (gs > best) { best = gs; best_g = gI; }
    }
    float c0 = 0.f, c1 = 0.f, c2 = 0.f, c3 = 0.f, t0 = 0.f, t1 = 0.f, t2 = 0.f, t3 = 0.f;
#pragma unroll
    for (int gI = 0; gI < 4; ++gI) if (gI == best_g) { c0 = ss[gI * 4]; c1 = ss[gI * 4 + 1]; c2 = ss[gI * 4 + 2]; c3 = ss[gI * 4 + 3]; t0 = sg[gI * 4]; t1 = sg[gI * 4 + 1]; t2 = sg[gI * 4 + 2]; t3 = sg[gI * 4 + 3]; }
    int i1 = 0; float v1 = c0, s1 = t0;
    if (c1 > v1) { i1 = 1; v1 = c1; s1 = t1; }
    if (c2 > v1) { i1 = 2; v1 = c2; s1 = t2; }
    if (c3 > v1) { i1 = 3; v1 = c3; s1 = t3; }
    int i2 = -1; float v2 = -INFINITY, s2 = 0.f;
    if (i1 != 0 && c0 > v2) { i2 = 0; v2 = c0; s2 = t0; }
    if (i1 != 1 && c1 > v2) { i2 = 1; v2 = c1; s2 = t1; }
    if (i1 != 2 && c2 > v2) { i2 = 2; v2 = c2; s2 = t2; }
    if (i1 != 3 && c3 > v2) { i2 = 3; v2 = c3; s2 = t3; }
    if (lane == 0) {
        const int e1 = best_g * 4 + i1, e2 = best_g * 4 + i2;
        const float inv = 1.f / (s1 + s2);
        GATE[tok * 2] = s1 * inv; GATE[tok * 2 + 1] = s2 * inv;
        const int p1 = atomicAdd(&CNT[e1], 1); LIST[e1 * NT + p1] = tok * 2;
        const int p2 = atomicAdd(&CNT[e2], 1); LIST[e2 * NT + p2] = tok * 2 + 1;
    }
}

__global__ __launch_bounds__(256) void moe_up(const float* __restrict__ X, const float* __restrict__ Wg, const float* __restrict__ Wu, const int* __restrict__ CNT, const int* __restrict__ LIST, float* __restrict__ HID) {
    extern __shared__ __attribute__((aligned(16))) float dyn_lds[];
    float (*xs)[16] = (float (*)[16])dyn_lds;
    int* asg_s = (int*)(dyn_lds + D * 16);
    const int e = blockIdx.y, start = blockIdx.x * 16, cnt = CNT[e];
    if (start >= cnt) return;
    const int n = min(16, cnt - start), tid = threadIdx.x;
    if (tid < 16) asg_s[tid] = tid < n ? LIST[e * NT + start + tid] : -1;
    __syncthreads();
    for (int i = tid; i < 16 * D; i += 256) { const int r = i >> 10, k = i & 1023; const int a = asg_s[r]; xs[k][r] = a >= 0 ? rb(X[(size_t)(a >> 1) * D + k]) : 0.f; }
    __syncthreads();
    float g0[16], g1[16], u0[16], u1[16];
#pragma unroll
    for (int r = 0; r < 16; ++r) { g0[r] = 0.f; g1[r] = 0.f; u0[r] = 0.f; u1[r] = 0.f; }
    const float* wg = Wg + (size_t)e * D * DE; const float* wu = Wu + (size_t)e * D * DE;
    for (int k = 0; k < D; ++k) {
        const float a0 = rb(wg[(size_t)k * DE + tid]), a1 = rb(wg[(size_t)k * DE + tid + 256]), b0 = rb(wu[(size_t)k * DE + tid]), b1 = rb(wu[(size_t)k * DE + tid + 256]);
#pragma unroll
        for (int r = 0; r < 16; ++r) { const float x = xs[k][r]; g0[r] = fmaf(x, a0, g0[r]); g1[r] = fmaf(x, a1, g1[r]); u0[r] = fmaf(x, b0, u0[r]); u1[r] = fmaf(x, b1, u1[r]); }
    }
#pragma unroll
    for (int r = 0; r < 16; ++r) { const int a = asg_s[r]; if (a >= 0) {
        HID[(size_t)a * DE + tid] = g0[r] * sigmoidf_(g0[r]) * u0[r]; HID[(size_t)a * DE + tid + 256] = g1[r] * sigmoidf_(g1[r]) * u1[r]; } }
}
__global__ __launch_bounds__(256) void moe_down(const float* __restrict__ HID, const float* __restrict__ Wd, const int* __restrict__ CNT, const int* __restrict__ LIST, float* __restrict__ YE) {
    __shared__ float hs[DE][16];
    __shared__ int asg_s[16];
    const int e = blockIdx.y, start = blockIdx.x * 16, cnt = CNT[e];
    if (start >= cnt) return;
    const int n = min(16, cnt - start), tid = threadIdx.x;
    if (tid < 16) asg_s[tid] = tid < n ? LIST[e * NT + start + tid] : -1;
    __syncthreads();
    for (int i = tid; i < 16 * DE; i += 256) { const int r = i >> 9, k = i & 511; const int a = asg_s[r]; hs[k][r] = a >= 0 ? rb(HID[(size_t)a * DE + k]) : 0.f; }
    __syncthreads();
    float y0[16], y1[16], y2[16], y3[16];
#pragma unroll
    for (int r = 0; r < 16; ++r) { y0[r] = 0.f; y1[r] = 0.f; y2[r] = 0.f; y3[r] = 0.f; }
    const float* wd = Wd + (size_t)e * DE * D;
    for (int k = 0; k < DE; ++k) {
        const float a0 = rb(wd[(size_t)k * D + tid]), a1 = rb(wd[(size_t)k * D + tid + 256]), a2 = rb(wd[(size_t)k * D + tid + 512]), a3 = rb(wd[(size_t)k * D + tid + 768]);
#pragma unroll
        for (int r = 0; r < 16; ++r) { const float x = hs[k][r]; y0[r] = fmaf(x, a0, y0[r]); y1[r] = fmaf(x, a1, y1[r]); y2[r] = fmaf(x, a2, y2[r]); y3[r] = fmaf(x, a3, y3[r]); }
    }
#pragma unroll
    for (int r = 0; r < 16; ++r) { const int a = asg_s[r]; if (a >= 0) { float* y = YE + (size_t)a * D; y[tid] = rb(y0[r]); y[tid + 256] = rb(y1[r]); y[tid + 512] = rb(y2[r]); y[tid + 768] = rb(y3[r]); } }
}

}

namespace rws {
constexpr size_t Z = 0;
constexpr size_t AB = Z + (size_t)NT * INW;
constexpr size_t Q = AB + (size_t)NT * 1024;
constexpr size_t KV = Q + (size_t)NT * QL;
constexpr size_t KPE = KV + (size_t)NT * 1024;
constexpr size_t MIX = KPE + (size_t)NT * 64;
constexpr size_t GATE = MIX + (size_t)NT * 1024;
constexpr size_t CNT = GATE + (size_t)NT * 2;
constexpr size_t LIST = CNT + 64;
constexpr size_t END = LIST + (size_t)NE * NT;
}


#endif
#ifndef MODE
#define MODE 1
#endif
#define LAS __attribute__((address_space(3)))
#ifndef PH
#define PH(k) 1
#endif
#ifndef DUP
#define DUP(k) 0
#endif
#define TID() ({ int _t = (int)threadIdx.x; asm volatile("" : "+v"(_t)); _t; })
#define BID() ({ int _b = (int)blockIdx.x; asm volatile("" : "+s"(_b)); _b; })
#define GDIM() ({ int _g = (int)gridDim.x; asm volatile("" : "+s"(_g)); _g; })
#define GAS __attribute__((address_space(1)))
typedef unsigned short bf16_t;
typedef short bf16x8 __attribute__((ext_vector_type(8)));
typedef float f32x4 __attribute__((ext_vector_type(4)));
typedef float f32x2 __attribute__((ext_vector_type(2)));
typedef unsigned u32x4 __attribute__((ext_vector_type(4)));
typedef unsigned u32x2 __attribute__((ext_vector_type(2)));

__device__ __forceinline__ unsigned f2bf(float f) { unsigned u = __builtin_bit_cast(unsigned, f); return (u + 0x7fffu + ((u >> 16) & 1u)) >> 16; }
__device__ __forceinline__ unsigned pk2(float lo, float hi) { return f2bf(lo) | (f2bf(hi) << 16); }
__device__ __forceinline__ float bf2f(unsigned short h) { return __builtin_bit_cast(float, (unsigned)h << 16); }
__device__ __forceinline__ float bflo(unsigned w) { return __builtin_bit_cast(float, w << 16); }
__device__ __forceinline__ float bfhi(unsigned w) { return __builtin_bit_cast(float, w & 0xffff0000u); }

namespace pg8 {
constexpr int BM = 256, BK = 64, HALF = 128, HTB = HALF * BK * 2, STAGE_BYTES = 8 * HTB;
__host__ __device__ __forceinline__ int lds_byte(int r, int c) { const int st = (r >> 4) * 2 + (c >> 5), rr = r & 15, cc = c & 31, ob = rr * 64 + cc * 2; return st * 1024 + (ob ^ (((ob >> 9) & 1) << 5)); }
__host__ __device__ __forceinline__ void stage_rc(int b, int& R, int& C) { const int st = b / 1024, sb = b % 1024, swz = sb ^ (((sb >> 9) & 1) << 5); R = (st >> 1) * 16 + swz / 64; C = (st & 1) * 32 + (swz % 64) / 2; }
__host__ __device__ __forceinline__ int perm32(int rho) { const int n = rho >> 4, i = rho & 15; return 8 * (i >> 2) + 4 * n + (i & 3); }

struct UnitD { const char* A; const int* rows; const char* B; unsigned lda, ldb; int nt; int type, pm, pn, aux; };

__device__ __forceinline__ unsigned cvt_pk_bf16(float lo, float hi) { unsigned r; asm volatile("v_cvt_pk_bf16_f32 %0, %1, %2" : "=v"(r) : "v"(lo), "v"(hi)); return r; }

template <bool PERM, class Sched, class Epi>
__device__ __forceinline__ void gemm_phase(LAS unsigned char* lds, const Sched& S, const Epi& E) {
    const int tid = TID(), wid = __builtin_amdgcn_readfirstlane(tid >> 6), wr = wid >> 2;
    const size_t kstep = (size_t)(BK * 2);
    const unsigned ldsw = (unsigned)wid * 1024u;
    int aoff, boff; { const int lane = tid & 63, wc = wid & 3, fr = lane & 15, fq = lane >> 4; aoff = lds_byte(wr * 64 + fr, fq * 8); boff = lds_byte(wc * 32 + fr, fq * 8); }
#define PG8_SA(b, h) (((b) * 2 + (h)) * HTB)
#define PG8_SB(b, h) ((4 + (b) * 2 + (h)) * HTB)
#define PG8_STAGE(bufoff, gbase, voff) do { _Pragma("unroll") for (int _i = 0; _i < 2; ++_i) \
        __builtin_amdgcn_global_load_lds((const unsigned*)((const char*)(gbase) + (voff)[_i]), (LAS unsigned*)(lds + (bufoff) + ldsw + _i * 8192), 16, 0, 0); } while (0)
#define PG8_LDA(dst, b, h) do { _Pragma("unroll") for (int m = 0; m < 4; ++m) _Pragma("unroll") for (int k = 0; k < 2; ++k) dst[m][k] = *(const LAS bf16x8*)(lds + PG8_SA(b, h) + aoff + m * 2048 + k * 1024); } while (0)
#define PG8_LDB(dst, b, h) do { _Pragma("unroll") for (int n = 0; n < 2; ++n) _Pragma("unroll") for (int k = 0; k < 2; ++k) dst[n][k] = *(const LAS bf16x8*)(lds + PG8_SB(b, h) + boff + n * 2048 + k * 1024); } while (0)
#define PG8_MMA(ai, bj, At, Bt) do { __builtin_amdgcn_s_setprio(1); _Pragma("unroll") for (int m = 0; m < 4; ++m) _Pragma("unroll") for (int n = 0; n < 2; ++n) _Pragma("unroll") for (int k = 0; k < 2; ++k) \
        acc[ai][bj][m][n] = __builtin_amdgcn_mfma_f32_16x16x32_bf16(Bt[n][k], At[m][k], acc[ai][bj][m][n], 0, 0, 0); __builtin_amdgcn_s_setprio(0); } while (0)
#define PG8_WAIT_V(n) asm volatile("s_waitcnt vmcnt(" #n ")" ::: "memory")
#define PG8_WAIT_L(n) asm volatile("s_waitcnt lgkmcnt(" #n ")" ::: "memory")
#define PG8_BAR __builtin_amdgcn_s_barrier()
#define PG8_SCHED __builtin_amdgcn_sched_barrier(0)
#define PG8_OFFS(u) do { int t_ = tid; asm volatile("" : "+v"(t_)); int R0, C0, R1, C1; stage_rc(t_ * 16, R0, C0); stage_rc(t_ * 16 + 8192, R1, C1); \
        const int RB0 = PERM ? ((R0 & ~31) + perm32(R0 & 31)) : R0, RB1 = PERM ? ((R1 & ~31) + perm32(R1 & 31)) : R1; const unsigned Cb = (unsigned)C0 * 2u; \
        if ((u).rows) { vA[0][0] = (unsigned)(u).rows[R0] * (u).lda + Cb; vA[0][1] = (unsigned)(u).rows[R1] * (u).lda + Cb; \
                                        vA[1][0] = (unsigned)(u).rows[128 + R0] * (u).lda + Cb; vA[1][1] = (unsigned)(u).rows[128 + R1] * (u).lda + Cb; } \
        else { vA[0][0] = (unsigned)R0 * (u).lda + Cb; vA[0][1] = (unsigned)R1 * (u).lda + Cb; vA[1][0] = (unsigned)(128 + R0) * (u).lda + Cb; vA[1][1] = (unsigned)(128 + R1) * (u).lda + Cb; } \
        vB[0] = (unsigned)RB0 * (u).ldb + Cb; vB[1] = (unsigned)RB1 * (u).ldb + Cb; hB = (size_t)128 * (u).ldb; } while (0)
#define PG8_EPI(u) do { int t_ = tid; asm volatile("" : "+v"(t_)); const int lane_ = t_ & 63; E(acc, (u), wr, wid & 3, lane_ & 15, lane_ >> 4); if (DUP(16)) E(acc, (u), wr, wid & 3, lane_ & 15, lane_ >> 4); if constexpr (Sched::HOOKS) S.done((u), lane_); } while (0)
    UnitD cur, nxt; int ui = 0;
    if (!S.next(0, cur)) return;
    f32x4 acc[2][2][4][2];
#pragma unroll
    for (int a = 0; a < 2; ++a)
#pragma unroll
        for (int b = 0; b < 2; ++b)
#pragma unroll
            for (int m = 0; m < 4; ++m)
#pragma unroll
                for (int n = 0; n < 2; ++n) acc[a][b][m][n] = (f32x4){0.f, 0.f, 0.f, 0.f};
    bf16x8 At[4][2], B0[2][2], B1[2][2];
    unsigned vA[2][2], vB[2]; size_t hB;
    if constexpr (Sched::HOOKS) S.a_ready(cur, wid);
    PG8_OFFS(cur);
    const char* cA = cur.A; const char* cB = cur.B; int nt = cur.nt;
    PG8_STAGE(PG8_SB(0, 0), cB, vB); PG8_STAGE(PG8_SB(0, 1), cB + hB, vB); PG8_STAGE(PG8_SA(0, 0), cA, vA[0]); PG8_STAGE(PG8_SA(0, 1), cA, vA[1]);
    if (wr == 1) PG8_BAR;
    PG8_WAIT_V(2); PG8_BAR;
    PG8_STAGE(PG8_SB(1, 0), cB + kstep, vB); PG8_STAGE(PG8_SA(1, 0), cA + kstep, vA[0]); PG8_STAGE(PG8_SB(1, 1), cB + hB + kstep, vB);
    PG8_WAIT_V(6); PG8_BAR;
    for (;;) {
        const bool has_next = S.next(ui + 1, nxt);
        for (int t = 0; t < nt; t += 2) {
            const bool last = (t == nt - 2);
            if constexpr (Sched::HOOKS) { if (last && has_next) S.a_ready(nxt, wid); }
            const char* a1 = cA + (size_t)(t + 1) * kstep;
            PG8_LDB(B0, 0, 0); PG8_LDB(B1, 0, 1); PG8_SCHED; PG8_LDA(At, 0, 0); PG8_STAGE(PG8_SA(1, 1), a1, vA[1]);
            PG8_WAIT_V(8); PG8_WAIT_L(0); PG8_BAR; PG8_MMA(0, 0, At, B0); PG8_MMA(0, 1, At, B1); PG8_BAR; PG8_SCHED;
            const char* a2; const char* b2;
            if (last) { if (has_next) { PG8_OFFS(nxt); a2 = nxt.A; b2 = nxt.B; } else { a2 = cA; b2 = cB; } }
            else { a2 = cA + (size_t)(t + 2) * kstep; b2 = cB + (size_t)(t + 2) * kstep; }
            const char* a3 = a2 + kstep; const char* b3 = b2 + kstep;
            PG8_LDA(At, 0, 1); PG8_STAGE(PG8_SB(0, 0), b2, vB); PG8_STAGE(PG8_SB(0, 1), b2 + hB, vB); PG8_STAGE(PG8_SA(0, 0), a2, vA[0]);
            PG8_WAIT_V(8); PG8_WAIT_L(0); PG8_BAR; PG8_MMA(1, 0, At, B0); PG8_MMA(1, 1, At, B1); PG8_BAR; PG8_SCHED;
            PG8_LDB(B0, 1, 0); PG8_LDB(B1, 1, 1); PG8_SCHED; PG8_LDA(At, 1, 0); PG8_STAGE(PG8_SA(0, 1), a2, vA[1]);
            PG8_WAIT_V(8); PG8_WAIT_L(0); PG8_BAR; PG8_MMA(0, 0, At, B0); PG8_MMA(0, 1, At, B1); PG8_BAR; PG8_SCHED;
            PG8_LDA(At, 1, 1); PG8_STAGE(PG8_SB(1, 0), b3, vB); PG8_STAGE(PG8_SB(1, 1), b3 + hB, vB); PG8_STAGE(PG8_SA(1, 0), a3, vA[0]);
            PG8_WAIT_V(8); PG8_WAIT_L(0); PG8_BAR; PG8_MMA(1, 0, At, B0); PG8_MMA(1, 1, At, B1); PG8_BAR; PG8_SCHED;
        }
        if (wr == 0) PG8_BAR;
        PG8_EPI(cur);
        if (!has_next) break;
#pragma unroll
        for (int a = 0; a < 2; ++a)
#pragma unroll
            for (int b = 0; b < 2; ++b)
#pragma unroll
                for (int m = 0; m < 4; ++m)
#pragma unroll
                    for (int n = 0; n < 2; ++n) acc[a][b][m][n] = (f32x4){0.f, 0.f, 0.f, 0.f};
        cur = nxt; cA = nxt.A; cB = nxt.B; nt = nxt.nt; ++ui;
        if (wr == 1) PG8_BAR;
    }
    PG8_WAIT_V(0);
    PG8_BAR;
#undef PG8_SA
#undef PG8_SB
#undef PG8_STAGE
#undef PG8_LDA
#undef PG8_LDB
#undef PG8_MMA
#undef PG8_WAIT_V
#undef PG8_WAIT_L
#undef PG8_BAR
#undef PG8_SCHED
#undef PG8_OFFS
#undef PG8_EPI
}
__device__ __forceinline__ void tile_order(int L, int nM, int nN, int& pm, int& pn) {
    const int nwg = nM * nN; int wgid = L;
    { const int q = nwg / 8, r = nwg % 8, xcd = wgid % 8, off = wgid / 8; wgid = (xcd < r ? xcd * (q + 1) : r * (q + 1) + (xcd - r) * q) + off; }
    const int nig = 8 * nN, gid = wgid / nig, fm = gid * 8, gsz = (nM - fm) < 8 ? (nM - fm) : 8;
    pm = fm + ((wgid % nig) % gsz); pn = (wgid % nig) / gsz;
}
}

#define XB_TMO      128
#define XB_XCNT(j)  (256  + 64 * (j))
#define XB_XSUB(j)  (1280 + 64 * (j))
#define XB_XGEN(j)  (2304 + 64 * (j))
#define XB_TOP      3328
#define XB_TOPGEN   3392
#define XCD_BAR_WORDS 3456
#define XB_SPIN_CAP (1u << 18)
__device__ __forceinline__ unsigned xb_ld(unsigned* p)              { return __hip_atomic_load(p, __ATOMIC_RELAXED, __HIP_MEMORY_SCOPE_AGENT); }
__device__ __forceinline__ unsigned xb_add(unsigned* p, unsigned v) { return __hip_atomic_fetch_add(p, v, __ATOMIC_RELAXED, __HIP_MEMORY_SCOPE_AGENT); }
__device__ __forceinline__ unsigned xb_xcc_id() { return (unsigned)__builtin_amdgcn_s_getreg((3 << 11) | 20) & 0xFu; }
#define XB_SPIN(cond, bar) do { unsigned _sp = 0; while (cond) { __builtin_amdgcn_s_sleep(1); \
    if ((++_sp & 255u) == 0u) { if (xb_ld(&(bar)[XB_TMO])) break; if (_sp > XB_SPIN_CAP) { atomicAdd(&(bar)[XB_TMO], 1u); break; } } } } while (0)
struct XcdBarrier { unsigned* bar; unsigned x; volatile LAS unsigned* st; };
__device__ __forceinline__ XcdBarrier xcd_barrier_post(unsigned* bar, volatile LAS unsigned* st) {
    XcdBarrier b; b.bar = bar; b.x = xb_xcc_id(); b.st = st;
    if (threadIdx.x == 0) (void)xb_add(&bar[XB_XCNT(b.x)], 1u);
    return b;
}
__device__ __forceinline__ void xcd_barrier_complete(unsigned* bar, unsigned x, unsigned& nloc, unsigned& nx) {
    const unsigned G = gridDim.x * gridDim.y * gridDim.z;
    unsigned sum, cnt, mine, sp = 0u;
    for (;;) {
        sum = 0u; cnt = 0u;
#pragma unroll
        for (unsigned j = 0; j < 16; ++j) { const unsigned c = xb_ld(&bar[XB_XCNT(j)]); sum += c; cnt += (c > 0u) ? 1u : 0u; }
        if (sum == G) break;
        __builtin_amdgcn_s_sleep(1);
        if ((++sp & 255u) == 0u) { if (xb_ld(&bar[XB_TMO])) break; if (sp > XB_SPIN_CAP) { atomicAdd(&bar[XB_TMO], 1u); break; } }
    }
    mine = xb_ld(&bar[XB_XCNT(x)]);
    nloc = mine > 0u ? mine : 1u; nx = cnt > 0u ? cnt : 1u;
}
__device__ __forceinline__ void xcd_barrier(const XcdBarrier& b) {
    asm volatile("s_waitcnt vmcnt(0)" ::: "memory");
    __syncthreads();
    if (threadIdx.x == 0) {
        unsigned* bar = b.bar; unsigned bx_ = b.x;
        asm volatile("" : "+s"(bar), "+s"(bx_));
        __builtin_amdgcn_s_waitcnt(0);
        unsigned nloc = b.st[0], nx = b.st[1];
        if (nloc == 0u) { xcd_barrier_complete(bar, bx_, nloc, nx); b.st[0] = nloc; b.st[1] = nx; }
        const unsigned old = xb_add(&bar[XB_XSUB(bx_)], 1u);
        const unsigned gen = old / nloc;
        if (old + 1u == (gen + 1u) * nloc) {
            __builtin_amdgcn_fence(__ATOMIC_RELEASE, "agent");
            asm volatile("s_waitcnt vmcnt(0)" ::: "memory");
            const unsigned og = xb_add(&bar[XB_TOP], 1u);
            const unsigned tg = og / nx;
            if (og + 1u == (tg + 1u) * nx) xb_add(&bar[XB_TOPGEN], 1u);
            else XB_SPIN(xb_ld(&bar[XB_TOPGEN]) == tg, bar);
            __builtin_amdgcn_fence(__ATOMIC_ACQUIRE, "agent");
            xb_add(&bar[XB_XGEN(bx_)], 1u);
            asm volatile("s_waitcnt vmcnt(0)" ::: "memory");
        } else {
            XB_SPIN(xb_ld(&bar[XB_XGEN(bx_)]) == gen, bar);
            __builtin_amdgcn_fence(__ATOMIC_ACQUIRE, "agent");
            asm volatile("s_waitcnt vmcnt(0)" ::: "memory");
        }
    }
    __syncthreads();
}

constexpr int MOECNT_W = 16384;
constexpr int ZW = 2304;
constexpr int NWAVES = 8, NTHREADS = 512;
constexpr int RING_BYTES = 131072, LDS_BYTES = 163840, LDSCTL_OFF = LDS_BYTES - 4096, MISC_OFF = LDSCTL_OFF + 320, TAB_OFF = LDSCTL_OFF + 1024;
struct OW {
    const float* in[24];
    float* X;
    unsigned* ctl;
    bf16_t* XB;
    bf16_t* Z;
    float* SSQ;
    bf16_t *Win_t, *Wq_t, *Wkv_t, *Wo_t, *Wgu_t, *Wd_t, *Wlg_t;
    bf16_t* RWH; float* RGB;
    f32x2* ROPE;
    bf16_t *Q, *KN, *VV, *KPE;
    float *A, *DRV, *AGA, *AGB;
    bf16_t* OP; f32x2* ML;
    bf16_t* MIX; bf16_t* Y;
    int *EIDX, *HIST, *LRANK, *DEST, *ROWTOK; float* GATE;
    bf16_t *HE, *YE;
};

namespace ows {
constexpr size_t MiB = 1u << 20;
constexpr size_t CTL = 0, ROPE = 1 * MiB, SSQ = 2 * MiB, EIDX = 3 * MiB, GATE = EIDX + 131072, LRANK = GATE + 131072, DEST = LRANK + 131072, HIST = DEST + 131072, ROWTOK = HIST + 16384;
constexpr size_t AGA = 4 * MiB, AGB = AGA + 524288, ML = 5 * MiB, WLG = 6 * MiB, WIN = 7 * MiB, WQ = 12 * MiB, WKV = 14 * MiB, WO = 15 * MiB, WGU = 17 * MiB, WD = 49 * MiB;
constexpr size_t XB = 65 * MiB, Z = 97 * MiB, Y = Z, A = 169 * MiB, DRV = 201 * MiB, Q = 233 * MiB, YE = A, KN = 257 * MiB, VV = 273 * MiB, KPE = 289 * MiB, OP = 291 * MiB, HE = KN, MIX = 323 * MiB, WSET1 = 355 * MiB - WLG  , END = 414 * MiB;
static_assert(ROWTOK + 36864 * 4 <= AGA && WIN + (size_t)ZW * D * 2 <= WQ && YE + (size_t)36864 * 1024 * 2 <= KN && HE + (size_t)36864 * 512 * 2 <= OP + 32 * MiB && Z + (size_t)NT * ZW * 2 <= A, "opt workspace map");
}
__device__ __forceinline__ void tr_item(const float* W, int ldw, int k0, int n0, bf16_t* WT, int ldt, int drow0, const float* g, LAS float* scr, int lane) {
    float tv[32];
#pragma unroll
    for (int i = 0; i < 32; ++i) { const int kk = 2 * i + (lane >> 5); tv[i] = W[(size_t)(k0 + kk) * ldw + n0 + (lane & 31)]; }
    if (g) {
#pragma unroll
        for (int i = 0; i < 32; ++i) tv[i] *= g[k0 + 2 * i + (lane >> 5)]; }
#pragma unroll
    for (int i = 0; i < 32; ++i) scr[(2 * i + (lane >> 5)) * 33 + (lane & 31)] = tv[i];
    asm volatile("s_waitcnt lgkmcnt(0)" ::: "memory");
    const int c = lane & 7;
#pragma unroll
    for (int j = 0; j < 4; ++j) { const int n = (lane >> 3) + 8 * j; const LAS float* s = scr + (8 * c) * 33 + n;
        u32x4 o; o.x = pk2(s[0 * 33], s[1 * 33]); o.y = pk2(s[2 * 33], s[3 * 33]); o.z = pk2(s[4 * 33], s[5 * 33]); o.w = pk2(s[6 * 33], s[7 * 33]);
        *(u32x4*)(WT + (size_t)(drow0 + n) * ldt + k0 + 8 * c) = o; }
    asm volatile("s_waitcnt lgkmcnt(0)" ::: "memory");
}
struct PrepItem { const float* W; const float* g; bf16_t* WT; int ldw, ldt, k0, n0, drow0, ncols; };
__device__ __forceinline__ PrepItem prep_item(const OW& P, int l, int it) {
    const float* w_in = P.in[1] + (size_t)l * D * INW;
    const float* qng = P.in[9] + (size_t)l * QL;   const float* w_q = P.in[10] + (size_t)l * QL * 768;
    const float* kvng = P.in[11] + (size_t)l * KVL; const float* w_kv = P.in[12] + (size_t)l * KVL * 1024;
    const float* ong = P.in[13] + (size_t)l * 1024; const float* w_o = P.in[14] + (size_t)l * 1024 * D;
    const float* wg = P.in[19] + (size_t)l * NE * D * DE; const float* wu = P.in[20] + (size_t)l * NE * D * DE; const float* wd = P.in[21] + (size_t)l * NE * DE * D;
    constexpr int I_IN = 8 * 17, I_Q = 6 * 6, I_KV = 2 * 8, I_O = 8 * 8, I_G = 16 * 8 * 4, I_D = 16 * 4 * 8;
    PrepItem p; int r = it;
    if (r < I_IN) { const int kb = r / 17, nb = r % 17; p = PrepItem{w_in, nullptr, P.Win_t, INW, D, 128 * kb, 128 * nb, 128 * nb, nb == 16 ? 64 : 128}; return p; } r -= I_IN;
    if (r < I_Q) { const int kb = r / 6, nb = r % 6; p = PrepItem{w_q, qng, P.Wq_t, 768, QL, 128 * kb, 128 * nb, 128 * nb, 128}; return p; } r -= I_Q;
    if (r < I_KV) { const int kb = r / 8, nb = r % 8; p = PrepItem{w_kv, kvng, P.Wkv_t, 1024, KVL, 128 * kb, 128 * nb, 128 * nb, 128}; return p; } r -= I_KV;
    if (r < I_O) { const int kb = r / 8, nb = r % 8; p = PrepItem{w_o, ong, P.Wo_t, D, 1024, 128 * kb, 128 * nb, 128 * nb, 128}; return p; } r -= I_O;
    if (r < 2 * I_G) { const int up = r >= I_G; if (up) r -= I_G; const int e = r >> 5, q = r & 31, kb = q >> 2, nb = q & 3;
        p = PrepItem{(up ? wu : wg) + (size_t)e * D * DE, nullptr, P.Wgu_t + (size_t)e * 1024 * 1024, DE, 1024, 128 * kb, 128 * nb, 256 * nb + 128 * up, 128}; return p; }
    r -= 2 * I_G;
    { const int e = r >> 5, q = r & 31, kb = q >> 3, nb = q & 7; p = PrepItem{wd + (size_t)e * DE * D, nullptr, P.Wd_t + (size_t)e * 1024 * DE, D, DE, 128 * kb, 128 * nb, 128 * nb, 128}; }
    return p;
}
__device__ __forceinline__ void prep_weights(const OW& P, int l, LAS unsigned char* lds, int vcu, int G, int it0 = 0, int it1 = 1 << 30, int tail = 3) {
    const int tid = TID();
    LAS float* scr = (LAS float*)lds;
    constexpr int NITEMS = 8 * 17 + 6 * 6 + 2 * 8 + 8 * 8 + 2 * 16 * 8 * 4 + 16 * 4 * 8;
    const int lr = tid >> 5, lc = (tid & 31) * 4;
    const int tn = tid & 127, tq = tid >> 7;
    f32x4 v[8];
#define PW_LOAD(p_) do { _Pragma("unroll") for (int i = 0; i < 8; ++i) { const int kk = lr + 16 * i; v[i] = (f32x4){0.f, 0.f, 0.f, 0.f}; \
        if (lc < (p_).ncols) { v[i] = *(const f32x4*)((p_).W + (size_t)((p_).k0 + kk) * (p_).ldw + (p_).n0 + lc); if ((p_).g) v[i] = v[i] * (p_).g[(p_).k0 + kk]; } } } while (0)
    const int ITE = it1 < NITEMS ? it1 : NITEMS;
    int it = it0 + vcu;
    PrepItem cur; if (it < ITE) { cur = prep_item(P, l, it); PW_LOAD(cur); }
    for (; it < ITE; it += G) {
#pragma unroll
        for (int i = 0; i < 8; ++i) { const int kk = lr + 16 * i; scr[kk * 129 + lc] = v[i][0]; scr[kk * 129 + lc + 1] = v[i][1]; scr[kk * 129 + lc + 2] = v[i][2]; scr[kk * 129 + lc + 3] = v[i][3]; }
        const PrepItem me = cur;
        if (it + G < ITE) { cur = prep_item(P, l, it + G); PW_LOAD(cur); }
        __syncthreads();
        { bf16_t* dst = me.WT + (size_t)(me.drow0 + tn) * me.ldt + me.k0 + 32 * tq; const LAS float* sc = scr + (32 * tq) * 129 + tn;
#pragma unroll
          for (int c = 0; c < 4; ++c) { u32x4 o; o.x = pk2(sc[(8 * c + 0) * 129], sc[(8 * c + 1) * 129]); o.y = pk2(sc[(8 * c + 2) * 129], sc[(8 * c + 3) * 129]);
              o.z = pk2(sc[(8 * c + 4) * 129], sc[(8 * c + 5) * 129]); o.w = pk2(sc[(8 * c + 6) * 129], sc[(8 * c + 7) * 129]); *(u32x4*)(dst + 8 * c) = o; } }
        __syncthreads();
    }
#undef PW_LOAD
    if (tail & 1) { const int gt = vcu * NTHREADS + tid, NGT = G * NTHREADS; unsigned zz = 0u; asm volatile("" : "+v"(zz)); const u32x4 z = {zz, zz, zz, zz};
      for (int i = gt; i < 128 * 128; i += NGT) *(u32x4*)(P.Win_t + (size_t)2176 * D + (size_t)i * 8) = z; }
    if (tail & 2) { const int gt = vcu * NTHREADS + tid, NGT = G * NTHREADS;
      const float* w_r = P.in[4] + (size_t)l * 8 * 64 * 64; const float* w_i = P.in[6] + (size_t)l * 8 * 64 * 64;
      for (int i = gt; i < 8 * 128 * 64; i += NGT) { const int k = i & 63, j = (i >> 6) & 127, n = i >> 13; const int w = j >> 4, q = j & 15; const int d = 8 * w + (q & 7);
          const float v_ = (q < 8 ? w_r : w_i)[((size_t)n * 64 + k) * 64 + d]; P.Wlg_t[i] = (bf16_t)f2bf(v_); }
      const float* rw = P.in[17]; const float* g1 = P.in[15] + (size_t)l * D; const float* b1 = P.in[16] + (size_t)l * D;
      for (int i = gt; i < 16 * 1024; i += NGT) { const int k = i & 1023, e = i >> 10; const float v_ = g1[k] * rw[k * 16 + e]; const unsigned hi_ = f2bf(v_); const float rem = v_ - bf2f((unsigned short)hi_);
          P.RWH[e * 1024 + k] = (bf16_t)hi_; P.RWH[(16 + e) * 1024 + k] = (bf16_t)f2bf(rem); }
      { const int gwv = gt >> 6, ln = gt & 63;
        if (gwv < 32) { const int e = gwv & 15; const float* src = gwv < 16 ? g1 : b1; float acc = 0.f;
#pragma unroll
            for (int j = 0; j < 16; ++j) { const int k = ln + 64 * j; acc = fmaf(src[k], rw[k * 16 + e], acc); }
#pragma unroll
            for (int o = 1; o < 64; o <<= 1) acc += __shfl_xor(acc, o);
            if (ln == 0) P.RGB[gwv] = acc; } } }
}
__device__ __forceinline__ void prep_tables(const OW& P, int vcu, int G) {
    const int gt = vcu * NTHREADS + TID(), NGT = G * NTHREADS;
    for (int i = gt; i < S * 32; i += NGT) { const int s = i >> 5, j = i & 31; const float inv = powf(10000.0f, -(float)j / 32.0f); const float ang = (float)s * inv; P.ROPE[i] = (f32x2){cosf(ang), sinf(ang)}; }
    const float* x = P.in[0];
    for (size_t i = gt; i < (size_t)NT * D / 8; i += NGT) { const f32x4 a = *(const f32x4*)(x + i * 8), b = *(const f32x4*)(x + i * 8 + 4);
        u32x4 o; o.x = pk2(a[0], a[1]); o.y = pk2(a[2], a[3]); o.z = pk2(b[0], b[1]); o.w = pk2(b[2], b[3]); *(u32x4*)(P.XB + i * 8) = o; }
}

struct SchedInProj {
    static constexpr bool HOOKS = false;
    const OW* P; int G, c;
    __device__ __forceinline__ bool next(int i, pg8::UnitD& u) const {
        const int L = i * G + c; if (L >= 64 * 9) return false;
        int pm, pn; pg8::tile_order(L, 64, 9, pm, pn);
        u.A = (const char*)(P->XB + (size_t)pm * 256 * D); u.rows = nullptr; u.B = (const char*)(P->Win_t + (size_t)pn * 256 * D); u.lda = D * 2; u.ldb = D * 2; u.nt = D / 64; u.type = 0; u.pm = pm; u.pn = pn; u.aux = 0;
        return true;
    }
};
struct EpiInProj {
    bf16_t* Z; float* SSQ;
    __device__ __forceinline__ void operator()(const f32x4 (&acc)[2][2][4][2], const pg8::UnitD& u, int wr, int wc, int fr, int fq) const {
        const int row0 = u.pm * 256 + wr * 64 + fr, col0 = u.pn * 256 + wc * 32 + 8 * fq;
        const bool stats = u.pn >= 4 && u.pn < 8;
#pragma unroll
        for (int ai = 0; ai < 2; ++ai)
#pragma unroll
            for (int m = 0; m < 4; ++m) { const int row = row0 + ai * 128 + m * 16; bf16_t* rowp = Z + (size_t)row * ZW + col0; float ss = 0.f;
#pragma unroll
                for (int bj = 0; bj < 2; ++bj) { const f32x4 v0 = acc[ai][bj][m][0], v1 = acc[ai][bj][m][1];
                    ss += (v0[0] * v0[0] + v0[1] * v0[1]) + (v0[2] * v0[2] + v0[3] * v0[3]) + (v1[0] * v1[0] + v1[1] * v1[1]) + (v1[2] * v1[2] + v1[3] * v1[3]);
                    u32x4 w; w.x = pg8::cvt_pk_bf16(v0[0], v0[1]); w.y = pg8::cvt_pk_bf16(v0[2], v0[3]); w.z = pg8::cvt_pk_bf16(v1[0], v1[1]); w.w = pg8::cvt_pk_bf16(v1[2], v1[3]);
                    *(u32x4*)(rowp + bj * 128) = w; }
                if (stats) { ss += __shfl_xor(ss, 16); ss += __shfl_xor(ss, 32); if (fq == 0) SSQ[(size_t)row * 16 + (u.pn - 4) * 4 + wc] = ss; } }
    }
};
__device__ __forceinline__ void phase_inproj(const OW& P, LAS unsigned char* lds, int G) {
    SchedInProj Sd{&P, G, BID()}; EpiInProj E{P.Z, P.SSQ};
    pg8::gemm_phase<true>(lds, Sd, E);
}


struct SchedQKV {
    static constexpr bool HOOKS = false;
    const OW* P; int G, c;
    __device__ __forceinline__ bool next(int i, pg8::UnitD& u) const {
        if (G != 256) {
            const int Lq = i * G + c; if (Lq >= 448) return false;
            if (Lq < 192) { fill_q(u, Lq / 3, Lq % 3); } else { const int r = Lq - 192; fill_kv(u, r >> 2, r & 3); }
            return true;
        }
        if (c < 192) { if (i == 0) { fill_q(u, c / 3, c % 3); return true; } if (i == 1 && c % 3 == 0) { fill_kv(u, c / 3, 3); return true; } return false; }
        if (i >= 3) return false; fill_kv(u, c - 192, i); return true;
    }
    __device__ __forceinline__ void fill_q(pg8::UnitD& u, int pm, int pn) const {
        u.A = (const char*)(P->Z + (size_t)pm * 256 * ZW + 1024); u.rows = nullptr; u.B = (const char*)(P->Wq_t + (size_t)pn * 256 * QL); u.lda = ZW * 2; u.ldb = QL * 2; u.nt = QL / 64; u.type = 1; u.pm = pm; u.pn = pn; u.aux = 0; }
    __device__ __forceinline__ void fill_kv(pg8::UnitD& u, int pm, int pn) const {
        u.A = (const char*)(P->Z + (size_t)pm * 256 * ZW + 1792); u.rows = nullptr; u.B = (const char*)(P->Wkv_t + (size_t)pn * 256 * KVL); u.lda = ZW * 2; u.ldb = KVL * 2; u.nt = KVL / 64; u.type = 2; u.pm = pm; u.pn = pn; u.aux = 0; }
};
struct EpiQKV {
    const float* SSQ; bf16_t *Q, *KN, *VV;
    __device__ __forceinline__ void operator()(const f32x4 (&acc)[2][2][4][2], const pg8::UnitD& u, int wr, int wc, int fr, int fq) const {
        const int row0 = u.pm * 256 + wr * 64 + fr, cw = wc * 32 + 8 * fq;
        const bool isq = u.type == 1;
#pragma unroll
        for (int ai = 0; ai < 2; ++ai)
#pragma unroll
            for (int m = 0; m < 4; ++m) { const int row = row0 + ai * 128 + m * 16; const f32x4* sp = (const f32x4*)(SSQ + (size_t)row * 16);
                float rs;
                if (isq) { const f32x4 a = sp[0], b = sp[1], c = sp[2]; const float t = ((a[0] + a[1]) + (a[2] + a[3])) + ((b[0] + b[1]) + (b[2] + b[3])) + ((c[0] + c[1]) + (c[2] + c[3])); rs = rsqrtf(t * (1.f / QL) + EPS); }
                else { const f32x4 a = sp[3]; const float t = (a[0] + a[1]) + (a[2] + a[3]); rs = rsqrtf(t * (1.f / KVL) + EPS); }
#pragma unroll
                for (int bj = 0; bj < 2; ++bj) { const f32x4 v0 = acc[ai][bj][m][0] * rs, v1 = acc[ai][bj][m][1] * rs;
                    u32x4 w; w.x = pg8::cvt_pk_bf16(v0[0], v0[1]); w.y = pg8::cvt_pk_bf16(v0[2], v0[3]); w.z = pg8::cvt_pk_bf16(v1[0], v1[1]); w.w = pg8::cvt_pk_bf16(v1[2], v1[3]);
                    bf16_t* dst = isq ? Q + (size_t)row * QL + u.pn * 256 + bj * 128 + cw : (bj == 0 ? KN : VV) + (size_t)row * 512 + u.pn * 128 + cw;
                    *(u32x4*)dst = w; } }
    }
};
__device__ __forceinline__ float sigm(float x) { return __builtin_amdgcn_rcpf(1.f + __expf(-x)); }
__device__ __forceinline__ float neg_expm1(float x) {
    const float ser = -x * (1.f + x * (0.5f + x * (0.16666667f + x * (0.041666668f + x * 0.0083333338f))));
    return x > -0.25f ? ser : 1.f - __expf(x);
}
__device__ __forceinline__ void gates_tile(const OW& P, int l, LAS unsigned char* lds, int tile) {
    constexpr int URS = 1040, XRS = 144, SRS = 68;
    const int tid = TID(), lane = tid & 63, wid = __builtin_amdgcn_readfirstlane(tid >> 6), fr = lane & 15, fq = lane >> 4;
    LAS unsigned char* U = lds;
    LAS unsigned char* XC = lds + 67 * URS + 64;
    LAS float* SA = (LAS float*)(lds + 81920);
    LAS float* SD = SA + 64 * SRS;
    LAS f32x2* PP = (LAS f32x2*)(lds + 81920 + 2 * 64 * SRS * 4);
    LAS float* PAR = (LAS float*)(lds + 81920 + 2 * 64 * SRS * 4 + 4096);
    const int tok0 = tile * 64, s0 = tok0 & (S - 1);
    const float* conv_w = P.in[2] + (size_t)l * 4 * LW; const float* conv_b = P.in[3] + (size_t)l * LW;
    const float* b_r = P.in[5] + (size_t)l * LW; const float* b_i = P.in[7] + (size_t)l * LW; const float* lam = P.in[8] + (size_t)l * LW;
    const bf16_t* pZ = P.Z; const f32x2* pROPE = P.ROPE; bf16_t* pKPE = P.KPE; float* pA = P.A; float* pDRV = P.DRV; float* pAGA = P.AGA; float* pAGB = P.AGB; const bf16_t* pWlg = P.Wlg_t;
    { u32x4 uv[9]; unsigned short k1[4], k2[4]; f32x2 cs[4];
#pragma unroll
      for (int q = 0; q < 9; ++q) { const int i = tid + q * NTHREADS; const int r = i >> 6, ch = i & 63; uv[q] = (u32x4){0u, 0u, 0u, 0u};
          if (i < 67 * 64 && (r >= 3 || s0 != 0)) uv[q] = *(const u32x4*)(pZ + (size_t)(tok0 - 3 + r) * ZW + ch * 8); }
#pragma unroll
      for (int q = 0; q < 4; ++q) { const int i = tid + q * NTHREADS; const int t = i >> 5, j = i & 31; const size_t tok = (size_t)tok0 + t;
          k1[q] = pZ[tok * ZW + 2048 + j]; k2[q] = pZ[tok * ZW + 2080 + j]; cs[q] = pROPE[(s0 + t) * 32 + j]; }
#pragma unroll
      for (int q = 0; q < 9; ++q) { const int i = tid + q * NTHREADS; const int r = i >> 6, ch = i & 63; if (i < 67 * 64) *(LAS u32x4*)(U + r * URS + ch * 16) = uv[q]; }
#pragma unroll
      for (int q = 0; q < 4; ++q) { const int i = tid + q * NTHREADS; const int t = i >> 5, j = i & 31; const size_t tok = (size_t)tok0 + t; const float x1 = bf2f(k1[q]), x2 = bf2f(k2[q]);
          pKPE[tok * 64 + j] = (bf16_t)f2bf(x1 * cs[q].x - x2 * cs[q].y); pKPE[tok * 64 + 32 + j] = (bf16_t)f2bf(x1 * cs[q].y + x2 * cs[q].x); } }
    { const int ch = tid;
      PAR[0 * LW + ch] = conv_w[0 * LW + ch]; PAR[1 * LW + ch] = conv_w[1 * LW + ch]; PAR[2 * LW + ch] = conv_w[2 * LW + ch]; PAR[3 * LW + ch] = conv_w[3 * LW + ch];
      PAR[4 * LW + ch] = conv_b[ch]; PAR[5 * LW + ch] = b_r[ch]; PAR[6 * LW + ch] = b_i[ch]; PAR[7 * LW + ch] = -8.0f * log1pf(__expf(-lam[ch])); }
    __syncthreads();
    bf16x8 nb0, nb1; { const bf16_t* wb = pWlg + ((size_t)16 * wid + fr) * 64 + 8 * fq; nb0 = *(const bf16x8*)wb; nb1 = *(const bf16x8*)(wb + 32); }
    for (int n = 0; n < 8; ++n) {
        { const int chb = 64 * n + 8 * wid; float xc[8];
#pragma unroll
          for (int j = 0; j < 8; ++j) xc[j] = PAR[4 * LW + chb + j];
#pragma unroll
          for (int w = 0; w < 4; ++w) { const u32x4 uv = *(const LAS u32x4*)(U + (lane + w) * URS + chb * 2);
              const f32x4 c0 = *(const LAS f32x4*)(PAR + w * LW + chb), c1 = *(const LAS f32x4*)(PAR + w * LW + chb + 4);
              xc[0] = fmaf(bflo(uv.x), c0[0], xc[0]); xc[1] = fmaf(bfhi(uv.x), c0[1], xc[1]); xc[2] = fmaf(bflo(uv.y), c0[2], xc[2]); xc[3] = fmaf(bfhi(uv.y), c0[3], xc[3]);
              xc[4] = fmaf(bflo(uv.z), c1[0], xc[4]); xc[5] = fmaf(bfhi(uv.z), c1[1], xc[5]); xc[6] = fmaf(bflo(uv.w), c1[2], xc[6]); xc[7] = fmaf(bfhi(uv.w), c1[3], xc[7]); }
          u32x4 o; o.x = pk2(xc[0], xc[1]); o.y = pk2(xc[2], xc[3]); o.z = pk2(xc[4], xc[5]); o.w = pk2(xc[6], xc[7]);
          *(LAS u32x4*)(XC + lane * XRS + wid * 16) = o; }
        __syncthreads();
        f32x4 acc[4];
        { const bf16x8 b0 = nb0, b1 = nb1;
          if (n + 1 < 8) { const bf16_t* wb = pWlg + ((size_t)(n + 1) * 128 + 16 * wid + fr) * 64 + 8 * fq; nb0 = *(const bf16x8*)wb; nb1 = *(const bf16x8*)(wb + 32); }
#pragma unroll
          for (int m = 0; m < 4; ++m) { const bf16x8 a0 = *(const LAS bf16x8*)(XC + (16 * m + fr) * XRS + fq * 16), a1 = *(const LAS bf16x8*)(XC + (16 * m + fr) * XRS + 64 + fq * 16);
              f32x4 c = {0.f, 0.f, 0.f, 0.f};
              c = __builtin_amdgcn_mfma_f32_16x16x32_bf16(b0, a0, c, 0, 0, 0); c = __builtin_amdgcn_mfma_f32_16x16x32_bf16(b1, a1, c, 0, 0, 0); acc[m] = c; } }
        const bool lo = fq < 2;
        f32x4 rv[2], iv[2];
#pragma unroll
        for (int j = 0; j < 2; ++j) { const f32x4 snd = lo ? acc[2 + j] : acc[j]; f32x4 rc;
#pragma unroll
            for (int x = 0; x < 4; ++x) rc[x] = __shfl_xor(snd[x], 32);
            rv[j] = lo ? acc[j] : rc; iv[j] = lo ? rc : acc[2 + j]; }
        const int d0 = 8 * wid + 4 * (fq & 1), ch0 = 64 * n + d0;
        const f32x4 brv = *(const LAS f32x4*)(PAR + 5 * LW + ch0), biv = *(const LAS f32x4*)(PAR + 6 * LW + ch0), spv = *(const LAS f32x4*)(PAR + 7 * LW + ch0), cbv = *(const LAS f32x4*)(PAR + 4 * LW + ch0);
        f32x4 cw[4];
#pragma unroll
        for (int w = 0; w < 4; ++w) cw[w] = *(const LAS f32x4*)(PAR + w * LW + ch0);
#pragma unroll
        for (int j = 0; j < 2; ++j) { const int t = 16 * ((lo ? 0 : 2) + j) + fr; f32x4 av, dv;
#pragma unroll
            for (int x = 0; x < 4; ++x) {
                float xcv = cbv[x];
#pragma unroll
                for (int w = 0; w < 4; ++w) xcv = fmaf(bf2f(*(const LAS unsigned short*)(U + (t + w) * URS + (ch0 + x) * 2)), cw[w][x], xcv);
                const float r = sigm(rv[j][x] + brv[x]), ig = sigm(iv[j][x] + biv[x]);
                const float log_a = r * spv[x];
                av[x] = __expf(log_a); dv[x] = __builtin_amdgcn_sqrtf(neg_expm1(2.0f * log_a)) * (ig * xcv); }
            *(LAS f32x4*)(SA + t * SRS + d0) = av; *(LAS f32x4*)(SD + t * SRS + d0) = dv; }
        __syncthreads();
        { float Ap = 1.f, Bp = 0.f;
#pragma unroll
          for (int j = 0; j < 8; ++j) { const int t = 8 * wid + j; const float a = SA[t * SRS + lane], dv = SD[t * SRS + lane];
              ((unsigned*)pA)[((size_t)tok0 + t) * LW + 64 * n + lane] = pk2(1.f - a, dv);
              Ap *= a; Bp = fmaf(a, Bp, dv); }
          PP[wid * 64 + lane] = (f32x2){Ap, Bp}; }
        __syncthreads();
        if (wid == 0) { float Aa = 1.f, Bb = 0.f;
#pragma unroll
            for (int g = 0; g < 8; ++g) { const f32x2 p = PP[g * 64 + lane]; Aa *= p.x; Bb = fmaf(p.x, Bb, p.y); }
            pAGA[(size_t)tile * LW + 64 * n + lane] = Aa; pAGB[(size_t)tile * LW + 64 * n + lane] = Bb; }
    }
    __syncthreads();
}
__device__ __forceinline__ void phase_qkv(const OW& P, int l, LAS unsigned char* lds, int G) {
#ifndef P2SEL
#define P2SEL 3
#endif
    if (P2SEL & 1) { SchedQKV Sd{&P, G, BID()}; EpiQKV E{P.SSQ, P.Q, P.KN, P.VV};
    pg8::gemm_phase<true>(lds, Sd, E); }
    if (P2SEL & 2) for (int tile = BID(); tile < NT / 64; tile += G) gates_tile(P, l, lds, tile);
}


namespace att {
typedef short s16x4 __attribute__((ext_vector_type(4)));
typedef float f32x16 __attribute__((ext_vector_type(16)));
constexpr int KVBLK = 64, SHM_V = 16384, SHM_K = 24576, OFF_K = 3 * SHM_V, OFF_WS = OFF_K + 3 * SHM_K, OFF_QR = OFF_WS + 8 * 64 * 4, LDS_NEED = OFF_QR + 8 * 4096;
static_assert(LDS_NEED <= LDSCTL_OFF, "attention LDS");
constexpr float SCALE = 0.07216878364870322f, THR = 8.f;
#define SBAR() __builtin_amdgcn_sched_barrier(0)
__device__ __forceinline__ int v_st(int k, int c) { const int kk = (k & ~0xC) | ((k & 4) << 1) | ((k & 8) >> 1); return ((kk >> 3) * 4 + (c >> 5)) * 512 + ((kk & 7) * 32 + (c & 31)) * 2; }
__device__ __forceinline__ int v_rd_base(int lane) { return ((lane & 3) << 3) | (((lane >> 2) & 3) << 6) | (((lane >> 4) & 1) << 5) | (((lane >> 5) & 1) << 8); }
constexpr int v_rd_off(int d0, int ks, int half) { return d0 * 512 + ks * 4096 + half * 2048; }
__device__ __forceinline__ int k_off(int row, int cc) { return (cc >> 3) * 8192 + row * 128 + (((cc & 7) ^ ((row >> 1) & 7)) << 4); }
__device__ __forceinline__ int crow(int r, int hi) { return (r & 3) + 8 * (r >> 2) + 4 * hi; }
__device__ __forceinline__ unsigned cvtpk(float lo, float hi) { unsigned r; asm volatile("v_cvt_pk_bf16_f32 %0, %1, %2" : "=v"(r) : "v"(lo), "v"(hi)); return r; }
__device__ __forceinline__ void mask_tile(f32x16& p0, f32x16& p1, int dq) {
    const float NEG = -__builtin_inff();
#pragma unroll
    for (int r = 0; r < 16; ++r) { const int c = (r & 3) + 8 * (r >> 2); if (dq - c < 0) p0[r] = NEG; if (dq - c - 32 < 0) p1[r] = NEG; }
}
__device__ __forceinline__ void partialSM(f32x16& p0, f32x16& p1, float& m_reg, float& mn, float& alpha) {
    float pmax = p0[0];
#pragma unroll
    for (int r = 1; r < 16; ++r) pmax = fmaxf(pmax, p0[r]);
#pragma unroll
    for (int r = 0; r < 16; ++r) pmax = fmaxf(pmax, p1[r]);
    { auto rr = __builtin_amdgcn_permlane32_swap(__float_as_uint(pmax), __float_as_uint(pmax), false, false); pmax = fmaxf(__uint_as_float(rr[0]), __uint_as_float(rr[1])); }
    constexpr float C2 = 1.4426950408889634f * SCALE;
    if (__builtin_expect(__all((pmax - m_reg) * SCALE <= THR), 1)) { mn = m_reg; alpha = 1.f; }
    else { mn = fmaxf(m_reg, pmax); alpha = __builtin_amdgcn_exp2f((m_reg - mn) * C2); m_reg = mn; }
    const float mnL = -mn * C2;
#pragma unroll
    for (int r = 0; r < 16; ++r) p0[r] = fmaf(p0[r], C2, mnL);
#pragma unroll
    for (int r = 0; r < 16; ++r) p1[r] = fmaf(p1[r], C2, mnL);
#pragma unroll
    for (int r = 0; r < 16; ++r) p0[r] = __builtin_amdgcn_exp2f(p0[r]);
}
__device__ __forceinline__ void finishSM(f32x16& p0, f32x16& p1, float alpha, float& l_reg, bf16x8& pa0, bf16x8& pa1, bf16x8& pa2, bf16x8& pa3) {
#pragma unroll
    for (int r = 0; r < 16; ++r) p1[r] = __builtin_amdgcn_exp2f(p1[r]);
    float ps = 0;
#pragma unroll
    for (int r = 0; r < 16; ++r) ps += p0[r];
#pragma unroll
    for (int r = 0; r < 16; ++r) ps += p1[r];
    { auto rr = __builtin_amdgcn_permlane32_swap(__float_as_uint(ps), __float_as_uint(ps), false, false); ps = __uint_as_float(rr[0]) + __uint_as_float(rr[1]); }
    l_reg = l_reg * alpha + ps;
#define PK4(P, B_, OUT) do { unsigned a0 = cvtpk(P[B_+0], P[B_+1]), a1 = cvtpk(P[B_+2], P[B_+3]);                          \
        unsigned b0 = cvtpk(P[B_+4], P[B_+5]), b1 = cvtpk(P[B_+6], P[B_+7]);                                             \
        auto r0 = __builtin_amdgcn_permlane32_swap(a0, b0, false, false); auto r1 = __builtin_amdgcn_permlane32_swap(a1, b1, false, false); \
        u32x4 w = {r0[0], r1[0], r0[1], r1[1]}; OUT = *reinterpret_cast<bf16x8*>(&w); } while (0)
    PK4(p0, 0, pa0); PK4(p0, 8, pa1); PK4(p1, 0, pa2); PK4(p1, 8, pa3);
#undef PK4
}
__device__ __forceinline__ void qkt(f32x16& p0, f32x16& p1, const char* K_slot, int r32, int hi, const bf16x8* qr, const char* qrl) {
    p0 = f32x16{}; p1 = f32x16{};
    const char* kb[4];
#pragma unroll
    for (int dd = 0; dd < 4; ++dd) kb[dd] = K_slot + r32 * 128 + (((2 * dd + hi) ^ ((r32 >> 1) & 7)) << 4);
    bf16x8 a0[4], a1[4], b0[4], b1[4], qf[4];
#define QK_LOAD(X0, X1, g) do { _Pragma("unroll") for (int dd = 0; dd < 4; ++dd) { const char* a_ = kb[dd] + (g) * 8192; X0[dd] = *reinterpret_cast<const bf16x8*>(a_); X1[dd] = *reinterpret_cast<const bf16x8*>(a_ + 32 * 128); } } while (0)
#define QK_MMA(X0, X1, Q_) do { _Pragma("unroll") for (int dd = 0; dd < 4; ++dd) { p0 = __builtin_amdgcn_mfma_f32_32x32x16_bf16(X0[dd], Q_[dd], p0, 0, 0, 0); p1 = __builtin_amdgcn_mfma_f32_32x32x16_bf16(X1[dd], Q_[dd], p1, 0, 0, 0); } } while (0)
    QK_LOAD(a0, a1, 0); SBAR();
    QK_LOAD(b0, b1, 1); SBAR();
    QK_MMA(a0, a1, qr); SBAR();
    QK_LOAD(a0, a1, 2);
#pragma unroll
    for (int dd = 0; dd < 4; ++dd) qf[dd] = *reinterpret_cast<const bf16x8*>(qrl + dd * 1024);
    SBAR();
    QK_MMA(b0, b1, (qr + 4)); SBAR();
    QK_MMA(a0, a1, qf);
#undef QK_LOAD
#undef QK_MMA
}
__device__ __forceinline__ void pv_tile(f32x16* o, int vb0, bf16x8 pa0, bf16x8 pa1, bf16x8 pa2, bf16x8 pa3) {
#define TRRD(dst, off) asm volatile("ds_read_b64_tr_b16 %0, %1 offset:%2" : "=&v"(dst) : "v"(vb0), "i"(off) : "memory")
#define PV_RD(S, d0) do { constexpr int b_ = v_rd_off(d0, 0, 0); \
        TRRD(S##l0, b_); TRRD(S##h0, b_ + 2048); TRRD(S##l1, b_ + 4096); TRRD(S##h1, b_ + 6144); TRRD(S##l2, b_ + 8192); TRRD(S##h2, b_ + 10240); TRRD(S##l3, b_ + 12288); TRRD(S##h3, b_ + 14336); } while (0)
#define PV_MM(S, d0) do { \
        o[d0] = __builtin_amdgcn_mfma_f32_32x32x16_bf16(pa0, (bf16x8){S##l0[0], S##l0[1], S##l0[2], S##l0[3], S##h0[0], S##h0[1], S##h0[2], S##h0[3]}, o[d0], 0, 0, 0);   \
        o[d0] = __builtin_amdgcn_mfma_f32_32x32x16_bf16(pa1, (bf16x8){S##l1[0], S##l1[1], S##l1[2], S##l1[3], S##h1[0], S##h1[1], S##h1[2], S##h1[3]}, o[d0], 0, 0, 0);   \
        o[d0] = __builtin_amdgcn_mfma_f32_32x32x16_bf16(pa2, (bf16x8){S##l2[0], S##l2[1], S##l2[2], S##l2[3], S##h2[0], S##h2[1], S##h2[2], S##h2[3]}, o[d0], 0, 0, 0);   \
        o[d0] = __builtin_amdgcn_mfma_f32_32x32x16_bf16(pa3, (bf16x8){S##l3[0], S##l3[1], S##l3[2], S##l3[3], S##h3[0], S##h3[1], S##h3[2], S##h3[3]}, o[d0], 0, 0, 0); } while (0)
    s16x4 Al0, Al1, Al2, Al3, Ah0, Ah1, Ah2, Ah3, Bl0, Bl1, Bl2, Bl3, Bh0, Bh1, Bh2, Bh3;
    asm volatile("s_waitcnt lgkmcnt(0)" ::: "memory");
    PV_RD(A, 0);
    PV_RD(B, 1); asm volatile("s_waitcnt lgkmcnt(8)" ::: "memory"); SBAR(); PV_MM(A, 0); SBAR();
    PV_RD(A, 2); asm volatile("s_waitcnt lgkmcnt(8)" ::: "memory"); SBAR(); PV_MM(B, 1); SBAR();
    PV_RD(B, 3); asm volatile("s_waitcnt lgkmcnt(8)" ::: "memory"); SBAR(); PV_MM(A, 2); SBAR();
    asm volatile("s_waitcnt lgkmcnt(0)" ::: "memory"); SBAR(); PV_MM(B, 3);
#undef PV_RD
#undef PV_MM
#undef TRRD
}
__device__ __forceinline__ void unit(const OW& P, char* lds, int b, int h, int qb, int part) {
    const int tid = TID(), wid = __builtin_amdgcn_readfirstlane(tid >> 6), lane = tid & 63, r32 = lane & 31, hi = lane >> 5;
    const int NTall = 4 * (qb + 1), t_lo = part ? NTall / 2 : 0, NT_ = NTall / 2;
    const size_t rowbase = (size_t)b * S;
    const int q0 = qb * 256, qlo = q0 + wid * 32, qm = qlo + r32 - 4 * hi;
    char* V_lds = lds; char* K_lds = lds + OFF_K;
    float* ws = (float*)(lds + OFF_WS) + wid * 64; float* li_l = ws; float* al_l = ws + 32;
    float m_reg = -1e30f, l_reg = 0; f32x16 o[4] = {};
    const int vb0 = (int)(uintptr_t)V_lds + v_rd_base(lane);
    unsigned go_k01, go_k2, go_v0, go_v1;
    { const int row = 8 * wid + (lane >> 3), c = (lane & 7) ^ ((row >> 1) & 7);
      go_k01 = (unsigned)(row * 512 + c * 8) * 2u; go_k2 = (unsigned)(row * 64 + c * 8) * 2u;
      const int si0 = 2 * wid + (lane >> 5), si1 = si0 + 16;
      const int kk0 = (si0 >> 2) * 8 + ((lane & 31) >> 2), kk1 = (si1 >> 2) * 8 + ((lane & 31) >> 2);
      const int k0_ = (kk0 & ~0xC) | ((kk0 & 4) << 1) | ((kk0 & 8) >> 1), k1_ = (kk1 & ~0xC) | ((kk1 & 4) << 1) | ((kk1 & 8) >> 1);
      go_v0 = (unsigned)(k0_ * 512 + (si0 & 3) * 32 + (lane & 3) * 8) * 2u; go_v1 = (unsigned)(k1_ * 512 + (si1 & 3) * 32 + (lane & 3) * 8) * 2u; }
    const char* KnB = (const char*)(P.KN + rowbase * 512 + h * 128); const char* VhB = (const char*)(P.VV + rowbase * 512 + h * 128); const char* KpB = (const char*)(P.KPE + rowbase * 64);
    LAS unsigned char* ldsK = (LAS unsigned char*)(uintptr_t)(unsigned)(uintptr_t)K_lds; LAS unsigned char* ldsV = (LAS unsigned char*)(uintptr_t)(unsigned)(uintptr_t)V_lds;
#define KBASE(t) ((t_lo + (t)) * KVBLK)
#define GLDS(gp, lp) __builtin_amdgcn_global_load_lds((const unsigned*)(gp), (LAS unsigned*)(lp), 16, 0, 0)
#define STAGE(k0, ks_, vs_) do { const size_t kb_ = (size_t)(k0); \
        GLDS(KnB + kb_ * 1024 + go_k01, ldsK + (ks_) * SHM_K + wid * 1024); GLDS(KnB + kb_ * 1024 + 128 + go_k01, ldsK + (ks_) * SHM_K + 8192 + wid * 1024); \
        GLDS(KpB + kb_ * 128 + go_k2, ldsK + (ks_) * SHM_K + 16384 + wid * 1024); \
        GLDS(VhB + kb_ * 1024 + go_v0, ldsV + (vs_) * SHM_V + wid * 1024); GLDS(VhB + kb_ * 1024 + go_v1, ldsV + (vs_) * SHM_V + (wid + 8) * 1024); } while (0)
#define RESC(a) do { if (__any((a) < 1.f)) { if (hi == 0) al_l[r32] = (a); asm volatile("s_waitcnt lgkmcnt(0)" ::: "memory");              \
                     _Pragma("unroll") for (int d_ = 0; d_ < 4; ++d_) _Pragma("unroll") for (int r = 0; r < 16; ++r) o[d_][r] *= al_l[crow(r, hi)]; } } while (0)
#define MASKT(P0_, P1_, t) do { const int kb_ = KBASE(t); if (kb_ + KVBLK - 1 > qlo) mask_tile(P0_, P1_, qm - kb_); } while (0)
    STAGE(KBASE(0), 0, 0); if (NT_ > 1) { STAGE(KBASE(1), 1, 1); }
    bf16x8 qr[8]; char* qrl = lds + OFF_QR + wid * 4096 + lane * 16;
    { const bf16_t* qp = P.Q + (rowbase + qlo + r32) * QL + h * QH + hi * 8;
#pragma unroll
      for (int d0 = 0; d0 < 8; ++d0) qr[d0] = *(const bf16x8*)(qp + d0 * 16);
      const f32x2* rp = P.ROPE + (size_t)(qlo + r32) * 32 + hi * 8;
#pragma unroll
      for (int g = 0; g < 2; ++g) {
          u32x4 x1 = *(const u32x4*)(qp + (8 + g) * 16), x2 = *(const u32x4*)(qp + (10 + g) * 16); u32x4 y1, y2;
#pragma unroll
          for (int jj = 0; jj < 4; ++jj) { const f32x2 cs0 = rp[16 * g + 2 * jj], cs1 = rp[16 * g + 2 * jj + 1];
              const float a0 = bflo(x1[jj]), a1 = bfhi(x1[jj]), b0 = bflo(x2[jj]), b1 = bfhi(x2[jj]);
              y1[jj] = pk2(a0 * cs0.x - b0 * cs0.y, a1 * cs1.x - b1 * cs1.y); y2[jj] = pk2(a0 * cs0.y + b0 * cs0.x, a1 * cs1.y + b1 * cs1.x); }
          *(u32x4*)(qrl + g * 1024) = y1; *(u32x4*)(qrl + (2 + g) * 1024) = y2; } }
    f32x16 p0, p1; float mn, al; bf16x8 pa0, pa1, pa2, pa3;
    asm volatile("s_waitcnt vmcnt(0)" ::: "memory"); __syncthreads();
    int sl = 0;
    for (int t = 0; t < NT_; ++t) {
        const int s2 = sl == 0 ? 2 : sl - 1;
        if (t + 2 < NT_) { STAGE(KBASE(t + 2), s2, s2); }
        qkt(p0, p1, K_lds + sl * SHM_K, r32, hi, qr, qrl);
        MASKT(p0, p1, t); partialSM(p0, p1, m_reg, mn, al); RESC(al);
        finishSM(p0, p1, al, l_reg, pa0, pa1, pa2, pa3); SBAR();
        pv_tile(o, vb0 + sl * SHM_V, pa0, pa1, pa2, pa3);
        if (t + 2 < NT_) asm volatile("s_waitcnt vmcnt(5) lgkmcnt(0)" ::: "memory"); else asm volatile("s_waitcnt vmcnt(0) lgkmcnt(0)" ::: "memory");
        __builtin_amdgcn_s_barrier(); asm volatile("" ::: "memory");
        sl = sl == 2 ? 0 : sl + 1;
    }
    bf16_t* Ow = P.OP + ((size_t)part * NT + rowbase + qlo) * 512 + h * 128;
#pragma unroll
    for (int r = 0; r < 16; ++r) { const int orow = crow(r, hi);
#pragma unroll
        for (int d0 = 0; d0 < 4; ++d0) { const float v = o[d0][r]; const float vn = __shfl_xor(v, 1);
            if ((r32 & 1) == 0) *(unsigned*)(Ow + (size_t)orow * 512 + d0 * 32 + r32) = cvtpk(v, vn); } }
    if (hi == 0) P.ML[((size_t)part * NT + rowbase + qlo + r32) * 4 + h] = (f32x2){m_reg * (1.4426950408889634f * SCALE), l_reg};
    __syncthreads();
#undef KBASE
#undef GLDS
#undef STAGE
#undef RESC
#undef MASKT
}
#undef SBAR
}
__device__ __forceinline__ void phase_attn(const OW& P, LAS unsigned char* lds, int vcu, int G) {
    for (int v = vcu; v < 256; v += G) { const int bh = v >> 4, r = v & 15;
        att::unit(P, (char*)lds, bh >> 2, bh & 3, r, 0);
        att::unit(P, (char*)lds, bh >> 2, bh & 3, 15 - r, 1); }
}
#if MODE == 0
__global__ void shim_attn(const bf16_t* OP, const f32x2* ML, float* MIXf) {
    const size_t i = (size_t)blockIdx.x * 256 + threadIdx.x; if (i >= (size_t)NT * 512) return;
    const size_t row = i >> 9; const int c = (int)(i & 511), h = c >> 7;
    const f32x2 a = ML[row * 4 + h], b = ML[((size_t)NT + row) * 4 + h];
    const float M = fmaxf(a.x, b.x), w0 = exp2f(a.x - M), w1 = exp2f(b.x - M);
    MIXf[row * D + 512 + c] = (w0 * bf2f(OP[i]) + w1 * bf2f(OP[(size_t)NT * 512 + i])) / (w0 * a.y + w1 * b.y);
}
#endif


__device__ __forceinline__ float wsum(float v) {
#pragma unroll
    for (int o = 1; o < 64; o <<= 1) v += __shfl_xor(v, o);
    return v;
}
__device__ __forceinline__ float gelu_t(float x) { const float u = 0.7978845608028654f * (x + 0.044715f * x * x * x); const float t = 1.f - 2.f * __builtin_amdgcn_rcpf(1.f + __expf(2.f * u)); return 0.5f * x * (1.f + t); }
__device__ __forceinline__ void mix_tile(const OW& P, LAS unsigned char* lds, int tile) {
    const int tid = TID(), lane = tid & 63, wid = __builtin_amdgcn_readfirstlane(tid >> 6);
    LAS float* LR = (LAS float*)lds;
    const int tok0 = tile * 64, j = tile & 63, tile0 = tile - j;
    float h = 0.f;
    if (j > 0) {
        { float a[32], b[32];
#pragma unroll
          for (int q = 0; q < 32; ++q) { const int t_ = q < j ? tile0 + q : tile0; a[q] = P.AGA[(size_t)t_ * LW + tid]; b[q] = P.AGB[(size_t)t_ * LW + tid]; }
#pragma unroll
          for (int q = 0; q < 32; ++q) if (q < j) h = fmaf(a[q], h, b[q]); }
        if (j > 32) { float a[32], b[32];
#pragma unroll
          for (int q = 0; q < 32; ++q) { const int t_ = 32 + q < j ? tile0 + 32 + q : tile0; a[q] = P.AGA[(size_t)t_ * LW + tid]; b[q] = P.AGB[(size_t)t_ * LW + tid]; }
#pragma unroll
          for (int q = 0; q < 32; ++q) if (32 + q < j) h = fmaf(a[q], h, b[q]); }
    }
    { unsigned ad[64]; unsigned short gg[64];
#pragma unroll
      for (int q = 0; q < 64; ++q) { const size_t tok = (size_t)tok0 + q; ad[q] = ((const unsigned*)P.A)[tok * LW + tid]; gg[q] = P.Z[tok * ZW + LW + tid]; }
#pragma unroll
      for (int q = 0; q < 64; ++q) { h = fmaf(1.f - bflo(ad[q]), h, bfhi(ad[q])); LR[q * LW + tid] = h * gelu_t(bf2f(gg[q])); } }
    __syncthreads();
    { const int hh = lane >> 4;
      f32x2 nma, nmb; u32x4 noa, nob;
#define MX_LOAD(r_) do { const size_t row_ = (size_t)tok0 + (r_); nma = P.ML[row_ * 4 + hh]; nmb = P.ML[((size_t)NT + row_) * 4 + hh]; \
        noa = *(const u32x4*)(P.OP + row_ * 512 + lane * 8); nob = *(const u32x4*)(P.OP + ((size_t)NT + row_) * 512 + lane * 8); } while (0)
      MX_LOAD(wid);
      for (int r = wid; r < 64; r += NWAVES) { const size_t row = (size_t)tok0 + r;
        const f32x2 ma = nma, mb = nmb; const u32x4 oa = noa, ob = nob;
        if (r + NWAVES < 64) MX_LOAD(r + NWAVES);
        { const f32x4 v0 = *(const LAS f32x4*)(LR + r * LW + lane * 8), v1 = *(const LAS f32x4*)(LR + r * LW + lane * 8 + 4);
          float ss = (v0[0] * v0[0] + v0[1] * v0[1]) + (v0[2] * v0[2] + v0[3] * v0[3]) + (v1[0] * v1[0] + v1[1] * v1[1]) + (v1[2] * v1[2] + v1[3] * v1[3]);
          const float rs = rsqrtf(wsum(ss) * (1.f / 512.f) + EPS);
          u32x4 o; o.x = pk2(v0[0] * rs, v0[1] * rs); o.y = pk2(v0[2] * rs, v0[3] * rs); o.z = pk2(v1[0] * rs, v1[1] * rs); o.w = pk2(v1[2] * rs, v1[3] * rs);
          *(u32x4*)(P.MIX + row * D + lane * 8) = o; }
        { const float M = fmaxf(ma.x, mb.x), w0 = __builtin_amdgcn_exp2f(ma.x - M), w1 = __builtin_amdgcn_exp2f(mb.x - M), inv = 1.f / (w0 * ma.y + w1 * mb.y);
          float v[8];
#pragma unroll
          for (int q = 0; q < 4; ++q) { v[2 * q] = (w0 * bflo(oa[q]) + w1 * bflo(ob[q])) * inv; v[2 * q + 1] = (w0 * bfhi(oa[q]) + w1 * bfhi(ob[q])) * inv; }
          float ss = 0.f;
#pragma unroll
          for (int q = 0; q < 8; ++q) ss += v[q] * v[q];
          const float rs = rsqrtf(wsum(ss) * (1.f / 512.f) + EPS);
          u32x4 o; o.x = pk2(v[0] * rs, v[1] * rs); o.y = pk2(v[2] * rs, v[3] * rs); o.z = pk2(v[4] * rs, v[5] * rs); o.w = pk2(v[6] * rs, v[7] * rs);
          *(u32x4*)(P.MIX + row * D + 512 + lane * 8) = o; } }
#undef MX_LOAD
    }
    __syncthreads();
}
struct SchedOut {
    static constexpr bool HOOKS = false;
    const OW* P; int G, c;
    __device__ __forceinline__ bool next(int i, pg8::UnitD& u) const {
        const int L = i * G + c; if (L >= 256) return false;
        int pm, pn; pg8::tile_order(L, 64, 4, pm, pn);
        u.A = (const char*)(P->MIX + (size_t)pm * 256 * D); u.rows = nullptr; u.B = (const char*)(P->Wo_t + (size_t)pn * 256 * 1024); u.lda = D * 2; u.ldb = 2048; u.nt = 16; u.type = 3; u.pm = pm; u.pn = pn; u.aux = 0;
        return true;
    }
};
struct EpiOut {
    const bf16_t* xres; bf16_t* Y;
    __device__ __forceinline__ void operator()(const f32x4 (&acc)[2][2][4][2], const pg8::UnitD& u, int wr, int wc, int fr, int fq) const {
        const int row0 = u.pm * 256 + wr * 64 + fr, col0 = u.pn * 256 + wc * 32 + 8 * fq;
#pragma unroll
        for (int ai = 0; ai < 2; ++ai) { u32x4 xb[4][2];
#pragma unroll
            for (int m = 0; m < 4; ++m) { const size_t off = (size_t)(row0 + ai * 128 + m * 16) * D + col0;
#pragma unroll
                for (int bj = 0; bj < 2; ++bj) xb[m][bj] = *(const u32x4*)(xres + off + bj * 128); }
#pragma unroll
            for (int m = 0; m < 4; ++m) { const size_t off = (size_t)(row0 + ai * 128 + m * 16) * D + col0;
#pragma unroll
                for (int bj = 0; bj < 2; ++bj) { const u32x4 x_ = xb[m][bj]; const f32x4 v0 = acc[ai][bj][m][0], v1 = acc[ai][bj][m][1];
                    u32x4 w; w.x = pg8::cvt_pk_bf16(ALPHA * bflo(x_.x) + v0[0], ALPHA * bfhi(x_.x) + v0[1]); w.y = pg8::cvt_pk_bf16(ALPHA * bflo(x_.y) + v0[2], ALPHA * bfhi(x_.y) + v0[3]);
                    w.z = pg8::cvt_pk_bf16(ALPHA * bflo(x_.z) + v1[0], ALPHA * bfhi(x_.z) + v1[1]); w.w = pg8::cvt_pk_bf16(ALPHA * bflo(x_.w) + v1[2], ALPHA * bfhi(x_.w) + v1[3]);
                    *(u32x4*)(Y + off + bj * 128) = w; } } }
    }
};
__device__ __forceinline__ void ln1_router_tile(const OW& P, int l, LAS unsigned char* lds, int tile) {
    const int tid = TID(), lane = tid & 63, wid = __builtin_amdgcn_readfirstlane(tid >> 6), fr = lane & 15, fq = lane >> 4;
    LAS float* PL = (LAS float*)lds;
    LAS f32x2* ST = (LAS f32x2*)(lds + 8192);
    LAS int* EI = (LAS int*)(lds + 8192 + 512);
    const float* g1 = P.in[15] + (size_t)l * D; const float* b1 = P.in[16] + (size_t)l * D; const float* rb = P.in[18];
    const int tok0 = tile * 64;
    { const int mt = wid & 3, kh = wid >> 2;
      const bf16_t* yp = P.Y + ((size_t)tok0 + 16 * mt + fr) * D + 512 * kh + 8 * fq; const bf16_t* wp = P.RWH + (size_t)fr * 1024 + 512 * kh + 8 * fq;
      bf16x8 ya[16];
#pragma unroll
      for (int ks = 0; ks < 16; ++ks) ya[ks] = *(const bf16x8*)(yp + 32 * ks);
      f32x4 acc = {0.f, 0.f, 0.f, 0.f};
#pragma unroll
      for (int ks = 0; ks < 16; ++ks) { const bf16x8 bh = *(const bf16x8*)(wp + 32 * ks), bl = *(const bf16x8*)(wp + 16 * 1024 + 32 * ks);
          acc = __builtin_amdgcn_mfma_f32_16x16x32_bf16(ya[ks], bh, acc, 0, 0, 0); acc = __builtin_amdgcn_mfma_f32_16x16x32_bf16(ya[ks], bl, acc, 0, 0, 0); }
#pragma unroll
      for (int x = 0; x < 4; ++x) PL[(kh * 64 + 16 * mt + 4 * fq + x) * 16 + fr] = acc[x]; }
    f32x4 gv[4], bv[4];
#pragma unroll
    for (int j = 0; j < 4; ++j) { gv[j] = *(const f32x4*)(g1 + lane * 16 + 4 * j); bv[j] = *(const f32x4*)(b1 + lane * 16 + 4 * j); }
    u32x4 n0 = *(const u32x4*)(P.Y + ((size_t)tok0 + wid * 8) * D + lane * 16), n1 = *(const u32x4*)(P.Y + ((size_t)tok0 + wid * 8) * D + lane * 16 + 8);
    for (int rr = 0; rr < 8; ++rr) { const int r = wid * 8 + rr; const size_t row = (size_t)tok0 + r;
        float v[16]; float s_ = 0.f;
#pragma unroll
        for (int q = 0; q < 4; ++q) { v[2 * q] = bflo(n0[q]); v[2 * q + 1] = bfhi(n0[q]); v[8 + 2 * q] = bflo(n1[q]); v[8 + 2 * q + 1] = bfhi(n1[q]); }
#pragma unroll
        for (int j = 0; j < 16; ++j) s_ += v[j];
        if (rr + 1 < 8) { n0 = *(const u32x4*)(P.Y + (row + 1) * D + lane * 16); n1 = *(const u32x4*)(P.Y + (row + 1) * D + lane * 16 + 8); }
        const float mu = wsum(s_) * (1.f / D); float q_ = 0.f;
#pragma unroll
        for (int j = 0; j < 16; ++j) { v[j] -= mu; q_ += v[j] * v[j]; }
        const float rs = rsqrtf(wsum(q_) * (1.f / D) + EPS);
#pragma unroll
        for (int j = 0; j < 16; ++j) v[j] = v[j] * rs * gv[j >> 2][j & 3] + bv[j >> 2][j & 3];
        u32x4 o0, o1;
#pragma unroll
        for (int q = 0; q < 4; ++q) { o0[q] = pk2(v[2 * q], v[2 * q + 1]); o1[q] = pk2(v[8 + 2 * q], v[8 + 2 * q + 1]); }
        *(u32x4*)(P.XB + row * D + lane * 16) = o0; *(u32x4*)(P.XB + row * D + lane * 16 + 8) = o1;
        if (lane == 0) ST[r] = (f32x2){mu, rs}; }
    __syncthreads();
    if (tid < 64) { const int r = tid; const size_t row = (size_t)tok0 + r; const f32x2 st = ST[r];
        float sg[16], ss[16];
#pragma unroll
        for (int q4 = 0; q4 < 4; ++q4) { const f32x4 pa = *(const LAS f32x4*)(PL + r * 16 + 4 * q4), pb = *(const LAS f32x4*)(PL + (64 + r) * 16 + 4 * q4);
#pragma unroll
            for (int x = 0; x < 4; ++x) { const int e = 4 * q4 + x; const float lg = st.y * ((pa[x] + pb[x]) - st.x * P.RGB[e]) + P.RGB[16 + e];
                sg[e] = __builtin_amdgcn_rcpf(1.f + __expf(-lg)); ss[e] = sg[e] + rb[e]; } }
        int best_g = 0; float best = -INFINITY;
#pragma unroll
        for (int gI = 0; gI < 4; ++gI) { float m1 = -INFINITY, m2 = -INFINITY;
#pragma unroll
            for (int k = 0; k < 4; ++k) { const float vv = ss[gI * 4 + k]; if (vv > m1) { m2 = m1; m1 = vv; } else if (vv > m2) { m2 = vv; } }
            const float gs = m1 + m2; if (gs > best) { best = gs; best_g = gI; } }
        float c0 = 0.f, c1 = 0.f, c2 = 0.f, c3 = 0.f, t0 = 0.f, t1 = 0.f, t2 = 0.f, t3 = 0.f;
#pragma unroll
        for (int gI = 0; gI < 4; ++gI) if (gI == best_g) { c0 = ss[gI * 4]; c1 = ss[gI * 4 + 1]; c2 = ss[gI * 4 + 2]; c3 = ss[gI * 4 + 3]; t0 = sg[gI * 4]; t1 = sg[gI * 4 + 1]; t2 = sg[gI * 4 + 2]; t3 = sg[gI * 4 + 3]; }
        int i1 = 0; float v1 = c0, s1 = t0;
        if (c1 > v1) { i1 = 1; v1 = c1; s1 = t1; }
        if (c2 > v1) { i1 = 2; v1 = c2; s1 = t2; }
        if (c3 > v1) { i1 = 3; v1 = c3; s1 = t3; }
        int i2 = -1; float v2 = -INFINITY, s2 = 0.f;
        if (i1 != 0 && c0 > v2) { i2 = 0; v2 = c0; s2 = t0; }
        if (i1 != 1 && c1 > v2) { i2 = 1; v2 = c1; s2 = t1; }
        if (i1 != 2 && c2 > v2) { i2 = 2; v2 = c2; s2 = t2; }
        if (i1 != 3 && c3 > v2) { i2 = 3; v2 = c3; s2 = t3; }
        const int e1 = best_g * 4 + i1, e2 = best_g * 4 + i2; const float inv = 1.f / (s1 + s2);
        P.GATE[row * 2] = s1 * inv; P.GATE[row * 2 + 1] = s2 * inv; P.EIDX[row * 2] = e1; P.EIDX[row * 2 + 1] = e2; EI[r * 2] = e1; EI[r * 2 + 1] = e2; }
    __syncthreads();
    if (tid < 16) { int cnt = 0;
        for (int a = 0; a < 128; ++a) if (EI[a] == tid) { P.LRANK[(size_t)tok0 * 2 + a] = cnt; ++cnt; }
        P.HIST[tile * 16 + tid] = cnt; }
    __syncthreads();
}
__device__ __forceinline__ void moe_table(const OW& P, LAS unsigned char* lds) {
    const int tid = TID(); LAS int* HS = (LAS int*)lds; LAS int* TAB = (LAS int*)(lds + TAB_OFF);
    for (int i = tid; i < 256 * 16; i += NTHREADS) HS[i] = P.HIST[i];
    __syncthreads();
    if (tid < 16) { int tot = 0; for (int w = 0; w < 256; ++w) tot += HS[w * 16 + tid]; TAB[32 + tid] = tot; }
    __syncthreads();
    if (tid == 0) { int acc = 0; for (int e = 0; e < 16; ++e) { TAB[e] = acc; acc += (TAB[32 + e] + 255) >> 8; } TAB[16] = acc; }
    __syncthreads();
}
__device__ __forceinline__ void dest_tile(const OW& P, LAS unsigned char* lds, int tile) {
    const int tid = TID(); LAS int* HS = (LAS int*)lds; LAS int* TAB = (LAS int*)(lds + TAB_OFF); LAS int* BS = (LAS int*)(lds + 16384);
    if (tid < 16) { int b = 0; for (int w = 0; w < tile; ++w) b += HS[w * 16 + tid]; BS[tid] = b; }
    __syncthreads();
    if (tid < 128) { const size_t a = (size_t)tile * 128 + tid; const int e = P.EIDX[a]; const int dst = 256 * TAB[e] + BS[e] + P.LRANK[a]; P.DEST[a] = dst; P.ROWTOK[dst] = (int)(a >> 1); }
    if (tile < 16) { const int e = tile, lo = 256 * TAB[e] + TAB[32 + e], hi = 256 * TAB[e + 1]; for (int i = lo + tid; i < hi; i += NTHREADS) P.ROWTOK[i] = 0; }
    __syncthreads();
}
struct SchedMoe {
    static constexpr bool HOOKS = false;
    const OW* P; LAS int* TAB; int G, c; bool down;
    __device__ __forceinline__ bool next(int i, pg8::UnitD& u) const {
        const int NB = __builtin_amdgcn_readfirstlane(TAB[16]); const int L = i * G + c; if (L >= NB * 4) return false;
        const int rb = L >> 2, pn = L & 3; int e = 0;
#pragma unroll
        for (int q = 1; q < 16; ++q) e += (__builtin_amdgcn_readfirstlane(TAB[q]) <= rb) ? 1 : 0;
        if (!down) { u.A = (const char*)P->XB; u.rows = P->ROWTOK + rb * 256; u.B = (const char*)(P->Wgu_t + ((size_t)e * 1024 + pn * 256) * 1024); u.lda = 2048; u.ldb = 2048; u.nt = 16; u.type = 4; }
        else { u.A = (const char*)(P->HE + (size_t)rb * 256 * DE); u.rows = nullptr; u.B = (const char*)(P->Wd_t + ((size_t)e * 1024 + pn * 256) * DE); u.lda = 1024; u.ldb = 1024; u.nt = 8; u.type = 5; }
        u.pm = rb; u.pn = pn; u.aux = e; return true;
    }
};
struct EpiMoeUp {
    bf16_t* HE;
    __device__ __forceinline__ void operator()(const f32x4 (&acc)[2][2][4][2], const pg8::UnitD& u, int wr, int wc, int fr, int fq) const {
        const int row0 = u.pm * 256 + wr * 64 + fr, col0 = u.pn * 128 + wc * 32 + 8 * fq;
#pragma unroll
        for (int ai = 0; ai < 2; ++ai)
#pragma unroll
            for (int m = 0; m < 4; ++m) { float hv[8];
#pragma unroll
                for (int n = 0; n < 2; ++n)
#pragma unroll
                    for (int x = 0; x < 4; ++x) { const float g = acc[ai][0][m][n][x], up = acc[ai][1][m][n][x]; hv[4 * n + x] = g / (1.f + __expf(-g)) * up; }
                u32x4 w; w.x = pg8::cvt_pk_bf16(hv[0], hv[1]); w.y = pg8::cvt_pk_bf16(hv[2], hv[3]); w.z = pg8::cvt_pk_bf16(hv[4], hv[5]); w.w = pg8::cvt_pk_bf16(hv[6], hv[7]);
                *(u32x4*)(HE + (size_t)(row0 + ai * 128 + m * 16) * DE + col0) = w; }
    }
};
struct EpiMoeDown {
    bf16_t* YE;
    __device__ __forceinline__ void operator()(const f32x4 (&acc)[2][2][4][2], const pg8::UnitD& u, int wr, int wc, int fr, int fq) const {
        const int row0 = u.pm * 256 + wr * 64 + fr, col0 = u.pn * 256 + wc * 32 + 8 * fq;
#pragma unroll
        for (int ai = 0; ai < 2; ++ai)
#pragma unroll
            for (int m = 0; m < 4; ++m) { bf16_t* rowp = YE + (size_t)(row0 + ai * 128 + m * 16) * D + col0;
#pragma unroll
                for (int bj = 0; bj < 2; ++bj) { const f32x4 v0 = acc[ai][bj][m][0], v1 = acc[ai][bj][m][1];
                    u32x4 w; w.x = pg8::cvt_pk_bf16(v0[0], v0[1]); w.y = pg8::cvt_pk_bf16(v0[2], v0[3]); w.z = pg8::cvt_pk_bf16(v1[0], v1[1]); w.w = pg8::cvt_pk_bf16(v1[2], v1[3]);
                    *(u32x4*)(rowp + bj * 128) = w; } }
    }
};

__device__ __forceinline__ void store16_sc1(void* p, u32x4 v) { asm volatile("global_store_dwordx4 %0, %1, off sc1\n\ts_nop 1" :: "v"(p), "v"(v) : "memory"); }
struct SchedMoe2 {
    static constexpr bool HOOKS = true;
    const OW* P; LAS int* TAB; unsigned* cnt;
    int G, c, U, nup, ndn, jA, jB;
    __device__ __forceinline__ void init(int G_, int c_) {
        G = G_; c = c_; const int NB = __builtin_amdgcn_readfirstlane(TAB[16]); U = 4 * NB;
        const int nmax = (U + G - 1) / G, nfull = U - (nmax - 1) * G;
        const bool allsame = nfull >= G; const int Lc = allsame ? 0 : G - nfull;
        nup = (c < nfull || allsame) ? nmax : nmax - 1; if (c >= U) nup = 0;
        const bool light = !allsame && c >= nfull; const int cl = c - nfull;
        const int nA = 2 * Lc < U ? 2 * Lc : U; const int R = U - nA;
        int a_cnt = 0; if (light) { a_cnt = nA - 2 * cl; a_cnt = a_cnt < 0 ? 0 : (a_cnt > 2 ? 2 : a_cnt); }
        const int o = light ? cl : Lc + c;
        const int b_cnt = o < R ? (R - o + G - 1) / G : 0;
        jA = 2 * cl; jB = nA + o; ndn = a_cnt + b_cnt; nA_mine = a_cnt;
    }
    int nA_mine;
    __device__ __forceinline__ bool next(int i, pg8::UnitD& u) const {
        if (i < nup) { const int Lq = c + i * G; fill(u, Lq >> 2, Lq & 3, false); return true; }
        const int k = i - nup; if (k >= ndn) return false;
        const int j = k < nA_mine ? jA + k : jB + (k - nA_mine) * G; fill(u, j >> 2, j & 3, true); return true;
    }
    __device__ __forceinline__ void fill(pg8::UnitD& u, int rb, int pn, bool down) const {
        int e = 0;
#pragma unroll
        for (int q = 1; q < 16; ++q) e += (__builtin_amdgcn_readfirstlane(TAB[q]) <= rb) ? 1 : 0;
        if (!down) { u.A = (const char*)P->XB; u.rows = P->ROWTOK + rb * 256; u.B = (const char*)(P->Wgu_t + ((size_t)e * 1024 + pn * 256) * 1024); u.lda = 2048; u.ldb = 2048; u.nt = 16; u.type = 4; }
        else { u.A = (const char*)(P->HE + (size_t)rb * 256 * DE); u.rows = nullptr; u.B = (const char*)(P->Wd_t + ((size_t)e * 1024 + pn * 256) * DE); u.lda = 1024; u.ldb = 1024; u.nt = 8; u.type = 5; }
        u.pm = rb; u.pn = pn; u.aux = e;
    }
    __device__ __forceinline__ void a_ready(const pg8::UnitD& u, int wid) const {
        if (u.type != 5) return;
        if (wid == 0) {
            const unsigned* w = cnt + 64 * u.pm; unsigned spins = 0;
            for (;;) { unsigned v;
                asm volatile("v_mov_b32 %0, 0\n\tglobal_load_dword %0, %0, %1 sc1\n\ts_waitcnt vmcnt(0)" : "=&v"(v) : "s"(w) : "memory");
                if ((unsigned)__builtin_amdgcn_readfirstlane((int)v) >= 32u) break;
                if (++spins > 200000u) break;
                __builtin_amdgcn_s_sleep(2); }
            __builtin_amdgcn_fence(__ATOMIC_ACQUIRE, "agent");
            asm volatile("s_waitcnt vmcnt(0)" ::: "memory");
        }
        asm volatile("" ::: "memory"); __builtin_amdgcn_s_barrier(); asm volatile("" ::: "memory");
    }
    __device__ __forceinline__ void done(const pg8::UnitD& u, int lane) const {
        if (u.type != 4) return;
        asm volatile("s_waitcnt vmcnt(0)" ::: "memory");
        if (lane == 0) __hip_atomic_fetch_add(cnt + 64 * u.pm, 1u, __ATOMIC_RELAXED, __HIP_MEMORY_SCOPE_AGENT);
    }
};
struct EpiMoe2 {
    bf16_t* HE; bf16_t* YE;
    __device__ __forceinline__ void operator()(const f32x4 (&acc)[2][2][4][2], const pg8::UnitD& u, int wr, int wc, int fr, int fq) const {
        const int row0 = u.pm * 256 + wr * 64 + fr;
        if (u.type == 4) { const int col0 = u.pn * 128 + wc * 32 + 8 * fq;
#pragma unroll
            for (int ai = 0; ai < 2; ++ai)
#pragma unroll
                for (int m = 0; m < 4; ++m) { float hv[8];
                    int rr = row0 + ai * 128 + m * 16; asm volatile("" : "+v"(rr));
#pragma unroll
                    for (int n = 0; n < 2; ++n)
#pragma unroll
                        for (int x = 0; x < 4; ++x) { const float g = acc[ai][0][m][n][x], up = acc[ai][1][m][n][x]; hv[4 * n + x] = g * __builtin_amdgcn_rcpf(1.f + __expf(-g)) * up; }
                    u32x4 w; w.x = pg8::cvt_pk_bf16(hv[0], hv[1]); w.y = pg8::cvt_pk_bf16(hv[2], hv[3]); w.z = pg8::cvt_pk_bf16(hv[4], hv[5]); w.w = pg8::cvt_pk_bf16(hv[6], hv[7]);
                    store16_sc1(HE + (size_t)rr * DE + col0, w); }
        } else { const int col0 = u.pn * 256 + wc * 32 + 8 * fq;
#pragma unroll
            for (int ai = 0; ai < 2; ++ai)
#pragma unroll
                for (int m = 0; m < 4; ++m) { int rr = row0 + ai * 128 + m * 16; asm volatile("" : "+v"(rr)); bf16_t* rowp = YE + (size_t)rr * D + col0;
#pragma unroll
                    for (int bj = 0; bj < 2; ++bj) { const f32x4 v0 = acc[ai][bj][m][0], v1 = acc[ai][bj][m][1];
                        u32x4 w; w.x = pg8::cvt_pk_bf16(v0[0], v0[1]); w.y = pg8::cvt_pk_bf16(v0[2], v0[3]); w.z = pg8::cvt_pk_bf16(v1[0], v1[1]); w.w = pg8::cvt_pk_bf16(v1[2], v1[3]);
                        *(u32x4*)(rowp + bj * 128) = w; } }
        }
    }
};
__device__ __forceinline__ void ln2_rows(const OW& P, int l, int vcu, int G, float* Xdst) {
    const int tid_ = TID(); const int lane = tid_ & 63, wid = __builtin_amdgcn_readfirstlane(tid_ >> 6);
    const float* g2 = P.in[22] + (size_t)l * D; const float* b2 = P.in[23] + (size_t)l * D;
    f32x4 gv[4], bv[4];
#pragma unroll
    for (int j = 0; j < 4; ++j) { const int c = lane * 8 + 512 * (j >> 1) + 4 * (j & 1); gv[j] = *(const f32x4*)(g2 + c); bv[j] = *(const f32x4*)(b2 + c); }
    const size_t first = (size_t)vcu * NWAVES + wid, stride = (size_t)G * NWAVES;
    for (size_t base = first; base < NT; base += 8 * stride) {
        float ga[8], gb[8]; int da[8], db[8];
#pragma unroll
        for (int k = 0; k < 8; ++k) { const size_t row = base + k * stride; const bool ok = row < NT; const size_t r_ = ok ? row : base;
            ga[k] = P.GATE[r_ * 2]; gb[k] = P.GATE[r_ * 2 + 1]; da[k] = P.DEST[r_ * 2]; db[k] = P.DEST[r_ * 2 + 1]; }
#pragma unroll
        for (int kg = 0; kg < 8; kg += 4) {
        u32x4 nx[4][2], nya[4][2], nyb[4][2];
#pragma unroll
        for (int k4 = 0; k4 < 4; ++k4) { const int k = kg + k4; const size_t row_ = base + k * stride < NT ? base + k * stride : base;
#pragma unroll
            for (int j = 0; j < 2; ++j) { nx[k4][j] = *(const u32x4*)(P.XB + row_ * D + lane * 8 + 512 * j);
                nya[k4][j] = *(const u32x4*)(P.YE + (size_t)da[k] * D + lane * 8 + 512 * j); nyb[k4][j] = *(const u32x4*)(P.YE + (size_t)db[k] * D + lane * 8 + 512 * j); } }
#pragma unroll
        for (int k4 = 0; k4 < 4; ++k4) { const int k = kg + k4; const size_t row = base + k * stride; if (row >= NT) break;
            float v[16]; float s = 0.f; const float gA = ga[k], gB = gb[k];
#pragma unroll
            for (int j = 0; j < 2; ++j)
#pragma unroll
                for (int q = 0; q < 4; ++q) { const unsigned x = nx[k4][j][q], ya = nya[k4][j][q], yb = nyb[k4][j][q];
                    v[8 * j + 2 * q] = ALPHA * bflo(x) + gA * bflo(ya) + gB * bflo(yb); v[8 * j + 2 * q + 1] = ALPHA * bfhi(x) + gA * bfhi(ya) + gB * bfhi(yb); }
#pragma unroll
            for (int i = 0; i < 16; ++i) s += v[i];
            const float mu = wsum(s) * (1.f / D); float q_ = 0.f;
#pragma unroll
            for (int i = 0; i < 16; ++i) { v[i] -= mu; q_ += v[i] * v[i]; }
            const float rs = rsqrtf(wsum(q_) * (1.f / D) + EPS);
#pragma unroll
            for (int i = 0; i < 16; ++i) v[i] = v[i] * rs * gv[i >> 2][i & 3] + bv[i >> 2][i & 3];
#pragma unroll
            for (int j = 0; j < 2; ++j) { u32x4 o;
#pragma unroll
                for (int q = 0; q < 4; ++q) o[q] = pk2(v[8 * j + 2 * q], v[8 * j + 2 * q + 1]);
                *(u32x4*)(P.XB + row * D + lane * 8 + 512 * j) = o;
                if (Xdst) { *(f32x4*)(Xdst + row * D + lane * 8 + 512 * j) = (f32x4){v[8 * j], v[8 * j + 1], v[8 * j + 2], v[8 * j + 3]}; *(f32x4*)(Xdst + row * D + lane * 8 + 512 * j + 4) = (f32x4){v[8 * j + 4], v[8 * j + 5], v[8 * j + 6], v[8 * j + 7]}; } }
        }
        }
    }
}

#if MODE == 0
__global__ void __launch_bounds__(NTHREADS, 2) opt_phase(OW P, int phase, int layer) {
    extern __shared__ __attribute__((aligned(16))) unsigned char lds_raw[];
    LAS unsigned char* lds = (LAS unsigned char*)lds_raw;
    const int G = gridDim.x, bx = blockIdx.x, vcu = (G % 8 == 0) ? (bx % 8) * (G / 8) + bx / 8 : bx;
    switch (phase) {
        case 0: if (PH(0)) { prep_tables(P, vcu, G); prep_weights(P, layer, lds, vcu, G); } break;
        case 1: if (PH(1)) phase_inproj(P, lds, G); break;
        case 2: if (PH(2)) phase_qkv(P, layer, lds, G); break;
        case 3: if (PH(3)) phase_attn(P, lds, vcu, G); break;
        case 4: if (PH(4)) { for (int tile = blockIdx.x; tile < NT / 64; tile += G) mix_tile(P, lds, tile); } break;
        case 5: if (PH(5)) { SchedOut Sd{&P, G, (int)blockIdx.x}; EpiOut E{P.XB, P.Y}; pg8::gemm_phase<true>(lds, Sd, E); } break;
        case 6: if (PH(6)) { for (int tile = blockIdx.x; tile < NT / 64; tile += G) ln1_router_tile(P, layer, lds, tile); } break;
        case 7: if (PH(7)) { moe_table(P, lds); for (int tile = blockIdx.x; tile < NT / 64; tile += G) dest_tile(P, lds, tile); } break;
        case 8: if (PH(8)) { moe_table(P, lds); SchedMoe Sd{&P, (LAS int*)(lds + TAB_OFF), G, (int)blockIdx.x, false}; EpiMoeUp E{P.HE}; pg8::gemm_phase<true>(lds, Sd, E); } break;
        case 9: if (PH(9)) { moe_table(P, lds); SchedMoe Sd{&P, (LAS int*)(lds + TAB_OFF), G, (int)blockIdx.x, true}; EpiMoeDown E{P.YE}; pg8::gemm_phase<true>(lds, Sd, E); } break;
        case 10: if (PH(10)) { ln2_rows(P, layer, vcu, G, layer == L - 1 ? P.X : nullptr); if (layer + 1 < L) prep_weights(P, layer + 1, lds, vcu, G); } break;
        default: break;
    }
}

#endif
struct MArgs { const float* in[24]; float* X; char* ws; };
constexpr int PT_OFF = LDSCTL_OFF + 2048;
__device__ __forceinline__ unsigned long long ldq(LAS unsigned char* lds, int k) {
    const LAS unsigned* p = (const LAS unsigned*)(lds + PT_OFF) + 2 * k;
    const unsigned lo = (unsigned)__builtin_amdgcn_readfirstlane((int)p[0]), hi = (unsigned)__builtin_amdgcn_readfirstlane((int)p[1]);
    return ((unsigned long long)hi << 32) | lo;
}
__device__ __forceinline__ OW load_ow(LAS unsigned char* lds_, int wsel = 0) {
    unsigned la = (unsigned)(uintptr_t)lds_; asm volatile("" : "+s"(la) :: "memory"); LAS unsigned char* lds = (LAS unsigned char*)(uintptr_t)la;
    OW P;
#pragma unroll
    for (int i = 0; i < 24; ++i) P.in[i] = (const float*)(GAS const float*)ldq(lds, i);
    P.X = (float*)(GAS float*)ldq(lds, 24); GAS char* ws = (GAS char*)ldq(lds, 25); GAS char* wsw = ws + (wsel ? ows::WSET1 : 0);
    P.ctl = (unsigned*)(GAS unsigned*)(ws + ows::CTL); P.XB = (bf16_t*)(GAS bf16_t*)(ws + ows::XB); P.Z = (bf16_t*)(GAS bf16_t*)(ws + ows::Z); P.SSQ = (float*)(GAS float*)(ws + ows::SSQ);
    P.Win_t = (bf16_t*)(GAS bf16_t*)(wsw + ows::WIN); P.Wq_t = (bf16_t*)(GAS bf16_t*)(wsw + ows::WQ); P.Wkv_t = (bf16_t*)(GAS bf16_t*)(wsw + ows::WKV); P.Wo_t = (bf16_t*)(GAS bf16_t*)(wsw + ows::WO);
    P.Wgu_t = (bf16_t*)(GAS bf16_t*)(wsw + ows::WGU); P.Wd_t = (bf16_t*)(GAS bf16_t*)(wsw + ows::WD); P.Wlg_t = (bf16_t*)(GAS bf16_t*)(wsw + ows::WLG); P.RWH = (bf16_t*)(GAS bf16_t*)(wsw + ows::WLG + 262144); P.RGB = (float*)(GAS float*)(wsw + ows::WLG + 393216);
    P.ROPE = (f32x2*)(GAS f32x2*)(ws + ows::ROPE); P.Q = (bf16_t*)(GAS bf16_t*)(ws + ows::Q); P.KN = (bf16_t*)(GAS bf16_t*)(ws + ows::KN); P.VV = (bf16_t*)(GAS bf16_t*)(ws + ows::VV); P.KPE = (bf16_t*)(GAS bf16_t*)(ws + ows::KPE);
    P.A = (float*)(GAS float*)(ws + ows::A); P.DRV = (float*)(GAS float*)(ws + ows::DRV); P.AGA = (float*)(GAS float*)(ws + ows::AGA); P.AGB = (float*)(GAS float*)(ws + ows::AGB);
    P.OP = (bf16_t*)(GAS bf16_t*)(ws + ows::OP); P.ML = (f32x2*)(GAS f32x2*)(ws + ows::ML); P.MIX = (bf16_t*)(GAS bf16_t*)(ws + ows::MIX); P.Y = (bf16_t*)(GAS bf16_t*)(ws + ows::Y);
    P.EIDX = (int*)(GAS int*)(ws + ows::EIDX); P.HIST = (int*)(GAS int*)(ws + ows::HIST); P.LRANK = (int*)(GAS int*)(ws + ows::LRANK); P.DEST = (int*)(GAS int*)(ws + ows::DEST); P.ROWTOK = (int*)(GAS int*)(ws + ows::ROWTOK); P.GATE = (float*)(GAS float*)(ws + ows::GATE);
    P.HE = (bf16_t*)(GAS bf16_t*)(ws + ows::HE); P.YE = (bf16_t*)(GAS bf16_t*)(ws + ows::YE);
    return P;
}
__global__ void __launch_bounds__(NTHREADS, 2) mega_fwd(MArgs a) {
    extern __shared__ __attribute__((aligned(16))) unsigned char lds_raw[];
    LAS unsigned char* lds = (LAS unsigned char*)lds_raw;
    for (int u = threadIdx.x; u < (LDS_BYTES - LDSCTL_OFF) / 4; u += NTHREADS) ((LAS unsigned*)(lds + LDSCTL_OFF))[u] = 0u;
    __syncthreads();
    { LAS unsigned long long* PT = (LAS unsigned long long*)(lds + PT_OFF);
#pragma unroll
      for (int i = 0; i < 24; ++i) if (threadIdx.x == i) PT[i] = (unsigned long long)a.in[i];
      if (threadIdx.x == 24) PT[24] = (unsigned long long)a.X;
      if (threadIdx.x == 25) PT[25] = (unsigned long long)a.ws; }
    __syncthreads();
    XcdBarrier bar; { const OW P = load_ow(lds); bar = xcd_barrier_post(P.ctl + 4096, (volatile LAS unsigned*)(lds + MISC_OFF) + 8); }
    LAS int* TAB = (LAS int*)(lds + TAB_OFF);
    if (PH(0)) { const OW P = load_ow(lds); const int G = GDIM(); const int b_ = BID(); const int v_ = (G % 8 == 0) ? (b_ % 8) * (G / 8) + b_ / 8 : b_; prep_tables(P, v_, G); prep_weights(P, 0, lds, v_, G, 0, 136, 1); }
    xcd_barrier(bar);
    for (int l = 0; l < L; ++l) {
        for (int rep_ = 0; rep_ < (DUP(1) ? 2 : 1); ++rep_) if (PH(1)) { const OW P = load_ow(lds, 0); const int G = GDIM(); phase_inproj(P, lds, G); }
        if (PH(10)) {
            const OW P = load_ow(lds, 0); const int G = GDIM(), b_ = BID(); const int nmax = (576 + G - 1) / G, nfull = 576 - (nmax - 1) * G;
            constexpr int SPLIT = 1236;
            if (G == 256) { if (b_ >= nfull) prep_weights(P, l, lds, b_ - nfull, G - nfull, 136, SPLIT, 2); }
            else prep_weights(P, l, lds, b_, G, 136, 1 << 30, 2); }
        xcd_barrier(bar);
        for (int rep_ = 0; rep_ < (DUP(2) ? 2 : 1); ++rep_) if (PH(2)) { { const OW P = load_ow(lds, 0); const int G = GDIM(); SchedQKV Sd{&P, G, BID()}; EpiQKV E{P.SSQ, P.Q, P.KN, P.VV}; pg8::gemm_phase<true>(lds, Sd, E); }
                     { const OW P = load_ow(lds, 0); const int G = GDIM(); for (int tile = BID(); tile < NT / 64; tile += G) { gates_tile(P, l, lds, tile); if (DUP(15)) gates_tile(P, l, lds, tile); } }
                     if (PH(10)) { const OW P = load_ow(lds, 0); const int G = GDIM(), b_ = BID();
                         if (G == 256) { if (b_ < 192) { prep_weights(P, l, lds, b_, 192, 1236, 1 << 30, 0); if (l + 1 < L) prep_weights(P, l + 1, lds, b_, 192, 0, 136, 1); } }
                         else if (l + 1 < L) prep_weights(P, l + 1, lds, b_, G, 0, 136, 1); } }
        xcd_barrier(bar);
        for (int rep_ = 0; rep_ < (DUP(3) ? 2 : 1); ++rep_) if (PH(3)) { const OW P = load_ow(lds, 0); const int G = GDIM(); { const int b_ = BID(); phase_attn(P, lds, (G % 8 == 0) ? (b_ % 8) * (G / 8) + b_ / 8 : b_, G); } }
        xcd_barrier(bar);
        for (int rep_ = 0; rep_ < (DUP(4) ? 2 : 1); ++rep_) if (PH(4)) { const OW P = load_ow(lds, 0); const int G = GDIM(); for (int tile = BID(); tile < NT / 64; tile += G) mix_tile(P, lds, tile); }
        xcd_barrier(bar);
        for (int rep_ = 0; rep_ < (DUP(5) ? 2 : 1); ++rep_) if (PH(5)) { const OW P = load_ow(lds, 0); const int G = GDIM(); SchedOut Sd{&P, G, BID()}; EpiOut E{P.XB, P.Y}; pg8::gemm_phase<true>(lds, Sd, E); }
        xcd_barrier(bar);
        for (int rep_ = 0; rep_ < (DUP(6) ? 2 : 1); ++rep_) if (PH(6)) { const OW P = load_ow(lds, 0); const int G = GDIM(); for (int tile = BID(); tile < NT / 64; tile += G) { ln1_router_tile(P, l, lds, tile); if (DUP(13)) ln1_router_tile(P, l, lds, tile); } }
        xcd_barrier(bar);
        for (int rep_ = 0; rep_ < (DUP(7) ? 2 : 1); ++rep_) if (PH(7)) { const OW P = load_ow(lds, 0); const int G = GDIM(); moe_table(P, lds); for (int tile = BID(); tile < NT / 64; tile += G) dest_tile(P, lds, tile); }
        xcd_barrier(bar);
        for (int rep_ = 0; rep_ < (DUP(8) ? 2 : 1); ++rep_) if (PH(8)) { const OW P = load_ow(lds, 0); const int G = GDIM(); SchedMoe2 Sd; Sd.P = &P; Sd.TAB = TAB; Sd.cnt = P.ctl + MOECNT_W + l * 144 * 64; Sd.init(G, BID()); EpiMoe2 E{P.HE, P.YE}; pg8::gemm_phase<true>(lds, Sd, E); }
        xcd_barrier(bar);
        if (PH(10)) { const OW P = load_ow(lds, 0); const int G = GDIM(); { const int b_ = BID(); const int v_ = (G % 8 == 0) ? (b_ % 8) * (G / 8) + b_ / 8 : b_; ln2_rows(P, l, v_, G, l == L - 1 ? P.X : nullptr); } }
        if (l + 1 < L) xcd_barrier(bar);
        if (DUP(12)) for (int rep_ = 0; rep_ < 10; ++rep_) xcd_barrier(bar);
    }
}
#if MODE == 0
__global__ void shim_q(const bf16_t* Qb, float* Qf) { const size_t i = (size_t)blockIdx.x * 256 + threadIdx.x; if (i < (size_t)NT * QL) Qf[i] = bf2f(Qb[i]); }
__global__ void shim_kv(const bf16_t* KN, const bf16_t* VV, float* KV) { const size_t i = (size_t)blockIdx.x * 256 + threadIdx.x; if (i < (size_t)NT * 1024) { const size_t r = i >> 10; const int c = (int)(i & 1023), h = c >> 8, d = c & 255;
    KV[i] = d < 128 ? bf2f(KN[r * 512 + h * 128 + d]) : bf2f(VV[r * 512 + h * 128 + d - 128]); } }
__global__ void shim_kpe(const bf16_t* Kb, float* Kf) { const size_t i = (size_t)blockIdx.x * 256 + threadIdx.x; if (i < (size_t)NT * 64) Kf[i] = bf2f(Kb[i]); }
__global__ void shim_z(const bf16_t* Zb, float* Zf) { const size_t i = (size_t)blockIdx.x * 256 + threadIdx.x; if (i < (size_t)NT * INW) { const size_t r = i / INW, c = i % INW; Zf[i] = bf2f(Zb[r * ZW + c]); } }


#endif
#if MODE == 0
static OW make_ow(void* const* d_in, float* out, char* ws) {
    OW P{};
    for (int i = 0; i < 24; ++i) P.in[i] = (const float*)d_in[i];
    P.X = out; P.ctl = (unsigned*)(ws + ows::CTL); P.XB = (bf16_t*)(ws + ows::XB); P.Z = (bf16_t*)(ws + ows::Z); P.SSQ = (float*)(ws + ows::SSQ);
    P.Win_t = (bf16_t*)(ws + ows::WIN); P.Wq_t = (bf16_t*)(ws + ows::WQ); P.Wkv_t = (bf16_t*)(ws + ows::WKV); P.Wo_t = (bf16_t*)(ws + ows::WO); P.Wgu_t = (bf16_t*)(ws + ows::WGU); P.Wd_t = (bf16_t*)(ws + ows::WD); P.Wlg_t = (bf16_t*)(ws + ows::WLG);
    P.ROPE = (f32x2*)(ws + ows::ROPE); P.Q = (bf16_t*)(ws + ows::Q); P.KN = (bf16_t*)(ws + ows::KN); P.VV = (bf16_t*)(ws + ows::VV); P.KPE = (bf16_t*)(ws + ows::KPE);
    P.A = (float*)(ws + ows::A); P.DRV = (float*)(ws + ows::DRV); P.AGA = (float*)(ws + ows::AGA); P.AGB = (float*)(ws + ows::AGB);
    P.OP = (bf16_t*)(ws + ows::OP); P.ML = (f32x2*)(ws + ows::ML); P.MIX = (bf16_t*)(ws + ows::MIX); P.Y = (bf16_t*)(ws + ows::Y);
    P.EIDX = (int*)(ws + ows::EIDX); P.HIST = (int*)(ws + ows::HIST); P.LRANK = (int*)(ws + ows::LRANK); P.DEST = (int*)(ws + ows::DEST); P.ROWTOK = (int*)(ws + ows::ROWTOK); P.GATE = (float*)(ws + ows::GATE);
    P.HE = (bf16_t*)(ws + ows::HE); P.YE = (bf16_t*)(ws + ows::YE); P.RWH = (bf16_t*)(ws + ows::WLG + 262144); P.RGB = (float*)(ws + ows::WLG + 393216);
    return P;
}

#endif
constexpr int ATT_LDS = (4 * S + 4 * QH) * 4, MOEUP_LDS = D * 16 * 4 + 64;
#ifndef OPT_STAGES
#define OPT_STAGES 0
#endif
#ifndef OPT_LAYERS
#define OPT_LAYERS 1
#endif
#if MODE == 0
static void hybrid_forward(void* const* d_in, float* out, float* ws, hipStream_t st) {
    const float* x0 = (const float*)d_in[0];
    float* Z = ws + rws::Z; float* YE = Z; float* A = ws + rws::AB; float* DRV = A + (size_t)NT * LW; float* HID = A;
    float* Q = ws + rws::Q; float* KV = ws + rws::KV; float* Y = KV; float* KPE = ws + rws::KPE; float* MIX = ws + rws::MIX;
    float* GATE = ws + rws::GATE; int* CNT = (int*)(ws + rws::CNT); int* LIST = (int*)(ws + rws::LIST);
    OW P{};
    for (int i = 0; i < 24; ++i) P.in[i] = (const float*)d_in[i];
    P.X = out;
    char* tailp = (char*)(ws + rws::END);
    P.ctl = (unsigned*)tailp; tailp += 65536;
    P.ROPE = (f32x2*)tailp; tailp += (size_t)S * 32 * 8;
    P.SSQ = (float*)tailp; tailp += (size_t)NT * 16 * 4;
    P.Win_t = (bf16_t*)tailp; tailp += (size_t)ZW * D * 2;
    P.Wq_t = (bf16_t*)tailp; tailp += (size_t)768 * 768 * 2;
    P.Wkv_t = (bf16_t*)tailp; tailp += (size_t)1024 * 256 * 2;
    P.Wo_t = (bf16_t*)tailp; tailp += (size_t)1024 * 1024 * 2;
    P.Wlg_t = (bf16_t*)tailp; tailp += (size_t)8 * 128 * 64 * 2;
    P.Wgu_t = (bf16_t*)tailp; tailp += (size_t)16 * 1024 * 1024 * 2;
    P.Wd_t = (bf16_t*)tailp; tailp += (size_t)16 * 1024 * 512 * 2;
    P.AGA = (float*)tailp; tailp += (size_t)256 * LW * 4;
    P.AGB = (float*)tailp; tailp += (size_t)256 * LW * 4;
    P.OP = (bf16_t*)tailp; tailp += (size_t)2 * NT * 512 * 2;
    P.ML = (f32x2*)tailp; tailp += (size_t)2 * NT * 4 * 8;
    P.A = A; P.DRV = DRV;
    { char* m = (char*)(ws + rws::MIX) ; P.Q = (bf16_t*)m; m += (size_t)NT * QL * 2; P.KN = (bf16_t*)m; m += (size_t)NT * 512 * 2; P.VV = (bf16_t*)m; m += (size_t)NT * 512 * 2; P.KPE = (bf16_t*)m; }
    P.XB = (bf16_t*)(ws + rws::MIX);
    P.Z = (bf16_t*)(ws + rws::KV);
    P.Z = (bf16_t*)(ws + rws::Q);
    const OW PF = make_ow(d_in, out, (char*)ws);
    for (int l = 0; l < L; ++l) {
        if (l < OPT_LAYERS) {
            if (l == 0) opt_phase<<<256, NTHREADS, LDS_BYTES, st>>>(PF, 0, 0);
            for (int ph = 1; ph <= 10; ++ph) opt_phase<<<256, NTHREADS, LDS_BYTES, st>>>(PF, ph, l);
            continue;
        }
        const float* xin = l == 0 ? x0 : out;
        const float* w_in = (const float*)d_in[1] + (size_t)l * D * INW;
        const float* conv_w = (const float*)d_in[2] + (size_t)l * 4 * LW;
        const float* conv_b = (const float*)d_in[3] + (size_t)l * LW;
        const float* w_r = (const float*)d_in[4] + (size_t)l * 8 * 64 * 64;
        const float* b_r = (const float*)d_in[5] + (size_t)l * LW;
        const float* w_i = (const float*)d_in[6] + (size_t)l * 8 * 64 * 64;
        const float* b_i = (const float*)d_in[7] + (size_t)l * LW;
        const float* lam = (const float*)d_in[8] + (size_t)l * LW;
        const float* qng = (const float*)d_in[9] + (size_t)l * QL;
        const float* w_qup = (const float*)d_in[10] + (size_t)l * QL * 768;
        const float* kvng = (const float*)d_in[11] + (size_t)l * KVL;
        const float* w_kvup = (const float*)d_in[12] + (size_t)l * KVL * 1024;
        const float* ong = (const float*)d_in[13] + (size_t)l * 1024;
        const float* w_out = (const float*)d_in[14] + (size_t)l * 1024 * D;
        const float* ln1g = (const float*)d_in[15] + (size_t)l * D;
        const float* ln1b = (const float*)d_in[16] + (size_t)l * D;
        const float* rw = (const float*)d_in[17];
        const float* rb = (const float*)d_in[18];
        const float* wg = (const float*)d_in[19] + (size_t)l * NE * D * DE;
        const float* wu = (const float*)d_in[20] + (size_t)l * NE * D * DE;
        const float* wd = (const float*)d_in[21] + (size_t)l * NE * DE * D;
        const float* ln2g = (const float*)d_in[22] + (size_t)l * D;
        const float* ln2b = (const float*)d_in[23] + (size_t)l * D;
        const int nopt = l == 0 ? OPT_STAGES : 0;
        if (nopt >= 1) {
            opt_phase<<<256, NTHREADS, LDS_BYTES, st>>>(P, 0, l);
            opt_phase<<<256, NTHREADS, LDS_BYTES, st>>>(P, 1, l);
            if (nopt >= 2) opt_phase<<<256, NTHREADS, LDS_BYTES, st>>>(P, 2, l);
            if (nopt >= 3) opt_phase<<<256, NTHREADS, LDS_BYTES, st>>>(P, 3, l);
            shim_z<<<(unsigned)(((size_t)NT * INW + 255) / 256), 256, 0, st>>>(P.Z, Z);
        } else {
            ref::gemm<true><<<dim3(INW / 64, NT / 64), 256, 0, st>>>(xin, D, w_in, INW, Z, INW, D);
        }
        if (nopt >= 3) {
            ref::lru_scan<<<B * LW / 256, 256, 0, st>>>(A, DRV, Z, MIX);
            shim_attn<<<(unsigned)(((size_t)NT * 512 + 255) / 256), 256, 0, st>>>(P.OP, P.ML, MIX);
        } else if (nopt >= 2) {
            shim_q<<<(unsigned)(((size_t)NT * QL + 255) / 256), 256, 0, st>>>(P.Q, Q);
            shim_kv<<<(unsigned)(((size_t)NT * 1024 + 255) / 256), 256, 0, st>>>(P.KN, P.VV, KV);
            shim_kpe<<<(unsigned)(((size_t)NT * 64 + 255) / 256), 256, 0, st>>>(P.KPE, KPE);
            ref::lru_scan<<<B * LW / 256, 256, 0, st>>>(A, DRV, Z, MIX);
            ref::q_post<<<NT * 4 * 96 / 256, 256, 0, st>>>(Q);
        } else {
            ref::lru_gates<<<NT * LW / 256, 256, 0, st>>>(Z, conv_w, conv_b, w_r, b_r, w_i, b_i, lam, A, DRV);
            ref::lru_scan<<<B * LW / 256, 256, 0, st>>>(A, DRV, Z, MIX);
            ref::rmsnorm<<<NT / 4, 256, 0, st>>>(Z, INW, 1024, QL, qng);
            ref::rmsnorm<<<NT / 4, 256, 0, st>>>(Z, INW, 1792, KVL, kvng);
            ref::gemm<true><<<dim3(768 / 64, NT / 64), 256, 0, st>>>(Z + 1024, INW, w_qup, 768, Q, QL, QL);
            ref::gemm<true><<<dim3(1024 / 64, NT / 64), 256, 0, st>>>(Z + 1792, INW, w_kvup, 1024, KV, 1024, KVL);
            ref::q_post<<<NT * 4 * 96 / 256, 256, 0, st>>>(Q);
            ref::kpe_rope<<<NT * 32 / 256, 256, 0, st>>>(Z, KPE);
        }
        if (nopt < 3) ref::attention<<<B * H * S / 4, 64, ATT_LDS, st>>>(Q, KV, KPE, MIX);
        ref::rmsnorm<<<NT / 4, 256, 0, st>>>(MIX, D, 0, 512, ong);
        ref::rmsnorm<<<NT / 4, 256, 0, st>>>(MIX, D, 512, 512, ong + 512);
        ref::gemm<false><<<dim3(D / 64, NT / 64), 256, 0, st>>>(MIX, D, w_out, D, Y, D, 1024);
        ref::ln_res<<<NT / 4, 256, 0, st>>>(xin, Y, out, ln1g, ln1b);
        (void)hipMemsetAsync(CNT, 0, 64 * sizeof(int), st);
        ref::router<<<NT / 4, 256, 0, st>>>(out, rw, rb, GATE, CNT, LIST);
        ref::moe_up<<<dim3(NT / 16, NE), 256, MOEUP_LDS, st>>>(out, wg, wu, CNT, LIST, HID);
        ref::moe_down<<<dim3(NT / 16, NE), 256, 0, st>>>(HID, wd, CNT, LIST, YE);
        ref::ln_moe<<<NT / 4, 256, 0, st>>>(out, YE, GATE, ln2g, ln2b);
    }
}

#endif
extern "C" void kernel_launch(void* const* d_in, const int* in_sizes, int n_in, void* d_out, int out_size, void* d_ws, size_t ws_size, hipStream_t stream) {
    if (n_in != 24 || out_size != NT * D || ws_size < (size_t)536870912) {
        fprintf(stderr, "kernel_launch: unexpected shapes (n_in %d, out %d, ws %zu)\n", n_in, out_size, ws_size);
        return;
    }
#if MODE == 0
    static bool attr_done = false;
    if (!attr_done) { attr_done = true;
        (void)hipFuncSetAttribute((const void*)ref::attention, hipFuncAttributeMaxDynamicSharedMemorySize, ATT_LDS);
        (void)hipFuncSetAttribute((const void*)ref::moe_up, hipFuncAttributeMaxDynamicSharedMemorySize, MOEUP_LDS);
        (void)hipFuncSetAttribute((const void*)opt_phase, hipFuncAttributeMaxDynamicSharedMemorySize, LDS_BYTES);
    }
#endif
#if MODE == 0
    hybrid_forward(d_in, (float*)d_out, (float*)d_ws, stream);
#else
    static int grid = 0;
    if (grid == 0) { int dev = 0, cus = 0; (void)hipGetDevice(&dev); if (hipDeviceGetAttribute(&cus, hipDeviceAttributeMultiprocessorCount, dev) != hipSuccess || cus <= 0) cus = 256; grid = cus;
        (void)hipFuncSetAttribute((const void*)mega_fwd, hipFuncAttributeMaxDynamicSharedMemorySize, LDS_BYTES); }
    MArgs a{};
    for (int i = 0; i < 24; ++i) a.in[i] = (const float*)d_in[i];
    a.X = (float*)d_out; a.ws = (char*)d_ws;
    (void)hipMemsetAsync((char*)d_ws + ows::CTL, 0, 262144, stream);
    hipLaunchKernelGGL(mega_fwd, dim3(grid), dim3(NTHREADS), LDS_BYTES, stream, a);
#endif
}
```

```cpp
#include <hip/hip_runtime.h>
#include <cstdint>
#include <cstdio>

namespace cfg {
constexpr int D = 1024, B = 4, S = 4096, NT = B * S, L = 4;
constexpr int LW = 512, NBLK = 8, BLK = 64;
constexpr int H = 4, QNOPE = 128, QROPE = 64, QH = 192, VH = 128, QL = 768, KVL = 256;
constexpr int INW = 2112;
constexpr int NE = 16, DE = 512;
constexpr float ALPHA = 1.681792830507429f, EPS = 1e-6f;
}
using namespace cfg;

#ifndef MODE
#define MODE 1
#endif
#if MODE == 0
namespace ref {

__device__ __forceinline__ float wave_sum(float v) {
#pragma unroll
    for (int o = 1; o < 64; o <<= 1) v += __shfl_xor(v, o);
    return v;
}
__device__ __forceinline__ float wave_max(float v) {
#pragma unroll
    for (int o = 1; o < 64; o <<= 1) v = fmaxf(v, __shfl_xor(v, o));
    return v;
}
#define BF16_EMU 1
__device__ __forceinline__ float rb(float f) {
#if BF16_EMU
    unsigned u = __float_as_uint(f); u = (u + 0x7fffu + ((u >> 16) & 1u)) & 0xffff0000u; return __uint_as_float(u);
#else
    return f;
#endif
}
__device__ __forceinline__ float sigmoidf_(float x) { return 1.f / (1.f + expf(-x)); }
__device__ __forceinline__ float gelu_tanh(float x) { return 0.5f * x * (1.f + tanhf(0.7978845608028654f * (x + 0.044715f * x * x * x))); }

template <bool RO> __global__ __launch_bounds__(256) void gemm(const float* __restrict__ A, int lda, const float* __restrict__ Bm, int ldb, float* __restrict__ C, int ldc, int K) {
    __shared__ float As[16][68];
    __shared__ float Bs[16][68];
    const int tid = threadIdx.x, tx = tid & 15, ty = tid >> 4;
    const int m0 = blockIdx.y * 64, n0 = blockIdx.x * 64;
    float acc[4][4];
#pragma unroll
    for (int i = 0; i < 4; ++i)
#pragma unroll
        for (int j = 0; j < 4; ++j) acc[i][j] = 0.f;
    for (int k0 = 0; k0 < K; k0 += 16) {
#pragma unroll
        for (int it = 0; it < 4; ++it) { const int i = tid + it * 256; const int m = i >> 4, k = i & 15; As[k][m] = rb(A[(size_t)(m0 + m) * lda + k0 + k]); }
#pragma unroll
        for (int it = 0; it < 4; ++it) { const int i = tid + it * 256; const int k = i >> 6, n = i & 63; Bs[k][n] = rb(Bm[(size_t)(k0 + k) * ldb + n0 + n]); }
        __syncthreads();
#pragma unroll
        for (int k = 0; k < 16; ++k) {
            float a[4], b[4];
#pragma unroll
            for (int i = 0; i < 4; ++i) { a[i] = As[k][ty * 4 + i]; b[i] = Bs[k][tx * 4 + i]; }
#pragma unroll
            for (int i = 0; i < 4; ++i)
#pragma unroll
                for (int j = 0; j < 4; ++j) acc[i][j] = fmaf(a[i], b[j], acc[i][j]);
        }
        __syncthreads();
    }
#pragma unroll
    for (int i = 0; i < 4; ++i)
#pragma unroll
        for (int j = 0; j < 4; ++j) C[(size_t)(m0 + ty * 4 + i) * ldc + n0 + tx * 4 + j] = RO ? rb(acc[i][j]) : acc[i][j];
}

__global__ __launch_bounds__(256) void rmsnorm(float* X, int ld, int off, int n, const float* __restrict__ g) {
    const int row = blockIdx.x * 4 + (threadIdx.x >> 6), lane = threadIdx.x & 63;
    float* x = X + (size_t)row * ld + off;
    float s = 0.f;
    for (int i = lane; i < n; i += 64) { const float v = x[i]; s += v * v; }
    s = wave_sum(s);
    const float r = rsqrtf(s / (float)n + EPS);
    for (int i = lane; i < n; i += 64) x[i] = x[i] * r * g[i];
}

__global__ __launch_bounds__(256) void lru_gates(const float* __restrict__ Z, const float* __restrict__ conv_w, const float* __restrict__ conv_b,
                                                 const float* __restrict__ wr, const float* __restrict__ br, const float* __restrict__ wi, const float* __restrict__ bi,
                                                 const float* __restrict__ lam, float* __restrict__ Aout, float* __restrict__ Dout) {
    const int idx = blockIdx.x * 256 + threadIdx.x;
    const int tok = idx >> 9, ch = idx & 511, n = ch >> 6, d = ch & 63, s = tok & (S - 1);
    float accr = br[ch], acci = bi[ch], xc_own = 0.f;
    for (int c = 0; c < 64; ++c) {
        const int cc = n * 64 + c;
        float xc = conv_b[cc];
#pragma unroll
        for (int w = 0; w < 4; ++w) { const int sp = s + w - 3; if (sp >= 0) xc = fmaf(Z[(size_t)(tok + w - 3) * INW + cc], conv_w[w * LW + cc], xc); }
        accr = fmaf(xc, wr[(size_t)cc * 64 + d], accr);
        acci = fmaf(xc, wi[(size_t)cc * 64 + d], acci);
        if (c == d) xc_own = xc;
    }
    const float r = sigmoidf_(accr), ig = sigmoidf_(acci);
    const float sp = log1pf(expf(-lam[ch]));
    const float log_a = -8.0f * r * sp;
    Aout[idx] = expf(log_a);
    Dout[idx] = sqrtf(-expm1f(2.0f * log_a)) * (ig * xc_own);
}

__global__ __launch_bounds__(256) void lru_scan(const float* __restrict__ Ain, const float* __restrict__ Din, const float* __restrict__ Z, float* __restrict__ MIX) {
    const int idx = blockIdx.x * 256 + threadIdx.x;
    const int b = idx >> 9, ch = idx & 511;
    float h = 0.f;
    for (int s0 = 0; s0 < S; s0 += 8) {
        float a[8], d[8], g[8];
#pragma unroll
        for (int j = 0; j < 8; ++j) { const size_t t = (size_t)b * S + s0 + j; a[j] = Ain[t * LW + ch]; d[j] = Din[t * LW + ch]; g[j] = Z[t * INW + LW + ch]; }
#pragma unroll
        for (int j = 0; j < 8; ++j) { h = fmaf(a[j], h, d[j]); const size_t t = (size_t)b * S + s0 + j; MIX[t * D + ch] = h * gelu_tanh(g[j]); }
    }
}

__global__ __launch_bounds__(256) void q_post(float* Q) {
    const int idx = blockIdx.x * 256 + threadIdx.x;
    const int j = idx % 96, th = idx / 96, h = th & 3, tok = th >> 2, s = tok & (S - 1);
    float* q = Q + (size_t)tok * QL + h * QH;
    const float sc = 0.07216878364870322f;
    if (j < 64) { q[j] *= sc; q[j + 64] *= sc; }
    else {
        const int i = j - 64;
        const float inv = powf(10000.0f, -(float)i / 32.0f);
        const float ang = (float)s * inv;
        const float c = cosf(ang), sn = sinf(ang);
        const float x1 = q[128 + i], x2 = q[160 + i];
        q[128 + i] = (x1 * c - x2 * sn) * sc; q[160 + i] = (x1 * sn + x2 * c) * sc;
    }
}
__global__ __launch_bounds__(256) void kpe_rope(const float* __restrict__ Z, float* __restrict__ KPE) {
    const int idx = blockIdx.x * 256 + threadIdx.x;
    const int i = idx & 31, tok = idx >> 5, s = tok & (S - 1);
    const float inv = powf(10000.0f, -(float)i / 32.0f);
    const float ang = (float)s * inv;
    const float c = cosf(ang), sn = sinf(ang);
    const float x1 = Z[(size_t)tok * INW + 2048 + i], x2 = Z[(size_t)tok * INW + 2048 + 32 + i];
    KPE[(size_t)tok * 64 + i] = x1 * c - x2 * sn; KPE[(size_t)tok * 64 + 32 + i] = x1 * sn + x2 * c;
}

__global__ __launch_bounds__(64) void attention(const float* __restrict__ Q, const float* __restrict__ KV, const float* __restrict__ KPE, float* __restrict__ MIX) {
    extern __shared__ __attribute__((aligned(16))) float dyn_lds[];
    float (*sc)[S] = (float (*)[S])dyn_lds;
    float (*qs)[QH] = (float (*)[QH])(dyn_lds + 4 * S);
    const int lane = threadIdx.x;
    const int blk = blockIdx.x;
    const int qb = blk % (S / 4), bh = blk / (S / 4), h = bh & 3, b = bh >> 2;
    const int q0 = qb * 4;
    for (int i = lane; i < 4 * QH; i += 64) { const int r = i / QH, d = i % QH; qs[r][d] = rb(Q[(size_t)(b * S + q0 + r) * QL + h * QH + d]); }
    __syncthreads();
    const int nk = q0 + 4;
    for (int j = lane; j < nk; j += 64) {
        const float* kn = KV + (size_t)(b * S + j) * 1024 + h * 256;
        const float* kp = KPE + (size_t)(b * S + j) * 64;
        float d0 = 0.f, d1 = 0.f, d2 = 0.f, d3 = 0.f;
        for (int d = 0; d < 128; d += 4) {
            float4 kv = *(const float4*)(kn + d); kv.x = rb(kv.x); kv.y = rb(kv.y); kv.z = rb(kv.z); kv.w = rb(kv.w);
            d0 += kv.x * qs[0][d] + kv.y * qs[0][d + 1] + kv.z * qs[0][d + 2] + kv.w * qs[0][d + 3];
            d1 += kv.x * qs[1][d] + kv.y * qs[1][d + 1] + kv.z * qs[1][d + 2] + kv.w * qs[1][d + 3];
            d2 += kv.x * qs[2][d] + kv.y * qs[2][d + 1] + kv.z * qs[2][d + 2] + kv.w * qs[2][d + 3];
            d3 += kv.x * qs[3][d] + kv.y * qs[3][d + 1] + kv.z * qs[3][d + 2] + kv.w * qs[3][d + 3];
        }
        for (int d = 0; d < 64; d += 4) {
            float4 kv = *(const float4*)(kp + d); kv.x = rb(kv.x); kv.y = rb(kv.y); kv.z = rb(kv.z); kv.w = rb(kv.w);
            d0 += kv.x * qs[0][128 + d] + kv.y * qs[0][129 + d] + kv.z * qs[0][130 + d] + kv.w * qs[0][131 + d];
            d1 += kv.x * qs[1][128 + d] + kv.y * qs[1][129 + d] + kv.z * qs[1][130 + d] + kv.w * qs[1][131 + d];
            d2 += kv.x * qs[2][128 + d] + kv.y * qs[2][129 + d] + kv.z * qs[2][130 + d] + kv.w * qs[2][131 + d];
            d3 += kv.x * qs[3][128 + d] + kv.y * qs[3][129 + d] + kv.z * qs[3][130 + d] + kv.w * qs[3][131 + d];
        }
        const float NEG = -INFINITY;
        sc[0][j] = (j <= q0 + 0) ? d0 : NEG; sc[1][j] = (j <= q0 + 1) ? d1 : NEG; sc[2][j] = (j <= q0 + 2) ? d2 : NEG; sc[3][j] = (j <= q0 + 3) ? d3 : NEG;
    }
    __syncthreads();
    float inv_l[4];
#pragma unroll
    for (int r = 0; r < 4; ++r) {
        float m = -INFINITY;
        for (int j = lane; j < nk; j += 64) m = fmaxf(m, sc[r][j]);
        m = wave_max(m);
        float l = 0.f;
        for (int j = lane; j < nk; j += 64) { const float p = expf(sc[r][j] - m); sc[r][j] = rb(p); l += p; }
        l = wave_sum(l);
        inv_l[r] = 1.f / l;
    }
    __syncthreads();
    float o[4][2];
#pragma unroll
    for (int r = 0; r < 4; ++r) { o[r][0] = 0.f; o[r][1] = 0.f; }
    for (int j = 0; j < nk; ++j) {
        const float* v = KV + (size_t)(b * S + j) * 1024 + h * 256 + 128;
        const float v0 = rb(v[lane]), v1 = rb(v[lane + 64]);
#pragma unroll
        for (int r = 0; r < 4; ++r) { const float p = sc[r][j]; o[r][0] = fmaf(p, v0, o[r][0]); o[r][1] = fmaf(p, v1, o[r][1]); }
    }
#pragma unroll
    for (int r = 0; r < 4; ++r) {
        float* out = MIX + (size_t)(b * S + q0 + r) * D + 512 + h * 128;
        out[lane] = o[r][0] * inv_l[r]; out[lane + 64] = o[r][1] * inv_l[r];
    }
}

__global__ __launch_bounds__(256) void ln_res(const float* Xin, const float* __restrict__ Y, float* Xout, const float* __restrict__ g, const float* __restrict__ bta) {
    const int row = blockIdx.x * 4 + (threadIdx.x >> 6), lane = threadIdx.x & 63;
    float v[16]; float s = 0.f;
#pragma unroll
    for (int j = 0; j < 16; ++j) { const int c = lane + 64 * j; v[j] = ALPHA * Xin[(size_t)row * D + c] + Y[(size_t)row * D + c]; s += v[j]; }
    const float mu = wave_sum(s) * (1.f / D);
    float q = 0.f;
#pragma unroll
    for (int j = 0; j < 16; ++j) { v[j] -= mu; q += v[j] * v[j]; }
    const float r = rsqrtf(wave_sum(q) * (1.f / D) + EPS);
#pragma unroll
    for (int j = 0; j < 16; ++j) { const int c = lane + 64 * j; Xout[(size_t)row * D + c] = v[j] * r * g[c] + bta[c]; }
}
__global__ __launch_bounds__(256) void ln_moe(float* X, const float* __restrict__ YE, const float* __restrict__ GATE, const float* __restrict__ g, const float* __restrict__ bta) {
    const int row = blockIdx.x * 4 + (threadIdx.x >> 6), lane = threadIdx.x & 63;
    const float g0 = GATE[row * 2], g1 = GATE[row * 2 + 1];
    float v[16]; float s = 0.f;
#pragma unroll
    for (int j = 0; j < 16; ++j) { const int c = lane + 64 * j; v[j] = ALPHA * X[(size_t)row * D + c] + g0 * YE[(size_t)(2 * row) * D + c] + g1 * YE[(size_t)(2 * row + 1) * D + c]; s += v[j]; }
    const float mu = wave_sum(s) * (1.f / D);
    float q = 0.f;
#pragma unroll
    for (int j = 0; j < 16; ++j) { v[j] -= mu; q += v[j] * v[j]; }
    const float r = rsqrtf(wave_sum(q) * (1.f / D) + EPS);
#pragma unroll
    for (int j = 0; j < 16; ++j) { const int c = lane + 64 * j; X[(size_t)row * D + c] = v[j] * r * g[c] + bta[c]; }
}

__global__ __launch_bounds__(256) void router(const float* __restrict__ X, const float* __restrict__ RW, const float* __restrict__ RB, float* __restrict__ GATE, int* CNT, int* LIST) {
    const int tok = blockIdx.x * 4 + (threadIdx.x >> 6), lane = threadIdx.x & 63;
    float acc[16];
#pragma unroll
    for (int e = 0; e < 16; ++e) acc[e] = 0.f;
    for (int j = 0; j < 16; ++j) {
        const int i = lane + 64 * j;
        const float x = X[(size_t)tok * D + i];
        const float4* w = (const float4*)(RW + (size_t)i * 16);
        const float4 w0 = w[0], w1 = w[1], w2 = w[2], w3 = w[3];
        acc[0] = fmaf(x, w0.x, acc[0]); acc[1] = fmaf(x, w0.y, acc[1]); acc[2] = fmaf(x, w0.z, acc[2]); acc[3] = fmaf(x, w0.w, acc[3]);
        acc[4] = fmaf(x, w1.x, acc[4]); acc[5] = fmaf(x, w1.y, acc[5]); acc[6] = fmaf(x, w1.z, acc[6]); acc[7] = fmaf(x, w1.w, acc[7]);
        acc[8] = fmaf(x, w2.x, acc[8]); acc[9] = fmaf(x, w2.y, acc[9]); acc[10] = fmaf(x, w2.z, acc[10]); acc[11] = fmaf(x, w2.w, acc[11]);
        acc[12] = fmaf(x, w3.x, acc[12]); acc[13] = fmaf(x, w3.y, acc[13]); acc[14] = fmaf(x, w3.z, acc[14]); acc[15] = fmaf(x, w3.w, acc[15]);
    }
    float sg[16], ss[16];
#pragma unroll
    for (int e = 0; e < 16; ++e) { sg[e] = sigmoidf_(wave_sum(acc[e])); ss[e] = sg[e] + RB[e]; }
    int best_g = 0; float best = -INFINITY;
#pragma unroll
    for (int gI = 0; gI < 4; ++gI) {
        float m1 = -INFINITY, m2 = -INFINITY;
#pragma unroll
        for (int k = 0; k < 4; ++k) { const float v = ss[gI * 4 + k]; if (v > m1) { m2 = m1; m1 = v; } else if (v > m2) { m2 = v; } }
        const float gs = m1 + m2;
        if (gs > best) { best = gs; best_g = gI; }
    }
    float c0 = 0.f, c1 = 0.f, c2 = 0.f, c3 = 0.f, t0 = 0.f, t1 = 0.f, t2 = 0.f, t3 = 0.f;
#pragma unroll
    for (int gI = 0; gI < 4; ++gI) if (gI == best_g) { c0 = ss[gI * 4]; c1 = ss[gI * 4 + 1]; c2 = ss[gI * 4 + 2]; c3 = ss[gI * 4 + 3]; t0 = sg[gI * 4]; t1 = sg[gI * 4 + 1]; t2 = sg[gI * 4 + 2]; t3 = sg[gI * 4 + 3]; }
    int i1 = 0; float v1 = c0, s1 = t0;
    if (c1 > v1) { i1 = 1; v1 = c1; s1 = t1; }
    if (c2 > v1) { i1 = 2; v1 = c2; s1 = t2; }
    if (c3 > v1) { i1 = 3; v1 = c3; s1 = t3; }
    int i2 = -1; float v2 = -INFINITY, s2 = 0.f;
    if (i1 != 0 && c0 > v2) { i2 = 0; v2 = c0; s2 = t0; }
    if (i1 != 1 && c1 > v2) { i2 = 1; v2 = c1; s2 = t1; }
    if (i1 != 2 && c2 > v2) { i2 = 2; v2 = c2; s2 = t2; }
    if (i1 != 3 && c3 > v2) { i2 = 3; v2 = c3; s2 = t3; }
    if (lane == 0) {
        const int e1 = best_g * 4 + i1, e2 = best_g * 4 + i2;
        const float inv = 1.f / (s1 + s2);
        GATE[tok * 2] = s1 * inv; GATE[tok * 2 + 1] = s2 * inv;
        const int p1 = atomicAdd(&CNT[e1], 1); LIST[e1 * NT + p1] = tok * 2;
        const int p2 = atomicAdd(&CNT[e2], 1); LIST[e2 * NT + p2] = tok * 2 + 1;
    }
}

__global__ __launch_bounds__(256) void moe_up(const float* __restrict__ X, const float* __restrict__ Wg, const float* __restrict__ Wu, const int* __restrict__ CNT, const int* __restrict__ LIST, float* __restrict__ HID) {
    extern __shared__ __attribute__((aligned(16))) float dyn_lds[];
    float (*xs)[16] = (float (*)[16])dyn_lds;
    int* asg_s = (int*)(dyn_lds + D * 16);
    const int e = blockIdx.y, start = blockIdx.x * 16, cnt = CNT[e];
    if (start >= cnt) return;
    const int n = min(16, cnt - start), tid = threadIdx.x;
    if (tid < 16) asg_s[tid] = tid < n ? LIST[e * NT + start + tid] : -1;
    __syncthreads();
    for (int i = tid; i < 16 * D; i += 256) { const int r = i >> 10, k = i & 1023; const int a = asg_s[r]; xs[k][r] = a >= 0 ? rb(X[(size_t)(a >> 1) * D + k]) : 0.f; }
    __syncthreads();
    float g0[16], g1[16], u0[16], u1[16];
#pragma unroll
    for (int r = 0; r < 16; ++r) { g0[r] = 0.f; g1[r] = 0.f; u0[r] = 0.f; u1[r] = 0.f; }
    const float* wg = Wg + (size_t)e * D * DE; const float* wu = Wu + (size_t)e * D * DE;
    for (int k = 0; k < D; ++k) {
        const float a0 = rb(wg[(size_t)k * DE + tid]), a1 = rb(wg[(size_t)k * DE + tid + 256]), b0 = rb(wu[(size_t)k * DE + tid]), b1 = rb(wu[(size_t)k * DE + tid + 256]);
#pragma unroll
        for (int r = 0; r < 16; ++r) { const float x = xs[k][r]; g0[r] = fmaf(x, a0, g0[r]); g1[r] = fmaf(x, a1, g1[r]); u0[r] = fmaf(x, b0, u0[r]); u1[r] = fmaf(x, b1, u1[r]); }
    }
#pragma unroll
    for (int r = 0; r < 16; ++r) { const int a = asg_s[r]; if (a >= 0) {
        HID[(size_t)a * DE + tid] = g0[r] * sigmoidf_(g0[r]) * u0[r]; HID[(size_t)a * DE + tid + 256] = g1[r] * sigmoidf_(g1[r]) * u1[r]; } }
}
__global__ __launch_bounds__(256) void moe_down(const float* __restrict__ HID, const float* __restrict__ Wd, const int* __restrict__ CNT, const int* __restrict__ LIST, float* __restrict__ YE) {
    __shared__ float hs[DE][16];
    __shared__ int asg_s[16];
    const int e = blockIdx.y, start = blockIdx.x * 16, cnt = CNT[e];
    if (start >= cnt) return;
    const int n = min(16, cnt - start), tid = threadIdx.x;
    if (tid < 16) asg_s[tid] = tid < n ? LIST[e * NT + start + tid] : -1;
    __syncthreads();
    for (int i = tid; i < 16 * DE; i += 256) { const int r = i >> 9, k = i & 511; const int a = asg_s[r]; hs[k][r] = a >= 0 ? rb(HID[(size_t)a * DE + k]) : 0.f; }
    __syncthreads();
    float y0[16], y1[16], y2[16], y3[16];
#pragma unroll
    for (int r = 0; r < 16; ++r) { y0[r] = 0.f; y1[r] = 0.f; y2[r] = 0.f; y3[r] = 0.f; }
    const float* wd = Wd + (size_t)e * DE * D;
    for (int k = 0; k < DE; ++k) {
        const float a0 = rb(wd[(size_t)k * D + tid]), a1 = rb(wd[(size_t)k * D + tid + 256]), a2 = rb(wd[(size_t)k * D + tid + 512]), a3 = rb(wd[(size_t)k * D + tid + 768]);
#pragma unroll
        for (int r = 0; r < 16; ++r) { const float x = hs[k][r]; y0[r] = fmaf(x, a0, y0[r]); y1[r] = fmaf(x, a1, y1[r]); y2[r] = fmaf(x, a2, y2[r]); y3[r] = fmaf(x, a3, y3[r]); }
    }
#pragma unroll
    for (int r = 0; r < 16; ++r) { const int a = asg_s[r]; if (a >= 0) { float* y = YE + (size_t)a * D; y[tid] = rb(y0[r]); y[tid + 256] = rb(y1[r]); y[tid + 512] = rb(y2[r]); y[tid + 768] = rb(y3[r]); } }
}

}

namespace rws {
constexpr size_t Z = 0;
constexpr size_t AB = Z + (size_t)NT * INW;
constexpr size_t Q = AB + (size_t)NT * 1024;
constexpr size_t KV = Q + (size_t)NT * QL;
constexpr size_t KPE = KV + (size_t)NT * 1024;
constexpr size_t MIX = KPE + (size_t)NT * 64;
constexpr size_t GATE = MIX + (size_t)NT * 1024;
constexpr size_t CNT = GATE + (size_t)NT * 2;
constexpr size_t LIST = CNT + 64;
constexpr size_t END = LIST + (size_t)NE * NT;
}


#endif
#ifndef MODE
#define MODE 1
#endif
#define LAS __attribute__((address_space(3)))
#ifndef PH
#define PH(k) 1
#endif
#ifndef DUP
#define DUP(k) 0
#endif
#define TID() ({ int _t = (int)threadIdx.x; asm volatile("" : "+v"(_t)); _t; })
#define BID() ({ int _b = (int)blockIdx.x; asm volatile("" : "+s"(_b)); _b; })
#define GDIM() ({ int _g = (int)gridDim.x; asm volatile("" : "+s"(_g)); _g; })
#define GAS __attribute__((address_space(1)))
typedef unsigned short bf16_t;
typedef short bf16x8 __attribute__((ext_vector_type(8)));
typedef float f32x4 __attribute__((ext_vector_type(4)));
typedef float f32x2 __attribute__((ext_vector_type(2)));
typedef unsigned u32x4 __attribute__((ext_vector_type(4)));
typedef unsigned u32x2 __attribute__((ext_vector_type(2)));

__device__ __forceinline__ unsigned f2bf(float f) { unsigned u = __builtin_bit_cast(unsigned, f); return (u + 0x7fffu + ((u >> 16) & 1u)) >> 16; }
__device__ __forceinline__ unsigned pk2(float lo, float hi) { return f2bf(lo) | (f2bf(hi) << 16); }
__device__ __forceinline__ float bf2f(unsigned short h) { return __builtin_bit_cast(float, (unsigned)h << 16); }
__device__ __forceinline__ float bflo(unsigned w) { return __builtin_bit_cast(float, w << 16); }
__device__ __forceinline__ float bfhi(unsigned w) { return __builtin_bit_cast(float, w & 0xffff0000u); }

namespace pg8 {
constexpr int BM = 256, BK = 64, HALF = 128, HTB = HALF * BK * 2, STAGE_BYTES = 8 * HTB;
__host__ __device__ __forceinline__ int lds_byte(int r, int c) { const int st = (r >> 4) * 2 + (c >> 5), rr = r & 15, cc = c & 31, ob = rr * 64 + cc * 2; return st * 1024 + (ob ^ (((ob >> 9) & 1) << 5)); }
__host__ __device__ __forceinline__ void stage_rc(int b, int& R, int& C) { const int st = b / 1024, sb = b % 1024, swz = sb ^ (((sb >> 9) & 1) << 5); R = (st >> 1) * 16 + swz / 64; C = (st & 1) * 32 + (swz % 64) / 2; }
__host__ __device__ __forceinline__ int perm32(int rho) { const int n = rho >> 4, i = rho & 15; return 8 * (i >> 2) + 4 * n + (i & 3); }

struct UnitD { const char* A; const int* rows; const char* B; unsigned lda, ldb; int nt; int type, pm, pn, aux; };

__device__ __forceinline__ unsigned cvt_pk_bf16(float lo, float hi) { unsigned r; asm volatile("v_cvt_pk_bf16_f32 %0, %1, %2" : "=v"(r) : "v"(lo), "v"(hi)); return r; }

template <bool PERM, class Sched, class Epi>
__device__ __forceinline__ void gemm_phase(LAS unsigned char* lds, const Sched& S, const Epi& E) {
    const int tid = TID(), wid = __builtin_amdgcn_readfirstlane(tid >> 6), wr = wid >> 2;
    const size_t kstep = (size_t)(BK * 2);
    const unsigned ldsw = (unsigned)wid * 1024u;
    int aoff, boff; { const int lane = tid & 63, wc = wid & 3, fr = lane & 15, fq = lane >> 4; aoff = lds_byte(wr * 64 + fr, fq * 8); boff = lds_byte(wc * 32 + fr, fq * 8); }
#define PG8_SA(b, h) (((b) * 2 + (h)) * HTB)
#define PG8_SB(b, h) ((4 + (b) * 2 + (h)) * HTB)
#define PG8_STAGE(bufoff, gbase, voff) do { _Pragma("unroll") for (int _i = 0; _i < 2; ++_i) \
        __builtin_amdgcn_global_load_lds((const unsigned*)((const char*)(gbase) + (voff)[_i]), (LAS unsigned*)(lds + (bufoff) + ldsw + _i * 8192), 16, 0, 0); } while (0)
#define PG8_LDA(dst, b, h) do { _Pragma("unroll") for (int m = 0; m < 4; ++m) _Pragma("unroll") for (int k = 0; k < 2; ++k) dst[m][k] = *(const LAS bf16x8*)(lds + PG8_SA(b, h) + aoff + m * 2048 + k * 1024); } while (0)
#define PG8_LDB(dst, b, h) do { _Pragma("unroll") for (int n = 0; n < 2; ++n) _Pragma("unroll") for (int k = 0; k < 2; ++k) dst[n][k] = *(const LAS bf16x8*)(lds + PG8_SB(b, h) + boff + n * 2048 + k * 1024); } while (0)
#define PG8_MMA(ai, bj, At, Bt) do { __builtin_amdgcn_s_setprio(1); _Pragma("unroll") for (int m = 0; m < 4; ++m) _Pragma("unroll") for (int n = 0; n < 2; ++n) _Pragma("unroll") for (int k = 0; k < 2; ++k) \
        acc[ai][bj][m][n] = __builtin_amdgcn_mfma_f32_16x16x32_bf16(Bt[n][k], At[m][k], acc[ai][bj][m][n], 0, 0, 0); __builtin_amdgcn_s_setprio(0); } while (0)
#define PG8_WAIT_V(n) asm volatile("s_waitcnt vmcnt(" #n ")" ::: "memory")
#define PG8_WAIT_L(n) asm volatile("s_waitcnt lgkmcnt(" #n ")" ::: "memory")
#define PG8_BAR __builtin_amdgcn_s_barrier()
#define PG8_SCHED __builtin_amdgcn_sched_barrier(0)
#define PG8_OFFS(u) do { int t_ = tid; asm volatile("" : "+v"(t_)); int R0, C0, R1, C1; stage_rc(t_ * 16, R0, C0); stage_rc(t_ * 16 + 8192, R1, C1); \
        const int RB0 = PERM ? ((R0 & ~31) + perm32(R0 & 31)) : R0, RB1 = PERM ? ((R1 & ~31) + perm32(R1 & 31)) : R1; const unsigned Cb = (unsigned)C0 * 2u; \
        if ((u).rows) { vA[0][0] = (unsigned)(u).rows[R0] * (u).lda + Cb; vA[0][1] = (unsigned)(u).rows[R1] * (u).lda + Cb; \
                                        vA[1][0] = (unsigned)(u).rows[128 + R0] * (u).lda + Cb; vA[1][1] = (unsigned)(u).rows[128 + R1] * (u).lda + Cb; } \
        else { vA[0][0] = (unsigned)R0 * (u).lda + Cb; vA[0][1] = (unsigned)R1 * (u).lda + Cb; vA[1][0] = (unsigned)(128 + R0) * (u).lda + Cb; vA[1][1] = (unsigned)(128 + R1) * (u).lda + Cb; } \
        vB[0] = (unsigned)RB0 * (u).ldb + Cb; vB[1] = (unsigned)RB1 * (u).ldb + Cb; hB = (size_t)128 * (u).ldb; } while (0)
#define PG8_EPI(u) do { int t_ = tid; asm volatile("" : "+v"(t_)); const int lane_ = t_ & 63; E(acc, (u), wr, wid & 3, lane_ & 15, lane_ >> 4); if (DUP(16)) E(acc, (u), wr, wid & 3, lane_ & 15, lane_ >> 4); if constexpr (Sched::HOOKS) S.done((u), lane_); } while (0)
    UnitD cur, nxt; int ui = 0;
    if (!S.next(0, cur)) return;
    f32x4 acc[2][2][4][2];
#pragma unroll
    for (int a = 0; a < 2; ++a)
#pragma unroll
        for (int b = 0; b < 2; ++b)
#pragma unroll
            for (int m = 0; m < 4; ++m)
#pragma unroll
                for (int n = 0; n < 2; ++n) acc[a][b][m][n] = (f32x4){0.f, 0.f, 0.f, 0.f};
    bf16x8 At[4][2], B0[2][2], B1[2][2];
    unsigned vA[2][2], vB[2]; size_t hB;
    if constexpr (Sched::HOOKS) S.a_ready(cur, wid);
    PG8_OFFS(cur);
    const char* cA = cur.A; const char* cB = cur.B; int nt = cur.nt;
    PG8_STAGE(PG8_SB(0, 0), cB, vB); PG8_STAGE(PG8_SB(0, 1), cB + hB, vB); PG8_STAGE(PG8_SA(0, 0), cA, vA[0]); PG8_STAGE(PG8_SA(0, 1), cA, vA[1]);
    if (wr == 1) PG8_BAR;
    PG8_WAIT_V(2); PG8_BAR;
    PG8_STAGE(PG8_SB(1, 0), cB + kstep, vB); PG8_STAGE(PG8_SA(1, 0), cA + kstep, vA[0]); PG8_STAGE(PG8_SB(1, 1), cB + hB + kstep, vB);
    PG8_WAIT_V(6); PG8_BAR;
    for (;;) {
        const bool has_next = S.next(ui + 1, nxt);
        for (int t = 0; t < nt; t += 2) {
            const bool last = (t == nt - 2);
            if constexpr (Sched::HOOKS) { if (last && has_next) S.a_ready(nxt, wid); }
            const char* a1 = cA + (size_t)(t + 1) * kstep;
            PG8_LDB(B0, 0, 0); PG8_LDB(B1, 0, 1); PG8_SCHED; PG8_LDA(At, 0, 0); PG8_STAGE(PG8_SA(1, 1), a1, vA[1]);
            PG8_WAIT_V(8); PG8_WAIT_L(0); PG8_BAR; PG8_MMA(0, 0, At, B0); PG8_MMA(0, 1, At, B1); PG8_BAR; PG8_SCHED;
            const char* a2; const char* b2;
            if (last) { if (has_next) { PG8_OFFS(nxt); a2 = nxt.A; b2 = nxt.B; } else { a2 = cA; b2 = cB; } }
            else { a2 = cA + (size_t)(t + 2) * kstep; b2 = cB + (size_t)(t + 2) * kstep; }
            const char* a3 = a2 + kstep; const char* b3 = b2 + kstep;
            PG8_LDA(At, 0, 1); PG8_STAGE(PG8_SB(0, 0), b2, vB); PG8_STAGE(PG8_SB(0, 1), b2 + hB, vB); PG8_STAGE(PG8_SA(0, 0), a2, vA[0]);
            PG8_WAIT_V(8); PG8_WAIT_L(0); PG8_BAR; PG8_MMA(1, 0, At, B0); PG8_MMA(1, 1, At, B1); PG8_BAR; PG8_SCHED;
            PG8_LDB(B0, 1, 0); PG8_LDB(B1, 1, 1); PG8_SCHED; PG8_LDA(At, 1, 0); PG8_STAGE(PG8_SA(0, 1), a2, vA[1]);
            PG8_WAIT_V(8); PG8_WAIT_L(0); PG8_BAR; PG8_MMA(0, 0, At, B0); PG8_MMA(0, 1, At, B1); PG8_BAR; PG8_SCHED;
            PG8_LDA(At, 1, 1); PG8_STAGE(PG8_SB(1, 0), b3, vB); PG8_STAGE(PG8_SB(1, 1), b3 + hB, vB); PG8_STAGE(PG8_SA(1, 0), a3, vA[0]);
            PG8_WAIT_V(8); PG8_WAIT_L(0); PG8_BAR; PG8_MMA(1, 0, At, B0); PG8_MMA(1, 1, At, B1); PG8_BAR; PG8_SCHED;
        }
        if (wr == 0) PG8_BAR;
        PG8_EPI(cur);
        if (!has_next) break;
#pragma unroll
        for (int a = 0; a < 2; ++a)
#pragma unroll
            for (int b = 0; b < 2; ++b)
#pragma unroll
                for (int m = 0; m < 4; ++m)
#pragma unroll
                    for (int n = 0; n < 2; ++n) acc[a][b][m][n] = (f32x4){0.f, 0.f, 0.f, 0.f};
        cur = nxt; cA = nxt.A; cB = nxt.B; nt = nxt.nt; ++ui;
        if (wr == 1) PG8_BAR;
    }
    PG8_WAIT_V(0);
    PG8_BAR;
#undef PG8_SA
#undef PG8_SB
#undef PG8_STAGE
#undef PG8_LDA
#undef PG8_LDB
#undef PG8_MMA
#undef PG8_WAIT_V
#undef PG8_WAIT_L
#undef PG8_BAR
#undef PG8_SCHED
#undef PG8_OFFS
#undef PG8_EPI
}
__device__ __forceinline__ void tile_order(int L, int nM, int nN, int& pm, int& pn) {
    const int nwg = nM * nN; int wgid = L;
    { const int q = nwg / 8, r = nwg % 8, xcd = wgid % 8, off = wgid / 8; wgid = (xcd < r ? xcd * (q + 1) : r * (q + 1) + (xcd - r) * q) + off; }
    const int nig = 8 * nN, gid = wgid / nig, fm = gid * 8, gsz = (nM - fm) < 8 ? (nM - fm) : 8;
    pm = fm + ((wgid % nig) % gsz); pn = (wgid % nig) / gsz;
}
}

#define XB_TMO      128
#define XB_XCNT(j)  (256  + 64 * (j))
#define XB_XSUB(j)  (1280 + 64 * (j))
#define XB_XGEN(j)  (2304 + 64 * (j))
#define XB_TOP      3328
#define XB_TOPGEN   3392
#define XCD_BAR_WORDS 3456
#define XB_SPIN_CAP (1u << 18)
__device__ __forceinline__ unsigned xb_ld(unsigned* p)              { return __hip_atomic_load(p, __ATOMIC_RELAXED, __HIP_MEMORY_SCOPE_AGENT); }
__device__ __forceinline__ unsigned xb_add(unsigned* p, unsigned v) { return __hip_atomic_fetch_add(p, v, __ATOMIC_RELAXED, __HIP_MEMORY_SCOPE_AGENT); }
__device__ __forceinline__ unsigned xb_xcc_id() { return (unsigned)__builtin_amdgcn_s_getreg((3 << 11) | 20) & 0xFu; }
#define XB_SPIN(cond, bar) do { unsigned _sp = 0; while (cond) { __builtin_amdgcn_s_sleep(1); \
    if ((++_sp & 255u) == 0u) { if (xb_ld(&(bar)[XB_TMO])) break; if (_sp > XB_SPIN_CAP) { atomicAdd(&(bar)[XB_TMO], 1u); break; } } } } while (0)
struct XcdBarrier { unsigned* bar; unsigned x; volatile LAS unsigned* st; };
__device__ __forceinline__ XcdBarrier xcd_barrier_post(unsigned* bar, volatile LAS unsigned* st) {
    XcdBarrier b; b.bar = bar; b.x = xb_xcc_id(); b.st = st;
    if (threadIdx.x == 0) (void)xb_add(&bar[XB_XCNT(b.x)], 1u);
    return b;
}
__device__ __forceinline__ void xcd_barrier_complete(unsigned* bar, unsigned x, unsigned& nloc, unsigned& nx) {
    const unsigned G = gridDim.x * gridDim.y * gridDim.z;
    unsigned sum, cnt, mine, sp = 0u;
    for (;;) {
        sum = 0u; cnt = 0u;
#pragma unroll
        for (unsigned j = 0; j < 16; ++j) { const unsigned c = xb_ld(&bar[XB_XCNT(j)]); sum += c; cnt += (c > 0u) ? 1u : 0u; }
        if (sum == G) break;
        __builtin_amdgcn_s_sleep(1);
        if ((++sp & 255u) == 0u) { if (xb_ld(&bar[XB_TMO])) break; if (sp > XB_SPIN_CAP) { atomicAdd(&bar[XB_TMO], 1u); break; } }
    }
    mine = xb_ld(&bar[XB_XCNT(x)]);
    nloc = mine > 0u ? mine : 1u; nx = cnt > 0u ? cnt : 1u;
}
__device__ __forceinline__ void xcd_barrier(const XcdBarrier& b) {
    asm volatile("s_waitcnt vmcnt(0)" ::: "memory");
    __syncthreads();
    if (threadIdx.x == 0) {
        unsigned* bar = b.bar; unsigned bx_ = b.x;
        asm volatile("" : "+s"(bar), "+s"(bx_));
        __builtin_amdgcn_s_waitcnt(0);
        unsigned nloc = b.st[0], nx = b.st[1];
        if (nloc == 0u) { xcd_barrier_complete(bar, bx_, nloc, nx); b.st[0] = nloc; b.st[1] = nx; }
        const unsigned old = xb_add(&bar[XB_XSUB(bx_)], 1u);
        const unsigned gen = old / nloc;
        if (old + 1u == (gen + 1u) * nloc) {
            __builtin_amdgcn_fence(__ATOMIC_RELEASE, "agent");
            asm volatile("s_waitcnt vmcnt(0)" ::: "memory");
            const unsigned og = xb_add(&bar[XB_TOP], 1u);
            const unsigned tg = og / nx;
            if (og + 1u == (tg + 1u) * nx) xb_add(&bar[XB_TOPGEN], 1u);
            else XB_SPIN(xb_ld(&bar[XB_TOPGEN]) == tg, bar);
            __builtin_amdgcn_fence(__ATOMIC_ACQUIRE, "agent");
            xb_add(&bar[XB_XGEN(bx_)], 1u);
            asm volatile("s_waitcnt vmcnt(0)" ::: "memory");
        } else {
            XB_SPIN(xb_ld(&bar[XB_XGEN(bx_)]) == gen, bar);
            __builtin_amdgcn_fence(__ATOMIC_ACQUIRE, "agent");
            asm volatile("s_waitcnt vmcnt(0)" ::: "memory");
        }
    }
    __syncthreads();
}

constexpr int MOECNT_W = 16384;
constexpr int ZW = 2304;
constexpr int NWAVES = 8, NTHREADS = 512;
constexpr int RING_BYTES = 131072, LDS_BYTES = 163840, LDSCTL_OFF = LDS_BYTES - 4096, MISC_OFF = LDSCTL_OFF + 320, TAB_OFF = LDSCTL_OFF + 1024;
struct OW {
    const float* in[24];
    float* X;
    unsigned* ctl;
    bf16_t* XB;
    bf16_t* Z;
    float* SSQ;
    bf16_t *Win_t, *Wq_t, *Wkv_t, *Wo_t, *Wgu_t, *Wd_t, *Wlg_t;
    bf16_t* RWH; float* RGB;
    f32x2* ROPE;
    bf16_t *Q, *KN, *VV, *KPE;
    float *A, *DRV, *AGA, *AGB;
    bf16_t* OP; f32x2* ML;
    bf16_t* MIX; bf16_t* Y;
    int *EIDX, *HIST, *LRANK, *DEST, *ROWTOK; float* GATE;
    bf16_t *HE, *YE;
};

namespace ows {
constexpr size_t MiB = 1u << 20;
constexpr size_t CTL = 0, ROPE = 1 * MiB, SSQ = 2 * MiB, EIDX = 3 * MiB, GATE = EIDX + 131072, LRANK = GATE + 131072, DEST = LRANK + 131072, HIST = DEST + 131072, ROWTOK = HIST + 16384;
constexpr size_t AGA = 4 * MiB, AGB = AGA + 524288, ML = 5 * MiB, WLG = 6 * MiB, WIN = 7 * MiB, WQ = 12 * MiB, WKV = 14 * MiB, WO = 15 * MiB, WGU = 17 * MiB, WD = 49 * MiB;
constexpr size_t XB = 65 * MiB, Z = 97 * MiB, Y = Z, A = 169 * MiB, DRV = 201 * MiB, Q = 233 * MiB, YE = A, KN = 257 * MiB, VV = 273 * MiB, KPE = 289 * MiB, OP = 291 * MiB, HE = KN, MIX = 323 * MiB, WSET1 = 355 * MiB - WLG  , END = 414 * MiB;
static_assert(ROWTOK + 36864 * 4 <= AGA && WIN + (size_t)ZW * D * 2 <= WQ && YE + (size_t)36864 * 1024 * 2 <= KN && HE + (size_t)36864 * 512 * 2 <= OP + 32 * MiB && Z + (size_t)NT * ZW * 2 <= A, "opt workspace map");
}
__device__ __forceinline__ void tr_item(const float* W, int ldw, int k0, int n0, bf16_t* WT, int ldt, int drow0, const float* g, LAS float* scr, int lane) {
    float tv[32];
#pragma unroll
    for (int i = 0; i < 32; ++i) { const int kk = 2 * i + (lane >> 5); tv[i] = W[(size_t)(k0 + kk) * ldw + n0 + (lane & 31)]; }
    if (g) {
#pragma unroll
        for (int i = 0; i < 32; ++i) tv[i] *= g[k0 + 2 * i + (lane >> 5)]; }
#pragma unroll
    for (int i = 0; i < 32; ++i) scr[(2 * i + (lane >> 5)) * 33 + (lane & 31)] = tv[i];
    asm volatile("s_waitcnt lgkmcnt(0)" ::: "memory");
    const int c = lane & 7;
#pragma unroll
    for (int j = 0; j < 4; ++j) { const int n = (lane >> 3) + 8 * j; const LAS float* s = scr + (8 * c) * 33 + n;
        u32x4 o; o.x = pk2(s[0 * 33], s[1 * 33]); o.y = pk2(s[2 * 33], s[3 * 33]); o.z = pk2(s[4 * 33], s[5 * 33]); o.w = pk2(s[6 * 33], s[7 * 33]);
        *(u32x4*)(WT + (size_t)(drow0 + n) * ldt + k0 + 8 * c) = o; }
    asm volatile("s_waitcnt lgkmcnt(0)" ::: "memory");
}
struct PrepItem { const float* W; const float* g; bf16_t* WT; int ldw, ldt, k0, n0, drow0, ncols; };
__device__ __forceinline__ PrepItem prep_item(const OW& P, int l, int it) {
    const float* w_in = P.in[1] + (size_t)l * D * INW;
    const float* qng = P.in[9] + (size_t)l * QL;   const float* w_q = P.in[10] + (size_t)l * QL * 768;
    const float* kvng = P.in[11] + (size_t)l * KVL; const float* w_kv = P.in[12] + (size_t)l * KVL * 1024;
    const float* ong = P.in[13] + (size_t)l * 1024; const float* w_o = P.in[14] + (size_t)l * 1024 * D;
    const float* wg = P.in[19] + (size_t)l * NE * D * DE; const float* wu = P.in[20] + (size_t)l * NE * D * DE; const float* wd = P.in[21] + (size_t)l * NE * DE * D;
    constexpr int I_IN = 8 * 17, I_Q = 6 * 6, I_KV = 2 * 8, I_O = 8 * 8, I_G = 16 * 8 * 4, I_D = 16 * 4 * 8;
    PrepItem p; int r = it;
    if (r < I_IN) { const int kb = r / 17, nb = r % 17; p = PrepItem{w_in, nullptr, P.Win_t, INW, D, 128 * kb, 128 * nb, 128 * nb, nb == 16 ? 64 : 128}; return p; } r -= I_IN;
    if (r < I_Q) { const int kb = r / 6, nb = r % 6; p = PrepItem{w_q, qng, P.Wq_t, 768, QL, 128 * kb, 128 * nb, 128 * nb, 128}; return p; } r -= I_Q;
    if (r < I_KV) { const int kb = r / 8, nb = r % 8; p = PrepItem{w_kv, kvng, P.Wkv_t, 1024, KVL, 128 * kb, 128 * nb, 128 * nb, 128}; return p; } r -= I_KV;
    if (r < I_O) { const int kb = r / 8, nb = r % 8; p = PrepItem{w_o, ong, P.Wo_t, D, 1024, 128 * kb, 128 * nb, 128 * nb, 128}; return p; } r -= I_O;
    if (r < 2 * I_G) { const int up = r >= I_G; if (up) r -= I_G; const int e = r >> 5, q = r & 31, kb = q >> 2, nb = q & 3;
        p = PrepItem{(up ? wu : wg) + (size_t)e * D * DE, nullptr, P.Wgu_t + (size_t)e * 1024 * 1024, DE, 1024, 128 * kb, 128 * nb, 256 * nb + 128 * up, 128}; return p; }
    r -= 2 * I_G;
    { const int e = r >> 5, q = r & 31, kb = q >> 3, nb = q & 7; p = PrepItem{wd + (size_t)e * DE * D, nullptr, P.Wd_t + (size_t)e * 1024 * DE, D, DE, 128 * kb, 128 * nb, 128 * nb, 128}; }
    return p;
}
__device__ __forceinline__ void prep_weights(const OW& P, int l, LAS unsigned char* lds, int vcu, int G, int it0 = 0, int it1 = 1 << 30, int tail = 3) {
    const int tid = TID();
    LAS float* scr = (LAS float*)lds;
    constexpr int NITEMS = 8 * 17 + 6 * 6 + 2 * 8 + 8 * 8 + 2 * 16 * 8 * 4 + 16 * 4 * 8;
    const int lr = tid >> 5, lc = (tid & 31) * 4;
    const int tn = tid & 127, tq = tid >> 7;
    f32x4 v[8];
#define PW_LOAD(p_) do { _Pragma("unroll") for (int i = 0; i < 8; ++i) { const int kk = lr + 16 * i; v[i] = (f32x4){0.f, 0.f, 0.f, 0.f}; \
        if (lc < (p_).ncols) { v[i] = *(const f32x4*)((p_).W + (size_t)((p_).k0 + kk) * (p_).ldw + (p_).n0 + lc); if ((p_).g) v[i] = v[i] * (p_).g[(p_).k0 + kk]; } } } while (0)
    const int ITE = it1 < NITEMS ? it1 : NITEMS;
    int it = it0 + vcu;
    PrepItem cur; if (it < ITE) { cur = prep_item(P, l, it); PW_LOAD(cur); }
    for (; it < ITE; it += G) {
#pragma unroll
        for (int i = 0; i < 8; ++i) { const int kk = lr + 16 * i; scr[kk * 129 + lc] = v[i][0]; scr[kk * 129 + lc + 1] = v[i][1]; scr[kk * 129 + lc + 2] = v[i][2]; scr[kk * 129 + lc + 3] = v[i][3]; }
        const PrepItem me = cur;
        if (it + G < ITE) { cur = prep_item(P, l, it + G); PW_LOAD(cur); }
        __syncthreads();
        { bf16_t* dst = me.WT + (size_t)(me.drow0 + tn) * me.ldt + me.k0 + 32 * tq; const LAS float* sc = scr + (32 * tq) * 129 + tn;
#pragma unroll
          for (int c = 0; c < 4; ++c) { u32x4 o; o.x = pk2(sc[(8 * c + 0) * 129], sc[(8 * c + 1) * 129]); o.y = pk2(sc[(8 * c + 2) * 129], sc[(8 * c + 3) * 129]);
              o.z = pk2(sc[(8 * c + 4) * 129], sc[(8 * c + 5) * 129]); o.w = pk2(sc[(8 * c + 6) * 129], sc[(8 * c + 7) * 129]); *(u32x4*)(dst + 8 * c) = o; } }
        __syncthreads();
    }
#undef PW_LOAD
    if (tail & 1) { const int gt = vcu * NTHREADS + tid, NGT = G * NTHREADS; unsigned zz = 0u; asm volatile("" : "+v"(zz)); const u32x4 z = {zz, zz, zz, zz};
      for (int i = gt; i < 128 * 128; i += NGT) *(u32x4*)(P.Win_t + (size_t)2176 * D + (size_t)i * 8) = z; }
    if (tail & 2) { const int gt = vcu * NTHREADS + tid, NGT = G * NTHREADS;
      const float* w_r = P.in[4] + (size_t)l * 8 * 64 * 64; const float* w_i = P.in[6] + (size_t)l * 8 * 64 * 64;
      for (int i = gt; i < 8 * 128 * 64; i += NGT) { const int k = i & 63, j = (i >> 6) & 127, n = i >> 13; const int w = j >> 4, q = j & 15; const int d = 8 * w + (q & 7);
          const float v_ = (q < 8 ? w_r : w_i)[((size_t)n * 64 + k) * 64 + d]; P.Wlg_t[i] = (bf16_t)f2bf(v_); }
      const float* rw = P.in[17]; const float* g1 = P.in[15] + (size_t)l * D; const float* b1 = P.in[16] + (size_t)l * D;
      for (int i = gt; i < 16 * 1024; i += NGT) { const int k = i & 1023, e = i >> 10; const float v_ = g1[k] * rw[k * 16 + e]; const unsigned hi_ = f2bf(v_); const float rem = v_ - bf2f((unsigned short)hi_);
          P.RWH[e * 1024 + k] = (bf16_t)hi_; P.RWH[(16 + e) * 1024 + k] = (bf16_t)f2bf(rem); }
      { const int gwv = gt >> 6, ln = gt & 63;
        if (gwv < 32) { const int e = gwv & 15; const float* src = gwv < 16 ? g1 : b1; float acc = 0.f;
#pragma unroll
            for (int j = 0; j < 16; ++j) { const int k = ln + 64 * j; acc = fmaf(src[k], rw[k * 16 + e], acc); }
#pragma unroll
            for (int o = 1; o < 64; o <<= 1) acc += __shfl_xor(acc, o);
            if (ln == 0) P.RGB[gwv] = acc; } } }
}
__device__ __forceinline__ void prep_tables(const OW& P, int vcu, int G) {
    const int gt = vcu * NTHREADS + TID(), NGT = G * NTHREADS;
    for (int i = gt; i < S * 32; i += NGT) { const int s = i >> 5, j = i & 31; const float inv = powf(10000.0f, -(float)j / 32.0f); const float ang = (float)s * inv; P.ROPE[i] = (f32x2){cosf(ang), sinf(ang)}; }
    const float* x = P.in[0];
    for (size_t i0 = gt; i0 < (size_t)NT * D / 8; i0 += (size_t)4 * NGT) { f32x4 a[4], b[4];
#pragma unroll
        for (int q = 0; q < 4; ++q) { const size_t i = i0 + (size_t)q * NGT; if (i < (size_t)NT * D / 8) { a[q] = *(const f32x4*)(x + i * 8); b[q] = *(const f32x4*)(x + i * 8 + 4); } }
#pragma unroll
        for (int q = 0; q < 4; ++q) { const size_t i = i0 + (size_t)q * NGT; if (i < (size_t)NT * D / 8) { u32x4 o; o.x = pg8::cvt_pk_bf16(a[q][0], a[q][1]); o.y = pg8::cvt_pk_bf16(a[q][2], a[q][3]); o.z = pg8::cvt_pk_bf16(b[q][0], b[q][1]); o.w = pg8::cvt_pk_bf16(b[q][2], b[q][3]); *(u32x4*)(P.XB + i * 8) = o; } } }
}

struct SchedInProj {
    static constexpr bool HOOKS = false;
    const OW* P; int G, c;
    __device__ __forceinline__ bool next(int i, pg8::UnitD& u) const {
        const int L = i * G + c; if (L >= 64 * 9) return false;
        int pm, pn; pg8::tile_order(L, 64, 9, pm, pn);
        u.A = (const char*)(P->XB + (size_t)pm * 256 * D); u.rows = nullptr; u.B = (const char*)(P->Win_t + (size_t)pn * 256 * D); u.lda = D * 2; u.ldb = D * 2; u.nt = D / 64; u.type = 0; u.pm = pm; u.pn = pn; u.aux = 0;
        return true;
    }
};
struct EpiInProj {
    bf16_t* Z; float* SSQ;
    __device__ __forceinline__ void operator()(const f32x4 (&acc)[2][2][4][2], const pg8::UnitD& u, int wr, int wc, int fr, int fq) const {
        const int row0 = u.pm * 256 + wr * 64 + fr, col0 = u.pn * 256 + wc * 32 + 8 * fq;
        const bool stats = u.pn >= 4 && u.pn < 8;
#pragma unroll
        for (int ai = 0; ai < 2; ++ai)
#pragma unroll
            for (int m = 0; m < 4; ++m) { const int row = row0 + ai * 128 + m * 16; bf16_t* rowp = Z + (size_t)row * ZW + col0; float ss = 0.f;
#pragma unroll
                for (int bj = 0; bj < 2; ++bj) { const f32x4 v0 = acc[ai][bj][m][0], v1 = acc[ai][bj][m][1];
                    ss += (v0[0] * v0[0] + v0[1] * v0[1]) + (v0[2] * v0[2] + v0[3] * v0[3]) + (v1[0] * v1[0] + v1[1] * v1[1]) + (v1[2] * v1[2] + v1[3] * v1[3]);
                    u32x4 w; w.x = pg8::cvt_pk_bf16(v0[0], v0[1]); w.y = pg8::cvt_pk_bf16(v0[2], v0[3]); w.z = pg8::cvt_pk_bf16(v1[0], v1[1]); w.w = pg8::cvt_pk_bf16(v1[2], v1[3]);
                    *(u32x4*)(rowp + bj * 128) = w; }
                if (stats) { ss += __shfl_xor(ss, 16); ss += __shfl_xor(ss, 32); if (fq == 0) SSQ[(size_t)row * 16 + (u.pn - 4) * 4 + wc] = ss; } }
    }
};
__device__ __forceinline__ void phase_inproj(const OW& P, LAS unsigned char* lds, int G) {
    SchedInProj Sd{&P, G, BID()}; EpiInProj E{P.Z, P.SSQ};
    pg8::gemm_phase<true>(lds, Sd, E);
}


struct SchedQKV {
    static constexpr bool HOOKS = false;
    const OW* P; int G, c;
    __device__ __forceinline__ bool next(int i, pg8::UnitD& u) const {
        if (G != 256) {
            const int Lq = i * G + c; if (Lq >= 448) return false;
            if (Lq < 192) { fill_q(u, Lq / 3, Lq % 3); } else { const int r = Lq - 192; fill_kv(u, r >> 2, r & 3); }
            return true;
        }
        if (c < 192) { if (i == 0) { fill_q(u, c / 3, c % 3); return true; } if (i == 1 && c % 3 == 0) { fill_kv(u, c / 3, 3); return true; } return false; }
        if (i >= 3) return false; fill_kv(u, c - 192, i); return true;
    }
    __device__ __forceinline__ void fill_q(pg8::UnitD& u, int pm, int pn) const {
        u.A = (const char*)(P->Z + (size_t)pm * 256 * ZW + 1024); u.rows = nullptr; u.B = (const char*)(P->Wq_t + (size_t)pn * 256 * QL); u.lda = ZW * 2; u.ldb = QL * 2; u.nt = QL / 64; u.type = 1; u.pm = pm; u.pn = pn; u.aux = 0; }
    __device__ __forceinline__ void fill_kv(pg8::UnitD& u, int pm, int pn) const {
        u.A = (const char*)(P->Z + (size_t)pm * 256 * ZW + 1792); u.rows = nullptr; u.B = (const char*)(P->Wkv_t + (size_t)pn * 256 * KVL); u.lda = ZW * 2; u.ldb = KVL * 2; u.nt = KVL / 64; u.type = 2; u.pm = pm; u.pn = pn; u.aux = 0; }
};
struct EpiQKV {
    const float* SSQ; bf16_t *Q, *KN, *VV;
    __device__ __forceinline__ void operator()(const f32x4 (&acc)[2][2][4][2], const pg8::UnitD& u, int wr, int wc, int fr, int fq) const {
        const int row0 = u.pm * 256 + wr * 64 + fr, cw = wc * 32 + 8 * fq;
        const bool isq = u.type == 1;
#pragma unroll
        for (int ai = 0; ai < 2; ++ai)
#pragma unroll
            for (int m = 0; m < 4; ++m) { const int row = row0 + ai * 128 + m * 16; const f32x4* sp = (const f32x4*)(SSQ + (size_t)row * 16);
                float rs;
                if (isq) { const f32x4 a = sp[0], b = sp[1], c = sp[2]; const float t = ((a[0] + a[1]) + (a[2] + a[3])) + ((b[0] + b[1]) + (b[2] + b[3])) + ((c[0] + c[1]) + (c[2] + c[3])); rs = rsqrtf(t * (1.f / QL) + EPS); }
                else { const f32x4 a = sp[3]; const float t = (a[0] + a[1]) + (a[2] + a[3]); rs = rsqrtf(t * (1.f / KVL) + EPS); }
#pragma unroll
                for (int bj = 0; bj < 2; ++bj) { const f32x4 v0 = acc[ai][bj][m][0] * rs, v1 = acc[ai][bj][m][1] * rs;
                    u32x4 w; w.x = pg8::cvt_pk_bf16(v0[0], v0[1]); w.y = pg8::cvt_pk_bf16(v0[2], v0[3]); w.z = pg8::cvt_pk_bf16(v1[0], v1[1]); w.w = pg8::cvt_pk_bf16(v1[2], v1[3]);
                    bf16_t* dst = isq ? Q + (size_t)row * QL + u.pn * 256 + bj * 128 + cw : (bj == 0 ? KN : VV) + (size_t)row * 512 + u.pn * 128 + cw;
                    *(u32x4*)dst = w; } }
    }
};
__device__ __forceinline__ float sigm(float x) { return __builtin_amdgcn_rcpf(1.f + __expf(-x)); }
__device__ __forceinline__ float one_minus_sq(float a, float x) {
    return x > -0.015625f ? -x * (1.f + 0.5f * x) : 1.f - a * a;
}
__device__ __forceinline__ void gates_tile(const OW& P, int l, LAS unsigned char* lds, int tile) {
    constexpr int URS = 1040, XRS = 144, SRS = 68;
    const int tid = TID(), lane = tid & 63, wid = __builtin_amdgcn_readfirstlane(tid >> 6), fr = lane & 15, fq = lane >> 4;
    LAS unsigned char* U = lds;
    LAS unsigned char* XC = lds + 67 * URS + 64;
    LAS float* SA = (LAS float*)(lds + 81920);
    LAS float* SD = SA + 64 * SRS;
    LAS f32x2* PP = (LAS f32x2*)(lds + 81920 + 2 * 64 * SRS * 4);
    LAS float* PAR = (LAS float*)(lds + 81920 + 2 * 64 * SRS * 4 + 4096);
    const int tok0 = tile * 64, s0 = tok0 & (S - 1);
    const float* conv_w = P.in[2] + (size_t)l * 4 * LW; const float* conv_b = P.in[3] + (size_t)l * LW;
    const float* b_r = P.in[5] + (size_t)l * LW; const float* b_i = P.in[7] + (size_t)l * LW; const float* lam = P.in[8] + (size_t)l * LW;
    const bf16_t* pZ = P.Z; const f32x2* pROPE = P.ROPE; bf16_t* pKPE = P.KPE; float* pA = P.A; float* pDRV = P.DRV; float* pAGA = P.AGA; float* pAGB = P.AGB; const bf16_t* pWlg = P.Wlg_t;
    { u32x4 uv[9]; unsigned short k1[4], k2[4]; f32x2 cs[4];
#pragma unroll
      for (int q = 0; q < 9; ++q) { const int i = tid + q * NTHREADS; const int r = i >> 6, ch = i & 63; uv[q] = (u32x4){0u, 0u, 0u, 0u};
          if (i < 67 * 64 && (r >= 3 || s0 != 0)) uv[q] = *(const u32x4*)(pZ + (size_t)(tok0 - 3 + r) * ZW + ch * 8); }
#pragma unroll
      for (int q = 0; q < 4; ++q) { const int i = tid + q * NTHREADS; const int t = i >> 5, j = i & 31; const size_t tok = (size_t)tok0 + t;
          k1[q] = pZ[tok * ZW + 2048 + j]; k2[q] = pZ[tok * ZW + 2080 + j]; cs[q] = pROPE[(s0 + t) * 32 + j]; }
#pragma unroll
      for (int q = 0; q < 9; ++q) { const int i = tid + q * NTHREADS; const int r = i >> 6, ch = i & 63; if (i < 67 * 64) *(LAS u32x4*)(U + r * URS + ch * 16) = uv[q]; }
#pragma unroll
      for (int q = 0; q < 4; ++q) { const int i = tid + q * NTHREADS; const int t = i >> 5, j = i & 31; const size_t tok = (size_t)tok0 + t; const float x1 = bf2f(k1[q]), x2 = bf2f(k2[q]);
          pKPE[tok * 64 + j] = (bf16_t)f2bf(x1 * cs[q].x - x2 * cs[q].y); pKPE[tok * 64 + 32 + j] = (bf16_t)f2bf(x1 * cs[q].y + x2 * cs[q].x); } }
    { const int ch = tid;
      PAR[0 * LW + ch] = conv_w[0 * LW + ch]; PAR[1 * LW + ch] = conv_w[1 * LW + ch]; PAR[2 * LW + ch] = conv_w[2 * LW + ch]; PAR[3 * LW + ch] = conv_w[3 * LW + ch];
      PAR[4 * LW + ch] = conv_b[ch]; PAR[5 * LW + ch] = b_r[ch]; PAR[6 * LW + ch] = b_i[ch]; PAR[7 * LW + ch] = -8.0f * log1pf(__expf(-lam[ch])); }
    __syncthreads();
    bf16x8 nb0, nb1; { const bf16_t* wb = pWlg + ((size_t)16 * wid + fr) * 64 + 8 * fq; nb0 = *(const bf16x8*)wb; nb1 = *(const bf16x8*)(wb + 32); }
    for (int n = 0; n < 8; ++n) {
        { const int chb = 64 * n + 8 * wid; float xc[8];
#pragma unroll
          for (int j = 0; j < 8; ++j) xc[j] = PAR[4 * LW + chb + j];
#pragma unroll
          for (int w = 0; w < 4; ++w) { const u32x4 uv = *(const LAS u32x4*)(U + (lane + w) * URS + chb * 2);
              const f32x4 c0 = *(const LAS f32x4*)(PAR + w * LW + chb), c1 = *(const LAS f32x4*)(PAR + w * LW + chb + 4);
              xc[0] = fmaf(bflo(uv.x), c0[0], xc[0]); xc[1] = fmaf(bfhi(uv.x), c0[1], xc[1]); xc[2] = fmaf(bflo(uv.y), c0[2], xc[2]); xc[3] = fmaf(bfhi(uv.y), c0[3], xc[3]);
              xc[4] = fmaf(bflo(uv.z), c1[0], xc[4]); xc[5] = fmaf(bfhi(uv.z), c1[1], xc[5]); xc[6] = fmaf(bflo(uv.w), c1[2], xc[6]); xc[7] = fmaf(bfhi(uv.w), c1[3], xc[7]); }
          u32x4 o; o.x = pk2(xc[0], xc[1]); o.y = pk2(xc[2], xc[3]); o.z = pk2(xc[4], xc[5]); o.w = pk2(xc[6], xc[7]);
          *(LAS u32x4*)(XC + lane * XRS + wid * 16) = o; }
        __syncthreads();
        f32x4 acc[4];
        { const bf16x8 b0 = nb0, b1 = nb1;
          if (n + 1 < 8) { const bf16_t* wb = pWlg + ((size_t)(n + 1) * 128 + 16 * wid + fr) * 64 + 8 * fq; nb0 = *(const bf16x8*)wb; nb1 = *(const bf16x8*)(wb + 32); }
#pragma unroll
          for (int m = 0; m < 4; ++m) { const bf16x8 a0 = *(const LAS bf16x8*)(XC + (16 * m + fr) * XRS + fq * 16), a1 = *(const LAS bf16x8*)(XC + (16 * m + fr) * XRS + 64 + fq * 16);
              f32x4 c = {0.f, 0.f, 0.f, 0.f};
              c = __builtin_amdgcn_mfma_f32_16x16x32_bf16(b0, a0, c, 0, 0, 0); c = __builtin_amdgcn_mfma_f32_16x16x32_bf16(b1, a1, c, 0, 0, 0); acc[m] = c; } }
        const bool lo = fq < 2;
        f32x4 rv[2], iv[2];
#pragma unroll
        for (int j = 0; j < 2; ++j) { const f32x4 snd = lo ? acc[2 + j] : acc[j]; f32x4 rc;
#pragma unroll
            for (int x = 0; x < 4; ++x) rc[x] = __shfl_xor(snd[x], 32);
            rv[j] = lo ? acc[j] : rc; iv[j] = lo ? rc : acc[2 + j]; }
        const int d0 = 8 * wid + 4 * (fq & 1), ch0 = 64 * n + d0;
        const f32x4 brv = *(const LAS f32x4*)(PAR + 5 * LW + ch0), biv = *(const LAS f32x4*)(PAR + 6 * LW + ch0), spv = *(const LAS f32x4*)(PAR + 7 * LW + ch0), cbv = *(const LAS f32x4*)(PAR + 4 * LW + ch0);
        f32x4 cw[4];
#pragma unroll
        for (int w = 0; w < 4; ++w) cw[w] = *(const LAS f32x4*)(PAR + w * LW + ch0);
#pragma unroll
        for (int j = 0; j < 2; ++j) { const int t = 16 * ((lo ? 0 : 2) + j) + fr; f32x4 av, dv;
            const u32x2 xcb = *(const LAS u32x2*)(XC + t * XRS + d0 * 2); const float xcq[4] = {bflo(xcb.x), bfhi(xcb.x), bflo(xcb.y), bfhi(xcb.y)};
#pragma unroll
            for (int x = 0; x < 4; ++x) {
                const float xcv = xcq[x];
                const float r = sigm(rv[j][x] + brv[x]), ig = sigm(iv[j][x] + biv[x]);
                const float log_a = r * spv[x];
                av[x] = __expf(log_a); dv[x] = __builtin_amdgcn_sqrtf(one_minus_sq(av[x], 2.0f * log_a)) * (ig * xcv); }
            *(LAS f32x4*)(SA + t * SRS + d0) = av; *(LAS f32x4*)(SD + t * SRS + d0) = dv; }
        __syncthreads();
        { float Ap = 1.f, Bp = 0.f;
#pragma unroll
          for (int j = 0; j < 8; ++j) { const int t = 8 * wid + j; const float a = SA[t * SRS + lane], dv = SD[t * SRS + lane];
              ((unsigned*)pA)[((size_t)tok0 + t) * LW + 64 * n + lane] = pg8::cvt_pk_bf16(1.f - a, dv);
              Ap *= a; Bp = fmaf(a, Bp, dv); }
          PP[wid * 64 + lane] = (f32x2){Ap, Bp}; }
        __syncthreads();
        if (wid == 0) { float Aa = 1.f, Bb = 0.f;
#pragma unroll
            for (int g = 0; g < 8; ++g) { const f32x2 p = PP[g * 64 + lane]; Aa *= p.x; Bb = fmaf(p.x, Bb, p.y); }
            pAGA[(size_t)tile * LW + 64 * n + lane] = Aa; pAGB[(size_t)tile * LW + 64 * n + lane] = Bb; }
    }
    __syncthreads();
}
__device__ __forceinline__ void phase_qkv(const OW& P, int l, LAS unsigned char* lds, int G) {
#ifndef P2SEL
#define P2SEL 3
#endif
    if (P2SEL & 1) { SchedQKV Sd{&P, G, BID()}; EpiQKV E{P.SSQ, P.Q, P.KN, P.VV};
    pg8::gemm_phase<true>(lds, Sd, E); }
    if (P2SEL & 2) for (int tile = BID(); tile < NT / 64; tile += G) gates_tile(P, l, lds, tile);
}


namespace att {
typedef short s16x4 __attribute__((ext_vector_type(4)));
typedef float f32x16 __attribute__((ext_vector_type(16)));
constexpr int KVBLK = 64, SHM_V = 16384, SHM_K = 24576, OFF_K = 3 * SHM_V, OFF_WS = OFF_K + 3 * SHM_K, OFF_QR = OFF_WS + 8 * 64 * 4, LDS_NEED = OFF_QR + 8 * 4096;
static_assert(LDS_NEED <= LDSCTL_OFF, "attention LDS");
constexpr float SCALE = 0.07216878364870322f, THR = 8.f;
#define SBAR() __builtin_amdgcn_sched_barrier(0)
__device__ __forceinline__ int v_st(int k, int c) { const int kk = (k & ~0xC) | ((k & 4) << 1) | ((k & 8) >> 1); return ((kk >> 3) * 4 + (c >> 5)) * 512 + ((kk & 7) * 32 + (c & 31)) * 2; }
__device__ __forceinline__ int v_rd_base(int lane) { return ((lane & 3) << 3) | (((lane >> 2) & 3) << 6) | (((lane >> 4) & 1) << 5) | (((lane >> 5) & 1) << 8); }
constexpr int v_rd_off(int d0, int ks, int half) { return d0 * 512 + ks * 4096 + half * 2048; }
__device__ __forceinline__ int k_off(int row, int cc) { return (cc >> 3) * 8192 + row * 128 + (((cc & 7) ^ ((row >> 1) & 7)) << 4); }
__device__ __forceinline__ int crow(int r, int hi) { return (r & 3) + 8 * (r >> 2) + 4 * hi; }
__device__ __forceinline__ unsigned cvtpk(float lo, float hi) { unsigned r; asm volatile("v_cvt_pk_bf16_f32 %0, %1, %2" : "=v"(r) : "v"(lo), "v"(hi)); return r; }
__device__ __forceinline__ void mask_tile(f32x16& p0, f32x16& p1, int dq) {
    const float NEG = -__builtin_inff();
#pragma unroll
    for (int r = 0; r < 16; ++r) { const int c = (r & 3) + 8 * (r >> 2); if (dq - c < 0) p0[r] = NEG; if (dq - c - 32 < 0) p1[r] = NEG; }
}
__device__ __forceinline__ void partialSM(f32x16& p0, f32x16& p1, float& m_reg, float& mn, float& alpha) {
    float pmax = p0[0];
#pragma unroll
    for (int r = 1; r < 16; ++r) pmax = fmaxf(pmax, p0[r]);
#pragma unroll
    for (int r = 0; r < 16; ++r) pmax = fmaxf(pmax, p1[r]);
    { auto rr = __builtin_amdgcn_permlane32_swap(__float_as_uint(pmax), __float_as_uint(pmax), false, false); pmax = fmaxf(__uint_as_float(rr[0]), __uint_as_float(rr[1])); }
    constexpr float C2 = 1.4426950408889634f * SCALE;
    if (__builtin_expect(__all((pmax - m_reg) * SCALE <= THR), 1)) { mn = m_reg; alpha = 1.f; }
    else { mn = fmaxf(m_reg, pmax); alpha = __builtin_amdgcn_exp2f((m_reg - mn) * C2); m_reg = mn; }
    const float mnL = -mn * C2;
#pragma unroll
    for (int r = 0; r < 16; ++r) p0[r] = fmaf(p0[r], C2, mnL);
#pragma unroll
    for (int r = 0; r < 16; ++r) p1[r] = fmaf(p1[r], C2, mnL);
#pragma unroll
    for (int r = 0; r < 16; ++r) p0[r] = __builtin_amdgcn_exp2f(p0[r]);
}
__device__ __forceinline__ void finishSM(f32x16& p0, f32x16& p1, float alpha, float& l_reg, bf16x8& pa0, bf16x8& pa1, bf16x8& pa2, bf16x8& pa3) {
#pragma unroll
    for (int r = 0; r < 16; ++r) p1[r] = __builtin_amdgcn_exp2f(p1[r]);
    float ps = 0;
#pragma unroll
    for (int r = 0; r < 16; ++r) ps += p0[r];
#pragma unroll
    for (int r = 0; r < 16; ++r) ps += p1[r];
    { auto rr = __builtin_amdgcn_permlane32_swap(__float_as_uint(ps), __float_as_uint(ps), false, false); ps = __uint_as_float(rr[0]) + __uint_as_float(rr[1]); }
    l_reg = l_reg * alpha + ps;
#define PK4(P, B_, OUT) do { unsigned a0 = cvtpk(P[B_+0], P[B_+1]), a1 = cvtpk(P[B_+2], P[B_+3]);                          \
        unsigned b0 = cvtpk(P[B_+4], P[B_+5]), b1 = cvtpk(P[B_+6], P[B_+7]);                                             \
        auto r0 = __builtin_amdgcn_permlane32_swap(a0, b0, false, false); auto r1 = __builtin_amdgcn_permlane32_swap(a1, b1, false, false); \
        u32x4 w = {r0[0], r1[0], r0[1], r1[1]}; OUT = *reinterpret_cast<bf16x8*>(&w); } while (0)
    PK4(p0, 0, pa0); PK4(p0, 8, pa1); PK4(p1, 0, pa2); PK4(p1, 8, pa3);
#undef PK4
}
__device__ __forceinline__ void qkt(f32x16& p0, f32x16& p1, const char* K_slot, int r32, int hi, const bf16x8* qr, const char* qrl) {
    p0 = f32x16{}; p1 = f32x16{};
    const char* kb[4];
#pragma unroll
    for (int dd = 0; dd < 4; ++dd) kb[dd] = K_slot + r32 * 128 + (((2 * dd + hi) ^ ((r32 >> 1) & 7)) << 4);
    bf16x8 a0[4], a1[4], b0[4], b1[4], qf[4];
#define QK_LOAD(X0, X1, g) do { _Pragma("unroll") for (int dd = 0; dd < 4; ++dd) { const char* a_ = kb[dd] + (g) * 8192; X0[dd] = *reinterpret_cast<const bf16x8*>(a_); X1[dd] = *reinterpret_cast<const bf16x8*>(a_ + 32 * 128); } } while (0)
#define QK_MMA(X0, X1, Q_) do { _Pragma("unroll") for (int dd = 0; dd < 4; ++dd) { p0 = __builtin_amdgcn_mfma_f32_32x32x16_bf16(X0[dd], Q_[dd], p0, 0, 0, 0); p1 = __builtin_amdgcn_mfma_f32_32x32x16_bf16(X1[dd], Q_[dd], p1, 0, 0, 0); } } while (0)
    QK_LOAD(a0, a1, 0); SBAR();
    QK_LOAD(b0, b1, 1); SBAR();
    QK_MMA(a0, a1, qr); SBAR();
    QK_LOAD(a0, a1, 2);
#pragma unroll
    for (int dd = 0; dd < 4; ++dd) qf[dd] = *reinterpret_cast<const bf16x8*>(qrl + dd * 1024);
    SBAR();
    QK_MMA(b0, b1, (qr + 4)); SBAR();
    QK_MMA(a0, a1, qf);
#undef QK_LOAD
#undef QK_MMA
}
__device__ __forceinline__ void pv_tile(f32x16* o, int vb0, bf16x8 pa0, bf16x8 pa1, bf16x8 pa2, bf16x8 pa3) {
#define TRRD(dst, off) asm volatile("ds_read_b64_tr_b16 %0, %1 offset:%2" : "=&v"(dst) : "v"(vb0), "i"(off) : "memory")
#define PV_RD(S, d0) do { constexpr int b_ = v_rd_off(d0, 0, 0); \
        TRRD(S##l0, b_); TRRD(S##h0, b_ + 2048); TRRD(S##l1, b_ + 4096); TRRD(S##h1, b_ + 6144); TRRD(S##l2, b_ + 8192); TRRD(S##h2, b_ + 10240); TRRD(S##l3, b_ + 12288); TRRD(S##h3, b_ + 14336); } while (0)
#define PV_MM(S, d0) do { \
        o[d0] = __builtin_amdgcn_mfma_f32_32x32x16_bf16(pa0, (bf16x8){S##l0[0], S##l0[1], S##l0[2], S##l0[3], S##h0[0], S##h0[1], S##h0[2], S##h0[3]}, o[d0], 0, 0, 0);   \
        o[d0] = __builtin_amdgcn_mfma_f32_32x32x16_bf16(pa1, (bf16x8){S##l1[0], S##l1[1], S##l1[2], S##l1[3], S##h1[0], S##h1[1], S##h1[2], S##h1[3]}, o[d0], 0, 0, 0);   \
        o[d0] = __builtin_amdgcn_mfma_f32_32x32x16_bf16(pa2, (bf16x8){S##l2[0], S##l2[1], S##l2[2], S##l2[3], S##h2[0], S##h2[1], S##h2[2], S##h2[3]}, o[d0], 0, 0, 0);   \
        o[d0] = __builtin_amdgcn_mfma_f32_32x32x16_bf16(pa3, (bf16x8){S##l3[0], S##l3[1], S##l3[2], S##l3[3], S##h3[0], S##h3[1], S##h3[2], S##h3[3]}, o[d0], 0, 0, 0); } while (0)
    s16x4 Al0, Al1, Al2, Al3, Ah0, Ah1, Ah2, Ah3, Bl0, Bl1, Bl2, Bl3, Bh0, Bh1, Bh2, Bh3;
    asm volatile("s_waitcnt lgkmcnt(0)" ::: "memory");
    PV_RD(A, 0);
    PV_RD(B, 1); asm volatile("s_waitcnt lgkmcnt(8)" ::: "memory"); SBAR(); PV_MM(A, 0); SBAR();
    PV_RD(A, 2); asm volatile("s_waitcnt lgkmcnt(8)" ::: "memory"); SBAR(); PV_MM(B, 1); SBAR();
    PV_RD(B, 3); asm volatile("s_waitcnt lgkmcnt(8)" ::: "memory"); SBAR(); PV_MM(A, 2); SBAR();
    asm volatile("s_waitcnt lgkmcnt(0)" ::: "memory"); SBAR(); PV_MM(B, 3);
#undef PV_RD
#undef PV_MM
#undef TRRD
}
__device__ __forceinline__ void unit(const OW& P, char* lds, int b, int h, int qb, int part) {
    const int tid = TID(), wid = __builtin_amdgcn_readfirstlane(tid >> 6), lane = tid & 63, r32 = lane & 31, hi = lane >> 5;
    const int NTall = 4 * (qb + 1), t_lo = part ? NTall / 2 : 0, NT_ = NTall / 2;
    const size_t rowbase = (size_t)b * S;
    const int q0 = qb * 256, qlo = q0 + wid * 32, qm = qlo + r32 - 4 * hi;
    char* V_lds = lds; char* K_lds = lds + OFF_K;
    float* ws = (float*)(lds + OFF_WS) + wid * 64; float* li_l = ws; float* al_l = ws + 32;
    float m_reg = -1e30f, l_reg = 0; f32x16 o[4] = {};
    const int vb0 = (int)(uintptr_t)V_lds + v_rd_base(lane);
    unsigned go_k01, go_k2, go_v0, go_v1;
    { const int row = 8 * wid + (lane >> 3), c = (lane & 7) ^ ((row >> 1) & 7);
      go_k01 = (unsigned)(row * 512 + c * 8) * 2u; go_k2 = (unsigned)(row * 64 + c * 8) * 2u;
      const int si0 = 2 * wid + (lane >> 5), si1 = si0 + 16;
      const int kk0 = (si0 >> 2) * 8 + ((lane & 31) >> 2), kk1 = (si1 >> 2) * 8 + ((lane & 31) >> 2);
      const int k0_ = (kk0 & ~0xC) | ((kk0 & 4) << 1) | ((kk0 & 8) >> 1), k1_ = (kk1 & ~0xC) | ((kk1 & 4) << 1) | ((kk1 & 8) >> 1);
      go_v0 = (unsigned)(k0_ * 512 + (si0 & 3) * 32 + (lane & 3) * 8) * 2u; go_v1 = (unsigned)(k1_ * 512 + (si1 & 3) * 32 + (lane & 3) * 8) * 2u; }
    const char* KnB = (const char*)(P.KN + rowbase * 512 + h * 128); const char* VhB = (const char*)(P.VV + rowbase * 512 + h * 128); const char* KpB = (const char*)(P.KPE + rowbase * 64);
    LAS unsigned char* ldsK = (LAS unsigned char*)(uintptr_t)(unsigned)(uintptr_t)K_lds; LAS unsigned char* ldsV = (LAS unsigned char*)(uintptr_t)(unsigned)(uintptr_t)V_lds;
#define KBASE(t) ((t_lo + (t)) * KVBLK)
#define GLDS(gp, lp) __builtin_amdgcn_global_load_lds((const unsigned*)(gp), (LAS unsigned*)(lp), 16, 0, 0)
#define STAGE(k0, ks_, vs_) do { const size_t kb_ = (size_t)(k0); \
        GLDS(KnB + kb_ * 1024 + go_k01, ldsK + (ks_) * SHM_K + wid * 1024); GLDS(KnB + kb_ * 1024 + 128 + go_k01, ldsK + (ks_) * SHM_K + 8192 + wid * 1024); \
        GLDS(KpB + kb_ * 128 + go_k2, ldsK + (ks_) * SHM_K + 16384 + wid * 1024); \
        GLDS(VhB + kb_ * 1024 + go_v0, ldsV + (vs_) * SHM_V + wid * 1024); GLDS(VhB + kb_ * 1024 + go_v1, ldsV + (vs_) * SHM_V + (wid + 8) * 1024); } while (0)
#define RESC(a) do { if (__any((a) < 1.f)) { if (hi == 0) al_l[r32] = (a); asm volatile("s_waitcnt lgkmcnt(0)" ::: "memory");              \
                     _Pragma("unroll") for (int d_ = 0; d_ < 4; ++d_) _Pragma("unroll") for (int r = 0; r < 16; ++r) o[d_][r] *= al_l[crow(r, hi)]; } } while (0)
#define MASKT(P0_, P1_, t) do { const int kb_ = KBASE(t); if (kb_ + KVBLK - 1 > qlo) mask_tile(P0_, P1_, qm - kb_); } while (0)
    STAGE(KBASE(0), 0, 0); if (NT_ > 1) { STAGE(KBASE(1), 1, 1); }
    bf16x8 qr[8]; char* qrl = lds + OFF_QR + wid * 4096 + lane * 16;
    { const bf16_t* qp = P.Q + (rowbase + qlo + r32) * QL + h * QH + hi * 8;
#pragma unroll
      for (int d0 = 0; d0 < 8; ++d0) qr[d0] = *(const bf16x8*)(qp + d0 * 16);
      const f32x2* rp = P.ROPE + (size_t)(qlo + r32) * 32 + hi * 8;
#pragma unroll
      for (int g = 0; g < 2; ++g) {
          u32x4 x1 = *(const u32x4*)(qp + (8 + g) * 16), x2 = *(const u32x4*)(qp + (10 + g) * 16); u32x4 y1, y2;
#pragma unroll
          for (int jj = 0; jj < 4; ++jj) { const f32x2 cs0 = rp[16 * g + 2 * jj], cs1 = rp[16 * g + 2 * jj + 1];
              const float a0 = bflo(x1[jj]), a1 = bfhi(x1[jj]), b0 = bflo(x2[jj]), b1 = bfhi(x2[jj]);
              y1[jj] = pk2(a0 * cs0.x - b0 * cs0.y, a1 * cs1.x - b1 * cs1.y); y2[jj] = pk2(a0 * cs0.y + b0 * cs0.x, a1 * cs1.y + b1 * cs1.x); }
          *(u32x4*)(qrl + g * 1024) = y1; *(u32x4*)(qrl + (2 + g) * 1024) = y2; } }
    f32x16 p0, p1; float mn, al; bf16x8 pa0, pa1, pa2, pa3;
    asm volatile("s_waitcnt vmcnt(0)" ::: "memory"); __syncthreads();
    int sl = 0;
    for (int t = 0; t < NT_; ++t) {
        const int s2 = sl == 0 ? 2 : sl - 1;
        if (t + 2 < NT_) { STAGE(KBASE(t + 2), s2, s2); }
        qkt(p0, p1, K_lds + sl * SHM_K, r32, hi, qr, qrl);
        MASKT(p0, p1, t); partialSM(p0, p1, m_reg, mn, al); RESC(al);
        finishSM(p0, p1, al, l_reg, pa0, pa1, pa2, pa3); SBAR();
        pv_tile(o, vb0 + sl * SHM_V, pa0, pa1, pa2, pa3);
        if (t + 2 < NT_) asm volatile("s_waitcnt vmcnt(5) lgkmcnt(0)" ::: "memory"); else asm volatile("s_waitcnt vmcnt(0) lgkmcnt(0)" ::: "memory");
        __builtin_amdgcn_s_barrier(); asm volatile("" ::: "memory");
        sl = sl == 2 ? 0 : sl + 1;
    }
    bf16_t* Ow = P.OP + ((size_t)part * NT + rowbase + qlo) * 512 + h * 128;
#pragma unroll
    for (int r = 0; r < 16; ++r) { const int orow = crow(r, hi);
#pragma unroll
        for (int d0 = 0; d0 < 4; ++d0) { const float v = o[d0][r]; const float vn = __shfl_xor(v, 1);
            if ((r32 & 1) == 0) *(unsigned*)(Ow + (size_t)orow * 512 + d0 * 32 + r32) = cvtpk(v, vn); } }
    if (hi == 0) P.ML[((size_t)part * NT + rowbase + qlo + r32) * 4 + h] = (f32x2){m_reg * (1.4426950408889634f * SCALE), l_reg};
    __syncthreads();
#undef KBASE
#undef GLDS
#undef STAGE
#undef RESC
#undef MASKT
}
#undef SBAR
}
__device__ __forceinline__ void phase_attn(const OW& P, LAS unsigned char* lds, int vcu, int G) {
    for (int v = vcu; v < 256; v += G) { const int bh = v >> 4, r = v & 15;
        att::unit(P, (char*)lds, bh >> 2, bh & 3, r, 0);
        att::unit(P, (char*)lds, bh >> 2, bh & 3, 15 - r, 1); }
}
#if MODE == 0
__global__ void shim_attn(const bf16_t* OP, const f32x2* ML, float* MIXf) {
    const size_t i = (size_t)blockIdx.x * 256 + threadIdx.x; if (i >= (size_t)NT * 512) return;
    const size_t row = i >> 9; const int c = (int)(i & 511), h = c >> 7;
    const f32x2 a = ML[row * 4 + h], b = ML[((size_t)NT + row) * 4 + h];
    const float M = fmaxf(a.x, b.x), w0 = exp2f(a.x - M), w1 = exp2f(b.x - M);
    MIXf[row * D + 512 + c] = (w0 * bf2f(OP[i]) + w1 * bf2f(OP[(size_t)NT * 512 + i])) / (w0 * a.y + w1 * b.y);
}
#endif


__device__ __forceinline__ float wsum(float v) {
#pragma unroll
    for (int o = 1; o < 64; o <<= 1) v += __shfl_xor(v, o);
    return v;
}
__device__ __forceinline__ float gelu_t(float x) { const float u = 0.7978845608028654f * (x + 0.044715f * x * x * x); const float t = 1.f - 2.f * __builtin_amdgcn_rcpf(1.f + __expf(2.f * u)); return 0.5f * x * (1.f + t); }
__device__ __forceinline__ void mix_tile(const OW& P, LAS unsigned char* lds, int tile) {
    const int tid = TID(), lane = tid & 63, wid = __builtin_amdgcn_readfirstlane(tid >> 6);
    LAS float* LR = (LAS float*)lds;
    const int tok0 = tile * 64, j = tile & 63, tile0 = tile - j;
    float h = 0.f;
    if (j > 0) {
        { float a[32], b[32];
#pragma unroll
          for (int q = 0; q < 32; ++q) { const int t_ = q < j ? tile0 + q : tile0; a[q] = P.AGA[(size_t)t_ * LW + tid]; b[q] = P.AGB[(size_t)t_ * LW + tid]; }
#pragma unroll
          for (int q = 0; q < 32; ++q) if (q < j) h = fmaf(a[q], h, b[q]); }
        if (j > 32) { float a[32], b[32];
#pragma unroll
          for (int q = 0; q < 32; ++q) { const int t_ = 32 + q < j ? tile0 + 32 + q : tile0; a[q] = P.AGA[(size_t)t_ * LW + tid]; b[q] = P.AGB[(size_t)t_ * LW + tid]; }
#pragma unroll
          for (int q = 0; q < 32; ++q) if (32 + q < j) h = fmaf(a[q], h, b[q]); }
    }
    { unsigned ad[64]; unsigned short gg[64];
#pragma unroll
      for (int q = 0; q < 64; ++q) { const size_t tok = (size_t)tok0 + q; ad[q] = ((const unsigned*)P.A)[tok * LW + tid]; gg[q] = P.Z[tok * ZW + LW + tid]; }
#pragma unroll
      for (int q = 0; q < 64; ++q) { h = fmaf(1.f - bflo(ad[q]), h, bfhi(ad[q])); LR[q * LW + tid] = h * gelu_t(bf2f(gg[q])); } }
    __syncthreads();
    { const int hh = lane >> 4;
      f32x2 nma, nmb; u32x4 noa, nob;
#define MX_LOAD(r_) do { const size_t row_ = (size_t)tok0 + (r_); nma = P.ML[row_ * 4 + hh]; nmb = P.ML[((size_t)NT + row_) * 4 + hh]; \
        noa = *(const u32x4*)(P.OP + row_ * 512 + lane * 8); nob = *(const u32x4*)(P.OP + ((size_t)NT + row_) * 512 + lane * 8); } while (0)
      MX_LOAD(wid);
      for (int r = wid; r < 64; r += NWAVES) { const size_t row = (size_t)tok0 + r;
        const f32x2 ma = nma, mb = nmb; const u32x4 oa = noa, ob = nob;
        if (r + NWAVES < 64) MX_LOAD(r + NWAVES);
        { const f32x4 v0 = *(const LAS f32x4*)(LR + r * LW + lane * 8), v1 = *(const LAS f32x4*)(LR + r * LW + lane * 8 + 4);
          float ss = (v0[0] * v0[0] + v0[1] * v0[1]) + (v0[2] * v0[2] + v0[3] * v0[3]) + (v1[0] * v1[0] + v1[1] * v1[1]) + (v1[2] * v1[2] + v1[3] * v1[3]);
          const float rs = rsqrtf(wsum(ss) * (1.f / 512.f) + EPS);
          u32x4 o; o.x = pk2(v0[0] * rs, v0[1] * rs); o.y = pk2(v0[2] * rs, v0[3] * rs); o.z = pk2(v1[0] * rs, v1[1] * rs); o.w = pk2(v1[2] * rs, v1[3] * rs);
          *(u32x4*)(P.MIX + row * D + lane * 8) = o; }
        { const float M = fmaxf(ma.x, mb.x), w0 = __builtin_amdgcn_exp2f(ma.x - M), w1 = __builtin_amdgcn_exp2f(mb.x - M), inv = 1.f / (w0 * ma.y + w1 * mb.y);
          float v[8];
#pragma unroll
          for (int q = 0; q < 4; ++q) { v[2 * q] = (w0 * bflo(oa[q]) + w1 * bflo(ob[q])) * inv; v[2 * q + 1] = (w0 * bfhi(oa[q]) + w1 * bfhi(ob[q])) * inv; }
          float ss = 0.f;
#pragma unroll
          for (int q = 0; q < 8; ++q) ss += v[q] * v[q];
          const float rs = rsqrtf(wsum(ss) * (1.f / 512.f) + EPS);
          u32x4 o; o.x = pk2(v[0] * rs, v[1] * rs); o.y = pk2(v[2] * rs, v[3] * rs); o.z = pk2(v[4] * rs, v[5] * rs); o.w = pk2(v[6] * rs, v[7] * rs);
          *(u32x4*)(P.MIX + row * D + 512 + lane * 8) = o; } }
#undef MX_LOAD
    }
    __syncthreads();
}
struct SchedOut {
    static constexpr bool HOOKS = false;
    const OW* P; int G, c;
    __device__ __forceinline__ bool next(int i, pg8::UnitD& u) const {
        const int L = i * G + c; if (L >= 256) return false;
        int pm, pn; pg8::tile_order(L, 64, 4, pm, pn);
        u.A = (const char*)(P->MIX + (size_t)pm * 256 * D); u.rows = nullptr; u.B = (const char*)(P->Wo_t + (size_t)pn * 256 * 1024); u.lda = D * 2; u.ldb = 2048; u.nt = 16; u.type = 3; u.pm = pm; u.pn = pn; u.aux = 0;
        return true;
    }
};
struct EpiOut {
    const bf16_t* xres; bf16_t* Y;
    __device__ __forceinline__ void operator()(const f32x4 (&acc)[2][2][4][2], const pg8::UnitD& u, int wr, int wc, int fr, int fq) const {
        const int row0 = u.pm * 256 + wr * 64 + fr, col0 = u.pn * 256 + wc * 32 + 8 * fq;
#pragma unroll
        for (int ai = 0; ai < 2; ++ai) { u32x4 xb[4][2];
#pragma unroll
            for (int m = 0; m < 4; ++m) { const size_t off = (size_t)(row0 + ai * 128 + m * 16) * D + col0;
#pragma unroll
                for (int bj = 0; bj < 2; ++bj) xb[m][bj] = *(const u32x4*)(xres + off + bj * 128); }
#pragma unroll
            for (int m = 0; m < 4; ++m) { const size_t off = (size_t)(row0 + ai * 128 + m * 16) * D + col0;
#pragma unroll
                for (int bj = 0; bj < 2; ++bj) { const u32x4 x_ = xb[m][bj]; const f32x4 v0 = acc[ai][bj][m][0], v1 = acc[ai][bj][m][1];
                    u32x4 w; w.x = pg8::cvt_pk_bf16(ALPHA * bflo(x_.x) + v0[0], ALPHA * bfhi(x_.x) + v0[1]); w.y = pg8::cvt_pk_bf16(ALPHA * bflo(x_.y) + v0[2], ALPHA * bfhi(x_.y) + v0[3]);
                    w.z = pg8::cvt_pk_bf16(ALPHA * bflo(x_.z) + v1[0], ALPHA * bfhi(x_.z) + v1[1]); w.w = pg8::cvt_pk_bf16(ALPHA * bflo(x_.w) + v1[2], ALPHA * bfhi(x_.w) + v1[3]);
                    *(u32x4*)(Y + off + bj * 128) = w; } } }
    }
};
__device__ __forceinline__ void ln1_router_tile(const OW& P, int l, LAS unsigned char* lds, int tile) {
    const int tid = TID(), lane = tid & 63, wid = __builtin_amdgcn_readfirstlane(tid >> 6), fr = lane & 15, fq = lane >> 4;
    LAS float* PL = (LAS float*)lds;
    LAS f32x2* ST = (LAS f32x2*)(lds + 8192);
    LAS int* EI = (LAS int*)(lds + 8192 + 512);
    const float* g1 = P.in[15] + (size_t)l * D; const float* b1 = P.in[16] + (size_t)l * D; const float* rb = P.in[18];
    const int tok0 = tile * 64;
    { const int mt = wid & 3, kh = wid >> 2;
      const bf16_t* yp = P.Y + ((size_t)tok0 + 16 * mt + fr) * D + 512 * kh + 8 * fq; const bf16_t* wp = P.RWH + (size_t)fr * 1024 + 512 * kh + 8 * fq;
      bf16x8 ya[16];
#pragma unroll
      for (int ks = 0; ks < 16; ++ks) ya[ks] = *(const bf16x8*)(yp + 32 * ks);
      f32x4 acc = {0.f, 0.f, 0.f, 0.f};
#pragma unroll
      for (int ks = 0; ks < 16; ++ks) { const bf16x8 bh = *(const bf16x8*)(wp + 32 * ks), bl = *(const bf16x8*)(wp + 16 * 1024 + 32 * ks);
          acc = __builtin_amdgcn_mfma_f32_16x16x32_bf16(ya[ks], bh, acc, 0, 0, 0); acc = __builtin_amdgcn_mfma_f32_16x16x32_bf16(ya[ks], bl, acc, 0, 0, 0); }
#pragma unroll
      for (int x = 0; x < 4; ++x) PL[(kh * 64 + 16 * mt + 4 * fq + x) * 16 + fr] = acc[x]; }
    f32x4 gv[4], bv[4];
#pragma unroll
    for (int j = 0; j < 4; ++j) { gv[j] = *(const f32x4*)(g1 + lane * 16 + 4 * j); bv[j] = *(const f32x4*)(b1 + lane * 16 + 4 * j); }
    u32x4 n0 = *(const u32x4*)(P.Y + ((size_t)tok0 + wid * 8) * D + lane * 16), n1 = *(const u32x4*)(P.Y + ((size_t)tok0 + wid * 8) * D + lane * 16 + 8);
    for (int rr = 0; rr < 8; ++rr) { const int r = wid * 8 + rr; const size_t row = (size_t)tok0 + r;
        float v[16]; float s_ = 0.f;
#pragma unroll
        for (int q = 0; q < 4; ++q) { v[2 * q] = bflo(n0[q]); v[2 * q + 1] = bfhi(n0[q]); v[8 + 2 * q] = bflo(n1[q]); v[8 + 2 * q + 1] = bfhi(n1[q]); }
#pragma unroll
        for (int j = 0; j < 16; ++j) s_ += v[j];
        if (rr + 1 < 8) { n0 = *(const u32x4*)(P.Y + (row + 1) * D + lane * 16); n1 = *(const u32x4*)(P.Y + (row + 1) * D + lane * 16 + 8); }
        const float mu = wsum(s_) * (1.f / D); float q_ = 0.f;
#pragma unroll
        for (int j = 0; j < 16; ++j) { v[j] -= mu; q_ += v[j] * v[j]; }
        const float rs = rsqrtf(wsum(q_) * (1.f / D) + EPS);
#pragma unroll
        for (int j = 0; j < 16; ++j) v[j] = v[j] * rs * gv[j >> 2][j & 3] + bv[j >> 2][j & 3];
        u32x4 o0, o1;
#pragma unroll
        for (int q = 0; q < 4; ++q) { o0[q] = pk2(v[2 * q], v[2 * q + 1]); o1[q] = pk2(v[8 + 2 * q], v[8 + 2 * q + 1]); }
        *(u32x4*)(P.XB + row * D + lane * 16) = o0; *(u32x4*)(P.XB + row * D + lane * 16 + 8) = o1;
        if (lane == 0) ST[r] = (f32x2){mu, rs}; }
    __syncthreads();
    if (tid < 64) { const int r = tid; const size_t row = (size_t)tok0 + r; const f32x2 st = ST[r];
        float sg[16], ss[16];
#pragma unroll
        for (int q4 = 0; q4 < 4; ++q4) { const f32x4 pa = *(const LAS f32x4*)(PL + r * 16 + 4 * q4), pb = *(const LAS f32x4*)(PL + (64 + r) * 16 + 4 * q4);
#pragma unroll
            for (int x = 0; x < 4; ++x) { const int e = 4 * q4 + x; const float lg = st.y * ((pa[x] + pb[x]) - st.x * P.RGB[e]) + P.RGB[16 + e];
                sg[e] = __builtin_amdgcn_rcpf(1.f + __expf(-lg)); ss[e] = sg[e] + rb[e]; } }
        int best_g = 0; float best = -INFINITY;
#pragma unroll
        for (int gI = 0; gI < 4; ++gI) { float m1 = -INFINITY, m2 = -INFINITY;
#pragma unroll
            for (int k = 0; k < 4; ++k) { const float vv = ss[gI * 4 + k]; if (vv > m1) { m2 = m1; m1 = vv; } else if (vv > m2) { m2 = vv; } }
            const float gs = m1 + m2; if (gs > best) { best = gs; best_g = gI; } }
        float c0 = 0.f, c1 = 0.f, c2 = 0.f, c3 = 0.f, t0 = 0.f, t1 = 0.f, t2 = 0.f, t3 = 0.f;
#pragma unroll
        for (int gI = 0; gI < 4; ++gI) if (gI == best_g) { c0 = ss[gI * 4]; c1 = ss[gI * 4 + 1]; c2 = ss[gI * 4 + 2]; c3 = ss[gI * 4 + 3]; t0 = sg[gI * 4]; t1 = sg[gI * 4 + 1]; t2 = sg[gI * 4 + 2]; t3 = sg[gI * 4 + 3]; }
        int i1 = 0; float v1 = c0, s1 = t0;
        if (c1 > v1) { i1 = 1; v1 = c1; s1 = t1; }
        if (c2 > v1) { i1 = 2; v1 = c2; s1 = t2; }
        if (c3 > v1) { i1 = 3; v1 = c3; s1 = t3; }
        int i2 = -1; float v2 = -INFINITY, s2 = 0.f;
        if (i1 != 0 && c0 > v2) { i2 = 0; v2 = c0; s2 = t0; }
        if (i1 != 1 && c1 > v2) { i2 = 1; v2 = c1; s2 = t1; }
        if (i1 != 2 && c2 > v2) { i2 = 2; v2 = c2; s2 = t2; }
        if (i1 != 3 && c3 > v2) { i2 = 3; v2 = c3; s2 = t3; }
        const int e1 = best_g * 4 + i1, e2 = best_g * 4 + i2; const float inv = 1.f / (s1 + s2);
        P.GATE[row * 2] = s1 * inv; P.GATE[row * 2 + 1] = s2 * inv; P.EIDX[row * 2] = e1; P.EIDX[row * 2 + 1] = e2; EI[r * 2] = e1; EI[r * 2 + 1] = e2; }
    __syncthreads();
    { LAS int* C0 = EI + 128;
      int rank = 0, mye = -1, c_lo = 0;
      if (tid < 128) { mye = EI[tid];
#pragma unroll
          for (int e = 0; e < 16; ++e) { const unsigned long long m = __ballot(mye == e); if (mye == e) rank = __builtin_popcountll(m & ((1ull << lane) - 1ull)); if (tid == e) c_lo = __builtin_popcountll(m); if (tid == 64 + e) c_lo = __builtin_popcountll(m); }
          if (tid < 16) C0[tid] = c_lo; }
      __syncthreads();
      if (tid < 128) { if (tid >= 64) rank += C0[mye]; P.LRANK[(size_t)tok0 * 2 + tid] = rank; if (tid >= 64 && tid < 80) P.HIST[tile * 16 + (tid - 64)] = C0[tid - 64] + c_lo; } }
    __syncthreads();
}
__device__ __forceinline__ void moe_table(const OW& P, LAS unsigned char* lds) {
    const int tid = TID(); LAS int* HS = (LAS int*)lds; LAS int* TAB = (LAS int*)(lds + TAB_OFF);
    { int hv[8];
#pragma unroll
      for (int q = 0; q < 8; ++q) hv[q] = P.HIST[tid + q * NTHREADS];
#pragma unroll
      for (int q = 0; q < 8; ++q) HS[tid + q * NTHREADS] = hv[q]; }
    __syncthreads();
    if (tid < 64) { const int e = tid & 15, qd = tid >> 4; int tot = 0;
#pragma unroll 8
        for (int w = 0; w < 64; ++w) tot += HS[(qd * 64 + w) * 16 + e];
        tot += __shfl_xor(tot, 16); tot += __shfl_xor(tot, 32);
        if (qd == 0) TAB[32 + e] = tot; }
    __syncthreads();
    if (tid == 0) { int acc = 0; for (int e = 0; e < 16; ++e) { TAB[e] = acc; acc += (TAB[32 + e] + 255) >> 8; } TAB[16] = acc; }
    __syncthreads();
}
__device__ __forceinline__ void dest_tile(const OW& P, LAS unsigned char* lds, int tile) {
    const int tid = TID(); LAS int* HS = (LAS int*)lds; LAS int* TAB = (LAS int*)(lds + TAB_OFF); LAS int* BS = (LAS int*)(lds + 16384);
    if (tid < 64) { const int e = tid & 15, qd = tid >> 4; int b = 0;
#pragma unroll 8
        for (int w = 0; w < 64; ++w) { const int ww = qd * 64 + w; b += ww < tile ? HS[ww * 16 + e] : 0; }
        b += __shfl_xor(b, 16); b += __shfl_xor(b, 32);
        if (qd == 0) BS[e] = b; }
    __syncthreads();
    if (tid < 128) { const size_t a = (size_t)tile * 128 + tid; const int e = P.EIDX[a]; const int dst = 256 * TAB[e] + BS[e] + P.LRANK[a]; P.DEST[a] = dst; P.ROWTOK[dst] = (int)(a >> 1); }
    if (tile < 16) { const int e = tile, lo = 256 * TAB[e] + TAB[32 + e], hi = 256 * TAB[e + 1]; for (int i = lo + tid; i < hi; i += NTHREADS) P.ROWTOK[i] = 0; }
    __syncthreads();
}
struct SchedMoe {
    static constexpr bool HOOKS = false;
    const OW* P; LAS int* TAB; int G, c; bool down;
    __device__ __forceinline__ bool next(int i, pg8::UnitD& u) const {
        const int NB = __builtin_amdgcn_readfirstlane(TAB[16]); const int L = i * G + c; if (L >= NB * 4) return false;
        const int rb = L >> 2, pn = L & 3; int e = 0;
#pragma unroll
        for (int q = 1; q < 16; ++q) e += (__builtin_amdgcn_readfirstlane(TAB[q]) <= rb) ? 1 : 0;
        if (!down) { u.A = (const char*)P->XB; u.rows = P->ROWTOK + rb * 256; u.B = (const char*)(P->Wgu_t + ((size_t)e * 1024 + pn * 256) * 1024); u.lda = 2048; u.ldb = 2048; u.nt = 16; u.type = 4; }
        else { u.A = (const char*)(P->HE + (size_t)rb * 256 * DE); u.rows = nullptr; u.B = (const char*)(P->Wd_t + ((size_t)e * 1024 + pn * 256) * DE); u.lda = 1024; u.ldb = 1024; u.nt = 8; u.type = 5; }
        u.pm = rb; u.pn = pn; u.aux = e; return true;
    }
};
struct EpiMoeUp {
    bf16_t* HE;
    __device__ __forceinline__ void operator()(const f32x4 (&acc)[2][2][4][2], const pg8::UnitD& u, int wr, int wc, int fr, int fq) const {
        const int row0 = u.pm * 256 + wr * 64 + fr, col0 = u.pn * 128 + wc * 32 + 8 * fq;
#pragma unroll
        for (int ai = 0; ai < 2; ++ai)
#pragma unroll
            for (int m = 0; m < 4; ++m) { float hv[8];
#pragma unroll
                for (int n = 0; n < 2; ++n)
#pragma unroll
                    for (int x = 0; x < 4; ++x) { const float g = acc[ai][0][m][n][x], up = acc[ai][1][m][n][x]; hv[4 * n + x] = g / (1.f + __expf(-g)) * up; }
                u32x4 w; w.x = pg8::cvt_pk_bf16(hv[0], hv[1]); w.y = pg8::cvt_pk_bf16(hv[2], hv[3]); w.z = pg8::cvt_pk_bf16(hv[4], hv[5]); w.w = pg8::cvt_pk_bf16(hv[6], hv[7]);
                *(u32x4*)(HE + (size_t)(row0 + ai * 128 + m * 16) * DE + col0) = w; }
    }
};
struct EpiMoeDown {
    bf16_t* YE;
    __device__ __forceinline__ void operator()(const f32x4 (&acc)[2][2][4][2], const pg8::UnitD& u, int wr, int wc, int fr, int fq) const {
        const int row0 = u.pm * 256 + wr * 64 + fr, col0 = u.pn * 256 + wc * 32 + 8 * fq;
#pragma unroll
        for (int ai = 0; ai < 2; ++ai)
#pragma unroll
            for (int m = 0; m < 4; ++m) { bf16_t* rowp = YE + (size_t)(row0 + ai * 128 + m * 16) * D + col0;
#pragma unroll
                for (int bj = 0; bj < 2; ++bj) { const f32x4 v0 = acc[ai][bj][m][0], v1 = acc[ai][bj][m][1];
                    u32x4 w; w.x = pg8::cvt_pk_bf16(v0[0], v0[1]); w.y = pg8::cvt_pk_bf16(v0[2], v0[3]); w.z = pg8::cvt_pk_bf16(v1[0], v1[1]); w.w = pg8::cvt_pk_bf16(v1[2], v1[3]);
                    *(u32x4*)(rowp + bj * 128) = w; } }
    }
};

__device__ __forceinline__ void store16_sc1(void* p, u32x4 v) { asm volatile("global_store_dwordx4 %0, %1, off sc1\n\ts_nop 1" :: "v"(p), "v"(v) : "memory"); }
struct SchedMoe2 {
    static constexpr bool HOOKS = true;
    const OW* P; LAS int* TAB; unsigned* cnt;
    int G, c, U, nup, ndn, jA, jB;
    __device__ __forceinline__ void init(int G_, int c_) {
        G = G_; c = c_; const int NB = __builtin_amdgcn_readfirstlane(TAB[16]); U = 4 * NB;
        const int nmax = (U + G - 1) / G, nfull = U - (nmax - 1) * G;
        const bool allsame = nfull >= G; const int Lc = allsame ? 0 : G - nfull;
        nup = (c < nfull || allsame) ? nmax : nmax - 1; if (c >= U) nup = 0;
        const bool light = !allsame && c >= nfull; const int cl = c - nfull;
        const int nA = 2 * Lc < U ? 2 * Lc : U; const int R = U - nA;
        int a_cnt = 0; if (light) { a_cnt = nA - 2 * cl; a_cnt = a_cnt < 0 ? 0 : (a_cnt > 2 ? 2 : a_cnt); }
        const int o = light ? cl : Lc + c;
        const int b_cnt = o < R ? (R - o + G - 1) / G : 0;
        jA = 2 * cl; jB = nA + o; ndn = a_cnt + b_cnt; nA_mine = a_cnt;
    }
    int nA_mine;
    __device__ __forceinline__ bool next(int i, pg8::UnitD& u) const {
        if (i < nup) { const int Lq = c + i * G; fill(u, Lq >> 2, Lq & 3, false); return true; }
        const int k = i - nup; if (k >= ndn) return false;
        const int j = k < nA_mine ? jA + k : jB + (k - nA_mine) * G; fill(u, j >> 2, j & 3, true); return true;
    }
    __device__ __forceinline__ void fill(pg8::UnitD& u, int rb, int pn, bool down) const {
        int e = 0;
#pragma unroll
        for (int q = 1; q < 16; ++q) e += (__builtin_amdgcn_readfirstlane(TAB[q]) <= rb) ? 1 : 0;
        if (!down) { u.A = (const char*)P->XB; u.rows = P->ROWTOK + rb * 256; u.B = (const char*)(P->Wgu_t + ((size_t)e * 1024 + pn * 256) * 1024); u.lda = 2048; u.ldb = 2048; u.nt = 16; u.type = 4; }
        else { u.A = (const char*)(P->HE + (size_t)rb * 256 * DE); u.rows = nullptr; u.B = (const char*)(P->Wd_t + ((size_t)e * 1024 + pn * 256) * DE); u.lda = 1024; u.ldb = 1024; u.nt = 8; u.type = 5; }
        u.pm = rb; u.pn = pn; u.aux = e;
    }
    __device__ __forceinline__ void a_ready(const pg8::UnitD& u, int wid) const {
        if (u.type != 5) return;
        if (wid == 0) {
            const unsigned* w = cnt + 64 * u.pm; unsigned spins = 0;
            for (;;) { unsigned v;
                asm volatile("v_mov_b32 %0, 0\n\tglobal_load_dword %0, %0, %1 sc1\n\ts_waitcnt vmcnt(0)" : "=&v"(v) : "s"(w) : "memory");
                if ((unsigned)__builtin_amdgcn_readfirstlane((int)v) >= 32u) break;
                if (++spins > 200000u) break;
                __builtin_amdgcn_s_sleep(2); }
            __builtin_amdgcn_fence(__ATOMIC_ACQUIRE, "agent");
            asm volatile("s_waitcnt vmcnt(0)" ::: "memory");
        }
        asm volatile("" ::: "memory"); __builtin_amdgcn_s_barrier(); asm volatile("" ::: "memory");
    }
    __device__ __forceinline__ void done(const pg8::UnitD& u, int lane) const {
        if (u.type != 4) return;
        asm volatile("s_waitcnt vmcnt(0)" ::: "memory");
        if (lane == 0) __hip_atomic_fetch_add(cnt + 64 * u.pm, 1u, __ATOMIC_RELAXED, __HIP_MEMORY_SCOPE_AGENT);
    }
};
struct EpiMoe2 {
    bf16_t* HE; bf16_t* YE;
    __device__ __forceinline__ void operator()(const f32x4 (&acc)[2][2][4][2], const pg8::UnitD& u, int wr, int wc, int fr, int fq) const {
        const int row0 = u.pm * 256 + wr * 64 + fr;
        if (u.type == 4) { const int col0 = u.pn * 128 + wc * 32 + 8 * fq;
#pragma unroll
            for (int ai = 0; ai < 2; ++ai)
#pragma unroll
                for (int m = 0; m < 4; ++m) { float hv[8];
                    int rr = row0 + ai * 128 + m * 16; asm volatile("" : "+v"(rr));
#pragma unroll
                    for (int n = 0; n < 2; ++n)
#pragma unroll
                        for (int x = 0; x < 4; ++x) { const float g = acc[ai][0][m][n][x], up = acc[ai][1][m][n][x]; hv[4 * n + x] = g * __builtin_amdgcn_rcpf(1.f + __expf(-g)) * up; }
                    u32x4 w; w.x = pg8::cvt_pk_bf16(hv[0], hv[1]); w.y = pg8::cvt_pk_bf16(hv[2], hv[3]); w.z = pg8::cvt_pk_bf16(hv[4], hv[5]); w.w = pg8::cvt_pk_bf16(hv[6], hv[7]);
                    store16_sc1(HE + (size_t)rr * DE + col0, w); }
        } else { const int col0 = u.pn * 256 + wc * 32 + 8 * fq;
#pragma unroll
            for (int ai = 0; ai < 2; ++ai)
#pragma unroll
                for (int m = 0; m < 4; ++m) { int rr = row0 + ai * 128 + m * 16; asm volatile("" : "+v"(rr)); bf16_t* rowp = YE + (size_t)rr * D + col0;
#pragma unroll
                    for (int bj = 0; bj < 2; ++bj) { const f32x4 v0 = acc[ai][bj][m][0], v1 = acc[ai][bj][m][1];
                        u32x4 w; w.x = pg8::cvt_pk_bf16(v0[0], v0[1]); w.y = pg8::cvt_pk_bf16(v0[2], v0[3]); w.z = pg8::cvt_pk_bf16(v1[0], v1[1]); w.w = pg8::cvt_pk_bf16(v1[2], v1[3]);
                        *(u32x4*)(rowp + bj * 128) = w; } }
        }
    }
};
__device__ __forceinline__ void ln2_rows(const OW& P, int l, int vcu, int G, float* Xdst) {
    const int tid_ = TID(); const int lane = tid_ & 63, wid = __builtin_amdgcn_readfirstlane(tid_ >> 6);
    const float* g2 = P.in[22] + (size_t)l * D; const float* b2 = P.in[23] + (size_t)l * D;
    f32x4 gv[4], bv[4];
#pragma unroll
    for (int j = 0; j < 4; ++j) { const int c = lane * 8 + 512 * (j >> 1) + 4 * (j & 1); gv[j] = *(const f32x4*)(g2 + c); bv[j] = *(const f32x4*)(b2 + c); }
    const size_t first = (size_t)vcu * NWAVES + wid, stride = (size_t)G * NWAVES;
    for (size_t base = first; base < NT; base += 8 * stride) {
        float ga[8], gb[8]; int da[8], db[8];
#pragma unroll
        for (int k = 0; k < 8; ++k) { const size_t row = base + k * stride; const bool ok = row < NT; const size_t r_ = ok ? row : base;
            ga[k] = P.GATE[r_ * 2]; gb[k] = P.GATE[r_ * 2 + 1]; da[k] = P.DEST[r_ * 2]; db[k] = P.DEST[r_ * 2 + 1]; }
#pragma unroll
        for (int kg = 0; kg < 8; kg += 4) {
        u32x4 nx[4][2], nya[4][2], nyb[4][2];
#pragma unroll
        for (int k4 = 0; k4 < 4; ++k4) { const int k = kg + k4; const size_t row_ = base + k * stride < NT ? base + k * stride : base;
#pragma unroll
            for (int j = 0; j < 2; ++j) { nx[k4][j] = *(const u32x4*)(P.XB + row_ * D + lane * 8 + 512 * j);
                nya[k4][j] = *(const u32x4*)(P.YE + (size_t)da[k] * D + lane * 8 + 512 * j); nyb[k4][j] = *(const u32x4*)(P.YE + (size_t)db[k] * D + lane * 8 + 512 * j); } }
#pragma unroll
        for (int k4 = 0; k4 < 4; ++k4) { const int k = kg + k4; const size_t row = base + k * stride; if (row >= NT) break;
            float v[16]; float s = 0.f; const float gA = ga[k], gB = gb[k];
#pragma unroll
            for (int j = 0; j < 2; ++j)
#pragma unroll
                for (int q = 0; q < 4; ++q) { const unsigned x = nx[k4][j][q], ya = nya[k4][j][q], yb = nyb[k4][j][q];
                    v[8 * j + 2 * q] = ALPHA * bflo(x) + gA * bflo(ya) + gB * bflo(yb); v[8 * j + 2 * q + 1] = ALPHA * bfhi(x) + gA * bfhi(ya) + gB * bfhi(yb); }
#pragma unroll
            for (int i = 0; i < 16; ++i) s += v[i];
            const float mu = wsum(s) * (1.f / D); float q_ = 0.f;
#pragma unroll
            for (int i = 0; i < 16; ++i) { v[i] -= mu; q_ += v[i] * v[i]; }
            const float rs = rsqrtf(wsum(q_) * (1.f / D) + EPS);
#pragma unroll
            for (int i = 0; i < 16; ++i) v[i] = v[i] * rs * gv[i >> 2][i & 3] + bv[i >> 2][i & 3];
#pragma unroll
            for (int j = 0; j < 2; ++j) { u32x4 o;
#pragma unroll
                for (int q = 0; q < 4; ++q) o[q] = pk2(v[8 * j + 2 * q], v[8 * j + 2 * q + 1]);
                *(u32x4*)(P.XB + row * D + lane * 8 + 512 * j) = o;
                if (Xdst) { *(f32x4*)(Xdst + row * D + lane * 8 + 512 * j) = (f32x4){v[8 * j], v[8 * j + 1], v[8 * j + 2], v[8 * j + 3]}; *(f32x4*)(Xdst + row * D + lane * 8 + 512 * j + 4) = (f32x4){v[8 * j + 4], v[8 * j + 5], v[8 * j + 6], v[8 * j + 7]}; } }
        }
        }
    }
}

#if MODE == 0
__global__ void __launch_bounds__(NTHREADS, 2) opt_phase(OW P, int phase, int layer) {
    extern __shared__ __attribute__((aligned(16))) unsigned char lds_raw[];
    LAS unsigned char* lds = (LAS unsigned char*)lds_raw;
    const int G = gridDim.x, bx = blockIdx.x, vcu = (G % 8 == 0) ? (bx % 8) * (G / 8) + bx / 8 : bx;
    switch (phase) {
        case 0: if (PH(0)) { prep_tables(P, vcu, G); prep_weights(P, layer, lds, vcu, G); } break;
        case 1: if (PH(1)) phase_inproj(P, lds, G); break;
        case 2: if (PH(2)) phase_qkv(P, layer, lds, G); break;
        case 3: if (PH(3)) phase_attn(P, lds, vcu, G); break;
        case 4: if (PH(4)) { for (int tile = blockIdx.x; tile < NT / 64; tile += G) mix_tile(P, lds, tile); } break;
        case 5: if (PH(5)) { SchedOut Sd{&P, G, (int)blockIdx.x}; EpiOut E{P.XB, P.Y}; pg8::gemm_phase<true>(lds, Sd, E); } break;
        case 6: if (PH(6)) { for (int tile = blockIdx.x; tile < NT / 64; tile += G) ln1_router_tile(P, layer, lds, tile); } break;
        case 7: if (PH(7)) { moe_table(P, lds); for (int tile = blockIdx.x; tile < NT / 64; tile += G) dest_tile(P, lds, tile); } break;
        case 8: if (PH(8)) { moe_table(P, lds); SchedMoe Sd{&P, (LAS int*)(lds + TAB_OFF), G, (int)blockIdx.x, false}; EpiMoeUp E{P.HE}; pg8::gemm_phase<true>(lds, Sd, E); } break;
        case 9: if (PH(9)) { moe_table(P, lds); SchedMoe Sd{&P, (LAS int*)(lds + TAB_OFF), G, (int)blockIdx.x, true}; EpiMoeDown E{P.YE}; pg8::gemm_phase<true>(lds, Sd, E); } break;
        case 10: if (PH(10)) { ln2_rows(P, layer, vcu, G, layer == L - 1 ? P.X : nullptr); if (layer + 1 < L) prep_weights(P, layer + 1, lds, vcu, G); } break;
        default: break;
    }
}

#endif
struct MArgs { const float* in[24]; float* X; char* ws; };
constexpr int PT_OFF = LDSCTL_OFF + 2048;
__device__ __forceinline__ unsigned long long ldq(LAS unsigned char* lds, int k) {
    const LAS unsigned* p = (const LAS unsigned*)(lds + PT_OFF) + 2 * k;
    const unsigned lo = (unsigned)__builtin_amdgcn_readfirstlane((int)p[0]), hi = (unsigned)__builtin_amdgcn_readfirstlane((int)p[1]);
    return ((unsigned long long)hi << 32) | lo;
}
__device__ __forceinline__ OW load_ow(LAS unsigned char* lds_, int wsel = 0) {
    unsigned la = (unsigned)(uintptr_t)lds_; asm volatile("" : "+s"(la) :: "memory"); LAS unsigned char* lds = (LAS unsigned char*)(uintptr_t)la;
    OW P;
#pragma unroll
    for (int i = 0; i < 24; ++i) P.in[i] = (const float*)(GAS const float*)ldq(lds, i);
    P.X = (float*)(GAS float*)ldq(lds, 24); GAS char* ws = (GAS char*)ldq(lds, 25); GAS char* wsw = ws + (wsel ? ows::WSET1 : 0);
    P.ctl = (unsigned*)(GAS unsigned*)(ws + ows::CTL); P.XB = (bf16_t*)(GAS bf16_t*)(ws + ows::XB); P.Z = (bf16_t*)(GAS bf16_t*)(ws + ows::Z); P.SSQ = (float*)(GAS float*)(ws + ows::SSQ);
    P.Win_t = (bf16_t*)(GAS bf16_t*)(wsw + ows::WIN); P.Wq_t = (bf16_t*)(GAS bf16_t*)(wsw + ows::WQ); P.Wkv_t = (bf16_t*)(GAS bf16_t*)(wsw + ows::WKV); P.Wo_t = (bf16_t*)(GAS bf16_t*)(wsw + ows::WO);
    P.Wgu_t = (bf16_t*)(GAS bf16_t*)(wsw + ows::WGU); P.Wd_t = (bf16_t*)(GAS bf16_t*)(wsw + ows::WD); P.Wlg_t = (bf16_t*)(GAS bf16_t*)(wsw + ows::WLG); P.RWH = (bf16_t*)(GAS bf16_t*)(wsw + ows::WLG + 262144); P.RGB = (float*)(GAS float*)(wsw + ows::WLG + 393216);
    P.ROPE = (f32x2*)(GAS f32x2*)(ws + ows::ROPE); P.Q = (bf16_t*)(GAS bf16_t*)(ws + ows::Q); P.KN = (bf16_t*)(GAS bf16_t*)(ws + ows::KN); P.VV = (bf16_t*)(GAS bf16_t*)(ws + ows::VV); P.KPE = (bf16_t*)(GAS bf16_t*)(ws + ows::KPE);
    P.A = (float*)(GAS float*)(ws + ows::A); P.DRV = (float*)(GAS float*)(ws + ows::DRV); P.AGA = (float*)(GAS float*)(ws + ows::AGA); P.AGB = (float*)(GAS float*)(ws + ows::AGB);
    P.OP = (bf16_t*)(GAS bf16_t*)(ws + ows::OP); P.ML = (f32x2*)(GAS f32x2*)(ws + ows::ML); P.MIX = (bf16_t*)(GAS bf16_t*)(ws + ows::MIX); P.Y = (bf16_t*)(GAS bf16_t*)(ws + ows::Y);
    P.EIDX = (int*)(GAS int*)(ws + ows::EIDX); P.HIST = (int*)(GAS int*)(ws + ows::HIST); P.LRANK = (int*)(GAS int*)(ws + ows::LRANK); P.DEST = (int*)(GAS int*)(ws + ows::DEST); P.ROWTOK = (int*)(GAS int*)(ws + ows::ROWTOK); P.GATE = (float*)(GAS float*)(ws + ows::GATE);
    P.HE = (bf16_t*)(GAS bf16_t*)(ws + ows::HE); P.YE = (bf16_t*)(GAS bf16_t*)(ws + ows::YE);
    return P;
}
__global__ void __launch_bounds__(NTHREADS, 2) mega_fwd(MArgs a) {
    extern __shared__ __attribute__((aligned(16))) unsigned char lds_raw[];
    LAS unsigned char* lds = (LAS unsigned char*)lds_raw;
    for (int u = threadIdx.x; u < (LDS_BYTES - LDSCTL_OFF) / 4; u += NTHREADS) ((LAS unsigned*)(lds + LDSCTL_OFF))[u] = 0u;
    __syncthreads();
    { LAS unsigned long long* PT = (LAS unsigned long long*)(lds + PT_OFF);
#pragma unroll
      for (int i = 0; i < 24; ++i) if (threadIdx.x == i) PT[i] = (unsigned long long)a.in[i];
      if (threadIdx.x == 24) PT[24] = (unsigned long long)a.X;
      if (threadIdx.x == 25) PT[25] = (unsigned long long)a.ws; }
    __syncthreads();
    XcdBarrier bar; { const OW P = load_ow(lds); bar = xcd_barrier_post(P.ctl + 4096, (volatile LAS unsigned*)(lds + MISC_OFF) + 8); }
    LAS int* TAB = (LAS int*)(lds + TAB_OFF);
    if (PH(0)) { const OW P = load_ow(lds); const int G = GDIM(); const int b_ = BID(); const int v_ = (G % 8 == 0) ? (b_ % 8) * (G / 8) + b_ / 8 : b_; prep_tables(P, v_, G); prep_weights(P, 0, lds, v_, G, 0, 136, 1); }
    xcd_barrier(bar);
    for (int l = 0; l < L; ++l) {
        for (int rep_ = 0; rep_ < (DUP(1) ? 2 : 1); ++rep_) if (PH(1)) { const OW P = load_ow(lds, 0); const int G = GDIM(); phase_inproj(P, lds, G); }
        if (PH(10)) {
            const OW P = load_ow(lds, 0); const int G = GDIM(), b_ = BID(); const int nmax = (576 + G - 1) / G, nfull = 576 - (nmax - 1) * G;
            constexpr int SPLIT = 1236;
            if (G == 256) { if (b_ >= nfull) prep_weights(P, l, lds, b_ - nfull, G - nfull, 136, SPLIT, 2); }
            else prep_weights(P, l, lds, b_, G, 136, 1 << 30, 2); }
        xcd_barrier(bar);
        for (int rep_ = 0; rep_ < (DUP(2) ? 2 : 1); ++rep_) if (PH(2)) { { const OW P = load_ow(lds, 0); const int G = GDIM(); SchedQKV Sd{&P, G, BID()}; EpiQKV E{P.SSQ, P.Q, P.KN, P.VV}; pg8::gemm_phase<true>(lds, Sd, E); }
                     { const OW P = load_ow(lds, 0); const int G = GDIM(); for (int tile = BID(); tile < NT / 64; tile += G) { gates_tile(P, l, lds, tile); if (DUP(15)) gates_tile(P, l, lds, tile); } }
                     if (PH(10)) { const OW P = load_ow(lds, 0); const int G = GDIM(), b_ = BID();
                         if (G == 256) {
                             if (b_ < 192 && b_ % 3 != 0) prep_weights(P, l, lds, b_ - b_ / 3 - 1, 128, 1236, 1758, 0);
                             else if (b_ >= 192) { prep_weights(P, l, lds, b_ - 192, 64, 1758, 1 << 30, 0); if (l + 1 < L) prep_weights(P, l + 1, lds, b_ - 192, 64, 0, 136, 1); } }
                         else if (l + 1 < L) prep_weights(P, l + 1, lds, b_, G, 0, 136, 1); } }
        xcd_barrier(bar);
        for (int rep_ = 0; rep_ < (DUP(3) ? 2 : 1); ++rep_) if (PH(3)) { const OW P = load_ow(lds, 0); const int G = GDIM(); { const int b_ = BID(); phase_attn(P, lds, (G % 8 == 0) ? (b_ % 8) * (G / 8) + b_ / 8 : b_, G); } }
        xcd_barrier(bar);
        for (int rep_ = 0; rep_ < (DUP(4) ? 2 : 1); ++rep_) if (PH(4)) { const OW P = load_ow(lds, 0); const int G = GDIM(); for (int tile = BID(); tile < NT / 64; tile += G) mix_tile(P, lds, tile); }
        xcd_barrier(bar);
        for (int rep_ = 0; rep_ < (DUP(5) ? 2 : 1); ++rep_) if (PH(5)) { const OW P = load_ow(lds, 0); const int G = GDIM(); SchedOut Sd{&P, G, BID()}; EpiOut E{P.XB, P.Y}; pg8::gemm_phase<true>(lds, Sd, E); }
        xcd_barrier(bar);
        for (int rep_ = 0; rep_ < (DUP(6) ? 2 : 1); ++rep_) if (PH(6)) { const OW P = load_ow(lds, 0); const int G = GDIM(); for (int tile = BID(); tile < NT / 64; tile += G) { ln1_router_tile(P, l, lds, tile); if (DUP(13)) ln1_router_tile(P, l, lds, tile); } }
        xcd_barrier(bar);
        for (int rep_ = 0; rep_ < (DUP(7) ? 2 : 1); ++rep_) if (PH(7)) { const OW P = load_ow(lds, 0); const int G = GDIM(); moe_table(P, lds); for (int tile = BID(); tile < NT / 64; tile += G) dest_tile(P, lds, tile); }
        xcd_barrier(bar);
        for (int rep_ = 0; rep_ < (DUP(8) ? 2 : 1); ++rep_) if (PH(8)) { const OW P = load_ow(lds, 0); const int G = GDIM(); SchedMoe2 Sd; Sd.P = &P; Sd.TAB = TAB; Sd.cnt = P.ctl + MOECNT_W + l * 144 * 64; Sd.init(G, BID()); EpiMoe2 E{P.HE, P.YE}; pg8::gemm_phase<true>(lds, Sd, E); }
        xcd_barrier(bar);
        if (PH(10)) { const OW P = load_ow(lds, 0); const int G = GDIM(); { const int b_ = BID(); const int v_ = (G % 8 == 0) ? (b_ % 8) * (G / 8) + b_ / 8 : b_; ln2_rows(P, l, v_, G, l == L - 1 ? P.X : nullptr); } }
        if (l + 1 < L) xcd_barrier(bar);
        if (DUP(12)) for (int rep_ = 0; rep_ < 10; ++rep_) xcd_barrier(bar);
    }
}
#if MODE == 0
__global__ void shim_q(const bf16_t* Qb, float* Qf) { const size_t i = (size_t)blockIdx.x * 256 + threadIdx.x; if (i < (size_t)NT * QL) Qf[i] = bf2f(Qb[i]); }
__global__ void shim_kv(const bf16_t* KN, const bf16_t* VV, float* KV) { const size_t i = (size_t)blockIdx.x * 256 + threadIdx.x; if (i < (size_t)NT * 1024) { const size_t r = i >> 10; const int c = (int)(i & 1023), h = c >> 8, d = c & 255;
    KV[i] = d < 128 ? bf2f(KN[r * 512 + h * 128 + d]) : bf2f(VV[r * 512 + h * 128 + d - 128]); } }
__global__ void shim_kpe(const bf16_t* Kb, float* Kf) { const size_t i = (size_t)blockIdx.x * 256 + threadIdx.x; if (i < (size_t)NT * 64) Kf[i] = bf2f(Kb[i]); }
__global__ void shim_z(const bf16_t* Zb, float* Zf) { const size_t i = (size_t)blockIdx.x * 256 + threadIdx.x; if (i < (size_t)NT * INW) { const size_t r = i / INW, c = i % INW; Zf[i] = bf2f(Zb[r * ZW + c]); } }


#endif
#if MODE == 0
static OW make_ow(void* const* d_in, float* out, char* ws) {
    OW P{};
    for (int i = 0; i < 24; ++i) P.in[i] = (const float*)d_in[i];
    P.X = out; P.ctl = (unsigned*)(ws + ows::CTL); P.XB = (bf16_t*)(ws + ows::XB); P.Z = (bf16_t*)(ws + ows::Z); P.SSQ = (float*)(ws + ows::SSQ);
    P.Win_t = (bf16_t*)(ws + ows::WIN); P.Wq_t = (bf16_t*)(ws + ows::WQ); P.Wkv_t = (bf16_t*)(ws + ows::WKV); P.Wo_t = (bf16_t*)(ws + ows::WO); P.Wgu_t = (bf16_t*)(ws + ows::WGU); P.Wd_t = (bf16_t*)(ws + ows::WD); P.Wlg_t = (bf16_t*)(ws + ows::WLG);
    P.ROPE = (f32x2*)(ws + ows::ROPE); P.Q = (bf16_t*)(ws + ows::Q); P.KN = (bf16_t*)(ws + ows::KN); P.VV = (bf16_t*)(ws + ows::VV); P.KPE = (bf16_t*)(ws + ows::KPE);
    P.A = (float*)(ws + ows::A); P.DRV = (float*)(ws + ows::DRV); P.AGA = (float*)(ws + ows::AGA); P.AGB = (float*)(ws + ows::AGB);
    P.OP = (bf16_t*)(ws + ows::OP); P.ML = (f32x2*)(ws + ows::ML); P.MIX = (bf16_t*)(ws + ows::MIX); P.Y = (bf16_t*)(ws + ows::Y);
    P.EIDX = (int*)(ws + ows::EIDX); P.HIST = (int*)(ws + ows::HIST); P.LRANK = (int*)(ws + ows::LRANK); P.DEST = (int*)(ws + ows::DEST); P.ROWTOK = (int*)(ws + ows::ROWTOK); P.GATE = (float*)(ws + ows::GATE);
    P.HE = (bf16_t*)(ws + ows::HE); P.YE = (bf16_t*)(ws + ows::YE); P.RWH = (bf16_t*)(ws + ows::WLG + 262144); P.RGB = (float*)(ws + ows::WLG + 393216);
    return P;
}

#endif
constexpr int ATT_LDS = (4 * S + 4 * QH) * 4, MOEUP_LDS = D * 16 * 4 + 64;
#ifndef OPT_STAGES
#define OPT_STAGES 0
#endif
#ifndef OPT_LAYERS
#define OPT_LAYERS 1
#endif
#if MODE == 0
static void hybrid_forward(void* const* d_in, float* out, float* ws, hipStream_t st) {
    const float* x0 = (const float*)d_in[0];
    float* Z = ws + rws::Z; float* YE = Z; float* A = ws + rws::AB; float* DRV = A + (size_t)NT * LW; float* HID = A;
    float* Q = ws + rws::Q; float* KV = ws + rws::KV; float* Y = KV; float* KPE = ws + rws::KPE; float* MIX = ws + rws::MIX;
    float* GATE = ws + rws::GATE; int* CNT = (int*)(ws + rws::CNT); int* LIST = (int*)(ws + rws::LIST);
    OW P{};
    for (int i = 0; i < 24; ++i) P.in[i] = (const float*)d_in[i];
    P.X = out;
    char* tailp = (char*)(ws + rws::END);
    P.ctl = (unsigned*)tailp; tailp += 65536;
    P.ROPE = (f32x2*)tailp; tailp += (size_t)S * 32 * 8;
    P.SSQ = (float*)tailp; tailp += (size_t)NT * 16 * 4;
    P.Win_t = (bf16_t*)tailp; tailp += (size_t)ZW * D * 2;
    P.Wq_t = (bf16_t*)tailp; tailp += (size_t)768 * 768 * 2;
    P.Wkv_t = (bf16_t*)tailp; tailp += (size_t)1024 * 256 * 2;
    P.Wo_t = (bf16_t*)tailp; tailp += (size_t)1024 * 1024 * 2;
    P.Wlg_t = (bf16_t*)tailp; tailp += (size_t)8 * 128 * 64 * 2;
    P.Wgu_t = (bf16_t*)tailp; tailp += (size_t)16 * 1024 * 1024 * 2;
    P.Wd_t = (bf16_t*)tailp; tailp += (size_t)16 * 1024 * 512 * 2;
    P.AGA = (float*)tailp; tailp += (size_t)256 * LW * 4;
    P.AGB = (float*)tailp; tailp += (size_t)256 * LW * 4;
    P.OP = (bf16_t*)tailp; tailp += (size_t)2 * NT * 512 * 2;
    P.ML = (f32x2*)tailp; tailp += (size_t)2 * NT * 4 * 8;
    P.A = A; P.DRV = DRV;
    { char* m = (char*)(ws + rws::MIX) ; P.Q = (bf16_t*)m; m += (size_t)NT * QL * 2; P.KN = (bf16_t*)m; m += (size_t)NT * 512 * 2; P.VV = (bf16_t*)m; m += (size_t)NT * 512 * 2; P.KPE = (bf16_t*)m; }
    P.XB = (bf16_t*)(ws + rws::MIX);
    P.Z = (bf16_t*)(ws + rws::KV);
    P.Z = (bf16_t*)(ws + rws::Q);
    const OW PF = make_ow(d_in, out, (char*)ws);
    for (int l = 0; l < L; ++l) {
        if (l < OPT_LAYERS) {
            if (l == 0) opt_phase<<<256, NTHREADS, LDS_BYTES, st>>>(PF, 0, 0);
            for (int ph = 1; ph <= 10; ++ph) opt_phase<<<256, NTHREADS, LDS_BYTES, st>>>(PF, ph, l);
            continue;
        }
        const float* xin = l == 0 ? x0 : out;
        const float* w_in = (const float*)d_in[1] + (size_t)l * D * INW;
        const float* conv_w = (const float*)d_in[2] + (size_t)l * 4 * LW;
        const float* conv_b = (const float*)d_in[3] + (size_t)l * LW;
        const float* w_r = (const float*)d_in[4] + (size_t)l * 8 * 64 * 64;
        const float* b_r = (const float*)d_in[5] + (size_t)l * LW;
        const float* w_i = (const float*)d_in[6] + (size_t)l * 8 * 64 * 64;
        const float* b_i = (const float*)d_in[7] + (size_t)l * LW;
        const float* lam = (const float*)d_in[8] + (size_t)l * LW;
        const float* qng = (const float*)d_in[9] + (size_t)l * QL;
        const float* w_qup = (const float*)d_in[10] + (size_t)l * QL * 768;
        const float* kvng = (const float*)d_in[11] + (size_t)l * KVL;
        const float* w_kvup = (const float*)d_in[12] + (size_t)l * KVL * 1024;
        const float* ong = (const float*)d_in[13] + (size_t)l * 1024;
        const float* w_out = (const float*)d_in[14] + (size_t)l * 1024 * D;
        const float* ln1g = (const float*)d_in[15] + (size_t)l * D;
        const float* ln1b = (const float*)d_in[16] + (size_t)l * D;
        const float* rw = (const float*)d_in[17];
        const float* rb = (const float*)d_in[18];
        const float* wg = (const float*)d_in[19] + (size_t)l * NE * D * DE;
        const float* wu = (const float*)d_in[20] + (size_t)l * NE * D * DE;
        const float* wd = (const float*)d_in[21] + (size_t)l * NE * DE * D;
        const float* ln2g = (const float*)d_in[22] + (size_t)l * D;
        const float* ln2b = (const float*)d_in[23] + (size_t)l * D;
        const int nopt = l == 0 ? OPT_STAGES : 0;
        if (nopt >= 1) {
            opt_phase<<<256, NTHREADS, LDS_BYTES, st>>>(P, 0, l);
            opt_phase<<<256, NTHREADS, LDS_BYTES, st>>>(P, 1, l);
            if (nopt >= 2) opt_phase<<<256, NTHREADS, LDS_BYTES, st>>>(P, 2, l);
            if (nopt >= 3) opt_phase<<<256, NTHREADS, LDS_BYTES, st>>>(P, 3, l);
            shim_z<<<(unsigned)(((size_t)NT * INW + 255) / 256), 256, 0, st>>>(P.Z, Z);
        } else {
            ref::gemm<true><<<dim3(INW / 64, NT / 64), 256, 0, st>>>(xin, D, w_in, INW, Z, INW, D);
        }
        if (nopt >= 3) {
            ref::lru_scan<<<B * LW / 256, 256, 0, st>>>(A, DRV, Z, MIX);
            shim_attn<<<(unsigned)(((size_t)NT * 512 + 255) / 256), 256, 0, st>>>(P.OP, P.ML, MIX);
        } else if (nopt >= 2) {
            shim_q<<<(unsigned)(((size_t)NT * QL + 255) / 256), 256, 0, st>>>(P.Q, Q);
            shim_kv<<<(unsigned)(((size_t)NT * 1024 + 255) / 256), 256, 0, st>>>(P.KN, P.VV, KV);
            shim_kpe<<<(unsigned)(((size_t)NT * 64 + 255) / 256), 256, 0, st>>>(P.KPE, KPE);
            ref::lru_scan<<<B * LW / 256, 256, 0, st>>>(A, DRV, Z, MIX);
            ref::q_post<<<NT * 4 * 96 / 256, 256, 0, st>>>(Q);
        } else {
            ref::lru_gates<<<NT * LW / 256, 256, 0, st>>>(Z, conv_w, conv_b, w_r, b_r, w_i, b_i, lam, A, DRV);
            ref::lru_scan<<<B * LW / 256, 256, 0, st>>>(A, DRV, Z, MIX);
            ref::rmsnorm<<<NT / 4, 256, 0, st>>>(Z, INW, 1024, QL, qng);
            ref::rmsnorm<<<NT / 4, 256, 0, st>>>(Z, INW, 1792, KVL, kvng);
            ref::gemm<true><<<dim3(768 / 64, NT / 64), 256, 0, st>>>(Z + 1024, INW, w_qup, 768, Q, QL, QL);
            ref::gemm<true><<<dim3(1024 / 64, NT / 64), 256, 0, st>>>(Z + 1792, INW, w_kvup, 1024, KV, 1024, KVL);
            ref::q_post<<<NT * 4 * 96 / 256, 256, 0, st>>>(Q);
            ref::kpe_rope<<<NT * 32 / 256, 256, 0, st>>>(Z, KPE);
        }
        if (nopt < 3) ref::attention<<<B * H * S / 4, 64, ATT_LDS, st>>>(Q, KV, KPE, MIX);
        ref::rmsnorm<<<NT / 4, 256, 0, st>>>(MIX, D, 0, 512, ong);
        ref::rmsnorm<<<NT / 4, 256, 0, st>>>(MIX, D, 512, 512, ong + 512);
        ref::gemm<false><<<dim3(D / 64, NT / 64), 256, 0, st>>>(MIX, D, w_out, D, Y, D, 1024);
        ref::ln_res<<<NT / 4, 256, 0, st>>>(xin, Y, out, ln1g, ln1b);
        (void)hipMemsetAsync(CNT, 0, 64 * sizeof(int), st);
        ref::router<<<NT / 4, 256, 0, st>>>(out, rw, rb, GATE, CNT, LIST);
        ref::moe_up<<<dim3(NT / 16, NE), 256, MOEUP_LDS, st>>>(out, wg, wu, CNT, LIST, HID);
        ref::moe_down<<<dim3(NT / 16, NE), 256, 0, st>>>(HID, wd, CNT, LIST, YE);
        ref::ln_moe<<<NT / 4, 256, 0, st>>>(out, YE, GATE, ln2g, ln2b);
    }
}

#endif
extern "C" void kernel_launch(void* const* d_in, const int* in_sizes, int n_in, void* d_out, int out_size, void* d_ws, size_t ws_size, hipStream_t stream) {
    if (n_in != 24 || out_size != NT * D || ws_size < (size_t)536870912) {
        fprintf(stderr, "kernel_launch: unexpected shapes (n_in %d, out %d, ws %zu)\n", n_in, out_size, ws_size);
        return;
    }
#if MODE == 0
    static bool attr_done = false;
    if (!attr_done) { attr_done = true;
        (void)hipFuncSetAttribute((const void*)ref::attention, hipFuncAttributeMaxDynamicSharedMemorySize, ATT_LDS);
        (void)hipFuncSetAttribute((const void*)ref::moe_up, hipFuncAttributeMaxDynamicSharedMemorySize, MOEUP_LDS);
        (void)hipFuncSetAttribute((const void*)opt_phase, hipFuncAttributeMaxDynamicSharedMemorySize, LDS_BYTES);
    }
#endif
#if MODE == 0
    hybrid_forward(d_in, (float*)d_out, (float*)d_ws, stream);
#else
    static int grid = 0;
    if (grid == 0) { int dev = 0, cus = 0; (void)hipGetDevice(&dev); if (hipDeviceGetAttribute(&cus, hipDeviceAttributeMultiprocessorCount, dev) != hipSuccess || cus <= 0) cus = 256; grid = cus;
        (void)hipFuncSetAttribute((const void*)mega_fwd, hipFuncAttributeMaxDynamicSharedMemorySize, LDS_BYTES); }
    MArgs a{};
    for (int i = 0; i < 24; ++i) a.in[i] = (const float*)d_in[i];
    a.X = (float*)d_out; a.ws = (char*)d_ws;
    (void)hipMemsetAsync((char*)d_ws + ows::CTL, 0, 262144, stream);
    hipLaunchKernelGGL(mega_fwd, dim3(grid), dim3(NTHREADS), LDS_BYTES, stream, a);
#endif
}
```

```cpp
#include <hip/hip_runtime.h>
#include <cstdint>
#include <cstdio>

namespace cfg {
constexpr int D = 1024, B = 4, S = 4096, NT = B * S, L = 4;
constexpr int LW = 512, NBLK = 8, BLK = 64;
constexpr int H = 4, QNOPE = 128, QROPE = 64, QH = 192, VH = 128, QL = 768, KVL = 256;
constexpr int INW = 2112;
constexpr int NE = 16, DE = 512;
constexpr float ALPHA = 1.681792830507429f, EPS = 1e-6f;
}
using namespace cfg;

#ifndef MODE
#define MODE 1
#endif
#if MODE == 0
namespace ref {

__device__ __forceinline__ float wave_sum(float v) {
#pragma unroll
    for (int o = 1; o < 64; o <<= 1) v += __shfl_xor(v, o);
    return v;
}
__device__ __forceinline__ float wave_max(float v) {
#pragma unroll
    for (int o = 1; o < 64; o <<= 1) v = fmaxf(v, __shfl_xor(v, o));
    return v;
}
#define BF16_EMU 1
__device__ __forceinline__ float rb(float f) {
#if BF16_EMU
    unsigned u = __float_as_uint(f); u = (u + 0x7fffu + ((u >> 16) & 1u)) & 0xffff0000u; return __uint_as_float(u);
#else
    return f;
#endif
}
__device__ __forceinline__ float sigmoidf_(float x) { return 1.f / (1.f + expf(-x)); }
__device__ __forceinline__ float gelu_tanh(float x) { return 0.5f * x * (1.f + tanhf(0.7978845608028654f * (x + 0.044715f * x * x * x))); }

template <bool RO> __global__ __launch_bounds__(256) void gemm(const float* __restrict__ A, int lda, const float* __restrict__ Bm, int ldb, float* __restrict__ C, int ldc, int K) {
    __shared__ float As[16][68];
    __shared__ float Bs[16][68];
    const int tid = threadIdx.x, tx = tid & 15, ty = tid >> 4;
    const int m0 = blockIdx.y * 64, n0 = blockIdx.x * 64;
    float acc[4][4];
#pragma unroll
    for (int i = 0; i < 4; ++i)
#pragma unroll
        for (int j = 0; j < 4; ++j) acc[i][j] = 0.f;
    for (int k0 = 0; k0 < K; k0 += 16) {
#pragma unroll
        for (int it = 0; it < 4; ++it) { const int i = tid + it * 256; const int m = i >> 4, k = i & 15; As[k][m] = rb(A[(size_t)(m0 + m) * lda + k0 + k]); }
#pragma unroll
        for (int it = 0; it < 4; ++it) { const int i = tid + it * 256; const int k = i >> 6, n = i & 63; Bs[k][n] = rb(Bm[(size_t)(k0 + k) * ldb + n0 + n]); }
        __syncthreads();
#pragma unroll
        for (int k = 0; k < 16; ++k) {
            float a[4], b[4];
#pragma unroll
            for (int i = 0; i < 4; ++i) { a[i] = As[k][ty * 4 + i]; b[i] = Bs[k][tx * 4 + i]; }
#pragma unroll
            for (int i = 0; i < 4; ++i)
#pragma unroll
                for (int j = 0; j < 4; ++j) acc[i][j] = fmaf(a[i], b[j], acc[i][j]);
        }
        __syncthreads();
    }
#pragma unroll
    for (int i = 0; i < 4; ++i)
#pragma unroll
        for (int j = 0; j < 4; ++j) C[(size_t)(m0 + ty * 4 + i) * ldc + n0 + tx * 4 + j] = RO ? rb(acc[i][j]) : acc[i][j];
}

__global__ __launch_bounds__(256) void rmsnorm(float* X, int ld, int off, int n, const float* __restrict__ g) {
    const int row = blockIdx.x * 4 + (threadIdx.x >> 6), lane = threadIdx.x & 63;
    float* x = X + (size_t)row * ld + off;
    float s = 0.f;
    for (int i = lane; i < n; i += 64) { const float v = x[i]; s += v * v; }
    s = wave_sum(s);
    const float r = rsqrtf(s / (float)n + EPS);
    for (int i = lane; i < n; i += 64) x[i] = x[i] * r * g[i];
}

__global__ __launch_bounds__(256) void lru_gates(const float* __restrict__ Z, const float* __restrict__ conv_w, const float* __restrict__ conv_b,
                                                 const float* __restrict__ wr, const float* __restrict__ br, const float* __restrict__ wi, const float* __restrict__ bi,
                                                 const float* __restrict__ lam, float* __restrict__ Aout, float* __restrict__ Dout) {
    const int idx = blockIdx.x * 256 + threadIdx.x;
    const int tok = idx >> 9, ch = idx & 511, n = ch >> 6, d = ch & 63, s = tok & (S - 1);
    float accr = br[ch], acci = bi[ch], xc_own = 0.f;
    for (int c = 0; c < 64; ++c) {
        const int cc = n * 64 + c;
        float xc = conv_b[cc];
#pragma unroll
        for (int w = 0; w < 4; ++w) { const int sp = s + w - 3; if (sp >= 0) xc = fmaf(Z[(size_t)(tok + w - 3) * INW + cc], conv_w[w * LW + cc], xc); }
        accr = fmaf(xc, wr[(size_t)cc * 64 + d], accr);
        acci = fmaf(xc, wi[(size_t)cc * 64 + d], acci);
        if (c == d) xc_own = xc;
    }
    const float r = sigmoidf_(accr), ig = sigmoidf_(acci);
    const float sp = log1pf(expf(-lam[ch]));
    const float log_a = -8.0f * r * sp;
    Aout[idx] = expf(log_a);
    Dout[idx] = sqrtf(-expm1f(2.0f * log_a)) * (ig * xc_own);
}

__global__ __launch_bounds__(256) void lru_scan(const float* __restrict__ Ain, const float* __restrict__ Din, const float* __restrict__ Z, float* __restrict__ MIX) {
    const int idx = blockIdx.x * 256 + threadIdx.x;
    const int b = idx >> 9, ch = idx & 511;
    float h = 0.f;
    for (int s0 = 0; s0 < S; s0 += 8) {
        float a[8], d[8], g[8];
#pragma unroll
        for (int j = 0; j < 8; ++j) { const size_t t = (size_t)b * S + s0 + j; a[j] = Ain[t * LW + ch]; d[j] = Din[t * LW + ch]; g[j] = Z[t * INW + LW + ch]; }
#pragma unroll
        for (int j = 0; j < 8; ++j) { h = fmaf(a[j], h, d[j]); const size_t t = (size_t)b * S + s0 + j; MIX[t * D + ch] = h * gelu_tanh(g[j]); }
    }
}

__global__ __launch_bounds__(256) void q_post(float* Q) {
    const int idx = blockIdx.x * 256 + threadIdx.x;
    const int j = idx % 96, th = idx / 96, h = th & 3, tok = th >> 2, s = tok & (S - 1);
    float* q = Q + (size_t)tok * QL + h * QH;
    const float sc = 0.07216878364870322f;
    if (j < 64) { q[j] *= sc; q[j + 64] *= sc; }
    else {
        const int i = j - 64;
        const float inv = powf(10000.0f, -(float)i / 32.0f);
        const float ang = (float)s * inv;
        const float c = cosf(ang), sn = sinf(ang);
        const float x1 = q[128 + i], x2 = q[160 + i];
        q[128 + i] = (x1 * c - x2 * sn) * sc; q[160 + i] = (x1 * sn + x2 * c) * sc;
    }
}
__global__ __launch_bounds__(256) void kpe_rope(const float* __restrict__ Z, float* __restrict__ KPE) {
    const int idx = blockIdx.x * 256 + threadIdx.x;
    const int i = idx & 31, tok = idx >> 5, s = tok & (S - 1);
    const float inv = powf(10000.0f, -(float)i / 32.0f);
    const float ang = (float)s * inv;
    const float c = cosf(ang), sn = sinf(ang);
    const float x1 = Z[(size_t)tok * INW + 2048 + i], x2 = Z[(size_t)tok * INW + 2048 + 32 + i];
    KPE[(size_t)tok * 64 + i] = x1 * c - x2 * sn; KPE[(size_t)tok * 64 + 32 + i] = x1 * sn + x2 * c;
}

__global__ __launch_bounds__(64) void attention(const float* __restrict__ Q, const float* __restrict__ KV, const float* __restrict__ KPE, float* __restrict__ MIX) {
    extern __shared__ __attribute__((aligned(16))) float dyn_lds[];
    float (*sc)[S] = (float (*)[S])dyn_lds;
    float (*qs)[QH] = (float (*)[QH])(dyn_lds + 4 * S);
    const int lane = threadIdx.x;
    const int blk = blockIdx.x;
    const int qb = blk % (S / 4), bh = blk / (S / 4), h = bh & 3, b = bh >> 2;
    const int q0 = qb * 4;
    for (int i = lane; i < 4 * QH; i += 64) { const int r = i / QH, d = i % QH; qs[r][d] = rb(Q[(size_t)(b * S + q0 + r) * QL + h * QH + d]); }
    __syncthreads();
    const int nk = q0 + 4;
    for (int j = lane; j < nk; j += 64) {
        const float* kn = KV + (size_t)(b * S + j) * 1024 + h * 256;
        const float* kp = KPE + (size_t)(b * S + j) * 64;
        float d0 = 0.f, d1 = 0.f, d2 = 0.f, d3 = 0.f;
        for (int d = 0; d < 128; d += 4) {
            float4 kv = *(const float4*)(kn + d); kv.x = rb(kv.x); kv.y = rb(kv.y); kv.z = rb(kv.z); kv.w = rb(kv.w);
            d0 += kv.x * qs[0][d] + kv.y * qs[0][d + 1] + kv.z * qs[0][d + 2] + kv.w * qs[0][d + 3];
            d1 += kv.x * qs[1][d] + kv.y * qs[1][d + 1] + kv.z * qs[1][d + 2] + kv.w * qs[1][d + 3];
            d2 += kv.x * qs[2][d] + kv.y * qs[2][d + 1] + kv.z * qs[2][d + 2] + kv.w * qs[2][d + 3];
            d3 += kv.x * qs[3][d] + kv.y * qs[3][d + 1] + kv.z * qs[3][d + 2] + kv.w * qs[3][d + 3];
        }
        for (int d = 0; d < 64; d += 4) {
            float4 kv = *(const float4*)(kp + d); kv.x = rb(kv.x); kv.y = rb(kv.y); kv.z = rb(kv.z); kv.w = rb(kv.w);
            d0 += kv.x * qs[0][128 + d] + kv.y * qs[0][129 + d] + kv.z * qs[0][130 + d] + kv.w * qs[0][131 + d];
            d1 += kv.x * qs[1][128 + d] + kv.y * qs[1][129 + d] + kv.z * qs[1][130 + d] + kv.w * qs[1][131 + d];
            d2 += kv.x * qs[2][128 + d] + kv.y * qs[2][129 + d] + kv.z * qs[2][130 + d] + kv.w * qs[2][131 + d];
            d3 += kv.x * qs[3][128 + d] + kv.y * qs[3][129 + d] + kv.z * qs[3][130 + d] + kv.w * qs[3][131 + d];
        }
        const float NEG = -INFINITY;
        sc[0][j] = (j <= q0 + 0) ? d0 : NEG; sc[1][j] = (j <= q0 + 1) ? d1 : NEG; sc[2][j] = (j <= q0 + 2) ? d2 : NEG; sc[3][j] = (j <= q0 + 3) ? d3 : NEG;
    }
    __syncthreads();
    float inv_l[4];
#pragma unroll
    for (int r = 0; r < 4; ++r) {
        float m = -INFINITY;
        for (int j = lane; j < nk; j += 64) m = fmaxf(m, sc[r][j]);
        m = wave_max(m);
        float l = 0.f;
        for (int j = lane; j < nk; j += 64) { const float p = expf(sc[r][j] - m); sc[r][j] = rb(p); l += p; }
        l = wave_sum(l);
        inv_l[r] = 1.f / l;
    }
    __syncthreads();
    float o[4][2];
#pragma unroll
    for (int r = 0; r < 4; ++r) { o[r][0] = 0.f; o[r][1] = 0.f; }
    for (int j = 0; j < nk; ++j) {
        const float* v = KV + (size_t)(b * S + j) * 1024 + h * 256 + 128;
        const float v0 = rb(v[lane]), v1 = rb(v[lane + 64]);
#pragma unroll
        for (int r = 0; r < 4; ++r) { const float p = sc[r][j]; o[r][0] = fmaf(p, v0, o[r][0]); o[r][1] = fmaf(p, v1, o[r][1]); }
    }
#pragma unroll
    for (int r = 0; r < 4; ++r) {
        float* out = MIX + (size_t)(b * S + q0 + r) * D + 512 + h * 128;
        out[lane] = o[r][0] * inv_l[r]; out[lane + 64] = o[r][1] * inv_l[r];
    }
}

__global__ __launch_bounds__(256) void ln_res(const float* Xin, const float* __restrict__ Y, float* Xout, const float* __restrict__ g, const float* __restrict__ bta) {
    const int row = blockIdx.x * 4 + (threadIdx.x >> 6), lane = threadIdx.x & 63;
    float v[16]; float s = 0.f;
#pragma unroll
    for (int j = 0; j < 16; ++j) { const int c = lane + 64 * j; v[j] = ALPHA * Xin[(size_t)row * D + c] + Y[(size_t)row * D + c]; s += v[j]; }
    const float mu = wave_sum(s) * (1.f / D);
    float q = 0.f;
#pragma unroll
    for (int j = 0; j < 16; ++j) { v[j] -= mu; q += v[j] * v[j]; }
    const float r = rsqrtf(wave_sum(q) * (1.f / D) + EPS);
#pragma unroll
    for (int j = 0; j < 16; ++j) { const int c = lane + 64 * j; Xout[(size_t)row * D + c] = v[j] * r * g[c] + bta[c]; }
}
__global__ __launch_bounds__(256) void ln_moe(float* X, const float* __restrict__ YE, const float* __restrict__ GATE, const float* __restrict__ g, const float* __restrict__ bta) {
    const int row = blockIdx.x * 4 + (threadIdx.x >> 6), lane = threadIdx.x & 63;
    const float g0 = GATE[row * 2], g1 = GATE[row * 2 + 1];
    float v[16]; float s = 0.f;
#pragma unroll
    for (int j = 0; j < 16; ++j) { const int c = lane + 64 * j; v[j] = ALPHA * X[(size_t)row * D + c] + g0 * YE[(size_t)(2 * row) * D + c] + g1 * YE[(size_t)(2 * row + 1) * D + c]; s += v[j]; }
    const float mu = wave_sum(s) * (1.f / D);
    float q = 0.f;
#pragma unroll
    for (int j = 0; j < 16; ++j) { v[j] -= mu; q += v[j] * v[j]; }
    const float r = rsqrtf(wave_sum(q) * (1.f / D) + EPS);
#pragma unroll
    for (int j = 0; j < 16; ++j) { const int c = lane + 64 * j; X[(size_t)row * D + c] = v[j] * r * g[c] + bta[c]; }
}

__global__ __launch_bounds__(256) void router(const float* __restrict__ X, const float* __restrict__ RW, const float* __restrict__ RB, float* __restrict__ GATE, int* CNT, int* LIST) {
    const int tok = blockIdx.x * 4 + (threadIdx.x >> 6), lane = threadIdx.x & 63;
    float acc[16];
#pragma unroll
    for (int e = 0; e < 16; ++e) acc[e] = 0.f;
    for (int j = 0; j < 16; ++j) {
        const int i = lane + 64 * j;
        const float x = X[(size_t)tok * D + i];
        const float4* w = (const float4*)(RW + (size_t)i * 16);
        const float4 w0 = w[0], w1 = w[1], w2 = w[2], w3 = w[3];
        acc[0] = fmaf(x, w0.x, acc[0]); acc[1] = fmaf(x, w0.y, acc[1]); acc[2] = fmaf(x, w0.z, acc[2]); acc[3] = fmaf(x, w0.w, acc[3]);
        acc[4] = fmaf(x, w1.x, acc[4]); acc[5] = fmaf(x, w1.y, acc[5]); acc[6] = fmaf(x, w1.z, acc[6]); acc[7] = fmaf(x, w1.w, acc[7]);
        acc[8] = fmaf(x, w2.x, acc[8]); acc[9] = fmaf(x, w2.y, acc[9]); acc[10] = fmaf(x, w2.z, acc[10]); acc[11] = fmaf(x, w2.w, acc[11]);
        acc[12] = fmaf(x, w3.x, acc[12]); acc[13] = fmaf(x, w3.y, acc[13]); acc[14] = fmaf(x, w3.z, acc[14]); acc[15] = fmaf(x, w3.w, acc[15]);
    }
    float sg[16], ss[16];
#pragma unroll
    for (int e = 0; e < 16; ++e) { sg[e] = sigmoidf_(wave_sum(acc[e])); ss[e] = sg[e] + RB[e]; }
    int best_g = 0; float best = -INFINITY;
#pragma unroll
    for (int gI = 0; gI < 4; ++gI) {
        float m1 = -INFINITY, m2 = -INFINITY;
#pragma unroll
        for (int k = 0; k < 4; ++k) { const float v = ss[gI * 4 + k]; if (v > m1) { m2 = m1; m1 = v; } else if (v > m2) { m2 = v; } }
        const float gs = m1 + m2;
        if (gs > best) { best = gs; best_g = gI; }
    }
    float c0 = 0.f, c1 = 0.f, c2 = 0.f, c3 = 0.f, t0 = 0.f, t1 = 0.f, t2 = 0.f, t3 = 0.f;
#pragma unroll
    for (int gI = 0; gI < 4; ++gI) if (gI == best_g) { c0 = ss[gI * 4]; c1 = ss[gI * 4 + 1]; c2 = ss[gI * 4 + 2]; c3 = ss[gI * 4 + 3]; t0 = sg[gI * 4]; t1 = sg[gI * 4 + 1]; t2 = sg[gI * 4 + 2]; t3 = sg[gI * 4 + 3]; }
    int i1 = 0; float v1 = c0, s1 = t0;
    if (c1 > v1) { i1 = 1; v1 = c1; s1 = t1; }
    if (c2 > v1) { i1 = 2; v1 = c2; s1 = t2; }
    if (c3 > v1) { i1 = 3; v1 = c3; s1 = t3; }
    int i2 = -1; float v2 = -INFINITY, s2 = 0.f;
    if (i1 != 0 && c0 > v2) { i2 = 0; v2 = c0; s2 = t0; }
    if (i1 != 1 && c1 > v2) { i2 = 1; v2 = c1; s2 = t1; }
    if (i1 != 2 && c2 > v2) { i2 = 2; v2 = c2; s2 = t2; }
    if (i1 != 3 && c3 > v2) { i2 = 3; v2 = c3; s2 = t3; }
    if (lane == 0) {
        const int e1 = best_g * 4 + i1, e2 = best_g * 4 + i2;
        const float inv = 1.f / (s1 + s2);
        GATE[tok * 2] = s1 * inv; GATE[tok * 2 + 1] = s2 * inv;
        const int p1 = atomicAdd(&CNT[e1], 1); LIST[e1 * NT + p1] = tok * 2;
        const int p2 = atomicAdd(&CNT[e2], 1); LIST[e2 * NT + p2] = tok * 2 + 1;
    }
}

__global__ __launch_bounds__(256) void moe_up(const float* __restrict__ X, const float* __restrict__ Wg, const float* __restrict__ Wu, const int* __restrict__ CNT, const int* __restrict__ LIST, float* __restrict__ HID) {
    extern __shared__ __attribute__((aligned(16))) float dyn_lds[];
    float (*xs)[16] = (float (*)[16])dyn_lds;
    int* asg_s = (int*)(dyn_lds + D * 16);
    const int e = blockIdx.y, start = blockIdx.x * 16, cnt = CNT[e];
    if (start >= cnt) return;
    const int n = min(16, cnt - start), tid = threadIdx.x;
    if (tid < 16) asg_s[tid] = tid < n ? LIST[e * NT + start + tid] : -1;
    __syncthreads();
    for (int i = tid; i < 16 * D; i += 256) { const int r = i >> 10, k = i & 1023; const int a = asg_s[r]; xs[k][r] = a >= 0 ? rb(X[(size_t)(a >> 1) * D + k]) : 0.f; }
    __syncthreads();
    float g0[16], g1[16], u0[16], u1[16];
#pragma unroll
    for (int r = 0; r < 16; ++r) { g0[r] = 0.f; g1[r] = 0.f; u0[r] = 0.f; u1[r] = 0.f; }
    const float* wg = Wg + (size_t)e * D * DE; const float* wu = Wu + (size_t)e * D * DE;
    for (int k = 0; k < D; ++k) {
        const float a0 = rb(wg[(size_t)k * DE + tid]), a1 = rb(wg[(size_t)k * DE + tid + 256]), b0 = rb(wu[(size_t)k * DE + tid]), b1 = rb(wu[(size_t)k * DE + tid + 256]);
#pragma unroll
        for (int r = 0; r < 16; ++r) { const float x = xs[k][r]; g0[r] = fmaf(x, a0, g0[r]); g1[r] = fmaf(x, a1, g1[r]); u0[r] = fmaf(x, b0, u0[r]); u1[r] = fmaf(x, b1, u1[r]); }
    }
#pragma unroll
    for (int r = 0; r < 16; ++r) { const int a = asg_s[r]; if (a >= 0) {
        HID[(size_t)a * DE + tid] = g0[r] * sigmoidf_(g0[r]) * u0[r]; HID[(size_t)a * DE + tid + 256] = g1[r] * sigmoidf_(g1[r]) * u1[r]; } }
}
__global__ __launch_bounds__(256) void moe_down(const float* __restrict__ HID, const float* __restrict__ Wd, const int* __restrict__ CNT, const int* __restrict__ LIST, float* __restrict__ YE) {
    __shared__ float hs[DE][16];
    __shared__ int asg_s[16];
    const int e = blockIdx.y, start = blockIdx.x * 16, cnt = CNT[e];
    if (start >= cnt) return;
    const int n = min(16, cnt - start), tid = threadIdx.x;
    if (tid < 16) asg_s[tid] = tid < n ? LIST[e * NT + start + tid] : -1;
    __syncthreads();
    for (int i = tid; i < 16 * DE; i += 256) { const int r = i >> 9, k = i & 511; const int a = asg_s[r]; hs[k][r] = a >= 0 ? rb(HID[(size_t)a * DE + k]) : 0.f; }
    __syncthreads();
    float y0[16], y1[16], y2[16], y3[16];
#pragma unroll
    for (int r = 0; r < 16; ++r) { y0[r] = 0.f; y1[r] = 0.f; y2[r] = 0.f; y3[r] = 0.f; }
    const float* wd = Wd + (size_t)e * DE * D;
    for (int k = 0; k < DE; ++k) {
        const float a0 = rb(wd[(size_t)k * D + tid]), a1 = rb(wd[(size_t)k * D + tid + 256]), a2 = rb(wd[(size_t)k * D + tid + 512]), a3 = rb(wd[(size_t)k * D + tid + 768]);
#pragma unroll
        for (int r = 0; r < 16; ++r) { const float x = hs[k][r]; y0[r] = fmaf(x, a0, y0[r]); y1[r] = fmaf(x, a1, y1[r]); y2[r] = fmaf(x, a2, y2[r]); y3[r] = fmaf(x, a3, y3[r]); }
    }
#pragma unroll
    for (int r = 0; r < 16; ++r) { const int a = asg_s[r]; if (a >= 0) { float* y = YE + (size_t)a * D; y[tid] = rb(y0[r]); y[tid + 256] = rb(y1[r]); y[tid + 512] = rb(y2[r]); y[tid + 768] = rb(y3[r]); } }
}

}

namespace rws {
constexpr size_t Z = 0;
constexpr size_t AB = Z + (size_t)NT * INW;
constexpr size_t Q = AB + (size_t)NT * 1024;
constexpr size_t KV = Q + (size_t)NT * QL;
constexpr size_t KPE = KV + (size_t)NT * 1024;
constexpr size_t MIX = KPE + (size_t)NT * 64;
constexpr size_t GATE = MIX + (size_t)NT * 1024;
constexpr size_t CNT = GATE + (size_t)NT * 2;
constexpr size_t LIST = CNT + 64;
constexpr size_t END = LIST + (size_t)NE * NT;
}


#endif
#ifndef MODE
#define MODE 1
#endif
#define LAS __attribute__((address_space(3)))
#ifndef PH
#define PH(k) 1
#endif
#ifndef DUP
#define DUP(k) 0
#endif
#define TID() ({ int _t = (int)threadIdx.x; asm volatile("" : "+v"(_t)); _t; })
#define BID() ({ int _b = (int)blockIdx.x; asm volatile("" : "+s"(_b)); _b; })
#define GDIM() ({ int _g = (int)gridDim.x; asm volatile("" : "+s"(_g)); _g; })
#define GAS __attribute__((address_space(1)))
typedef unsigned short bf16_t;
typedef short bf16x8 __attribute__((ext_vector_type(8)));
typedef float f32x4 __attribute__((ext_vector_type(4)));
typedef float f32x2 __attribute__((ext_vector_type(2)));
typedef unsigned u32x4 __attribute__((ext_vector_type(4)));
typedef unsigned u32x2 __attribute__((ext_vector_type(2)));

__device__ __forceinline__ unsigned f2bf(float f) { unsigned u = __builtin_bit_cast(unsigned, f); return (u + 0x7fffu + ((u >> 16) & 1u)) >> 16; }
__device__ __forceinline__ unsigned pk2(float lo, float hi) { return f2bf(lo) | (f2bf(hi) << 16); }
__device__ __forceinline__ float bf2f(unsigned short h) { return __builtin_bit_cast(float, (unsigned)h << 16); }
__device__ __forceinline__ float bflo(unsigned w) { return __builtin_bit_cast(float, w << 16); }
__device__ __forceinline__ float bfhi(unsigned w) { return __builtin_bit_cast(float, w & 0xffff0000u); }

namespace pg8 {
constexpr int BM = 256, BK = 64, HALF = 128, HTB = HALF * BK * 2, STAGE_BYTES = 8 * HTB;
__host__ __device__ __forceinline__ int lds_byte(int r, int c) { const int st = (r >> 4) * 2 + (c >> 5), rr = r & 15, cc = c & 31, ob = rr * 64 + cc * 2; return st * 1024 + (ob ^ (((ob >> 9) & 1) << 5)); }
__host__ __device__ __forceinline__ void stage_rc(int b, int& R, int& C) { const int st = b / 1024, sb = b % 1024, swz = sb ^ (((sb >> 9) & 1) << 5); R = (st >> 1) * 16 + swz / 64; C = (st & 1) * 32 + (swz % 64) / 2; }
__host__ __device__ __forceinline__ int perm32(int rho) { const int n = rho >> 4, i = rho & 15; return 8 * (i >> 2) + 4 * n + (i & 3); }

struct UnitD { const char* A; const int* rows; const char* B; unsigned lda, ldb; int nt; int type, pm, pn, aux; };

__device__ __forceinline__ unsigned cvt_pk_bf16(float lo, float hi) { unsigned r; asm volatile("v_cvt_pk_bf16_f32 %0, %1, %2" : "=v"(r) : "v"(lo), "v"(hi)); return r; }

template <bool PERM, class Sched, class Epi>
__device__ __forceinline__ void gemm_phase(LAS unsigned char* lds, const Sched& S, const Epi& E) {
    const int tid = TID(), wid = __builtin_amdgcn_readfirstlane(tid >> 6), wr = wid >> 2;
    const size_t kstep = (size_t)(BK * 2);
    const unsigned ldsw = (unsigned)wid * 1024u;
    int aoff, boff; { const int lane = tid & 63, wc = wid & 3, fr = lane & 15, fq = lane >> 4; aoff = lds_byte(wr * 64 + fr, fq * 8); boff = lds_byte(wc * 32 + fr, fq * 8); }
#define PG8_SA(b, h) (((b) * 2 + (h)) * HTB)
#define PG8_SB(b, h) ((4 + (b) * 2 + (h)) * HTB)
#define PG8_STAGE(bufoff, gbase, voff) do { _Pragma("unroll") for (int _i = 0; _i < 2; ++_i) \
        __builtin_amdgcn_global_load_lds((const unsigned*)((const char*)(gbase) + (voff)[_i]), (LAS unsigned*)(lds + (bufoff) + ldsw + _i * 8192), 16, 0, 0); } while (0)
#define PG8_LDA(dst, b, h) do { _Pragma("unroll") for (int m = 0; m < 4; ++m) _Pragma("unroll") for (int k = 0; k < 2; ++k) dst[m][k] = *(const LAS bf16x8*)(lds + PG8_SA(b, h) + aoff + m * 2048 + k * 1024); } while (0)
#define PG8_LDB(dst, b, h) do { _Pragma("unroll") for (int n = 0; n < 2; ++n) _Pragma("unroll") for (int k = 0; k < 2; ++k) dst[n][k] = *(const LAS bf16x8*)(lds + PG8_SB(b, h) + boff + n * 2048 + k * 1024); } while (0)
#define PG8_MMA(ai, bj, At, Bt) do { __builtin_amdgcn_s_setprio(1); _Pragma("unroll") for (int m = 0; m < 4; ++m) _Pragma("unroll") for (int n = 0; n < 2; ++n) _Pragma("unroll") for (int k = 0; k < 2; ++k) \
        acc[ai][bj][m][n] = __builtin_amdgcn_mfma_f32_16x16x32_bf16(Bt[n][k], At[m][k], acc[ai][bj][m][n], 0, 0, 0); __builtin_amdgcn_s_setprio(0); } while (0)
#define PG8_WAIT_V(n) asm volatile("s_waitcnt vmcnt(" #n ")" ::: "memory")
#define PG8_WAIT_L(n) asm volatile("s_waitcnt lgkmcnt(" #n ")" ::: "memory")
#define PG8_BAR __builtin_amdgcn_s_barrier()
#define PG8_SCHED __builtin_amdgcn_sched_barrier(0)
#define PG8_OFFS(u) do { int t_ = tid; asm volatile("" : "+v"(t_)); int R0, C0, R1, C1; stage_rc(t_ * 16, R0, C0); stage_rc(t_ * 16 + 8192, R1, C1); \
        const int RB0 = PERM ? ((R0 & ~31) + perm32(R0 & 31)) : R0, RB1 = PERM ? ((R1 & ~31) + perm32(R1 & 31)) : R1; const unsigned Cb = (unsigned)C0 * 2u; \
        if ((u).rows) { vA[0][0] = (unsigned)(u).rows[R0] * (u).lda + Cb; vA[0][1] = (unsigned)(u).rows[R1] * (u).lda + Cb; \
                                        vA[1][0] = (unsigned)(u).rows[128 + R0] * (u).lda + Cb; vA[1][1] = (unsigned)(u).rows[128 + R1] * (u).lda + Cb; } \
        else { vA[0][0] = (unsigned)R0 * (u).lda + Cb; vA[0][1] = (unsigned)R1 * (u).lda + Cb; vA[1][0] = (unsigned)(128 + R0) * (u).lda + Cb; vA[1][1] = (unsigned)(128 + R1) * (u).lda + Cb; } \
        vB[0] = (unsigned)RB0 * (u).ldb + Cb; vB[1] = (unsigned)RB1 * (u).ldb + Cb; hB = (size_t)128 * (u).ldb; } while (0)
#define PG8_EPI(u) do { int t_ = tid; asm volatile("" : "+v"(t_)); const int lane_ = t_ & 63; E(acc, (u), wr, wid & 3, lane_ & 15, lane_ >> 4); if (DUP(16)) E(acc, (u), wr, wid & 3, lane_ & 15, lane_ >> 4); if constexpr (Sched::HOOKS) S.done((u), lane_); } while (0)
    UnitD cur, nxt; int ui = 0;
    if (!S.next(0, cur)) return;
    f32x4 acc[2][2][4][2];
#pragma unroll
    for (int a = 0; a < 2; ++a)
#pragma unroll
        for (int b = 0; b < 2; ++b)
#pragma unroll
            for (int m = 0; m < 4; ++m)
#pragma unroll
                for (int n = 0; n < 2; ++n) acc[a][b][m][n] = (f32x4){0.f, 0.f, 0.f, 0.f};
    bf16x8 At[4][2], B0[2][2], B1[2][2];
    unsigned vA[2][2], vB[2]; size_t hB;
    if constexpr (Sched::HOOKS) S.a_ready(cur, wid);
    PG8_OFFS(cur);
    const char* cA = cur.A; const char* cB = cur.B; int nt = cur.nt;
    PG8_STAGE(PG8_SB(0, 0), cB, vB); PG8_STAGE(PG8_SB(0, 1), cB + hB, vB); PG8_STAGE(PG8_SA(0, 0), cA, vA[0]); PG8_STAGE(PG8_SA(0, 1), cA, vA[1]);
    if (wr == 1) PG8_BAR;
    PG8_WAIT_V(2); PG8_BAR;
    PG8_STAGE(PG8_SB(1, 0), cB + kstep, vB); PG8_STAGE(PG8_SA(1, 0), cA + kstep, vA[0]); PG8_STAGE(PG8_SB(1, 1), cB + hB + kstep, vB);
    PG8_WAIT_V(6); PG8_BAR;
    for (;;) {
        const bool has_next = S.next(ui + 1, nxt);
        for (int t = 0; t < nt; t += 2) {
            const bool last = (t == nt - 2);
            if constexpr (Sched::HOOKS) { if (last && has_next) S.a_ready(nxt, wid); }
            const char* a1 = cA + (size_t)(t + 1) * kstep;
            PG8_LDB(B0, 0, 0); PG8_LDB(B1, 0, 1); PG8_SCHED; PG8_LDA(At, 0, 0); PG8_STAGE(PG8_SA(1, 1), a1, vA[1]);
            PG8_WAIT_V(8); PG8_WAIT_L(0); PG8_BAR; PG8_MMA(0, 0, At, B0); PG8_MMA(0, 1, At, B1); PG8_BAR; PG8_SCHED;
            const char* a2; const char* b2;
            if (last) { if (has_next) { PG8_OFFS(nxt); a2 = nxt.A; b2 = nxt.B; } else { a2 = cA; b2 = cB; } }
            else { a2 = cA + (size_t)(t + 2) * kstep; b2 = cB + (size_t)(t + 2) * kstep; }
            const char* a3 = a2 + kstep; const char* b3 = b2 + kstep;
            PG8_LDA(At, 0, 1); PG8_STAGE(PG8_SB(0, 0), b2, vB); PG8_STAGE(PG8_SB(0, 1), b2 + hB, vB); PG8_STAGE(PG8_SA(0, 0), a2, vA[0]);
            PG8_WAIT_V(8); PG8_WAIT_L(0); PG8_BAR; PG8_MMA(1, 0, At, B0); PG8_MMA(1, 1, At, B1); PG8_BAR; PG8_SCHED;
            PG8_LDB(B0, 1, 0); PG8_LDB(B1, 1, 1); PG8_SCHED; PG8_LDA(At, 1, 0); PG8_STAGE(PG8_SA(0, 1), a2, vA[1]);
            PG8_WAIT_V(8); PG8_WAIT_L(0); PG8_BAR; PG8_MMA(0, 0, At, B0); PG8_MMA(0, 1, At, B1); PG8_BAR; PG8_SCHED;
            PG8_LDA(At, 1, 1); PG8_STAGE(PG8_SB(1, 0), b3, vB); PG8_STAGE(PG8_SB(1, 1), b3 + hB, vB); PG8_STAGE(PG8_SA(1, 0), a3, vA[0]);
            PG8_WAIT_V(8); PG8_WAIT_L(0); PG8_BAR; PG8_MMA(1, 0, At, B0); PG8_MMA(1, 1, At, B1); PG8_BAR; PG8_SCHED;
        }
        if (wr == 0) PG8_BAR;
        PG8_EPI(cur);
        if (!has_next) break;
#pragma unroll
        for (int a = 0; a < 2; ++a)
#pragma unroll
            for (int b = 0; b < 2; ++b)
#pragma unroll
                for (int m = 0; m < 4; ++m)
#pragma unroll
                    for (int n = 0; n < 2; ++n) acc[a][b][m][n] = (f32x4){0.f, 0.f, 0.f, 0.f};
        cur = nxt; cA = nxt.A; cB = nxt.B; nt = nxt.nt; ++ui;
        if (wr == 1) PG8_BAR;
    }
    PG8_WAIT_V(0);
    PG8_BAR;
#undef PG8_SA
#undef PG8_SB
#undef PG8_STAGE
#undef PG8_LDA
#undef PG8_LDB
#undef PG8_MMA
#undef PG8_WAIT_V
#undef PG8_WAIT_L
#undef PG8_BAR
#undef PG8_SCHED
#undef PG8_OFFS
#undef PG8_EPI
}
__device__ __forceinline__ void tile_order(int L, int nM, int nN, int& pm, int& pn) {
    const int nwg = nM * nN; int wgid = L;
    { const int q = nwg / 8, r = nwg % 8, xcd = wgid % 8, off = wgid / 8; wgid = (xcd < r ? xcd * (q + 1) : r * (q + 1) + (xcd - r) * q) + off; }
    const int nig = 8 * nN, gid = wgid / nig, fm = gid * 8, gsz = (nM - fm) < 8 ? (nM - fm) : 8;
    pm = fm + ((wgid % nig) % gsz); pn = (wgid % nig) / gsz;
}
}

#define XB_TMO      128
#define XB_XCNT(j)  (256  + 64 * (j))
#define XB_XSUB(j)  (1280 + 64 * (j))
#define XB_XGEN(j)  (2304 + 64 * (j))
#define XB_TOP      3328
#define XB_TOPGEN   3392
#define XCD_BAR_WORDS 3456
#define XB_SPIN_CAP (1u << 18)
__device__ __forceinline__ unsigned xb_ld(unsigned* p)              { return __hip_atomic_load(p, __ATOMIC_RELAXED, __HIP_MEMORY_SCOPE_AGENT); }
__device__ __forceinline__ unsigned xb_add(unsigned* p, unsigned v) { return __hip_atomic_fetch_add(p, v, __ATOMIC_RELAXED, __HIP_MEMORY_SCOPE_AGENT); }
__device__ __forceinline__ unsigned xb_xcc_id() { return (unsigned)__builtin_amdgcn_s_getreg((3 << 11) | 20) & 0xFu; }
#define XB_SPIN(cond, bar) do { unsigned _sp = 0; while (cond) { __builtin_amdgcn_s_sleep(1); \
    if ((++_sp & 255u) == 0u) { if (xb_ld(&(bar)[XB_TMO])) break; if (_sp > XB_SPIN_CAP) { atomicAdd(&(bar)[XB_TMO], 1u); break; } } } } while (0)
struct XcdBarrier { unsigned* bar; unsigned x; volatile LAS unsigned* st; };
__device__ __forceinline__ XcdBarrier xcd_barrier_post(unsigned* bar, volatile LAS unsigned* st) {
    XcdBarrier b; b.bar = bar; b.x = xb_xcc_id(); b.st = st;
    if (threadIdx.x == 0) (void)xb_add(&bar[XB_XCNT(b.x)], 1u);
    return b;
}
__device__ __forceinline__ void xcd_barrier_complete(unsigned* bar, unsigned x, unsigned& nloc, unsigned& nx) {
    const unsigned G = gridDim.x * gridDim.y * gridDim.z;
    unsigned sum, cnt, mine, sp = 0u;
    for (;;) {
        sum = 0u; cnt = 0u;
#pragma unroll
        for (unsigned j = 0; j < 16; ++j) { const unsigned c = xb_ld(&bar[XB_XCNT(j)]); sum += c; cnt += (c > 0u) ? 1u : 0u; }
        if (sum == G) break;
        __builtin_amdgcn_s_sleep(1);
        if ((++sp & 255u) == 0u) { if (xb_ld(&bar[XB_TMO])) break; if (sp > XB_SPIN_CAP) { atomicAdd(&bar[XB_TMO], 1u); break; } }
    }
    mine = xb_ld(&bar[XB_XCNT(x)]);
    nloc = mine > 0u ? mine : 1u; nx = cnt > 0u ? cnt : 1u;
}
__device__ __forceinline__ void xcd_barrier(const XcdBarrier& b) {
    asm volatile("s_waitcnt vmcnt(0)" ::: "memory");
    __syncthreads();
    if (threadIdx.x == 0) {
        unsigned* bar = b.bar; unsigned bx_ = b.x;
        asm volatile("" : "+s"(bar), "+s"(bx_));
        __builtin_amdgcn_s_waitcnt(0);
        unsigned nloc = b.st[0], nx = b.st[1];
        if (nloc == 0u) { xcd_barrier_complete(bar, bx_, nloc, nx); b.st[0] = nloc; b.st[1] = nx; }
        const unsigned old = xb_add(&bar[XB_XSUB(bx_)], 1u);
        const unsigned gen = old / nloc;
        if (old + 1u == (gen + 1u) * nloc) {
            __builtin_amdgcn_fence(__ATOMIC_RELEASE, "agent");
            asm volatile("s_waitcnt vmcnt(0)" ::: "memory");
            const unsigned og = xb_add(&bar[XB_TOP], 1u);
            const unsigned tg = og / nx;
            if (og + 1u == (tg + 1u) * nx) xb_add(&bar[XB_TOPGEN], 1u);
            else XB_SPIN(xb_ld(&bar[XB_TOPGEN]) == tg, bar);
            __builtin_amdgcn_fence(__ATOMIC_ACQUIRE, "agent");
            xb_add(&bar[XB_XGEN(bx_)], 1u);
            asm volatile("s_waitcnt vmcnt(0)" ::: "memory");
        } else {
            XB_SPIN(xb_ld(&bar[XB_XGEN(bx_)]) == gen, bar);
            __builtin_amdgcn_fence(__ATOMIC_ACQUIRE, "agent");
            asm volatile("s_waitcnt vmcnt(0)" ::: "memory");
        }
    }
    __syncthreads();
}

constexpr int MOECNT_W = 16384;
constexpr int ZW = 2304;
constexpr int NWAVES = 8, NTHREADS = 512;
constexpr int RING_BYTES = 131072, LDS_BYTES = 163840, LDSCTL_OFF = LDS_BYTES - 4096, MISC_OFF = LDSCTL_OFF + 320, TAB_OFF = LDSCTL_OFF + 1024;
struct OW {
    const float* in[24];
    float* X;
    unsigned* ctl;
    bf16_t* XB;
    bf16_t* Z;
    float* SSQ;
    bf16_t *Win_t, *Wq_t, *Wkv_t, *Wo_t, *Wgu_t, *Wd_t, *Wlg_t;
    bf16_t* RWH; float* RGB;
    f32x2* ROPE;
    bf16_t *Q, *KN, *VV, *KPE;
    float *A, *DRV, *AGA, *AGB;
    bf16_t* OP; f32x2* ML;
    bf16_t* MIX; bf16_t* Y;
    int *EIDX, *HIST, *LRANK, *DEST, *ROWTOK; float* GATE;
    bf16_t *HE, *YE;
};

namespace ows {
constexpr size_t MiB = 1u << 20;
constexpr size_t CTL = 0, ROPE = 1 * MiB, SSQ = 2 * MiB, EIDX = 3 * MiB, GATE = EIDX + 131072, LRANK = GATE + 131072, DEST = LRANK + 131072, HIST = DEST + 131072, ROWTOK = HIST + 16384;
constexpr size_t AGA = 4 * MiB, AGB = AGA + 524288, ML = 5 * MiB, WLG = 6 * MiB, WIN = 7 * MiB, WQ = 12 * MiB, WKV = 14 * MiB, WO = 15 * MiB, WGU = 17 * MiB, WD = 49 * MiB;
constexpr size_t XB = 65 * MiB, Z = 97 * MiB, Y = Z, A = 169 * MiB, DRV = 201 * MiB, Q = 233 * MiB, YE = A, KN = 257 * MiB, VV = 273 * MiB, KPE = 289 * MiB, OP = 291 * MiB, HE = KN, MIX = 323 * MiB, WSET1 = 355 * MiB - WLG  , END = 414 * MiB;
static_assert(ROWTOK + 36864 * 4 <= AGA && WIN + (size_t)ZW * D * 2 <= WQ && YE + (size_t)36864 * 1024 * 2 <= KN && HE + (size_t)36864 * 512 * 2 <= OP + 32 * MiB && Z + (size_t)NT * ZW * 2 <= A, "opt workspace map");
}
__device__ __forceinline__ void tr_item(const float* W, int ldw, int k0, int n0, bf16_t* WT, int ldt, int drow0, const float* g, LAS float* scr, int lane) {
    float tv[32];
#pragma unroll
    for (int i = 0; i < 32; ++i) { const int kk = 2 * i + (lane >> 5); tv[i] = W[(size_t)(k0 + kk) * ldw + n0 + (lane & 31)]; }
    if (g) {
#pragma unroll
        for (int i = 0; i < 32; ++i) tv[i] *= g[k0 + 2 * i + (lane >> 5)]; }
#pragma unroll
    for (int i = 0; i < 32; ++i) scr[(2 * i + (lane >> 5)) * 33 + (lane & 31)] = tv[i];
    asm volatile("s_waitcnt lgkmcnt(0)" ::: "memory");
    const int c = lane & 7;
#pragma unroll
    for (int j = 0; j < 4; ++j) { const int n = (lane >> 3) + 8 * j; const LAS float* s = scr + (8 * c) * 33 + n;
        u32x4 o; o.x = pk2(s[0 * 33], s[1 * 33]); o.y = pk2(s[2 * 33], s[3 * 33]); o.z = pk2(s[4 * 33], s[5 * 33]); o.w = pk2(s[6 * 33], s[7 * 33]);
        *(u32x4*)(WT + (size_t)(drow0 + n) * ldt + k0 + 8 * c) = o; }
    asm volatile("s_waitcnt lgkmcnt(0)" ::: "memory");
}
struct PrepItem { const float* W; const float* g; bf16_t* WT; int ldw, ldt, k0, n0, drow0, ncols; };
__device__ __forceinline__ PrepItem prep_item(const OW& P, int l, int it) {
    const float* w_in = P.in[1] + (size_t)l * D * INW;
    const float* qng = P.in[9] + (size_t)l * QL;   const float* w_q = P.in[10] + (size_t)l * QL * 768;
    const float* kvng = P.in[11] + (size_t)l * KVL; const float* w_kv = P.in[12] + (size_t)l * KVL * 1024;
    const float* ong = P.in[13] + (size_t)l * 1024; const float* w_o = P.in[14] + (size_t)l * 1024 * D;
    const float* wg = P.in[19] + (size_t)l * NE * D * DE; const float* wu = P.in[20] + (size_t)l * NE * D * DE; const float* wd = P.in[21] + (size_t)l * NE * DE * D;
    constexpr int I_IN = 8 * 17, I_Q = 6 * 6, I_KV = 2 * 8, I_O = 8 * 8, I_G = 16 * 8 * 4, I_D = 16 * 4 * 8;
    PrepItem p; int r = it;
    if (r < I_IN) { const int kb = r / 17, nb = r % 17; p = PrepItem{w_in, nullptr, P.Win_t, INW, D, 128 * kb, 128 * nb, 128 * nb, nb == 16 ? 64 : 128}; return p; } r -= I_IN;
    if (r < I_Q) { const int kb = r / 6, nb = r % 6; p = PrepItem{w_q, qng, P.Wq_t, 768, QL, 128 * kb, 128 * nb, 128 * nb, 128}; return p; } r -= I_Q;
    if (r < I_KV) { const int kb = r / 8, nb = r % 8; p = PrepItem{w_kv, kvng, P.Wkv_t, 1024, KVL, 128 * kb, 128 * nb, 128 * nb, 128}; return p; } r -= I_KV;
    if (r < I_O) { const int kb = r / 8, nb = r % 8; p = PrepItem{w_o, ong, P.Wo_t, D, 1024, 128 * kb, 128 * nb, 128 * nb, 128}; return p; } r -= I_O;
    if (r < 2 * I_G) { const int up = r >= I_G; if (up) r -= I_G; const int e = r >> 5, q = r & 31, kb = q >> 2, nb = q & 3;
        p = PrepItem{(up ? wu : wg) + (size_t)e * D * DE, nullptr, P.Wgu_t + (size_t)e * 1024 * 1024, DE, 1024, 128 * kb, 128 * nb, 256 * nb + 128 * up, 128}; return p; }
    r -= 2 * I_G;
    { const int e = r >> 5, q = r & 31, kb = q >> 3, nb = q & 7; p = PrepItem{wd + (size_t)e * DE * D, nullptr, P.Wd_t + (size_t)e * 1024 * DE, D, DE, 128 * kb, 128 * nb, 128 * nb, 128}; }
    return p;
}
__device__ __forceinline__ void prep_weights(const OW& P, int l, LAS unsigned char* lds, int vcu, int G, int it0 = 0, int it1 = 1 << 30, int tail = 3) {
    const int tid = TID();
    LAS float* scr = (LAS float*)lds;
    constexpr int NITEMS = 8 * 17 + 6 * 6 + 2 * 8 + 8 * 8 + 2 * 16 * 8 * 4 + 16 * 4 * 8;
    const int lr = tid >> 5, lc = (tid & 31) * 4;
    const int tn = tid & 127, tq = tid >> 7;
    f32x4 v[8];
#define PW_LOAD(p_) do { _Pragma("unroll") for (int i = 0; i < 8; ++i) { const int kk = lr + 16 * i; v[i] = (f32x4){0.f, 0.f, 0.f, 0.f}; \
        if (lc < (p_).ncols) { v[i] = *(const f32x4*)((p_).W + (size_t)((p_).k0 + kk) * (p_).ldw + (p_).n0 + lc); if ((p_).g) v[i] = v[i] * (p_).g[(p_).k0 + kk]; } } } while (0)
    const int ITE = it1 < NITEMS ? it1 : NITEMS;
    int it = it0 + vcu;
    PrepItem cur; if (it < ITE) { cur = prep_item(P, l, it); PW_LOAD(cur); }
    for (; it < ITE; it += G) {
#pragma unroll
        for (int i = 0; i < 8; ++i) { const int kk = lr + 16 * i; scr[kk * 129 + lc] = v[i][0]; scr[kk * 129 + lc + 1] = v[i][1]; scr[kk * 129 + lc + 2] = v[i][2]; scr[kk * 129 + lc + 3] = v[i][3]; }
        const PrepItem me = cur;
        if (it + G < ITE) { cur = prep_item(P, l, it + G); PW_LOAD(cur); }
        __syncthreads();
        { bf16_t* dst = me.WT + (size_t)(me.drow0 + tn) * me.ldt + me.k0 + 32 * tq; const LAS float* sc = scr + (32 * tq) * 129 + tn;
#pragma unroll
          for (int c = 0; c < 4; ++c) { u32x4 o; o.x = pk2(sc[(8 * c + 0) * 129], sc[(8 * c + 1) * 129]); o.y = pk2(sc[(8 * c + 2) * 129], sc[(8 * c + 3) * 129]);
              o.z = pk2(sc[(8 * c + 4) * 129], sc[(8 * c + 5) * 129]); o.w = pk2(sc[(8 * c + 6) * 129], sc[(8 * c + 7) * 129]); *(u32x4*)(dst + 8 * c) = o; } }
        __syncthreads();
    }
#undef PW_LOAD
    if (tail & 1) { const int gt = vcu * NTHREADS + tid, NGT = G * NTHREADS; unsigned zz = 0u; asm volatile("" : "+v"(zz)); const u32x4 z = {zz, zz, zz, zz};
      for (int i = gt; i < 128 * 128; i += NGT) *(u32x4*)(P.Win_t + (size_t)2176 * D + (size_t)i * 8) = z; }
    if (tail & 2) { const int gt = vcu * NTHREADS + tid, NGT = G * NTHREADS;
      const float* w_r = P.in[4] + (size_t)l * 8 * 64 * 64; const float* w_i = P.in[6] + (size_t)l * 8 * 64 * 64;
      for (int i = gt; i < 8 * 128 * 64; i += NGT) { const int k = i & 63, j = (i >> 6) & 127, n = i >> 13; const int w = j >> 4, q = j & 15; const int d = 8 * w + (q & 7);
          const float v_ = (q < 8 ? w_r : w_i)[((size_t)n * 64 + k) * 64 + d]; P.Wlg_t[i] = (bf16_t)f2bf(v_); }
      const float* rw = P.in[17]; const float* g1 = P.in[15] + (size_t)l * D; const float* b1 = P.in[16] + (size_t)l * D;
      for (int i = gt; i < 16 * 1024; i += NGT) { const int k = i & 1023, e = i >> 10; const float v_ = g1[k] * rw[k * 16 + e]; const unsigned hi_ = f2bf(v_); const float rem = v_ - bf2f((unsigned short)hi_);
          P.RWH[e * 1024 + k] = (bf16_t)hi_; P.RWH[(16 + e) * 1024 + k] = (bf16_t)f2bf(rem); }
      { const int gwv = gt >> 6, ln = gt & 63;
        if (gwv < 32) { const int e = gwv & 15; const float* src = gwv < 16 ? g1 : b1; float acc = 0.f;
#pragma unroll
            for (int j = 0; j < 16; ++j) { const int k = ln + 64 * j; acc = fmaf(src[k], rw[k * 16 + e], acc); }
#pragma unroll
            for (int o = 1; o < 64; o <<= 1) acc += __shfl_xor(acc, o);
            if (ln == 0) P.RGB[gwv] = acc; } } }
}
__device__ __forceinline__ void prep_tables(const OW& P, int vcu, int G) {
    const int gt = vcu * NTHREADS + TID(), NGT = G * NTHREADS;
    for (int i = gt; i < S * 32; i += NGT) { const int s = i >> 5, j = i & 31; const float inv = powf(10000.0f, -(float)j / 32.0f); const float ang = (float)s * inv; P.ROPE[i] = (f32x2){cosf(ang), sinf(ang)}; }
    const float* x = P.in[0];
    for (size_t i0 = gt; i0 < (size_t)NT * D / 8; i0 += (size_t)4 * NGT) { f32x4 a[4], b[4];
#pragma unroll
        for (int q = 0; q < 4; ++q) { const size_t i = i0 + (size_t)q * NGT; if (i < (size_t)NT * D / 8) { a[q] = *(const f32x4*)(x + i * 8); b[q] = *(const f32x4*)(x + i * 8 + 4); } }
#pragma unroll
        for (int q = 0; q < 4; ++q) { const size_t i = i0 + (size_t)q * NGT; if (i < (size_t)NT * D / 8) { u32x4 o; o.x = pg8::cvt_pk_bf16(a[q][0], a[q][1]); o.y = pg8::cvt_pk_bf16(a[q][2], a[q][3]); o.z = pg8::cvt_pk_bf16(b[q][0], b[q][1]); o.w = pg8::cvt_pk_bf16(b[q][2], b[q][3]); *(u32x4*)(P.XB + i * 8) = o; } } }
}

struct SchedInProj {
    static constexpr bool HOOKS = false;
    const OW* P; int G, c;
    __device__ __forceinline__ bool next(int i, pg8::UnitD& u) const {
        const int L = i * G + c; if (L >= 64 * 9) return false;
        int pm, pn; pg8::tile_order(L, 64, 9, pm, pn);
        u.A = (const char*)(P->XB + (size_t)pm * 256 * D); u.rows = nullptr; u.B = (const char*)(P->Win_t + (size_t)pn * 256 * D); u.lda = D * 2; u.ldb = D * 2; u.nt = D / 64; u.type = 0; u.pm = pm; u.pn = pn; u.aux = 0;
        return true;
    }
};
struct EpiInProj {
    bf16_t* Z; float* SSQ;
    __device__ __forceinline__ void operator()(const f32x4 (&acc)[2][2][4][2], const pg8::UnitD& u, int wr, int wc, int fr, int fq) const {
        const int row0 = u.pm * 256 + wr * 64 + fr, col0 = u.pn * 256 + wc * 32 + 8 * fq;
        const bool stats = u.pn >= 4 && u.pn < 8;
#pragma unroll
        for (int ai = 0; ai < 2; ++ai)
#pragma unroll
            for (int m = 0; m < 4; ++m) { const int row = row0 + ai * 128 + m * 16; bf16_t* rowp = Z + (size_t)row * ZW + col0; float ss = 0.f;
#pragma unroll
                for (int bj = 0; bj < 2; ++bj) { const f32x4 v0 = acc[ai][bj][m][0], v1 = acc[ai][bj][m][1];
                    ss += (v0[0] * v0[0] + v0[1] * v0[1]) + (v0[2] * v0[2] + v0[3] * v0[3]) + (v1[0] * v1[0] + v1[1] * v1[1]) + (v1[2] * v1[2] + v1[3] * v1[3]);
                    u32x4 w; w.x = pg8::cvt_pk_bf16(v0[0], v0[1]); w.y = pg8::cvt_pk_bf16(v0[2], v0[3]); w.z = pg8::cvt_pk_bf16(v1[0], v1[1]); w.w = pg8::cvt_pk_bf16(v1[2], v1[3]);
                    *(u32x4*)(rowp + bj * 128) = w; }
                if (stats) { ss += __shfl_xor(ss, 16); ss += __shfl_xor(ss, 32); if (fq == 0) SSQ[(size_t)row * 16 + (u.pn - 4) * 4 + wc] = ss; } }
    }
};
__device__ __forceinline__ void phase_inproj(const OW& P, LAS unsigned char* lds, int G) {
    SchedInProj Sd{&P, G, BID()}; EpiInProj E{P.Z, P.SSQ};
    pg8::gemm_phase<true>(lds, Sd, E);
}


struct SchedQKV {
    static constexpr bool HOOKS = false;
    const OW* P; int G, c;
    __device__ __forceinline__ bool next(int i, pg8::UnitD& u) const {
        if (G != 256) {
            const int Lq = i * G + c; if (Lq >= 448) return false;
            if (Lq < 192) { fill_q(u, Lq / 3, Lq % 3); } else { const int r = Lq - 192; fill_kv(u, r >> 2, r & 3); }
            return true;
        }
        if (c < 192) { if (i == 0) { fill_q(u, c / 3, c % 3); return true; } if (i == 1 && c % 3 == 0) { fill_kv(u, c / 3, 3); return true; } return false; }
        if (i >= 3) return false; fill_kv(u, c - 192, i); return true;
    }
    __device__ __forceinline__ void fill_q(pg8::UnitD& u, int pm, int pn) const {
        u.A = (const char*)(P->Z + (size_t)pm * 256 * ZW + 1024); u.rows = nullptr; u.B = (const char*)(P->Wq_t + (size_t)pn * 256 * QL); u.lda = ZW * 2; u.ldb = QL * 2; u.nt = QL / 64; u.type = 1; u.pm = pm; u.pn = pn; u.aux = 0; }
    __device__ __forceinline__ void fill_kv(pg8::UnitD& u, int pm, int pn) const {
        u.A = (const char*)(P->Z + (size_t)pm * 256 * ZW + 1792); u.rows = nullptr; u.B = (const char*)(P->Wkv_t + (size_t)pn * 256 * KVL); u.lda = ZW * 2; u.ldb = KVL * 2; u.nt = KVL / 64; u.type = 2; u.pm = pm; u.pn = pn; u.aux = 0; }
};
struct EpiQKV {
    const float* SSQ; bf16_t *Q, *KN, *VV;
    __device__ __forceinline__ void operator()(const f32x4 (&acc)[2][2][4][2], const pg8::UnitD& u, int wr, int wc, int fr, int fq) const {
        const int row0 = u.pm * 256 + wr * 64 + fr, cw = wc * 32 + 8 * fq;
        const bool isq = u.type == 1;
#pragma unroll
        for (int ai = 0; ai < 2; ++ai)
#pragma unroll
            for (int m = 0; m < 4; ++m) { const int row = row0 + ai * 128 + m * 16; const f32x4* sp = (const f32x4*)(SSQ + (size_t)row * 16);
                float rs;
                if (isq) { const f32x4 a = sp[0], b = sp[1], c = sp[2]; const float t = ((a[0] + a[1]) + (a[2] + a[3])) + ((b[0] + b[1]) + (b[2] + b[3])) + ((c[0] + c[1]) + (c[2] + c[3])); rs = rsqrtf(t * (1.f / QL) + EPS); }
                else { const f32x4 a = sp[3]; const float t = (a[0] + a[1]) + (a[2] + a[3]); rs = rsqrtf(t * (1.f / KVL) + EPS); }
#pragma unroll
                for (int bj = 0; bj < 2; ++bj) { const f32x4 v0 = acc[ai][bj][m][0] * rs, v1 = acc[ai][bj][m][1] * rs;
                    u32x4 w; w.x = pg8::cvt_pk_bf16(v0[0], v0[1]); w.y = pg8::cvt_pk_bf16(v0[2], v0[3]); w.z = pg8::cvt_pk_bf16(v1[0], v1[1]); w.w = pg8::cvt_pk_bf16(v1[2], v1[3]);
                    bf16_t* dst = isq ? Q + (size_t)row * QL + u.pn * 256 + bj * 128 + cw : (bj == 0 ? KN : VV) + (size_t)row * 512 + u.pn * 128 + cw;
                    *(u32x4*)dst = w; } }
    }
};
__device__ __forceinline__ float sigm(float x) { return __builtin_amdgcn_rcpf(1.f + __expf(-x)); }
__device__ __forceinline__ float one_minus_sq(float a, float x) {
    return x > -0.015625f ? -x * (1.f + 0.5f * x) : 1.f - a * a;
}
__device__ __forceinline__ void gates_tile(const OW& P, int l, LAS unsigned char* lds, int tile) {
    constexpr int URS = 1040, XRS = 144, SRS = 68;
    const int tid = TID(), lane = tid & 63, wid = __builtin_amdgcn_readfirstlane(tid >> 6), fr = lane & 15, fq = lane >> 4;
    LAS unsigned char* U = lds;
    LAS unsigned char* XC = lds + 67 * URS + 64;
    LAS float* SA = (LAS float*)(lds + 81920);
    LAS float* SD = SA + 64 * SRS;
    LAS f32x2* PP = (LAS f32x2*)(lds + 81920 + 2 * 64 * SRS * 4);
    LAS float* PAR = (LAS float*)(lds + 81920 + 2 * 64 * SRS * 4 + 4096);
    const int tok0 = tile * 64, s0 = tok0 & (S - 1);
    const float* conv_w = P.in[2] + (size_t)l * 4 * LW; const float* conv_b = P.in[3] + (size_t)l * LW;
    const float* b_r = P.in[5] + (size_t)l * LW; const float* b_i = P.in[7] + (size_t)l * LW; const float* lam = P.in[8] + (size_t)l * LW;
    const bf16_t* pZ = P.Z; const f32x2* pROPE = P.ROPE; bf16_t* pKPE = P.KPE; float* pA = P.A; float* pDRV = P.DRV; float* pAGA = P.AGA; float* pAGB = P.AGB; const bf16_t* pWlg = P.Wlg_t;
    { u32x4 uv[9]; unsigned short k1[4], k2[4]; f32x2 cs[4];
#pragma unroll
      for (int q = 0; q < 9; ++q) { const int i = tid + q * NTHREADS; const int r = i >> 6, ch = i & 63; uv[q] = (u32x4){0u, 0u, 0u, 0u};
          if (i < 67 * 64 && (r >= 3 || s0 != 0)) uv[q] = *(const u32x4*)(pZ + (size_t)(tok0 - 3 + r) * ZW + ch * 8); }
#pragma unroll
      for (int q = 0; q < 4; ++q) { const int i = tid + q * NTHREADS; const int t = i >> 5, j = i & 31; const size_t tok = (size_t)tok0 + t;
          k1[q] = pZ[tok * ZW + 2048 + j]; k2[q] = pZ[tok * ZW + 2080 + j]; cs[q] = pROPE[(s0 + t) * 32 + j]; }
#pragma unroll
      for (int q = 0; q < 9; ++q) { const int i = tid + q * NTHREADS; const int r = i >> 6, ch = i & 63; if (i < 67 * 64) *(LAS u32x4*)(U + r * URS + ch * 16) = uv[q]; }
#pragma unroll
      for (int q = 0; q < 4; ++q) { const int i = tid + q * NTHREADS; const int t = i >> 5, j = i & 31; const size_t tok = (size_t)tok0 + t; const float x1 = bf2f(k1[q]), x2 = bf2f(k2[q]);
          pKPE[tok * 64 + j] = (bf16_t)f2bf(x1 * cs[q].x - x2 * cs[q].y); pKPE[tok * 64 + 32 + j] = (bf16_t)f2bf(x1 * cs[q].y + x2 * cs[q].x); } }
    { const int ch = tid;
      PAR[0 * LW + ch] = conv_w[0 * LW + ch]; PAR[1 * LW + ch] = conv_w[1 * LW + ch]; PAR[2 * LW + ch] = conv_w[2 * LW + ch]; PAR[3 * LW + ch] = conv_w[3 * LW + ch];
      PAR[4 * LW + ch] = conv_b[ch]; PAR[5 * LW + ch] = b_r[ch]; PAR[6 * LW + ch] = b_i[ch]; PAR[7 * LW + ch] = -8.0f * log1pf(__expf(-lam[ch])); }
    __syncthreads();
    bf16x8 nb0, nb1; { const bf16_t* wb = pWlg + ((size_t)16 * wid + fr) * 64 + 8 * fq; nb0 = *(const bf16x8*)wb; nb1 = *(const bf16x8*)(wb + 32); }
    for (int n = 0; n < 8; ++n) {
        { const int chb = 64 * n + 8 * wid; float xc[8];
#pragma unroll
          for (int j = 0; j < 8; ++j) xc[j] = PAR[4 * LW + chb + j];
#pragma unroll
          for (int w = 0; w < 4; ++w) { const u32x4 uv = *(const LAS u32x4*)(U + (lane + w) * URS + chb * 2);
              const f32x4 c0 = *(const LAS f32x4*)(PAR + w * LW + chb), c1 = *(const LAS f32x4*)(PAR + w * LW + chb + 4);
              xc[0] = fmaf(bflo(uv.x), c0[0], xc[0]); xc[1] = fmaf(bfhi(uv.x), c0[1], xc[1]); xc[2] = fmaf(bflo(uv.y), c0[2], xc[2]); xc[3] = fmaf(bfhi(uv.y), c0[3], xc[3]);
              xc[4] = fmaf(bflo(uv.z), c1[0], xc[4]); xc[5] = fmaf(bfhi(uv.z), c1[1], xc[5]); xc[6] = fmaf(bflo(uv.w), c1[2], xc[6]); xc[7] = fmaf(bfhi(uv.w), c1[3], xc[7]); }
          u32x4 o; o.x = pk2(xc[0], xc[1]); o.y = pk2(xc[2], xc[3]); o.z = pk2(xc[4], xc[5]); o.w = pk2(xc[6], xc[7]);
          *(LAS u32x4*)(XC + lane * XRS + wid * 16) = o; }
        __syncthreads();
        f32x4 acc[4];
        { const bf16x8 b0 = nb0, b1 = nb1;
          if (n + 1 < 8) { const bf16_t* wb = pWlg + ((size_t)(n + 1) * 128 + 16 * wid + fr) * 64 + 8 * fq; nb0 = *(const bf16x8*)wb; nb1 = *(const bf16x8*)(wb + 32); }
#pragma unroll
          for (int m = 0; m < 4; ++m) { const bf16x8 a0 = *(const LAS bf16x8*)(XC + (16 * m + fr) * XRS + fq * 16), a1 = *(const LAS bf16x8*)(XC + (16 * m + fr) * XRS + 64 + fq * 16);
              f32x4 c = {0.f, 0.f, 0.f, 0.f};
              c = __builtin_amdgcn_mfma_f32_16x16x32_bf16(b0, a0, c, 0, 0, 0); c = __builtin_amdgcn_mfma_f32_16x16x32_bf16(b1, a1, c, 0, 0, 0); acc[m] = c; } }
        const bool lo = fq < 2;
        f32x4 rv[2], iv[2];
#pragma unroll
        for (int j = 0; j < 2; ++j) { const f32x4 snd = lo ? acc[2 + j] : acc[j]; f32x4 rc;
#pragma unroll
            for (int x = 0; x < 4; ++x) rc[x] = __shfl_xor(snd[x], 32);
            rv[j] = lo ? acc[j] : rc; iv[j] = lo ? rc : acc[2 + j]; }
        const int d0 = 8 * wid + 4 * (fq & 1), ch0 = 64 * n + d0;
        const f32x4 brv = *(const LAS f32x4*)(PAR + 5 * LW + ch0), biv = *(const LAS f32x4*)(PAR + 6 * LW + ch0), spv = *(const LAS f32x4*)(PAR + 7 * LW + ch0), cbv = *(const LAS f32x4*)(PAR + 4 * LW + ch0);
        f32x4 cw[4];
#pragma unroll
        for (int w = 0; w < 4; ++w) cw[w] = *(const LAS f32x4*)(PAR + w * LW + ch0);
#pragma unroll
        for (int j = 0; j < 2; ++j) { const int t = 16 * ((lo ? 0 : 2) + j) + fr; f32x4 av, dv;
            const u32x2 xcb = *(const LAS u32x2*)(XC + t * XRS + d0 * 2); const float xcq[4] = {bflo(xcb.x), bfhi(xcb.x), bflo(xcb.y), bfhi(xcb.y)};
#pragma unroll
            for (int x = 0; x < 4; ++x) {
                const float xcv = xcq[x];
                const float r = sigm(rv[j][x] + brv[x]), ig = sigm(iv[j][x] + biv[x]);
                const float log_a = r * spv[x];
                av[x] = __expf(log_a); dv[x] = __builtin_amdgcn_sqrtf(one_minus_sq(av[x], 2.0f * log_a)) * (ig * xcv); }
            *(LAS f32x4*)(SA + t * SRS + d0) = av; *(LAS f32x4*)(SD + t * SRS + d0) = dv; }
        __syncthreads();
        { float Ap = 1.f, Bp = 0.f;
#pragma unroll
          for (int j = 0; j < 8; ++j) { const int t = 8 * wid + j; const float a = SA[t * SRS + lane], dv = SD[t * SRS + lane];
              ((unsigned*)pA)[((size_t)tok0 + t) * LW + 64 * n + lane] = pg8::cvt_pk_bf16(1.f - a, dv);
              Ap *= a; Bp = fmaf(a, Bp, dv); }
          PP[wid * 64 + lane] = (f32x2){Ap, Bp}; }
        __syncthreads();
        if (wid == 0) { float Aa = 1.f, Bb = 0.f;
#pragma unroll
            for (int g = 0; g < 8; ++g) { const f32x2 p = PP[g * 64 + lane]; Aa *= p.x; Bb = fmaf(p.x, Bb, p.y); }
            pAGA[(size_t)tile * LW + 64 * n + lane] = Aa; pAGB[(size_t)tile * LW + 64 * n + lane] = Bb; }
    }
    __syncthreads();
}
__device__ __forceinline__ void phase_qkv(const OW& P, int l, LAS unsigned char* lds, int G) {
#ifndef P2SEL
#define P2SEL 3
#endif
    if (P2SEL & 1) { SchedQKV Sd{&P, G, BID()}; EpiQKV E{P.SSQ, P.Q, P.KN, P.VV};
    pg8::gemm_phase<true>(lds, Sd, E); }
    if (P2SEL & 2) for (int tile = BID(); tile < NT / 64; tile += G) gates_tile(P, l, lds, tile);
}


namespace att {
typedef short s16x4 __attribute__((ext_vector_type(4)));
typedef float f32x16 __attribute__((ext_vector_type(16)));
constexpr int KVBLK = 64, SHM_V = 16384, SHM_K = 24576, OFF_K = 3 * SHM_V, OFF_WS = OFF_K + 3 * SHM_K, OFF_QR = OFF_WS + 8 * 64 * 4, LDS_NEED = OFF_QR + 8 * 4096;
static_assert(LDS_NEED <= LDSCTL_OFF, "attention LDS");
constexpr float SCALE = 0.07216878364870322f, THR = 8.f;
#define SBAR() __builtin_amdgcn_sched_barrier(0)
__device__ __forceinline__ int v_st(int k, int c) { const int kk = (k & ~0xC) | ((k & 4) << 1) | ((k & 8) >> 1); return ((kk >> 3) * 4 + (c >> 5)) * 512 + ((kk & 7) * 32 + (c & 31)) * 2; }
__device__ __forceinline__ int v_rd_base(int lane) { return ((lane & 3) << 3) | (((lane >> 2) & 3) << 6) | (((lane >> 4) & 1) << 5) | (((lane >> 5) & 1) << 8); }
constexpr int v_rd_off(int d0, int ks, int half) { return d0 * 512 + ks * 4096 + half * 2048; }
__device__ __forceinline__ int k_off(int row, int cc) { return (cc >> 3) * 8192 + row * 128 + (((cc & 7) ^ ((row >> 1) & 7)) << 4); }
__device__ __forceinline__ int crow(int r, int hi) { return (r & 3) + 8 * (r >> 2) + 4 * hi; }
__device__ __forceinline__ unsigned cvtpk(float lo, float hi) { unsigned r; asm volatile("v_cvt_pk_bf16_f32 %0, %1, %2" : "=v"(r) : "v"(lo), "v"(hi)); return r; }
__device__ __forceinline__ void mask_tile(f32x16& p0, f32x16& p1, int dq) {
    const float NEG = -__builtin_inff();
#pragma unroll
    for (int r = 0; r < 16; ++r) { const int c = (r & 3) + 8 * (r >> 2); if (dq - c < 0) p0[r] = NEG; if (dq - c - 32 < 0) p1[r] = NEG; }
}
__device__ __forceinline__ void partialSM(f32x16& p0, f32x16& p1, float& m_reg, float& mn, float& alpha) {
    float pmax = p0[0];
#pragma unroll
    for (int r = 1; r < 16; ++r) pmax = fmaxf(pmax, p0[r]);
#pragma unroll
    for (int r = 0; r < 16; ++r) pmax = fmaxf(pmax, p1[r]);
    { auto rr = __builtin_amdgcn_permlane32_swap(__float_as_uint(pmax), __float_as_uint(pmax), false, false); pmax = fmaxf(__uint_as_float(rr[0]), __uint_as_float(rr[1])); }
    constexpr float C2 = 1.4426950408889634f * SCALE;
    if (__builtin_expect(__all((pmax - m_reg) * SCALE <= THR), 1)) { mn = m_reg; alpha = 1.f; }
    else { mn = fmaxf(m_reg, pmax); alpha = __builtin_amdgcn_exp2f((m_reg - mn) * C2); m_reg = mn; }
    const float mnL = -mn * C2;
#pragma unroll
    for (int r = 0; r < 16; ++r) p0[r] = fmaf(p0[r], C2, mnL);
#pragma unroll
    for (int r = 0; r < 16; ++r) p1[r] = fmaf(p1[r], C2, mnL);
#pragma unroll
    for (int r = 0; r < 16; ++r) p0[r] = __builtin_amdgcn_exp2f(p0[r]);
}
__device__ __forceinline__ void finishSM(f32x16& p0, f32x16& p1, float alpha, float& l_reg, bf16x8& pa0, bf16x8& pa1, bf16x8& pa2, bf16x8& pa3) {
#pragma unroll
    for (int r = 0; r < 16; ++r) p1[r] = __builtin_amdgcn_exp2f(p1[r]);
    float ps = 0;
#pragma unroll
    for (int r = 0; r < 16; ++r) ps += p0[r];
#pragma unroll
    for (int r = 0; r < 16; ++r) ps += p1[r];
    { auto rr = __builtin_amdgcn_permlane32_swap(__float_as_uint(ps), __float_as_uint(ps), false, false); ps = __uint_as_float(rr[0]) + __uint_as_float(rr[1]); }
    l_reg = l_reg * alpha + ps;
#define PK4(P, B_, OUT) do { unsigned a0 = cvtpk(P[B_+0], P[B_+1]), a1 = cvtpk(P[B_+2], P[B_+3]);                          \
        unsigned b0 = cvtpk(P[B_+4], P[B_+5]), b1 = cvtpk(P[B_+6], P[B_+7]);                                             \
        auto r0 = __builtin_amdgcn_permlane32_swap(a0, b0, false, false); auto r1 = __builtin_amdgcn_permlane32_swap(a1, b1, false, false); \
        u32x4 w = {r0[0], r1[0], r0[1], r1[1]}; OUT = *reinterpret_cast<bf16x8*>(&w); } while (0)
    PK4(p0, 0, pa0); PK4(p0, 8, pa1); PK4(p1, 0, pa2); PK4(p1, 8, pa3);
#undef PK4
}
__device__ __forceinline__ void qkt(f32x16& p0, f32x16& p1, const char* K_slot, int r32, int hi, const bf16x8* qr, const char* qrl) {
    p0 = f32x16{}; p1 = f32x16{};
    const char* kb[4];
#pragma unroll
    for (int dd = 0; dd < 4; ++dd) kb[dd] = K_slot + r32 * 128 + (((2 * dd + hi) ^ ((r32 >> 1) & 7)) << 4);
    bf16x8 a0[4], a1[4], b0[4], b1[4], qf[4];
#define QK_LOAD(X0, X1, g) do { _Pragma("unroll") for (int dd = 0; dd < 4; ++dd) { const char* a_ = kb[dd] + (g) * 8192; X0[dd] = *reinterpret_cast<const bf16x8*>(a_); X1[dd] = *reinterpret_cast<const bf16x8*>(a_ + 32 * 128); } } while (0)
#define QK_MMA(X0, X1, Q_) do { _Pragma("unroll") for (int dd = 0; dd < 4; ++dd) { p0 = __builtin_amdgcn_mfma_f32_32x32x16_bf16(X0[dd], Q_[dd], p0, 0, 0, 0); p1 = __builtin_amdgcn_mfma_f32_32x32x16_bf16(X1[dd], Q_[dd], p1, 0, 0, 0); } } while (0)
    QK_LOAD(a0, a1, 0); SBAR();
    QK_LOAD(b0, b1, 1); SBAR();
    QK_MMA(a0, a1, qr); SBAR();
    QK_LOAD(a0, a1, 2);
#pragma unroll
    for (int dd = 0; dd < 4; ++dd) qf[dd] = *reinterpret_cast<const bf16x8*>(qrl + dd * 1024);
    SBAR();
    QK_MMA(b0, b1, (qr + 4)); SBAR();
    QK_MMA(a0, a1, qf);
#undef QK_LOAD
#undef QK_MMA
}
__device__ __forceinline__ void pv_tile(f32x16* o, int vb0, bf16x8 pa0, bf16x8 pa1, bf16x8 pa2, bf16x8 pa3) {
#define TRRD(dst, off) asm volatile("ds_read_b64_tr_b16 %0, %1 offset:%2" : "=&v"(dst) : "v"(vb0), "i"(off) : "memory")
#define PV_RD(S, d0) do { constexpr int b_ = v_rd_off(d0, 0, 0); \
        TRRD(S##l0, b_); TRRD(S##h0, b_ + 2048); TRRD(S##l1, b_ + 4096); TRRD(S##h1, b_ + 6144); TRRD(S##l2, b_ + 8192); TRRD(S##h2, b_ + 10240); TRRD(S##l3, b_ + 12288); TRRD(S##h3, b_ + 14336); } while (0)
#define PV_MM(S, d0) do { \
        o[d0] = __builtin_amdgcn_mfma_f32_32x32x16_bf16(pa0, (bf16x8){S##l0[0], S##l0[1], S##l0[2], S##l0[3], S##h0[0], S##h0[1], S##h0[2], S##h0[3]}, o[d0], 0, 0, 0);   \
        o[d0] = __builtin_amdgcn_mfma_f32_32x32x16_bf16(pa1, (bf16x8){S##l1[0], S##l1[1], S##l1[2], S##l1[3], S##h1[0], S##h1[1], S##h1[2], S##h1[3]}, o[d0], 0, 0, 0);   \
        o[d0] = __builtin_amdgcn_mfma_f32_32x32x16_bf16(pa2, (bf16x8){S##l2[0], S##l2[1], S##l2[2], S##l2[3], S##h2[0], S##h2[1], S##h2[2], S##h2[3]}, o[d0], 0, 0, 0);   \
        o[d0] = __builtin_amdgcn_mfma_f32_32x32x16_bf16(pa3, (bf16x8){S##l3[0], S##l3[1], S##l3[2], S##l3[3], S##h3[0], S##h3[1], S##h3[2], S##h3[3]}, o[d0], 0, 0, 0); } while (0)
    s16x4 Al0, Al1, Al2, Al3, Ah0, Ah1, Ah2, Ah3, Bl0, Bl1, Bl2, Bl3, Bh0, Bh1, Bh2, Bh3;
    asm volatile("s_waitcnt lgkmcnt(0)" ::: "memory");
    PV_RD(A, 0);
    PV_RD(B, 1); asm volatile("s_waitcnt lgkmcnt(8)" ::: "memory"); SBAR(); PV_MM(A, 0); SBAR();
    PV_RD(A, 2); asm volatile("s_waitcnt lgkmcnt(8)" ::: "memory"); SBAR(); PV_MM(B, 1); SBAR();
    PV_RD(B, 3); asm volatile("s_waitcnt lgkmcnt(8)" ::: "memory"); SBAR(); PV_MM(A, 2); SBAR();
    asm volatile("s_waitcnt lgkmcnt(0)" ::: "memory"); SBAR(); PV_MM(B, 3);
#undef PV_RD
#undef PV_MM
#undef TRRD
}
__device__ __forceinline__ void unit(const OW& P, char* lds, int b, int h, int qb, int part) {
    const int tid = TID(), wid = __builtin_amdgcn_readfirstlane(tid >> 6), lane = tid & 63, r32 = lane & 31, hi = lane >> 5;
    const int NTall = 4 * (qb + 1), t_lo = part ? NTall / 2 : 0, NT_ = NTall / 2;
    const size_t rowbase = (size_t)b * S;
    const int q0 = qb * 256, qlo = q0 + wid * 32, qm = qlo + r32 - 4 * hi;
    char* V_lds = lds; char* K_lds = lds + OFF_K;
    float* ws = (float*)(lds + OFF_WS) + wid * 64; float* li_l = ws; float* al_l = ws + 32;
    float m_reg = -1e30f, l_reg = 0; f32x16 o[4] = {};
    const int vb0 = (int)(uintptr_t)V_lds + v_rd_base(lane);
    unsigned go_k01, go_k2, go_v0, go_v1;
    { const int row = 8 * wid + (lane >> 3), c = (lane & 7) ^ ((row >> 1) & 7);
      go_k01 = (unsigned)(row * 512 + c * 8) * 2u; go_k2 = (unsigned)(row * 64 + c * 8) * 2u;
      const int si0 = 2 * wid + (lane >> 5), si1 = si0 + 16;
      const int kk0 = (si0 >> 2) * 8 + ((lane & 31) >> 2), kk1 = (si1 >> 2) * 8 + ((lane & 31) >> 2);
      const int k0_ = (kk0 & ~0xC) | ((kk0 & 4) << 1) | ((kk0 & 8) >> 1), k1_ = (kk1 & ~0xC) | ((kk1 & 4) << 1) | ((kk1 & 8) >> 1);
      go_v0 = (unsigned)(k0_ * 512 + (si0 & 3) * 32 + (lane & 3) * 8) * 2u; go_v1 = (unsigned)(k1_ * 512 + (si1 & 3) * 32 + (lane & 3) * 8) * 2u; }
    const char* KnB = (const char*)(P.KN + rowbase * 512 + h * 128); const char* VhB = (const char*)(P.VV + rowbase * 512 + h * 128); const char* KpB = (const char*)(P.KPE + rowbase * 64);
    LAS unsigned char* ldsK = (LAS unsigned char*)(uintptr_t)(unsigned)(uintptr_t)K_lds; LAS unsigned char* ldsV = (LAS unsigned char*)(uintptr_t)(unsigned)(uintptr_t)V_lds;
#define KBASE(t) ((t_lo + (t)) * KVBLK)
#define GLDS(gp, lp) __builtin_amdgcn_global_load_lds((const unsigned*)(gp), (LAS unsigned*)(lp), 16, 0, 0)
#define STAGE(k0, ks_, vs_) do { const size_t kb_ = (size_t)(k0); \
        GLDS(KnB + kb_ * 1024 + go_k01, ldsK + (ks_) * SHM_K + wid * 1024); GLDS(KnB + kb_ * 1024 + 128 + go_k01, ldsK + (ks_) * SHM_K + 8192 + wid * 1024); \
        GLDS(KpB + kb_ * 128 + go_k2, ldsK + (ks_) * SHM_K + 16384 + wid * 1024); \
        GLDS(VhB + kb_ * 1024 + go_v0, ldsV + (vs_) * SHM_V + wid * 1024); GLDS(VhB + kb_ * 1024 + go_v1, ldsV + (vs_) * SHM_V + (wid + 8) * 1024); } while (0)
#define RESC(a) do { if (__any((a) < 1.f)) { if (hi == 0) al_l[r32] = (a); asm volatile("s_waitcnt lgkmcnt(0)" ::: "memory");              \
                     _Pragma("unroll") for (int d_ = 0; d_ < 4; ++d_) _Pragma("unroll") for (int r = 0; r < 16; ++r) o[d_][r] *= al_l[crow(r, hi)]; } } while (0)
#define MASKT(P0_, P1_, t) do { const int kb_ = KBASE(t); if (kb_ + KVBLK - 1 > qlo) mask_tile(P0_, P1_, qm - kb_); } while (0)
    STAGE(KBASE(0), 0, 0); if (NT_ > 1) { STAGE(KBASE(1), 1, 1); }
    bf16x8 qr[8]; char* qrl = lds + OFF_QR + wid * 4096 + lane * 16;
    { const bf16_t* qp = P.Q + (rowbase + qlo + r32) * QL + h * QH + hi * 8;
#pragma unroll
      for (int d0 = 0; d0 < 8; ++d0) qr[d0] = *(const bf16x8*)(qp + d0 * 16);
      const f32x2* rp = P.ROPE + (size_t)(qlo + r32) * 32 + hi * 8;
#pragma unroll
      for (int g = 0; g < 2; ++g) {
          u32x4 x1 = *(const u32x4*)(qp + (8 + g) * 16), x2 = *(const u32x4*)(qp + (10 + g) * 16); u32x4 y1, y2;
#pragma unroll
          for (int jj = 0; jj < 4; ++jj) { const f32x2 cs0 = rp[16 * g + 2 * jj], cs1 = rp[16 * g + 2 * jj + 1];
              const float a0 = bflo(x1[jj]), a1 = bfhi(x1[jj]), b0 = bflo(x2[jj]), b1 = bfhi(x2[jj]);
              y1[jj] = pk2(a0 * cs0.x - b0 * cs0.y, a1 * cs1.x - b1 * cs1.y); y2[jj] = pk2(a0 * cs0.y + b0 * cs0.x, a1 * cs1.y + b1 * cs1.x); }
          *(u32x4*)(qrl + g * 1024) = y1; *(u32x4*)(qrl + (2 + g) * 1024) = y2; } }
    f32x16 p0, p1; float mn, al; bf16x8 pa0, pa1, pa2, pa3;
    asm volatile("s_waitcnt vmcnt(0)" ::: "memory"); __syncthreads();
    int sl = 0;
    for (int t = 0; t < NT_; ++t) {
        const int s2 = sl == 0 ? 2 : sl - 1;
        if (t + 2 < NT_) { STAGE(KBASE(t + 2), s2, s2); }
        qkt(p0, p1, K_lds + sl * SHM_K, r32, hi, qr, qrl);
        MASKT(p0, p1, t); partialSM(p0, p1, m_reg, mn, al); RESC(al);
        finishSM(p0, p1, al, l_reg, pa0, pa1, pa2, pa3); SBAR();
        pv_tile(o, vb0 + sl * SHM_V, pa0, pa1, pa2, pa3);
        if (t + 2 < NT_) asm volatile("s_waitcnt vmcnt(5) lgkmcnt(0)" ::: "memory"); else asm volatile("s_waitcnt vmcnt(0) lgkmcnt(0)" ::: "memory");
        __builtin_amdgcn_s_barrier(); asm volatile("" ::: "memory");
        sl = sl == 2 ? 0 : sl + 1;
    }
    bf16_t* Ow = P.OP + ((size_t)part * NT + rowbase + qlo) * 512 + h * 128;
#pragma unroll
    for (int r = 0; r < 16; ++r) { const int orow = crow(r, hi);
#pragma unroll
        for (int d0 = 0; d0 < 4; ++d0) { const float v = o[d0][r]; const float vn = __builtin_bit_cast(float, __builtin_amdgcn_update_dpp(0, __builtin_bit_cast(int, v), 0xB1, 0xF, 0xF, false));
            if ((r32 & 1) == 0) *(unsigned*)(Ow + (size_t)orow * 512 + d0 * 32 + r32) = cvtpk(v, vn); } }
    if (hi == 0) P.ML[((size_t)part * NT + rowbase + qlo + r32) * 4 + h] = (f32x2){m_reg * (1.4426950408889634f * SCALE), l_reg};
    __syncthreads();
#undef KBASE
#undef GLDS
#undef STAGE
#undef RESC
#undef MASKT
}
#undef SBAR
}
__device__ __forceinline__ void phase_attn(const OW& P, LAS unsigned char* lds, int vcu, int G) {
    for (int v = vcu; v < 256; v += G) { const int bh = v >> 4, r = v & 15;
        att::unit(P, (char*)lds, bh >> 2, bh & 3, r, 0);
        att::unit(P, (char*)lds, bh >> 2, bh & 3, 15 - r, 1); }
}
#if MODE == 0
__global__ void shim_attn(const bf16_t* OP, const f32x2* ML, float* MIXf) {
    const size_t i = (size_t)blockIdx.x * 256 + threadIdx.x; if (i >= (size_t)NT * 512) return;
    const size_t row = i >> 9; const int c = (int)(i & 511), h = c >> 7;
    const f32x2 a = ML[row * 4 + h], b = ML[((size_t)NT + row) * 4 + h];
    const float M = fmaxf(a.x, b.x), w0 = exp2f(a.x - M), w1 = exp2f(b.x - M);
    MIXf[row * D + 512 + c] = (w0 * bf2f(OP[i]) + w1 * bf2f(OP[(size_t)NT * 512 + i])) / (w0 * a.y + w1 * b.y);
}
#endif


template <int CTRL, int ROWMASK> __device__ __forceinline__ float dppf(float v) { return __builtin_bit_cast(float, __builtin_amdgcn_update_dpp(0, __builtin_bit_cast(int, v), CTRL, ROWMASK, 0xF, false)); }
__device__ __forceinline__ float wsum(float v) {
    v += dppf<0xB1, 0xF>(v);
    v += dppf<0x4E, 0xF>(v);
    v += dppf<0x141, 0xF>(v);
    v += dppf<0x140, 0xF>(v);
    v += dppf<0x142, 0xA>(v);
    v += dppf<0x143, 0xC>(v);
    return __builtin_bit_cast(float, __builtin_amdgcn_readlane(__builtin_bit_cast(int, v), 63));
}
__device__ __forceinline__ float gelu_t(float x) { const float u = 0.7978845608028654f * (x + 0.044715f * x * x * x); const float t = 1.f - 2.f * __builtin_amdgcn_rcpf(1.f + __expf(2.f * u)); return 0.5f * x * (1.f + t); }
__device__ __forceinline__ void mix_tile(const OW& P, LAS unsigned char* lds, int tile) {
    const int tid = TID(), lane = tid & 63, wid = __builtin_amdgcn_readfirstlane(tid >> 6);
    LAS float* LR = (LAS float*)lds;
    const int tok0 = tile * 64, j = tile & 63, tile0 = tile - j;
    float h = 0.f;
    if (j > 0) {
        { float a[32], b[32];
#pragma unroll
          for (int q = 0; q < 32; ++q) { const int t_ = q < j ? tile0 + q : tile0; a[q] = P.AGA[(size_t)t_ * LW + tid]; b[q] = P.AGB[(size_t)t_ * LW + tid]; }
#pragma unroll
          for (int q = 0; q < 32; ++q) if (q < j) h = fmaf(a[q], h, b[q]); }
        if (j > 32) { float a[32], b[32];
#pragma unroll
          for (int q = 0; q < 32; ++q) { const int t_ = 32 + q < j ? tile0 + 32 + q : tile0; a[q] = P.AGA[(size_t)t_ * LW + tid]; b[q] = P.AGB[(size_t)t_ * LW + tid]; }
#pragma unroll
          for (int q = 0; q < 32; ++q) if (32 + q < j) h = fmaf(a[q], h, b[q]); }
    }
    { unsigned ad[64]; unsigned short gg[64];
#pragma unroll
      for (int q = 0; q < 64; ++q) { const size_t tok = (size_t)tok0 + q; ad[q] = ((const unsigned*)P.A)[tok * LW + tid]; gg[q] = P.Z[tok * ZW + LW + tid]; }
#pragma unroll
      for (int q = 0; q < 64; ++q) { h = fmaf(1.f - bflo(ad[q]), h, bfhi(ad[q])); LR[q * LW + tid] = h * gelu_t(bf2f(gg[q])); } }
    __syncthreads();
    { const int hh = lane >> 4;
      f32x2 nma, nmb; u32x4 noa, nob;
#define MX_LOAD(r_) do { const size_t row_ = (size_t)tok0 + (r_); nma = P.ML[row_ * 4 + hh]; nmb = P.ML[((size_t)NT + row_) * 4 + hh]; \
        noa = *(const u32x4*)(P.OP + row_ * 512 + lane * 8); nob = *(const u32x4*)(P.OP + ((size_t)NT + row_) * 512 + lane * 8); } while (0)
      MX_LOAD(wid);
      for (int r = wid; r < 64; r += NWAVES) { const size_t row = (size_t)tok0 + r;
        const f32x2 ma = nma, mb = nmb; const u32x4 oa = noa, ob = nob;
        if (r + NWAVES < 64) MX_LOAD(r + NWAVES);
        { const f32x4 v0 = *(const LAS f32x4*)(LR + r * LW + lane * 8), v1 = *(const LAS f32x4*)(LR + r * LW + lane * 8 + 4);
          float ss = (v0[0] * v0[0] + v0[1] * v0[1]) + (v0[2] * v0[2] + v0[3] * v0[3]) + (v1[0] * v1[0] + v1[1] * v1[1]) + (v1[2] * v1[2] + v1[3] * v1[3]);
          const float rs = rsqrtf(wsum(ss) * (1.f / 512.f) + EPS);
          u32x4 o; o.x = pk2(v0[0] * rs, v0[1] * rs); o.y = pk2(v0[2] * rs, v0[3] * rs); o.z = pk2(v1[0] * rs, v1[1] * rs); o.w = pk2(v1[2] * rs, v1[3] * rs);
          *(u32x4*)(P.MIX + row * D + lane * 8) = o; }
        { const float M = fmaxf(ma.x, mb.x), w0 = __builtin_amdgcn_exp2f(ma.x - M), w1 = __builtin_amdgcn_exp2f(mb.x - M), inv = 1.f / (w0 * ma.y + w1 * mb.y);
          float v[8];
#pragma unroll
          for (int q = 0; q < 4; ++q) { v[2 * q] = (w0 * bflo(oa[q]) + w1 * bflo(ob[q])) * inv; v[2 * q + 1] = (w0 * bfhi(oa[q]) + w1 * bfhi(ob[q])) * inv; }
          float ss = 0.f;
#pragma unroll
          for (int q = 0; q < 8; ++q) ss += v[q] * v[q];
          const float rs = rsqrtf(wsum(ss) * (1.f / 512.f) + EPS);
          u32x4 o; o.x = pk2(v[0] * rs, v[1] * rs); o.y = pk2(v[2] * rs, v[3] * rs); o.z = pk2(v[4] * rs, v[5] * rs); o.w = pk2(v[6] * rs, v[7] * rs);
          *(u32x4*)(P.MIX + row * D + 512 + lane * 8) = o; } }
#undef MX_LOAD
    }
    __syncthreads();
}
struct SchedOut {
    static constexpr bool HOOKS = false;
    const OW* P; int G, c;
    __device__ __forceinline__ bool next(int i, pg8::UnitD& u) const {
        const int L = i * G + c; if (L >= 256) return false;
        int pm, pn; pg8::tile_order(L, 64, 4, pm, pn);
        u.A = (const char*)(P->MIX + (size_t)pm * 256 * D); u.rows = nullptr; u.B = (const char*)(P->Wo_t + (size_t)pn * 256 * 1024); u.lda = D * 2; u.ldb = 2048; u.nt = 16; u.type = 3; u.pm = pm; u.pn = pn; u.aux = 0;
        return true;
    }
};
struct EpiOut {
    const bf16_t* xres; bf16_t* Y;
    __device__ __forceinline__ void operator()(const f32x4 (&acc)[2][2][4][2], const pg8::UnitD& u, int wr, int wc, int fr, int fq) const {
        const int row0 = u.pm * 256 + wr * 64 + fr, col0 = u.pn * 256 + wc * 32 + 8 * fq;
#pragma unroll
        for (int ai = 0; ai < 2; ++ai) { u32x4 xb[4][2];
#pragma unroll
            for (int m = 0; m < 4; ++m) { const size_t off = (size_t)(row0 + ai * 128 + m * 16) * D + col0;
#pragma unroll
                for (int bj = 0; bj < 2; ++bj) xb[m][bj] = *(const u32x4*)(xres + off + bj * 128); }
#pragma unroll
            for (int m = 0; m < 4; ++m) { const size_t off = (size_t)(row0 + ai * 128 + m * 16) * D + col0;
#pragma unroll
                for (int bj = 0; bj < 2; ++bj) { const u32x4 x_ = xb[m][bj]; const f32x4 v0 = acc[ai][bj][m][0], v1 = acc[ai][bj][m][1];
                    u32x4 w; w.x = pg8::cvt_pk_bf16(ALPHA * bflo(x_.x) + v0[0], ALPHA * bfhi(x_.x) + v0[1]); w.y = pg8::cvt_pk_bf16(ALPHA * bflo(x_.y) + v0[2], ALPHA * bfhi(x_.y) + v0[3]);
                    w.z = pg8::cvt_pk_bf16(ALPHA * bflo(x_.z) + v1[0], ALPHA * bfhi(x_.z) + v1[1]); w.w = pg8::cvt_pk_bf16(ALPHA * bflo(x_.w) + v1[2], ALPHA * bfhi(x_.w) + v1[3]);
                    *(u32x4*)(Y + off + bj * 128) = w; } } }
    }
};
__device__ __forceinline__ void ln1_router_tile(const OW& P, int l, LAS unsigned char* lds, int tile) {
    const int tid = TID(), lane = tid & 63, wid = __builtin_amdgcn_readfirstlane(tid >> 6), fr = lane & 15, fq = lane >> 4;
    LAS float* PL = (LAS float*)lds;
    LAS f32x2* ST = (LAS f32x2*)(lds + 8192);
    LAS int* EI = (LAS int*)(lds + 8192 + 512);
    const float* g1 = P.in[15] + (size_t)l * D; const float* b1 = P.in[16] + (size_t)l * D; const float* rb = P.in[18];
    const int tok0 = tile * 64;
    { const int mt = wid & 3, kh = wid >> 2;
      const bf16_t* yp = P.Y + ((size_t)tok0 + 16 * mt + fr) * D + 512 * kh + 8 * fq; const bf16_t* wp = P.RWH + (size_t)fr * 1024 + 512 * kh + 8 * fq;
      bf16x8 ya[16];
#pragma unroll
      for (int ks = 0; ks < 16; ++ks) ya[ks] = *(const bf16x8*)(yp + 32 * ks);
      f32x4 acc = {0.f, 0.f, 0.f, 0.f};
#pragma unroll
      for (int ks = 0; ks < 16; ++ks) { const bf16x8 bh = *(const bf16x8*)(wp + 32 * ks), bl = *(const bf16x8*)(wp + 16 * 1024 + 32 * ks);
          acc = __builtin_amdgcn_mfma_f32_16x16x32_bf16(ya[ks], bh, acc, 0, 0, 0); acc = __builtin_amdgcn_mfma_f32_16x16x32_bf16(ya[ks], bl, acc, 0, 0, 0); }
#pragma unroll
      for (int x = 0; x < 4; ++x) PL[(kh * 64 + 16 * mt + 4 * fq + x) * 16 + fr] = acc[x]; }
    f32x4 gv[4], bv[4];
#pragma unroll
    for (int j = 0; j < 4; ++j) { gv[j] = *(const f32x4*)(g1 + lane * 16 + 4 * j); bv[j] = *(const f32x4*)(b1 + lane * 16 + 4 * j); }
    u32x4 n0 = *(const u32x4*)(P.Y + ((size_t)tok0 + wid * 8) * D + lane * 16), n1 = *(const u32x4*)(P.Y + ((size_t)tok0 + wid * 8) * D + lane * 16 + 8);
    for (int rr = 0; rr < 8; ++rr) { const int r = wid * 8 + rr; const size_t row = (size_t)tok0 + r;
        float v[16]; float s_ = 0.f;
#pragma unroll
        for (int q = 0; q < 4; ++q) { v[2 * q] = bflo(n0[q]); v[2 * q + 1] = bfhi(n0[q]); v[8 + 2 * q] = bflo(n1[q]); v[8 + 2 * q + 1] = bfhi(n1[q]); }
#pragma unroll
        for (int j = 0; j < 16; ++j) s_ += v[j];
        if (rr + 1 < 8) { n0 = *(const u32x4*)(P.Y + (row + 1) * D + lane * 16); n1 = *(const u32x4*)(P.Y + (row + 1) * D + lane * 16 + 8); }
        const float mu = wsum(s_) * (1.f / D); float q_ = 0.f;
#pragma unroll
        for (int j = 0; j < 16; ++j) { v[j] -= mu; q_ += v[j] * v[j]; }
        const float rs = rsqrtf(wsum(q_) * (1.f / D) + EPS);
#pragma unroll
        for (int j = 0; j < 16; ++j) v[j] = v[j] * rs * gv[j >> 2][j & 3] + bv[j >> 2][j & 3];
        u32x4 o0, o1;
#pragma unroll
        for (int q = 0; q < 4; ++q) { o0[q] = pk2(v[2 * q], v[2 * q + 1]); o1[q] = pk2(v[8 + 2 * q], v[8 + 2 * q + 1]); }
        *(u32x4*)(P.XB + row * D + lane * 16) = o0; *(u32x4*)(P.XB + row * D + lane * 16 + 8) = o1;
        if (lane == 0) ST[r] = (f32x2){mu, rs}; }
    __syncthreads();
    if (tid < 64) { const int r = tid; const size_t row = (size_t)tok0 + r; const f32x2 st = ST[r];
        float sg[16], ss[16];
#pragma unroll
        for (int q4 = 0; q4 < 4; ++q4) { const f32x4 pa = *(const LAS f32x4*)(PL + r * 16 + 4 * q4), pb = *(const LAS f32x4*)(PL + (64 + r) * 16 + 4 * q4);
#pragma unroll
            for (int x = 0; x < 4; ++x) { const int e = 4 * q4 + x; const float lg = st.y * ((pa[x] + pb[x]) - st.x * P.RGB[e]) + P.RGB[16 + e];
                sg[e] = __builtin_amdgcn_rcpf(1.f + __expf(-lg)); ss[e] = sg[e] + rb[e]; } }
        int best_g = 0; float best = -INFINITY;
#pragma unroll
        for (int gI = 0; gI < 4; ++gI) { float m1 = -INFINITY, m2 = -INFINITY;
#pragma unroll
            for (int k = 0; k < 4; ++k) { const float vv = ss[gI * 4 + k]; if (vv > m1) { m2 = m1; m1 = vv; } else if (vv > m2) { m2 = vv; } }
            const float gs = m1 + m2; if (gs > best) { best = gs; best_g = gI; } }
        float c0 = 0.f, c1 = 0.f, c2 = 0.f, c3 = 0.f, t0 = 0.f, t1 = 0.f, t2 = 0.f, t3 = 0.f;
#pragma unroll
        for (int gI = 0; gI < 4; ++gI) if (gI == best_g) { c0 = ss[gI * 4]; c1 = ss[gI * 4 + 1]; c2 = ss[gI * 4 + 2]; c3 = ss[gI * 4 + 3]; t0 = sg[gI * 4]; t1 = sg[gI * 4 + 1]; t2 = sg[gI * 4 + 2]; t3 = sg[gI * 4 + 3]; }
        int i1 = 0; float v1 = c0, s1 = t0;
        if (c1 > v1) { i1 = 1; v1 = c1; s1 = t1; }
        if (c2 > v1) { i1 = 2; v1 = c2; s1 = t2; }
        if (c3 > v1) { i1 = 3; v1 = c3; s1 = t3; }
        int i2 = -1; float v2 = -INFINITY, s2 = 0.f;
        if (i1 != 0 && c0 > v2) { i2 = 0; v2 = c0; s2 = t0; }
        if (i1 != 1 && c1 > v2) { i2 = 1; v2 = c1; s2 = t1; }
        if (i1 != 2 && c2 > v2) { i2 = 2; v2 = c2; s2 = t2; }
        if (i1 != 3 && c3 > v2) { i2 = 3; v2 = c3; s2 = t3; }
        const int e1 = best_g * 4 + i1, e2 = best_g * 4 + i2; const float inv = 1.f / (s1 + s2);
        P.GATE[row * 2] = s1 * inv; P.GATE[row * 2 + 1] = s2 * inv; P.EIDX[row * 2] = e1; P.EIDX[row * 2 + 1] = e2; EI[r * 2] = e1; EI[r * 2 + 1] = e2; }
    __syncthreads();
    { LAS int* C0 = EI + 128;
      int rank = 0, mye = -1, c_lo = 0;
      if (tid < 128) { mye = EI[tid];
#pragma unroll
          for (int e = 0; e < 16; ++e) { const unsigned long long m = __ballot(mye == e); if (mye == e) rank = __builtin_popcountll(m & ((1ull << lane) - 1ull)); if (tid == e) c_lo = __builtin_popcountll(m); if (tid == 64 + e) c_lo = __builtin_popcountll(m); }
          if (tid < 16) C0[tid] = c_lo; }
      __syncthreads();
      if (tid < 128) { if (tid >= 64) rank += C0[mye]; P.LRANK[(size_t)tok0 * 2 + tid] = rank; if (tid >= 64 && tid < 80) P.HIST[tile * 16 + (tid - 64)] = C0[tid - 64] + c_lo; } }
    __syncthreads();
}
__device__ __forceinline__ void moe_table(const OW& P, LAS unsigned char* lds) {
    const int tid = TID(); LAS int* HS = (LAS int*)lds; LAS int* TAB = (LAS int*)(lds + TAB_OFF);
    { int hv[8];
#pragma unroll
      for (int q = 0; q < 8; ++q) hv[q] = P.HIST[tid + q * NTHREADS];
#pragma unroll
      for (int q = 0; q < 8; ++q) HS[tid + q * NTHREADS] = hv[q]; }
    __syncthreads();
    if (tid < 64) { const int e = tid & 15, qd = tid >> 4; int tot = 0;
#pragma unroll 8
        for (int w = 0; w < 64; ++w) tot += HS[(qd * 64 + w) * 16 + e];
        tot += __shfl_xor(tot, 16); tot += __shfl_xor(tot, 32);
        if (qd == 0) TAB[32 + e] = tot; }
    __syncthreads();
    if (tid == 0) { int acc = 0; for (int e = 0; e < 16; ++e) { TAB[e] = acc; acc += (TAB[32 + e] + 255) >> 8; } TAB[16] = acc; }
    __syncthreads();
}
__device__ __forceinline__ void dest_tile(const OW& P, LAS unsigned char* lds, int tile) {
    const int tid = TID(); LAS int* HS = (LAS int*)lds; LAS int* TAB = (LAS int*)(lds + TAB_OFF); LAS int* BS = (LAS int*)(lds + 16384);
    if (tid < 64) { const int e = tid & 15, qd = tid >> 4; int b = 0;
#pragma unroll 8
        for (int w = 0; w < 64; ++w) { const int ww = qd * 64 + w; b += ww < tile ? HS[ww * 16 + e] : 0; }
        b += __shfl_xor(b, 16); b += __shfl_xor(b, 32);
        if (qd == 0) BS[e] = b; }
    __syncthreads();
    if (tid < 128) { const size_t a = (size_t)tile * 128 + tid; const int e = P.EIDX[a]; const int dst = 256 * TAB[e] + BS[e] + P.LRANK[a]; P.DEST[a] = dst; P.ROWTOK[dst] = (int)(a >> 1); }
    if (tile < 16) { const int e = tile, lo = 256 * TAB[e] + TAB[32 + e], hi = 256 * TAB[e + 1]; for (int i = lo + tid; i < hi; i += NTHREADS) P.ROWTOK[i] = 0; }
    __syncthreads();
}
struct SchedMoe {
    static constexpr bool HOOKS = false;
    const OW* P; LAS int* TAB; int G, c; bool down;
    __device__ __forceinline__ bool next(int i, pg8::UnitD& u) const {
        const int NB = __builtin_amdgcn_readfirstlane(TAB[16]); const int L = i * G + c; if (L >= NB * 4) return false;
        const int rb = L >> 2, pn = L & 3; int e = 0;
#pragma unroll
        for (int q = 1; q < 16; ++q) e += (__builtin_amdgcn_readfirstlane(TAB[q]) <= rb) ? 1 : 0;
        if (!down) { u.A = (const char*)P->XB; u.rows = P->ROWTOK + rb * 256; u.B = (const char*)(P->Wgu_t + ((size_t)e * 1024 + pn * 256) * 1024); u.lda = 2048; u.ldb = 2048; u.nt = 16; u.type = 4; }
        else { u.A = (const char*)(P->HE + (size_t)rb * 256 * DE); u.rows = nullptr; u.B = (const char*)(P->Wd_t + ((size_t)e * 1024 + pn * 256) * DE); u.lda = 1024; u.ldb = 1024; u.nt = 8; u.type = 5; }
        u.pm = rb; u.pn = pn; u.aux = e; return true;
    }
};
struct EpiMoeUp {
    bf16_t* HE;
    __device__ __forceinline__ void operator()(const f32x4 (&acc)[2][2][4][2], const pg8::UnitD& u, int wr, int wc, int fr, int fq) const {
        const int row0 = u.pm * 256 + wr * 64 + fr, col0 = u.pn * 128 + wc * 32 + 8 * fq;
#pragma unroll
        for (int ai = 0; ai < 2; ++ai)
#pragma unroll
            for (int m = 0; m < 4; ++m) { float hv[8];
#pragma unroll
                for (int n = 0; n < 2; ++n)
#pragma unroll
                    for (int x = 0; x < 4; ++x) { const float g = acc[ai][0][m][n][x], up = acc[ai][1][m][n][x]; hv[4 * n + x] = g / (1.f + __expf(-g)) * up; }
                u32x4 w; w.x = pg8::cvt_pk_bf16(hv[0], hv[1]); w.y = pg8::cvt_pk_bf16(hv[2], hv[3]); w.z = pg8::cvt_pk_bf16(hv[4], hv[5]); w.w = pg8::cvt_pk_bf16(hv[6], hv[7]);
                *(u32x4*)(HE + (size_t)(row0 + ai * 128 + m * 16) * DE + col0) = w; }
    }
};
struct EpiMoeDown {
    bf16_t* YE;
    __device__ __forceinline__ void operator()(const f32x4 (&acc)[2][2][4][2], const pg8::UnitD& u, int wr, int wc, int fr, int fq) const {
        const int row0 = u.pm * 256 + wr * 64 + fr, col0 = u.pn * 256 + wc * 32 + 8 * fq;
#pragma unroll
        for (int ai = 0; ai < 2; ++ai)
#pragma unroll
            for (int m = 0; m < 4; ++m) { bf16_t* rowp = YE + (size_t)(row0 + ai * 128 + m * 16) * D + col0;
#pragma unroll
                for (int bj = 0; bj < 2; ++bj) { const f32x4 v0 = acc[ai][bj][m][0], v1 = acc[ai][bj][m][1];
                    u32x4 w; w.x = pg8::cvt_pk_bf16(v0[0], v0[1]); w.y = pg8::cvt_pk_bf16(v0[2], v0[3]); w.z = pg8::cvt_pk_bf16(v1[0], v1[1]); w.w = pg8::cvt_pk_bf16(v1[2], v1[3]);
                    *(u32x4*)(rowp + bj * 128) = w; } }
    }
};

__device__ __forceinline__ void store16_sc1(void* p, u32x4 v) { asm volatile("global_store_dwordx4 %0, %1, off sc1\n\ts_nop 1" :: "v"(p), "v"(v) : "memory"); }
struct SchedMoe2 {
    static constexpr bool HOOKS = true;
    const OW* P; LAS int* TAB; unsigned* cnt;
    int G, c, U, nup, ndn, jA, jB;
    __device__ __forceinline__ void init(int G_, int c_) {
        G = G_; c = c_; const int NB = __builtin_amdgcn_readfirstlane(TAB[16]); U = 4 * NB;
        const int nmax = (U + G - 1) / G, nfull = U - (nmax - 1) * G;
        const bool allsame = nfull >= G; const int Lc = allsame ? 0 : G - nfull;
        nup = (c < nfull || allsame) ? nmax : nmax - 1; if (c >= U) nup = 0;
        const bool light = !allsame && c >= nfull; const int cl = c - nfull;
        const int nA = 2 * Lc < U ? 2 * Lc : U; const int R = U - nA;
        int a_cnt = 0; if (light) { a_cnt = nA - 2 * cl; a_cnt = a_cnt < 0 ? 0 : (a_cnt > 2 ? 2 : a_cnt); }
        const int o = light ? cl : Lc + c;
        const int b_cnt = o < R ? (R - o + G - 1) / G : 0;
        jA = 2 * cl; jB = nA + o; ndn = a_cnt + b_cnt; nA_mine = a_cnt;
    }
    int nA_mine;
    __device__ __forceinline__ bool next(int i, pg8::UnitD& u) const {
        if (i < nup) { const int Lq = c + i * G; fill(u, Lq >> 2, Lq & 3, false); return true; }
        const int k = i - nup; if (k >= ndn) return false;
        const int j = k < nA_mine ? jA + k : jB + (k - nA_mine) * G; fill(u, j >> 2, j & 3, true); return true;
    }
    __device__ __forceinline__ void fill(pg8::UnitD& u, int rb, int pn, bool down) const {
        int e = 0;
#pragma unroll
        for (int q = 1; q < 16; ++q) e += (__builtin_amdgcn_readfirstlane(TAB[q]) <= rb) ? 1 : 0;
        if (!down) { u.A = (const char*)P->XB; u.rows = P->ROWTOK + rb * 256; u.B = (const char*)(P->Wgu_t + ((size_t)e * 1024 + pn * 256) * 1024); u.lda = 2048; u.ldb = 2048; u.nt = 16; u.type = 4; }
        else { u.A = (const char*)(P->HE + (size_t)rb * 256 * DE); u.rows = nullptr; u.B = (const char*)(P->Wd_t + ((size_t)e * 1024 + pn * 256) * DE); u.lda = 1024; u.ldb = 1024; u.nt = 8; u.type = 5; }
        u.pm = rb; u.pn = pn; u.aux = e;
    }
    __device__ __forceinline__ void a_ready(const pg8::UnitD& u, int wid) const {
        if (u.type != 5) return;
        if (wid == 0) {
            const unsigned* w = cnt + 64 * u.pm; unsigned spins = 0;
            for (;;) { unsigned v;
                asm volatile("v_mov_b32 %0, 0\n\tglobal_load_dword %0, %0, %1 sc1\n\ts_waitcnt vmcnt(0)" : "=&v"(v) : "s"(w) : "memory");
                if ((unsigned)__builtin_amdgcn_readfirstlane((int)v) >= 32u) break;
                if (++spins > 200000u) break;
                __builtin_amdgcn_s_sleep(2); }
            __builtin_amdgcn_fence(__ATOMIC_ACQUIRE, "agent");
            asm volatile("s_waitcnt vmcnt(0)" ::: "memory");
        }
        asm volatile("" ::: "memory"); __builtin_amdgcn_s_barrier(); asm volatile("" ::: "memory");
    }
    __device__ __forceinline__ void done(const pg8::UnitD& u, int lane) const {
        if (u.type != 4) return;
        asm volatile("s_waitcnt vmcnt(0)" ::: "memory");
        if (lane == 0) __hip_atomic_fetch_add(cnt + 64 * u.pm, 1u, __ATOMIC_RELAXED, __HIP_MEMORY_SCOPE_AGENT);
    }
};
struct EpiMoe2 {
    bf16_t* HE; bf16_t* YE;
    __device__ __forceinline__ void operator()(const f32x4 (&acc)[2][2][4][2], const pg8::UnitD& u, int wr, int wc, int fr, int fq) const {
        const int row0 = u.pm * 256 + wr * 64 + fr;
        if (u.type == 4) { const int col0 = u.pn * 128 + wc * 32 + 8 * fq;
#pragma unroll
            for (int ai = 0; ai < 2; ++ai)
#pragma unroll
                for (int m = 0; m < 4; ++m) { float hv[8];
                    int rr = row0 + ai * 128 + m * 16; asm volatile("" : "+v"(rr));
#pragma unroll
                    for (int n = 0; n < 2; ++n)
#pragma unroll
                        for (int x = 0; x < 4; ++x) { const float g = acc[ai][0][m][n][x], up = acc[ai][1][m][n][x]; hv[4 * n + x] = g * __builtin_amdgcn_rcpf(1.f + __expf(-g)) * up; }
                    u32x4 w; w.x = pg8::cvt_pk_bf16(hv[0], hv[1]); w.y = pg8::cvt_pk_bf16(hv[2], hv[3]); w.z = pg8::cvt_pk_bf16(hv[4], hv[5]); w.w = pg8::cvt_pk_bf16(hv[6], hv[7]);
                    store16_sc1(HE + (size_t)rr * DE + col0, w); }
        } else { const int col0 = u.pn * 256 + wc * 32 + 8 * fq;
#pragma unroll
            for (int ai = 0; ai < 2; ++ai)
#pragma unroll
                for (int m = 0; m < 4; ++m) { int rr = row0 + ai * 128 + m * 16; asm volatile("" : "+v"(rr)); bf16_t* rowp = YE + (size_t)rr * D + col0;
#pragma unroll
                    for (int bj = 0; bj < 2; ++bj) { const f32x4 v0 = acc[ai][bj][m][0], v1 = acc[ai][bj][m][1];
                        u32x4 w; w.x = pg8::cvt_pk_bf16(v0[0], v0[1]); w.y = pg8::cvt_pk_bf16(v0[2], v0[3]); w.z = pg8::cvt_pk_bf16(v1[0], v1[1]); w.w = pg8::cvt_pk_bf16(v1[2], v1[3]);
                        *(u32x4*)(rowp + bj * 128) = w; } }
        }
    }
};
__device__ __forceinline__ void ln2_rows(const OW& P, int l, int vcu, int G, float* Xdst) {
    const int tid_ = TID(); const int lane = tid_ & 63, wid = __builtin_amdgcn_readfirstlane(tid_ >> 6);
    const float* g2 = P.in[22] + (size_t)l * D; const float* b2 = P.in[23] + (size_t)l * D;
    f32x4 gv[4], bv[4];
#pragma unroll
    for (int j = 0; j < 4; ++j) { const int c = lane * 8 + 512 * (j >> 1) + 4 * (j & 1); gv[j] = *(const f32x4*)(g2 + c); bv[j] = *(const f32x4*)(b2 + c); }
    const size_t first = (size_t)vcu * NWAVES + wid, stride = (size_t)G * NWAVES;
    for (size_t base = first; base < NT; base += 8 * stride) {
        float ga[8], gb[8]; int da[8], db[8];
#pragma unroll
        for (int k = 0; k < 8; ++k) { const size_t row = base + k * stride; const bool ok = row < NT; const size_t r_ = ok ? row : base;
            ga[k] = P.GATE[r_ * 2]; gb[k] = P.GATE[r_ * 2 + 1]; da[k] = P.DEST[r_ * 2]; db[k] = P.DEST[r_ * 2 + 1]; }
#pragma unroll
        for (int kg = 0; kg < 8; kg += 4) {
        u32x4 nx[4][2], nya[4][2], nyb[4][2];
#pragma unroll
        for (int k4 = 0; k4 < 4; ++k4) { const int k = kg + k4; const size_t row_ = base + k * stride < NT ? base + k * stride : base;
#pragma unroll
            for (int j = 0; j < 2; ++j) { nx[k4][j] = *(const u32x4*)(P.XB + row_ * D + lane * 8 + 512 * j);
                nya[k4][j] = *(const u32x4*)(P.YE + (size_t)da[k] * D + lane * 8 + 512 * j); nyb[k4][j] = *(const u32x4*)(P.YE + (size_t)db[k] * D + lane * 8 + 512 * j); } }
#pragma unroll
        for (int k4 = 0; k4 < 4; ++k4) { const int k = kg + k4; const size_t row = base + k * stride; if (row >= NT) break;
            float v[16]; float s = 0.f; const float gA = ga[k], gB = gb[k];
#pragma unroll
            for (int j = 0; j < 2; ++j)
#pragma unroll
                for (int q = 0; q < 4; ++q) { const unsigned x = nx[k4][j][q], ya = nya[k4][j][q], yb = nyb[k4][j][q];
                    v[8 * j + 2 * q] = ALPHA * bflo(x) + gA * bflo(ya) + gB * bflo(yb); v[8 * j + 2 * q + 1] = ALPHA * bfhi(x) + gA * bfhi(ya) + gB * bfhi(yb); }
#pragma unroll
            for (int i = 0; i < 16; ++i) s += v[i];
            const float mu = wsum(s) * (1.f / D); float q_ = 0.f;
#pragma unroll
            for (int i = 0; i < 16; ++i) { v[i] -= mu; q_ += v[i] * v[i]; }
            const float rs = rsqrtf(wsum(q_) * (1.f / D) + EPS);
#pragma unroll
            for (int i = 0; i < 16; ++i) v[i] = v[i] * rs * gv[i >> 2][i & 3] + bv[i >> 2][i & 3];
#pragma unroll
            for (int j = 0; j < 2; ++j) { u32x4 o;
#pragma unroll
                for (int q = 0; q < 4; ++q) o[q] = pk2(v[8 * j + 2 * q], v[8 * j + 2 * q + 1]);
                *(u32x4*)(P.XB + row * D + lane * 8 + 512 * j) = o;
                if (Xdst) { *(f32x4*)(Xdst + row * D + lane * 8 + 512 * j) = (f32x4){v[8 * j], v[8 * j + 1], v[8 * j + 2], v[8 * j + 3]}; *(f32x4*)(Xdst + row * D + lane * 8 + 512 * j + 4) = (f32x4){v[8 * j + 4], v[8 * j + 5], v[8 * j + 6], v[8 * j + 7]}; } }
        }
        }
    }
}

#if MODE == 0
__global__ void __launch_bounds__(NTHREADS, 2) opt_phase(OW P, int phase, int layer) {
    extern __shared__ __attribute__((aligned(16))) unsigned char lds_raw[];
    LAS unsigned char* lds = (LAS unsigned char*)lds_raw;
    const int G = gridDim.x, bx = blockIdx.x, vcu = (G % 8 == 0) ? (bx % 8) * (G / 8) + bx / 8 : bx;
    switch (phase) {
        case 0: if (PH(0)) { prep_tables(P, vcu, G); prep_weights(P, layer, lds, vcu, G); } break;
        case 1: if (PH(1)) phase_inproj(P, lds, G); break;
        case 2: if (PH(2)) phase_qkv(P, layer, lds, G); break;
        case 3: if (PH(3)) phase_attn(P, lds, vcu, G); break;
        case 4: if (PH(4)) { for (int tile = blockIdx.x; tile < NT / 64; tile += G) mix_tile(P, lds, tile); } break;
        case 5: if (PH(5)) { SchedOut Sd{&P, G, (int)blockIdx.x}; EpiOut E{P.XB, P.Y}; pg8::gemm_phase<true>(lds, Sd, E); } break;
        case 6: if (PH(6)) { for (int tile = blockIdx.x; tile < NT / 64; tile += G) ln1_router_tile(P, layer, lds, tile); } break;
        case 7: if (PH(7)) { moe_table(P, lds); for (int tile = blockIdx.x; tile < NT / 64; tile += G) dest_tile(P, lds, tile); } break;
        case 8: if (PH(8)) { moe_table(P, lds); SchedMoe Sd{&P, (LAS int*)(lds + TAB_OFF), G, (int)blockIdx.x, false}; EpiMoeUp E{P.HE}; pg8::gemm_phase<true>(lds, Sd, E); } break;
        case 9: if (PH(9)) { moe_table(P, lds); SchedMoe Sd{&P, (LAS int*)(lds + TAB_OFF), G, (int)blockIdx.x, true}; EpiMoeDown E{P.YE}; pg8::gemm_phase<true>(lds, Sd, E); } break;
        case 10: if (PH(10)) { ln2_rows(P, layer, vcu, G, layer == L - 1 ? P.X : nullptr); if (layer + 1 < L) prep_weights(P, layer + 1, lds, vcu, G); } break;
        default: break;
    }
}

#endif
struct MArgs { const float* in[24]; float* X; char* ws; };
constexpr int PT_OFF = LDSCTL_OFF + 2048;
__device__ __forceinline__ unsigned long long ldq(LAS unsigned char* lds, int k) {
    const LAS unsigned* p = (const LAS unsigned*)(lds + PT_OFF) + 2 * k;
    const unsigned lo = (unsigned)__builtin_amdgcn_readfirstlane((int)p[0]), hi = (unsigned)__builtin_amdgcn_readfirstlane((int)p[1]);
    return ((unsigned long long)hi << 32) | lo;
}
__device__ __forceinline__ OW load_ow(LAS unsigned char* lds_, int wsel = 0) {
    unsigned la = (unsigned)(uintptr_t)lds_; asm volatile("" : "+s"(la) :: "memory"); LAS unsigned char* lds = (LAS unsigned char*)(uintptr_t)la;
    OW P;
#pragma unroll
    for (int i = 0; i < 24; ++i) P.in[i] = (const float*)(GAS const float*)ldq(lds, i);
    P.X = (float*)(GAS float*)ldq(lds, 24); GAS char* ws = (GAS char*)ldq(lds, 25); GAS char* wsw = ws + (wsel ? ows::WSET1 : 0);
    P.ctl = (unsigned*)(GAS unsigned*)(ws + ows::CTL); P.XB = (bf16_t*)(GAS bf16_t*)(ws + ows::XB); P.Z = (bf16_t*)(GAS bf16_t*)(ws + ows::Z); P.SSQ = (float*)(GAS float*)(ws + ows::SSQ);
    P.Win_t = (bf16_t*)(GAS bf16_t*)(wsw + ows::WIN); P.Wq_t = (bf16_t*)(GAS bf16_t*)(wsw + ows::WQ); P.Wkv_t = (bf16_t*)(GAS bf16_t*)(wsw + ows::WKV); P.Wo_t = (bf16_t*)(GAS bf16_t*)(wsw + ows::WO);
    P.Wgu_t = (bf16_t*)(GAS bf16_t*)(wsw + ows::WGU); P.Wd_t = (bf16_t*)(GAS bf16_t*)(wsw + ows::WD); P.Wlg_t = (bf16_t*)(GAS bf16_t*)(wsw + ows::WLG); P.RWH = (bf16_t*)(GAS bf16_t*)(wsw + ows::WLG + 262144); P.RGB = (float*)(GAS float*)(wsw + ows::WLG + 393216);
    P.ROPE = (f32x2*)(GAS f32x2*)(ws + ows::ROPE); P.Q = (bf16_t*)(GAS bf16_t*)(ws + ows::Q); P.KN = (bf16_t*)(GAS bf16_t*)(ws + ows::KN); P.VV = (bf16_t*)(GAS bf16_t*)(ws + ows::VV); P.KPE = (bf16_t*)(GAS bf16_t*)(ws + ows::KPE);
    P.A = (float*)(GAS float*)(ws + ows::A); P.DRV = (float*)(GAS float*)(ws + ows::DRV); P.AGA = (float*)(GAS float*)(ws + ows::AGA); P.AGB = (float*)(GAS float*)(ws + ows::AGB);
    P.OP = (bf16_t*)(GAS bf16_t*)(ws + ows::OP); P.ML = (f32x2*)(GAS f32x2*)(ws + ows::ML); P.MIX = (bf16_t*)(GAS bf16_t*)(ws + ows::MIX); P.Y = (bf16_t*)(GAS bf16_t*)(ws + ows::Y);
    P.EIDX = (int*)(GAS int*)(ws + ows::EIDX); P.HIST = (int*)(GAS int*)(ws + ows::HIST); P.LRANK = (int*)(GAS int*)(ws + ows::LRANK); P.DEST = (int*)(GAS int*)(ws + ows::DEST); P.ROWTOK = (int*)(GAS int*)(ws + ows::ROWTOK); P.GATE = (float*)(GAS float*)(ws + ows::GATE);
    P.HE = (bf16_t*)(GAS bf16_t*)(ws + ows::HE); P.YE = (bf16_t*)(GAS bf16_t*)(ws + ows::YE);
    return P;
}
__global__ void __launch_bounds__(NTHREADS, 2) mega_fwd(MArgs a) {
    extern __shared__ __attribute__((aligned(16))) unsigned char lds_raw[];
    LAS unsigned char* lds = (LAS unsigned char*)lds_raw;
    for (int u = threadIdx.x; u < (LDS_BYTES - LDSCTL_OFF) / 4; u += NTHREADS) ((LAS unsigned*)(lds + LDSCTL_OFF))[u] = 0u;
    __syncthreads();
    { LAS unsigned long long* PT = (LAS unsigned long long*)(lds + PT_OFF);
#pragma unroll
      for (int i = 0; i < 24; ++i) if (threadIdx.x == i) PT[i] = (unsigned long long)a.in[i];
      if (threadIdx.x == 24) PT[24] = (unsigned long long)a.X;
      if (threadIdx.x == 25) PT[25] = (unsigned long long)a.ws; }
    __syncthreads();
    XcdBarrier bar; { const OW P = load_ow(lds); bar = xcd_barrier_post(P.ctl + 4096, (volatile LAS unsigned*)(lds + MISC_OFF) + 8); }
    LAS int* TAB = (LAS int*)(lds + TAB_OFF);
    if (PH(0)) { const OW P = load_ow(lds); const int G = GDIM(); const int b_ = BID(); const int v_ = (G % 8 == 0) ? (b_ % 8) * (G / 8) + b_ / 8 : b_; prep_tables(P, v_, G); prep_weights(P, 0, lds, v_, G, 0, 136, 1); }
    xcd_barrier(bar);
    for (int l = 0; l < L; ++l) {
        for (int rep_ = 0; rep_ < (DUP(1) ? 2 : 1); ++rep_) if (PH(1)) { const OW P = load_ow(lds, 0); const int G = GDIM(); phase_inproj(P, lds, G); }
        if (PH(10)) {
            const OW P = load_ow(lds, 0); const int G = GDIM(), b_ = BID(); const int nmax = (576 + G - 1) / G, nfull = 576 - (nmax - 1) * G;
            constexpr int SPLIT = 1236;
            if (G == 256) { if (b_ >= nfull) prep_weights(P, l, lds, b_ - nfull, G - nfull, 136, SPLIT, 2); }
            else prep_weights(P, l, lds, b_, G, 136, 1 << 30, 2); }
        xcd_barrier(bar);
        for (int rep_ = 0; rep_ < (DUP(2) ? 2 : 1); ++rep_) if (PH(2)) { { const OW P = load_ow(lds, 0); const int G = GDIM(); SchedQKV Sd{&P, G, BID()}; EpiQKV E{P.SSQ, P.Q, P.KN, P.VV}; pg8::gemm_phase<true>(lds, Sd, E); }
                     { const OW P = load_ow(lds, 0); const int G = GDIM(); for (int tile = BID(); tile < NT / 64; tile += G) { gates_tile(P, l, lds, tile); if (DUP(15)) gates_tile(P, l, lds, tile); } }
                     if (PH(10)) { const OW P = load_ow(lds, 0); const int G = GDIM(), b_ = BID();
                         if (G == 256) {
                             if (b_ < 192 && b_ % 3 != 0) prep_weights(P, l, lds, b_ - b_ / 3 - 1, 128, 1236, 1758, 0);
                             else if (b_ >= 192) { prep_weights(P, l, lds, b_ - 192, 64, 1758, 1 << 30, 0); if (l + 1 < L) prep_weights(P, l + 1, lds, b_ - 192, 64, 0, 136, 1); } }
                         else if (l + 1 < L) prep_weights(P, l + 1, lds, b_, G, 0, 136, 1); } }
        xcd_barrier(bar);
        for (int rep_ = 0; rep_ < (DUP(3) ? 2 : 1); ++rep_) if (PH(3)) { const OW P = load_ow(lds, 0); const int G = GDIM(); { const int b_ = BID(); phase_attn(P, lds, (G % 8 == 0) ? (b_ % 8) * (G / 8) + b_ / 8 : b_, G); } }
        xcd_barrier(bar);
        for (int rep_ = 0; rep_ < (DUP(4) ? 2 : 1); ++rep_) if (PH(4)) { const OW P = load_ow(lds, 0); const int G = GDIM(); for (int tile = BID(); tile < NT / 64; tile += G) mix_tile(P, lds, tile); }
        xcd_barrier(bar);
        for (int rep_ = 0; rep_ < (DUP(5) ? 2 : 1); ++rep_) if (PH(5)) { const OW P = load_ow(lds, 0); const int G = GDIM(); SchedOut Sd{&P, G, BID()}; EpiOut E{P.XB, P.Y}; pg8::gemm_phase<true>(lds, Sd, E); }
        xcd_barrier(bar);
        for (int rep_ = 0; rep_ < (DUP(6) ? 2 : 1); ++rep_) if (PH(6)) { const OW P = load_ow(lds, 0); const int G = GDIM(); for (int tile = BID(); tile < NT / 64; tile += G) { ln1_router_tile(P, l, lds, tile); if (DUP(13)) ln1_router_tile(P, l, lds, tile); } }
        xcd_barrier(bar);
        for (int rep_ = 0; rep_ < (DUP(7) ? 2 : 1); ++rep_) if (PH(7)) { const OW P = load_ow(lds, 0); const int G = GDIM(); moe_table(P, lds); for (int tile = BID(); tile < NT / 64; tile += G) dest_tile(P, lds, tile); }
        xcd_barrier(bar);
        for (int rep_ = 0; rep_ < (DUP(8) ? 2 : 1); ++rep_) if (PH(8)) { const OW P = load_ow(lds, 0); const int G = GDIM(); SchedMoe2 Sd; Sd.P = &P; Sd.TAB = TAB; Sd.cnt = P.ctl + MOECNT_W + l * 144 * 64; Sd.init(G, BID()); EpiMoe2 E{P.HE, P.YE}; pg8::gemm_phase<true>(lds, Sd, E); }
        xcd_barrier(bar);
        if (PH(10)) { const OW P = load_ow(lds, 0); const int G = GDIM(); { const int b_ = BID(); const int v_ = (G % 8 == 0) ? (b_ % 8) * (G / 8) + b_ / 8 : b_; ln2_rows(P, l, v_, G, l == L - 1 ? P.X : nullptr); } }
        if (l + 1 < L) xcd_barrier(bar);
        if (DUP(12)) for (int rep_ = 0; rep_ < 10; ++rep_) xcd_barrier(bar);
    }
}
#if MODE == 0
__global__ void shim_q(const bf16_t* Qb, float* Qf) { const size_t i = (size_t)blockIdx.x * 256 + threadIdx.x; if (i < (size_t)NT * QL) Qf[i] = bf2f(Qb[i]); }
__global__ void shim_kv(const bf16_t* KN, const bf16_t* VV, float* KV) { const size_t i = (size_t)blockIdx.x * 256 + threadIdx.x; if (i < (size_t)NT * 1024) { const size_t r = i >> 10; const int c = (int)(i & 1023), h = c >> 8, d = c & 255;
    KV[i] = d < 128 ? bf2f(KN[r * 512 + h * 128 + d]) : bf2f(VV[r * 512 + h * 128 + d - 128]); } }
__global__ void shim_kpe(const bf16_t* Kb, float* Kf) { const size_t i = (size_t)blockIdx.x * 256 + threadIdx.x; if (i < (size_t)NT * 64) Kf[i] = bf2f(Kb[i]); }
__global__ void shim_z(const bf16_t* Zb, float* Zf) { const size_t i = (size_t)blockIdx.x * 256 + threadIdx.x; if (i < (size_t)NT * INW) { const size_t r = i / INW, c = i % INW; Zf[i] = bf2f(Zb[r * ZW + c]); } }


#endif
#if MODE == 0
static OW make_ow(void* const* d_in, float* out, char* ws) {
    OW P{};
    for (int i = 0; i < 24; ++i) P.in[i] = (const float*)d_in[i];
    P.X = out; P.ctl = (unsigned*)(ws + ows::CTL); P.XB = (bf16_t*)(ws + ows::XB); P.Z = (bf16_t*)(ws + ows::Z); P.SSQ = (float*)(ws + ows::SSQ);
    P.Win_t = (bf16_t*)(ws + ows::WIN); P.Wq_t = (bf16_t*)(ws + ows::WQ); P.Wkv_t = (bf16_t*)(ws + ows::WKV); P.Wo_t = (bf16_t*)(ws + ows::WO); P.Wgu_t = (bf16_t*)(ws + ows::WGU); P.Wd_t = (bf16_t*)(ws + ows::WD); P.Wlg_t = (bf16_t*)(ws + ows::WLG);
    P.ROPE = (f32x2*)(ws + ows::ROPE); P.Q = (bf16_t*)(ws + ows::Q); P.KN = (bf16_t*)(ws + ows::KN); P.VV = (bf16_t*)(ws + ows::VV); P.KPE = (bf16_t*)(ws + ows::KPE);
    P.A = (float*)(ws + ows::A); P.DRV = (float*)(ws + ows::DRV); P.AGA = (float*)(ws + ows::AGA); P.AGB = (float*)(ws + ows::AGB);
    P.OP = (bf16_t*)(ws + ows::OP); P.ML = (f32x2*)(ws + ows::ML); P.MIX = (bf16_t*)(ws + ows::MIX); P.Y = (bf16_t*)(ws + ows::Y);
    P.EIDX = (int*)(ws + ows::EIDX); P.HIST = (int*)(ws + ows::HIST); P.LRANK = (int*)(ws + ows::LRANK); P.DEST = (int*)(ws + ows::DEST); P.ROWTOK = (int*)(ws + ows::ROWTOK); P.GATE = (float*)(ws + ows::GATE);
    P.HE = (bf16_t*)(ws + ows::HE); P.YE = (bf16_t*)(ws + ows::YE); P.RWH = (bf16_t*)(ws + ows::WLG + 262144); P.RGB = (float*)(ws + ows::WLG + 393216);
    return P;
}

#endif
constexpr int ATT_LDS = (4 * S + 4 * QH) * 4, MOEUP_LDS = D * 16 * 4 + 64;
#ifndef OPT_STAGES
#define OPT_STAGES 0
#endif
#ifndef OPT_LAYERS
#define OPT_LAYERS 1
#endif
#if MODE == 0
static void hybrid_forward(void* const* d_in, float* out, float* ws, hipStream_t st) {
    const float* x0 = (const float*)d_in[0];
    float* Z = ws + rws::Z; float* YE = Z; float* A = ws + rws::AB; float* DRV = A + (size_t)NT * LW; float* HID = A;
    float* Q = ws + rws::Q; float* KV = ws + rws::KV; float* Y = KV; float* KPE = ws + rws::KPE; float* MIX = ws + rws::MIX;
    float* GATE = ws + rws::GATE; int* CNT = (int*)(ws + rws::CNT); int* LIST = (int*)(ws + rws::LIST);
    OW P{};
    for (int i = 0; i < 24; ++i) P.in[i] = (const float*)d_in[i];
    P.X = out;
    char* tailp = (char*)(ws + rws::END);
    P.ctl = (unsigned*)tailp; tailp += 65536;
    P.ROPE = (f32x2*)tailp; tailp += (size_t)S * 32 * 8;
    P.SSQ = (float*)tailp; tailp += (size_t)NT * 16 * 4;
    P.Win_t = (bf16_t*)tailp; tailp += (size_t)ZW * D * 2;
    P.Wq_t = (bf16_t*)tailp; tailp += (size_t)768 * 768 * 2;
    P.Wkv_t = (bf16_t*)tailp; tailp += (size_t)1024 * 256 * 2;
    P.Wo_t = (bf16_t*)tailp; tailp += (size_t)1024 * 1024 * 2;
    P.Wlg_t = (bf16_t*)tailp; tailp += (size_t)8 * 128 * 64 * 2;
    P.Wgu_t = (bf16_t*)tailp; tailp += (size_t)16 * 1024 * 1024 * 2;
    P.Wd_t = (bf16_t*)tailp; tailp += (size_t)16 * 1024 * 512 * 2;
    P.AGA = (float*)tailp; tailp += (size_t)256 * LW * 4;
    P.AGB = (float*)tailp; tailp += (size_t)256 * LW * 4;
    P.OP = (bf16_t*)tailp; tailp += (size_t)2 * NT * 512 * 2;
    P.ML = (f32x2*)tailp; tailp += (size_t)2 * NT * 4 * 8;
    P.A = A; P.DRV = DRV;
    { char* m = (char*)(ws + rws::MIX) ; P.Q = (bf16_t*)m; m += (size_t)NT * QL * 2; P.KN = (bf16_t*)m; m += (size_t)NT * 512 * 2; P.VV = (bf16_t*)m; m += (size_t)NT * 512 * 2; P.KPE = (bf16_t*)m; }
    P.XB = (bf16_t*)(ws + rws::MIX);
    P.Z = (bf16_t*)(ws + rws::KV);
    P.Z = (bf16_t*)(ws + rws::Q);
    const OW PF = make_ow(d_in, out, (char*)ws);
    for (int l = 0; l < L; ++l) {
        if (l < OPT_LAYERS) {
            if (l == 0) opt_phase<<<256, NTHREADS, LDS_BYTES, st>>>(PF, 0, 0);
            for (int ph = 1; ph <= 10; ++ph) opt_phase<<<256, NTHREADS, LDS_BYTES, st>>>(PF, ph, l);
            continue;
        }
        const float* xin = l == 0 ? x0 : out;
        const float* w_in = (const float*)d_in[1] + (size_t)l * D * INW;
        const float* conv_w = (const float*)d_in[2] + (size_t)l * 4 * LW;
        const float* conv_b = (const float*)d_in[3] + (size_t)l * LW;
        const float* w_r = (const float*)d_in[4] + (size_t)l * 8 * 64 * 64;
        const float* b_r = (const float*)d_in[5] + (size_t)l * LW;
        const float* w_i = (const float*)d_in[6] + (size_t)l * 8 * 64 * 64;
        const float* b_i = (const float*)d_in[7] + (size_t)l * LW;
        const float* lam = (const float*)d_in[8] + (size_t)l * LW;
        const float* qng = (const float*)d_in[9] + (size_t)l * QL;
        const float* w_qup = (const float*)d_in[10] + (size_t)l * QL * 768;
        const float* kvng = (const float*)d_in[11] + (size_t)l * KVL;
        const float* w_kvup = (const float*)d_in[12] + (size_t)l * KVL * 1024;
        const float* ong = (const float*)d_in[13] + (size_t)l * 1024;
        const float* w_out = (const float*)d_in[14] + (size_t)l * 1024 * D;
        const float* ln1g = (const float*)d_in[15] + (size_t)l * D;
        const float* ln1b = (const float*)d_in[16] + (size_t)l * D;
        const float* rw = (const float*)d_in[17];
        const float* rb = (const float*)d_in[18];
        const float* wg = (const float*)d_in[19] + (size_t)l * NE * D * DE;
        const float* wu = (const float*)d_in[20] + (size_t)l * NE * D * DE;
        const float* wd = (const float*)d_in[21] + (size_t)l * NE * DE * D;
        const float* ln2g = (const float*)d_in[22] + (size_t)l * D;
        const float* ln2b = (const float*)d_in[23] + (size_t)l * D;
        const int nopt = l == 0 ? OPT_STAGES : 0;
        if (nopt >= 1) {
            opt_phase<<<256, NTHREADS, LDS_BYTES, st>>>(P, 0, l);
            opt_phase<<<256, NTHREADS, LDS_BYTES, st>>>(P, 1, l);
            if (nopt >= 2) opt_phase<<<256, NTHREADS, LDS_BYTES, st>>>(P, 2, l);
            if (nopt >= 3) opt_phase<<<256, NTHREADS, LDS_BYTES, st>>>(P, 3, l);
            shim_z<<<(unsigned)(((size_t)NT * INW + 255) / 256), 256, 0, st>>>(P.Z, Z);
        } else {
            ref::gemm<true><<<dim3(INW / 64, NT / 64), 256, 0, st>>>(xin, D, w_in, INW, Z, INW, D);
        }
        if (nopt >= 3) {
            ref::lru_scan<<<B * LW / 256, 256, 0, st>>>(A, DRV, Z, MIX);
            shim_attn<<<(unsigned)(((size_t)NT * 512 + 255) / 256), 256, 0, st>>>(P.OP, P.ML, MIX);
        } else if (nopt >= 2) {
            shim_q<<<(unsigned)(((size_t)NT * QL + 255) / 256), 256, 0, st>>>(P.Q, Q);
            shim_kv<<<(unsigned)(((size_t)NT * 1024 + 255) / 256), 256, 0, st>>>(P.KN, P.VV, KV);
            shim_kpe<<<(unsigned)(((size_t)NT * 64 + 255) / 256), 256, 0, st>>>(P.KPE, KPE);
            ref::lru_scan<<<B * LW / 256, 256, 0, st>>>(A, DRV, Z, MIX);
            ref::q_post<<<NT * 4 * 96 / 256, 256, 0, st>>>(Q);
        } else {
            ref::lru_gates<<<NT * LW / 256, 256, 0, st>>>(Z, conv_w, conv_b, w_r, b_r, w_i, b_i, lam, A, DRV);
            ref::lru_scan<<<B * LW / 256, 256, 0, st>>>(A, DRV, Z, MIX);
            ref::rmsnorm<<<NT / 4, 256, 0, st>>>(Z, INW, 1024, QL, qng);
            ref::rmsnorm<<<NT / 4, 256, 0, st>>>(Z, INW, 1792, KVL, kvng);
            ref::gemm<true><<<dim3(768 / 64, NT / 64), 256, 0, st>>>(Z + 1024, INW, w_qup, 768, Q, QL, QL);
            ref::gemm<true><<<dim3(1024 / 64, NT / 64), 256, 0, st>>>(Z + 1792, INW, w_kvup, 1024, KV, 1024, KVL);
            ref::q_post<<<NT * 4 * 96 / 256, 256, 0, st>>>(Q);
            ref::kpe_rope<<<NT * 32 / 256, 256, 0, st>>>(Z, KPE);
        }
        if (nopt < 3) ref::attention<<<B * H * S / 4, 64, ATT_LDS, st>>>(Q, KV, KPE, MIX);
        ref::rmsnorm<<<NT / 4, 256, 0, st>>>(MIX, D, 0, 512, ong);
        ref::rmsnorm<<<NT / 4, 256, 0, st>>>(MIX, D, 512, 512, ong + 512);
        ref::gemm<false><<<dim3(D / 64, NT / 64), 256, 0, st>>>(MIX, D, w_out, D, Y, D, 1024);
        ref::ln_res<<<NT / 4, 256, 0, st>>>(xin, Y, out, ln1g, ln1b);
        (void)hipMemsetAsync(CNT, 0, 64 * sizeof(int), st);
        ref::router<<<NT / 4, 256, 0, st>>>(out, rw, rb, GATE, CNT, LIST);
        ref::moe_up<<<dim3(NT / 16, NE), 256, MOEUP_LDS, st>>>(out, wg, wu, CNT, LIST, HID);
        ref::moe_down<<<dim3(NT / 16, NE), 256, 0, st>>>(HID, wd, CNT, LIST, YE);
        ref::ln_moe<<<NT / 4, 256, 0, st>>>(out, YE, GATE, ln2g, ln2b);
    }
}

#endif
extern "C" void kernel_launch(void* const* d_in, const int* in_sizes, int n_in, void* d_out, int out_size, void* d_ws, size_t ws_size, hipStream_t stream) {
    if (n_in != 24 || out_size != NT * D || ws_size < (size_t)536870912) {
        fprintf(stderr, "kernel_launch: unexpected shapes (n_in %d, out %d, ws %zu)\n", n_in, out_size, ws_size);
        return;
    }
#if MODE == 0
    static bool attr_done = false;
    if (!attr_done) { attr_done = true;
        (void)hipFuncSetAttribute((const void*)ref::attention, hipFuncAttributeMaxDynamicSharedMemorySize, ATT_LDS);
        (void)hipFuncSetAttribute((const void*)ref::moe_up, hipFuncAttributeMaxDynamicSharedMemorySize, MOEUP_LDS);
        (void)hipFuncSetAttribute((const void*)opt_phase, hipFuncAttributeMaxDynamicSharedMemorySize, LDS_BYTES);
    }
#endif
#if MODE == 0
    hybrid_forward(d_in, (float*)d_out, (float*)d_ws, stream);
#else
    static int grid = 0;
    if (grid == 0) { int dev = 0, cus = 0; (void)hipGetDevice(&dev); if (hipDeviceGetAttribute(&cus, hipDeviceAttributeMultiprocessorCount, dev) != hipSuccess || cus <= 0) cus = 256; grid = cus;
        (void)hipFuncSetAttribute((const void*)mega_fwd, hipFuncAttributeMaxDynamicSharedMemorySize, LDS_BYTES); }
    MArgs a{};
    for (int i = 0; i < 24; ++i) a.in[i] = (const float*)d_in[i];
    a.X = (float*)d_out; a.ws = (char*)d_ws;
    (void)hipMemsetAsync((char*)d_ws + ows::CTL, 0, 262144, stream);
    hipLaunchKernelGGL(mega_fwd, dim3(grid), dim3(NTHREADS), LDS_BYTES, stream, a);
#endif
}
```

```cpp
#include <hip/hip_runtime.h>
#include <cstdint>
#include <cstdio>

namespace cfg {
constexpr int D = 1024, B = 4, S = 4096, NT = B * S, L = 4;
constexpr int LW = 512, NBLK = 8, BLK = 64;
constexpr int H = 4, QNOPE = 128, QROPE = 64, QH = 192, VH = 128, QL = 768, KVL = 256;
constexpr int INW = 2112;
constexpr int NE = 16, DE = 512;
constexpr float ALPHA = 1.681792830507429f, EPS = 1e-6f;
}
using namespace cfg;

#ifndef MODE
#define MODE 1
#endif
#if MODE == 0
namespace ref {

__device__ __forceinline__ float wave_sum(float v) {
#pragma unroll
    for (int o = 1; o < 64; o <<= 1) v += __shfl_xor(v, o);
    return v;
}
__device__ __forceinline__ float wave_max(float v) {
#pragma unroll
    for (int o = 1; o < 64; o <<= 1) v = fmaxf(v, __shfl_xor(v, o));
    return v;
}
#define BF16_EMU 1
__device__ __forceinline__ float rb(float f) {
#if BF16_EMU
    unsigned u = __float_as_uint(f); u = (u + 0x7fffu + ((u >> 16) & 1u)) & 0xffff0000u; return __uint_as_float(u);
#else
    return f;
#endif
}
__device__ __forceinline__ float sigmoidf_(float x) { return 1.f / (1.f + expf(-x)); }
__device__ __forceinline__ float gelu_tanh(float x) { return 0.5f * x * (1.f + tanhf(0.7978845608028654f * (x + 0.044715f * x * x * x))); }

template <bool RO> __global__ __launch_bounds__(256) void gemm(const float* __restrict__ A, int lda, const float* __restrict__ Bm, int ldb, float* __restrict__ C, int ldc, int K) {
    __shared__ float As[16][68];
    __shared__ float Bs[16][68];
    const int tid = threadIdx.x, tx = tid & 15, ty = tid >> 4;
    const int m0 = blockIdx.y * 64, n0 = blockIdx.x * 64;
    float acc[4][4];
#pragma unroll
    for (int i = 0; i < 4; ++i)
#pragma unroll
        for (int j = 0; j < 4; ++j) acc[i][j] = 0.f;
    for (int k0 = 0; k0 < K; k0 += 16) {
#pragma unroll
        for (int it = 0; it < 4; ++it) { const int i = tid + it * 256; const int m = i >> 4, k = i & 15; As[k][m] = rb(A[(size_t)(m0 + m) * lda + k0 + k]); }
#pragma unroll
        for (int it = 0; it < 4; ++it) { const int i = tid + it * 256; const int k = i >> 6, n = i & 63; Bs[k][n] = rb(Bm[(size_t)(k0 + k) * ldb + n0 + n]); }
        __syncthreads();
#pragma unroll
        for (int k = 0; k < 16; ++k) {
            float a[4], b[4];
#pragma unroll
            for (int i = 0; i < 4; ++i) { a[i] = As[k][ty * 4 + i]; b[i] = Bs[k][tx * 4 + i]; }
#pragma unroll
            for (int i = 0; i < 4; ++i)
#pragma unroll
                for (int j = 0; j < 4; ++j) acc[i][j] = fmaf(a[i], b[j], acc[i][j]);
        }
        __syncthreads();
    }
#pragma unroll
    for (int i = 0; i < 4; ++i)
#pragma unroll
        for (int j = 0; j < 4; ++j) C[(size_t)(m0 + ty * 4 + i) * ldc + n0 + tx * 4 + j] = RO ? rb(acc[i][j]) : acc[i][j];
}

__global__ __launch_bounds__(256) void rmsnorm(float* X, int ld, int off, int n, const float* __restrict__ g) {
    const int row = blockIdx.x * 4 + (threadIdx.x >> 6), lane = threadIdx.x & 63;
    float* x = X + (size_t)row * ld + off;
    float s = 0.f;
    for (int i = lane; i < n; i += 64) { const float v = x[i]; s += v * v; }
    s = wave_sum(s);
    const float r = rsqrtf(s / (float)n + EPS);
    for (int i = lane; i < n; i += 64) x[i] = x[i] * r * g[i];
}

__global__ __launch_bounds__(256) void lru_gates(const float* __restrict__ Z, const float* __restrict__ conv_w, const float* __restrict__ conv_b,
                                                 const float* __restrict__ wr, const float* __restrict__ br, const float* __restrict__ wi, const float* __restrict__ bi,
                                                 const float* __restrict__ lam, float* __restrict__ Aout, float* __restrict__ Dout) {
    const int idx = blockIdx.x * 256 + threadIdx.x;
    const int tok = idx >> 9, ch = idx & 511, n = ch >> 6, d = ch & 63, s = tok & (S - 1);
    float accr = br[ch], acci = bi[ch], xc_own = 0.f;
    for (int c = 0; c < 64; ++c) {
        const int cc = n * 64 + c;
        float xc = conv_b[cc];
#pragma unroll
        for (int w = 0; w < 4; ++w) { const int sp = s + w - 3; if (sp >= 0) xc = fmaf(Z[(size_t)(tok + w - 3) * INW + cc], conv_w[w * LW + cc], xc); }
        accr = fmaf(xc, wr[(size_t)cc * 64 + d], accr);
        acci = fmaf(xc, wi[(size_t)cc * 64 + d], acci);
        if (c == d) xc_own = xc;
    }
    const float r = sigmoidf_(accr), ig = sigmoidf_(acci);
    const float sp = log1pf(expf(-lam[ch]));
    const float log_a = -8.0f * r * sp;
    Aout[idx] = expf(log_a);
    Dout[idx] = sqrtf(-expm1f(2.0f * log_a)) * (ig * xc_own);
}

__global__ __launch_bounds__(256) void lru_scan(const float* __restrict__ Ain, const float* __restrict__ Din, const float* __restrict__ Z, float* __restrict__ MIX) {
    const int idx = blockIdx.x * 256 + threadIdx.x;
    const int b = idx >> 9, ch = idx & 511;
    float h = 0.f;
    for (int s0 = 0; s0 < S; s0 += 8) {
        float a[8], d[8], g[8];
#pragma unroll
        for (int j = 0; j < 8; ++j) { const size_t t = (size_t)b * S + s0 + j; a[j] = Ain[t * LW + ch]; d[j] = Din[t * LW + ch]; g[j] = Z[t * INW + LW + ch]; }
#pragma unroll
        for (int j = 0; j < 8; ++j) { h = fmaf(a[j], h, d[j]); const size_t t = (size_t)b * S + s0 + j; MIX[t * D + ch] = h * gelu_tanh(g[j]); }
    }
}

__global__ __launch_bounds__(256) void q_post(float* Q) {
    const int idx = blockIdx.x * 256 + threadIdx.x;
    const int j = idx % 96, th = idx / 96, h = th & 3, tok = th >> 2, s = tok & (S - 1);
    float* q = Q + (size_t)tok * QL + h * QH;
    const float sc = 0.07216878364870322f;
    if (j < 64) { q[j] *= sc; q[j + 64] *= sc; }
    else {
        const int i = j - 64;
        const float inv = powf(10000.0f, -(float)i / 32.0f);
        const float ang = (float)s * inv;
        const float c = cosf(ang), sn = sinf(ang);
        const float x1 = q[128 + i], x2 = q[160 + i];
        q[128 + i] = (x1 * c - x2 * sn) * sc; q[160 + i] = (x1 * sn + x2 * c) * sc;
    }
}
__global__ __launch_bounds__(256) void kpe_rope(const float* __restrict__ Z, float* __restrict__ KPE) {
    const int idx = blockIdx.x * 256 + threadIdx.x;
    const int i = idx & 31, tok = idx >> 5, s = tok & (S - 1);
    const float inv = powf(10000.0f, -(float)i / 32.0f);
    const float ang = (float)s * inv;
    const float c = cosf(ang), sn = sinf(ang);
    const float x1 = Z[(size_t)tok * INW + 2048 + i], x2 = Z[(size_t)tok * INW + 2048 + 32 + i];
    KPE[(size_t)tok * 64 + i] = x1 * c - x2 * sn; KPE[(size_t)tok * 64 + 32 + i] = x1 * sn + x2 * c;
}

__global__ __launch_bounds__(64) void attention(const float* __restrict__ Q, const float* __restrict__ KV, const float* __restrict__ KPE, float* __restrict__ MIX) {
    extern __shared__ __attribute__((aligned(16))) float dyn_lds[];
    float (*sc)[S] = (float (*)[S])dyn_lds;
    float (*qs)[QH] = (float (*)[QH])(dyn_lds + 4 * S);
    const int lane = threadIdx.x;
    const int blk = blockIdx.x;
    const int qb = blk % (S / 4), bh = blk / (S / 4), h = bh & 3, b = bh >> 2;
    const int q0 = qb * 4;
    for (int i = lane; i < 4 * QH; i += 64) { const int r = i / QH, d = i % QH; qs[r][d] = rb(Q[(size_t)(b * S + q0 + r) * QL + h * QH + d]); }
    __syncthreads();
    const int nk = q0 + 4;
    for (int j = lane; j < nk; j += 64) {
        const float* kn = KV + (size_t)(b * S + j) * 1024 + h * 256;
        const float* kp = KPE + (size_t)(b * S + j) * 64;
        float d0 = 0.f, d1 = 0.f, d2 = 0.f, d3 = 0.f;
        for (int d = 0; d < 128; d += 4) {
            float4 kv = *(const float4*)(kn + d); kv.x = rb(kv.x); kv.y = rb(kv.y); kv.z = rb(kv.z); kv.w = rb(kv.w);
            d0 += kv.x * qs[0][d] + kv.y * qs[0][d + 1] + kv.z * qs[0][d + 2] + kv.w * qs[0][d + 3];
            d1 += kv.x * qs[1][d] + kv.y * qs[1][d + 1] + kv.z * qs[1][d + 2] + kv.w * qs[1][d + 3];
            d2 += kv.x * qs[2][d] + kv.y * qs[2][d + 1] + kv.z * qs[2][d + 2] + kv.w * qs[2][d + 3];
            d3 += kv.x * qs[3][d] + kv.y * qs[3][d + 1] + kv.z * qs[3][d + 2] + kv.w * qs[3][d + 3];
        }
        for (int d = 0; d < 64; d += 4) {
            float4 kv = *(const float4*)(kp + d); kv.x = rb(kv.x); kv.y = rb(kv.y); kv.z = rb(kv.z); kv.w = rb(kv.w);
            d0 += kv.x * qs[0][128 + d] + kv.y * qs[0][129 + d] + kv.z * qs[0][130 + d] + kv.w * qs[0][131 + d];
            d1 += kv.x * qs[1][128 + d] + kv.y * qs[1][129 + d] + kv.z * qs[1][130 + d] + kv.w * qs[1][131 + d];
            d2 += kv.x * qs[2][128 + d] + kv.y * qs[2][129 + d] + kv.z * qs[2][130 + d] + kv.w * qs[2][131 + d];
            d3 += kv.x * qs[3][128 + d] + kv.y * qs[3][129 + d] + kv.z * qs[3][130 + d] + kv.w * qs[3][131 + d];
        }
        const float NEG = -INFINITY;
        sc[0][j] = (j <= q0 + 0) ? d0 : NEG; sc[1][j] = (j <= q0 + 1) ? d1 : NEG; sc[2][j] = (j <= q0 + 2) ? d2 : NEG; sc[3][j] = (j <= q0 + 3) ? d3 : NEG;
    }
    __syncthreads();
    float inv_l[4];
#pragma unroll
    for (int r = 0; r < 4; ++r) {
        float m = -INFINITY;
        for (int j = lane; j < nk; j += 64) m = fmaxf(m, sc[r][j]);
        m = wave_max(m);
        float l = 0.f;
        for (int j = lane; j < nk; j += 64) { const float p = expf(sc[r][j] - m); sc[r][j] = rb(p); l += p; }
        l = wave_sum(l);
        inv_l[r] = 1.f / l;
    }
    __syncthreads();
    float o[4][2];
#pragma unroll
    for (int r = 0; r < 4; ++r) { o[r][0] = 0.f; o[r][1] = 0.f; }
    for (int j = 0; j < nk; ++j) {
        const float* v = KV + (size_t)(b * S + j) * 1024 + h * 256 + 128;
        const float v0 = rb(v[lane]), v1 = rb(v[lane + 64]);
#pragma unroll
        for (int r = 0; r < 4; ++r) { const float p = sc[r][j]; o[r][0] = fmaf(p, v0, o[r][0]); o[r][1] = fmaf(p, v1, o[r][1]); }
    }
#pragma unroll
    for (int r = 0; r < 4; ++r) {
        float* out = MIX + (size_t)(b * S + q0 + r) * D + 512 + h * 128;
        out[lane] = o[r][0] * inv_l[r]; out[lane + 64] = o[r][1] * inv_l[r];
    }
}

__global__ __launch_bounds__(256) void ln_res(const float* Xin, const float* __restrict__ Y, float* Xout, const float* __restrict__ g, const float* __restrict__ bta) {
    const int row = blockIdx.x * 4 + (threadIdx.x >> 6), lane = threadIdx.x & 63;
    float v[16]; float s = 0.f;
#pragma unroll
    for (int j = 0; j < 16; ++j) { const int c = lane + 64 * j; v[j] = ALPHA * Xin[(size_t)row * D + c] + Y[(size_t)row * D + c]; s += v[j]; }
    const float mu = wave_sum(s) * (1.f / D);
    float q = 0.f;
#pragma unroll
    for (int j = 0; j < 16; ++j) { v[j] -= mu; q += v[j] * v[j]; }
    const float r = rsqrtf(wave_sum(q) * (1.f / D) + EPS);
#pragma unroll
    for (int j = 0; j < 16; ++j) { const int c = lane + 64 * j; Xout[(size_t)row * D + c] = v[j] * r * g[c] + bta[c]; }
}
__global__ __launch_bounds__(256) void ln_moe(float* X, const float* __restrict__ YE, const float* __restrict__ GATE, const float* __restrict__ g, const float* __restrict__ bta) {
    const int row = blockIdx.x * 4 + (threadIdx.x >> 6), lane = threadIdx.x & 63;
    const float g0 = GATE[row * 2], g1 = GATE[row * 2 + 1];
    float v[16]; float s = 0.f;
#pragma unroll
    for (int j = 0; j < 16; ++j) { const int c = lane + 64 * j; v[j] = ALPHA * X[(size_t)row * D + c] + g0 * YE[(size_t)(2 * row) * D + c] + g1 * YE[(size_t)(2 * row + 1) * D + c]; s += v[j]; }
    const float mu = wave_sum(s) * (1.f / D);
    float q = 0.f;
#pragma unroll
    for (int j = 0; j < 16; ++j) { v[j] -= mu; q += v[j] * v[j]; }
    const float r = rsqrtf(wave_sum(q) * (1.f / D) + EPS);
#pragma unroll
    for (int j = 0; j < 16; ++j) { const int c = lane + 64 * j; X[(size_t)row * D + c] = v[j] * r * g[c] + bta[c]; }
}

__global__ __launch_bounds__(256) void router(const float* __restrict__ X, const float* __restrict__ RW, const float* __restrict__ RB, float* __restrict__ GATE, int* CNT, int* LIST) {
    const int tok = blockIdx.x * 4 + (threadIdx.x >> 6), lane = threadIdx.x & 63;
    float acc[16];
#pragma unroll
    for (int e = 0; e < 16; ++e) acc[e] = 0.f;
    for (int j = 0; j < 16; ++j) {
        const int i = lane + 64 * j;
        const float x = X[(size_t)tok * D + i];
        const float4* w = (const float4*)(RW + (size_t)i * 16);
        const float4 w0 = w[0], w1 = w[1], w2 = w[2], w3 = w[3];
        acc[0] = fmaf(x, w0.x, acc[0]); acc[1] = fmaf(x, w0.y, acc[1]); acc[2] = fmaf(x, w0.z, acc[2]); acc[3] = fmaf(x, w0.w, acc[3]);
        acc[4] = fmaf(x, w1.x, acc[4]); acc[5] = fmaf(x, w1.y, acc[5]); acc[6] = fmaf(x, w1.z, acc[6]); acc[7] = fmaf(x, w1.w, acc[7]);
        acc[8] = fmaf(x, w2.x, acc[8]); acc[9] = fmaf(x, w2.y, acc[9]); acc[10] = fmaf(x, w2.z, acc[10]); acc[11] = fmaf(x, w2.w, acc[11]);
        acc[12] = fmaf(x, w3.x, acc[12]); acc[13] = fmaf(x, w3.y, acc[13]); acc[14] = fmaf(x, w3.z, acc[14]); acc[15] = fmaf(x, w3.w, acc[15]);
    }
    float sg[16], ss[16];
#pragma unroll
    for (int e = 0; e < 16; ++e) { sg[e] = sigmoidf_(wave_sum(acc[e])); ss[e] = sg[e] + RB[e]; }
    int best_g = 0; float best = -INFINITY;
#pragma unroll
    for (int gI = 0; gI < 4; ++gI) {
        float m1 = -INFINITY, m2 = -INFINITY;
#pragma unroll
        for (int k = 0; k < 4; ++k) { const float v = ss[gI * 4 + k]; if (v > m1) { m2 = m1; m1 = v; } else if (v > m2) { m2 = v; } }
        const float gs = m1 + m2;
        if (gs > best) { best = gs; best_g = gI; }
    }
    float c0 = 0.f, c1 = 0.f, c2 = 0.f, c3 = 0.f, t0 = 0.f, t1 = 0.f, t2 = 0.f, t3 = 0.f;
#pragma unroll
    for (int gI = 0; gI < 4; ++gI) if (gI == best_g) { c0 = ss[gI * 4]; c1 = ss[gI * 4 + 1]; c2 = ss[gI * 4 + 2]; c3 = ss[gI * 4 + 3]; t0 = sg[gI * 4]; t1 = sg[gI * 4 + 1]; t2 = sg[gI * 4 + 2]; t3 = sg[gI * 4 + 3]; }
    int i1 = 0; float v1 = c0, s1 = t0;
    if (c1 > v1) { i1 = 1; v1 = c1; s1 = t1; }
    if (c2 > v1) { i1 = 2; v1 = c2; s1 = t2; }
    if (c3 > v1) { i1 = 3; v1 = c3; s1 = t3; }
    int i2 = -1; float v2 = -INFINITY, s2 = 0.f;
    if (i1 != 0 && c0 > v2) { i2 = 0; v2 = c0; s2 = t0; }
    if (i1 != 1 && c1 > v2) { i2 = 1; v2 = c1; s2 = t1; }
    if (i1 != 2 && c2 > v2) { i2 = 2; v2 = c2; s2 = t2; }
    if (i1 != 3 && c3 > v2) { i2 = 3; v2 = c3; s2 = t3; }
    if (lane == 0) {
        const int e1 = best_g * 4 + i1, e2 = best_g * 4 + i2;
        const float inv = 1.f / (s1 + s2);
        GATE[tok * 2] = s1 * inv; GATE[tok * 2 + 1] = s2 * inv;
        const int p1 = atomicAdd(&CNT[e1], 1); LIST[e1 * NT + p1] = tok * 2;
        const int p2 = atomicAdd(&CNT[e2], 1); LIST[e2 * NT + p2] = tok * 2 + 1;
    }
}

__global__ __launch_bounds__(256) void moe_up(const float* __restrict__ X, const float* __restrict__ Wg, const float* __restrict__ Wu, const int* __restrict__ CNT, const int* __restrict__ LIST, float* __restrict__ HID) {
    extern __shared__ __attribute__((aligned(16))) float dyn_lds[];
    float (*xs)[16] = (float (*)[16])dyn_lds;
    int* asg_s = (int*)(dyn_lds + D * 16);
    const int e = blockIdx.y, start = blockIdx.x * 16, cnt = CNT[e];
    if (start >= cnt) return;
    const int n = min(16, cnt - start), tid = threadIdx.x;
    if (tid < 16) asg_s[tid] = tid < n ? LIST[e * NT + start + tid] : -1;
    __syncthreads();
    for (int i = tid; i < 16 * D; i += 256) { const int r = i >> 10, k = i & 1023; const int a = asg_s[r]; xs[k][r] = a >= 0 ? rb(X[(size_t)(a >> 1) * D + k]) : 0.f; }
    __syncthreads();
    float g0[16], g1[16], u0[16], u1[16];
#pragma unroll
    for (int r = 0; r < 16; ++r) { g0[r] = 0.f; g1[r] = 0.f; u0[r] = 0.f; u1[r] = 0.f; }
    const float* wg = Wg + (size_t)e * D * DE; const float* wu = Wu + (size_t)e * D * DE;
    for (int k = 0; k < D; ++k) {
        const float a0 = rb(wg[(size_t)k * DE + tid]), a1 = rb(wg[(size_t)k * DE + tid + 256]), b0 = rb(wu[(size_t)k * DE + tid]), b1 = rb(wu[(size_t)k * DE + tid + 256]);
#pragma unroll
        for (int r = 0; r < 16; ++r) { const float x = xs[k][r]; g0[r] = fmaf(x, a0, g0[r]); g1[r] = fmaf(x, a1, g1[r]); u0[r] = fmaf(x, b0, u0[r]); u1[r] = fmaf(x, b1, u1[r]); }
    }
#pragma unroll
    for (int r = 0; r < 16; ++r) { const int a = asg_s[r]; if (a >= 0) {
        HID[(size_t)a * DE + tid] = g0[r] * sigmoidf_(g0[r]) * u0[r]; HID[(size_t)a * DE + tid + 256] = g1[r] * sigmoidf_(g1[r]) * u1[r]; } }
}
__global__ __launch_bounds__(256) void moe_down(const float* __restrict__ HID, const float* __restrict__ Wd, const int* __restrict__ CNT, const int* __restrict__ LIST, float* __restrict__ YE) {
    __shared__ float hs[DE][16];
    __shared__ int asg_s[16];
    const int e = blockIdx.y, start = blockIdx.x * 16, cnt = CNT[e];
    if (start >= cnt) return;
    const int n = min(16, cnt - start), tid = threadIdx.x;
    if (tid < 16) asg_s[tid] = tid < n ? LIST[e * NT + start + tid] : -1;
    __syncthreads();
    for (int i = tid; i < 16 * DE; i += 256) { const int r = i >> 9, k = i & 511; const int a = asg_s[r]; hs[k][r] = a >= 0 ? rb(HID[(size_t)a * DE + k]) : 0.f; }
    __syncthreads();
    float y0[16], y1[16], y2[16], y3[16];
#pragma unroll
    for (int r = 0; r < 16; ++r) { y0[r] = 0.f; y1[r] = 0.f; y2[r] = 0.f; y3[r] = 0.f; }
    const float* wd = Wd + (size_t)e * DE * D;
    for (int k = 0; k < DE; ++k) {
        const float a0 = rb(wd[(size_t)k * D + tid]), a1 = rb(wd[(size_t)k * D + tid + 256]), a2 = rb(wd[(size_t)k * D + tid + 512]), a3 = rb(wd[(size_t)k * D + tid + 768]);
#pragma unroll
        for (int r = 0; r < 16; ++r) { const float x = hs[k][r]; y0[r] = fmaf(x, a0, y0[r]); y1[r] = fmaf(x, a1, y1[r]); y2[r] = fmaf(x, a2, y2[r]); y3[r] = fmaf(x, a3, y3[r]); }
    }
#pragma unroll
    for (int r = 0; r < 16; ++r) { const int a = asg_s[r]; if (a >= 0) { float* y = YE + (size_t)a * D; y[tid] = rb(y0[r]); y[tid + 256] = rb(y1[r]); y[tid + 512] = rb(y2[r]); y[tid + 768] = rb(y3[r]); } }
}

}

namespace rws {
constexpr size_t Z = 0;
constexpr size_t AB = Z + (size_t)NT * INW;
constexpr size_t Q = AB + (size_t)NT * 1024;
constexpr size_t KV = Q + (size_t)NT * QL;
constexpr size_t KPE = KV + (size_t)NT * 1024;
constexpr size_t MIX = KPE + (size_t)NT * 64;
constexpr size_t GATE = MIX + (size_t)NT * 1024;
constexpr size_t CNT = GATE + (size_t)NT * 2;
constexpr size_t LIST = CNT + 64;
constexpr size_t END = LIST + (size_t)NE * NT;
}


#endif
#ifndef MODE
#define MODE 1
#endif
#define LAS __attribute__((address_space(3)))
#ifndef PH
#define PH(k) 1
#endif
#ifndef DUP
#define DUP(k) 0
#define LDS_SYNC() do { asm volatile("s_waitcnt lgkmcnt(0)" ::: "memory"); __builtin_amdgcn_s_barrier(); asm volatile("" ::: "memory"); } while (0)
#endif
#define TID() ({ int _t = (int)threadIdx.x; asm volatile("" : "+v"(_t)); _t; })
#define BID() ({ int _b = (int)blockIdx.x; asm volatile("" : "+s"(_b)); _b; })
#define GDIM() ({ int _g = (int)gridDim.x; asm volatile("" : "+s"(_g)); _g; })
#define GAS __attribute__((address_space(1)))
typedef unsigned short bf16_t;
typedef short bf16x8 __attribute__((ext_vector_type(8)));
typedef float f32x4 __attribute__((ext_vector_type(4)));
typedef float f32x2 __attribute__((ext_vector_type(2)));
typedef unsigned u32x4 __attribute__((ext_vector_type(4)));
typedef unsigned u32x2 __attribute__((ext_vector_type(2)));

__device__ __forceinline__ unsigned f2bf(float f) { unsigned u = __builtin_bit_cast(unsigned, f); return (u + 0x7fffu + ((u >> 16) & 1u)) >> 16; }
__device__ __forceinline__ unsigned pk2(float lo, float hi) { return f2bf(lo) | (f2bf(hi) << 16); }
__device__ __forceinline__ float bf2f(unsigned short h) { return __builtin_bit_cast(float, (unsigned)h << 16); }
__device__ __forceinline__ float bflo(unsigned w) { return __builtin_bit_cast(float, w << 16); }
__device__ __forceinline__ float bfhi(unsigned w) { return __builtin_bit_cast(float, w & 0xffff0000u); }

namespace pg8 {
constexpr int BM = 256, BK = 64, HALF = 128, HTB = HALF * BK * 2, STAGE_BYTES = 8 * HTB;
__host__ __device__ __forceinline__ int lds_byte(int r, int c) { const int st = (r >> 4) * 2 + (c >> 5), rr = r & 15, cc = c & 31, ob = rr * 64 + cc * 2; return st * 1024 + (ob ^ (((ob >> 9) & 1) << 5)); }
__host__ __device__ __forceinline__ void stage_rc(int b, int& R, int& C) { const int st = b / 1024, sb = b % 1024, swz = sb ^ (((sb >> 9) & 1) << 5); R = (st >> 1) * 16 + swz / 64; C = (st & 1) * 32 + (swz % 64) / 2; }
__host__ __device__ __forceinline__ int perm32(int rho) { const int n = rho >> 4, i = rho & 15; return 8 * (i >> 2) + 4 * n + (i & 3); }

struct UnitD { const char* A; const int* rows; const char* B; unsigned lda, ldb; int nt; int type, pm, pn, aux; };

__device__ __forceinline__ unsigned cvt_pk_bf16(float lo, float hi) { unsigned r; asm volatile("v_cvt_pk_bf16_f32 %0, %1, %2" : "=v"(r) : "v"(lo), "v"(hi)); return r; }

template <bool PERM, class Sched, class Epi>
__device__ __forceinline__ void gemm_phase(LAS unsigned char* lds, const Sched& S, const Epi& E) {
    const int tid = TID(), wid = __builtin_amdgcn_readfirstlane(tid >> 6), wr = wid >> 2;
    const size_t kstep = (size_t)(BK * 2);
    const unsigned ldsw = (unsigned)wid * 1024u;
    int aoff, boff; { const int lane = tid & 63, wc = wid & 3, fr = lane & 15, fq = lane >> 4; aoff = lds_byte(wr * 64 + fr, fq * 8); boff = lds_byte(wc * 32 + fr, fq * 8); }
#define PG8_SA(b, h) (((b) * 2 + (h)) * HTB)
#define PG8_SB(b, h) ((4 + (b) * 2 + (h)) * HTB)
#define PG8_STAGE(bufoff, gbase, voff) do { _Pragma("unroll") for (int _i = 0; _i < 2; ++_i) \
        __builtin_amdgcn_global_load_lds((const unsigned*)((const char*)(gbase) + (voff)[_i]), (LAS unsigned*)(lds + (bufoff) + ldsw + _i * 8192), 16, 0, 0); } while (0)
#define PG8_LDA(dst, b, h) do { _Pragma("unroll") for (int m = 0; m < 4; ++m) _Pragma("unroll") for (int k = 0; k < 2; ++k) dst[m][k] = *(const LAS bf16x8*)(lds + PG8_SA(b, h) + aoff + m * 2048 + k * 1024); } while (0)
#define PG8_LDB(dst, b, h) do { _Pragma("unroll") for (int n = 0; n < 2; ++n) _Pragma("unroll") for (int k = 0; k < 2; ++k) dst[n][k] = *(const LAS bf16x8*)(lds + PG8_SB(b, h) + boff + n * 2048 + k * 1024); } while (0)
#define PG8_MMA(ai, bj, At, Bt) do { __builtin_amdgcn_s_setprio(1); _Pragma("unroll") for (int m = 0; m < 4; ++m) _Pragma("unroll") for (int n = 0; n < 2; ++n) _Pragma("unroll") for (int k = 0; k < 2; ++k) \
        acc[ai][bj][m][n] = __builtin_amdgcn_mfma_f32_16x16x32_bf16(Bt[n][k], At[m][k], acc[ai][bj][m][n], 0, 0, 0); __builtin_amdgcn_s_setprio(0); } while (0)
#define PG8_WAIT_V(n) asm volatile("s_waitcnt vmcnt(" #n ")" ::: "memory")
#define PG8_WAIT_L(n) asm volatile("s_waitcnt lgkmcnt(" #n ")" ::: "memory")
#define PG8_BAR __builtin_amdgcn_s_barrier()
#define PG8_SCHED __builtin_amdgcn_sched_barrier(0)
#define PG8_OFFS(u) do { int t_ = tid; asm volatile("" : "+v"(t_)); int R0, C0, R1, C1; stage_rc(t_ * 16, R0, C0); stage_rc(t_ * 16 + 8192, R1, C1); \
        const int RB0 = PERM ? ((R0 & ~31) + perm32(R0 & 31)) : R0, RB1 = PERM ? ((R1 & ~31) + perm32(R1 & 31)) : R1; const unsigned Cb = (unsigned)C0 * 2u; \
        if ((u).rows) { vA[0][0] = (unsigned)(u).rows[R0] * (u).lda + Cb; vA[0][1] = (unsigned)(u).rows[R1] * (u).lda + Cb; \
                                        vA[1][0] = (unsigned)(u).rows[128 + R0] * (u).lda + Cb; vA[1][1] = (unsigned)(u).rows[128 + R1] * (u).lda + Cb; } \
        else { vA[0][0] = (unsigned)R0 * (u).lda + Cb; vA[0][1] = (unsigned)R1 * (u).lda + Cb; vA[1][0] = (unsigned)(128 + R0) * (u).lda + Cb; vA[1][1] = (unsigned)(128 + R1) * (u).lda + Cb; } \
        vB[0] = (unsigned)RB0 * (u).ldb + Cb; vB[1] = (unsigned)RB1 * (u).ldb + Cb; hB = (size_t)128 * (u).ldb; } while (0)
#define PG8_EPI(u) do { int t_ = tid; asm volatile("" : "+v"(t_)); const int lane_ = t_ & 63; E(acc, (u), wr, wid & 3, lane_ & 15, lane_ >> 4); if (DUP(16)) E(acc, (u), wr, wid & 3, lane_ & 15, lane_ >> 4); if constexpr (Sched::HOOKS) S.done((u), lane_); } while (0)
    UnitD cur, nxt; int ui = 0;
    if (!S.next(0, cur)) return;
    f32x4 acc[2][2][4][2];
#pragma unroll
    for (int a = 0; a < 2; ++a)
#pragma unroll
        for (int b = 0; b < 2; ++b)
#pragma unroll
            for (int m = 0; m < 4; ++m)
#pragma unroll
                for (int n = 0; n < 2; ++n) acc[a][b][m][n] = (f32x4){0.f, 0.f, 0.f, 0.f};
    bf16x8 At[4][2], B0[2][2], B1[2][2];
    unsigned vA[2][2], vB[2]; size_t hB;
    if constexpr (Sched::HOOKS) S.a_ready(cur, wid);
    PG8_OFFS(cur);
    const char* cA = cur.A; const char* cB = cur.B; int nt = cur.nt;
    PG8_STAGE(PG8_SB(0, 0), cB, vB); PG8_STAGE(PG8_SB(0, 1), cB + hB, vB); PG8_STAGE(PG8_SA(0, 0), cA, vA[0]); PG8_STAGE(PG8_SA(0, 1), cA, vA[1]);
    if (wr == 1) PG8_BAR;
    PG8_WAIT_V(2); PG8_BAR;
    PG8_STAGE(PG8_SB(1, 0), cB + kstep, vB); PG8_STAGE(PG8_SA(1, 0), cA + kstep, vA[0]); PG8_STAGE(PG8_SB(1, 1), cB + hB + kstep, vB);
    PG8_WAIT_V(6); PG8_BAR;
    for (;;) {
        const bool has_next = S.next(ui + 1, nxt);
        for (int t = 0; t < nt; t += 2) {
            const bool last = (t == nt - 2);
            if constexpr (Sched::HOOKS) { if (last && has_next) S.a_ready(nxt, wid); }
            const char* a1 = cA + (size_t)(t + 1) * kstep;
            PG8_LDB(B0, 0, 0); PG8_LDB(B1, 0, 1); PG8_SCHED; PG8_LDA(At, 0, 0); PG8_STAGE(PG8_SA(1, 1), a1, vA[1]);
            PG8_WAIT_V(8); PG8_WAIT_L(0); PG8_BAR; PG8_MMA(0, 0, At, B0); PG8_MMA(0, 1, At, B1); PG8_BAR; PG8_SCHED;
            const char* a2; const char* b2;
            if (last) { if (has_next) { PG8_OFFS(nxt); a2 = nxt.A; b2 = nxt.B; } else { a2 = cA; b2 = cB; } }
            else { a2 = cA + (size_t)(t + 2) * kstep; b2 = cB + (size_t)(t + 2) * kstep; }
            const char* a3 = a2 + kstep; const char* b3 = b2 + kstep;
            PG8_LDA(At, 0, 1); PG8_STAGE(PG8_SB(0, 0), b2, vB); PG8_STAGE(PG8_SB(0, 1), b2 + hB, vB); PG8_STAGE(PG8_SA(0, 0), a2, vA[0]);
            PG8_WAIT_V(8); PG8_WAIT_L(0); PG8_BAR; PG8_MMA(1, 0, At, B0); PG8_MMA(1, 1, At, B1); PG8_BAR; PG8_SCHED;
            PG8_LDB(B0, 1, 0); PG8_LDB(B1, 1, 1); PG8_SCHED; PG8_LDA(At, 1, 0); PG8_STAGE(PG8_SA(0, 1), a2, vA[1]);
            PG8_WAIT_V(8); PG8_WAIT_L(0); PG8_BAR; PG8_MMA(0, 0, At, B0); PG8_MMA(0, 1, At, B1); PG8_BAR; PG8_SCHED;
            PG8_LDA(At, 1, 1); PG8_STAGE(PG8_SB(1, 0), b3, vB); PG8_STAGE(PG8_SB(1, 1), b3 + hB, vB); PG8_STAGE(PG8_SA(1, 0), a3, vA[0]);
            PG8_WAIT_V(8); PG8_WAIT_L(0); PG8_BAR; PG8_MMA(1, 0, At, B0); PG8_MMA(1, 1, At, B1); PG8_BAR; PG8_SCHED;
        }
        if (wr == 0) PG8_BAR;
        PG8_EPI(cur);
        if (!has_next) break;
#pragma unroll
        for (int a = 0; a < 2; ++a)
#pragma unroll
            for (int b = 0; b < 2; ++b)
#pragma unroll
                for (int m = 0; m < 4; ++m)
#pragma unroll
                    for (int n = 0; n < 2; ++n) acc[a][b][m][n] = (f32x4){0.f, 0.f, 0.f, 0.f};
        cur = nxt; cA = nxt.A; cB = nxt.B; nt = nxt.nt; ++ui;
        if (wr == 1) PG8_BAR;
    }
    PG8_WAIT_V(0);
    PG8_BAR;
#undef PG8_SA
#undef PG8_SB
#undef PG8_STAGE
#undef PG8_LDA
#undef PG8_LDB
#undef PG8_MMA
#undef PG8_WAIT_V
#undef PG8_WAIT_L
#undef PG8_BAR
#undef PG8_SCHED
#undef PG8_OFFS
#undef PG8_EPI
}
__device__ __forceinline__ void tile_order(int L, int nM, int nN, int& pm, int& pn) {
    const int nwg = nM * nN; int wgid = L;
    { const int q = nwg / 8, r = nwg % 8, xcd = wgid % 8, off = wgid / 8; wgid = (xcd < r ? xcd * (q + 1) : r * (q + 1) + (xcd - r) * q) + off; }
    const int nig = 8 * nN, gid = wgid / nig, fm = gid * 8, gsz = (nM - fm) < 8 ? (nM - fm) : 8;
    pm = fm + ((wgid % nig) % gsz); pn = (wgid % nig) / gsz;
}
}

#define XB_TMO      128
#define XB_XCNT(j)  (256  + 64 * (j))
#define XB_XSUB(j)  (1280 + 64 * (j))
#define XB_XGEN(j)  (2304 + 64 * (j))
#define XB_TOP      3328
#define XB_TOPGEN   3392
#define XCD_BAR_WORDS 3456
#define XB_SPIN_CAP (1u << 18)
__device__ __forceinline__ unsigned xb_ld(unsigned* p)              { return __hip_atomic_load(p, __ATOMIC_RELAXED, __HIP_MEMORY_SCOPE_AGENT); }
__device__ __forceinline__ unsigned xb_add(unsigned* p, unsigned v) { return __hip_atomic_fetch_add(p, v, __ATOMIC_RELAXED, __HIP_MEMORY_SCOPE_AGENT); }
__device__ __forceinline__ unsigned xb_xcc_id() { return (unsigned)__builtin_amdgcn_s_getreg((3 << 11) | 20) & 0xFu; }
#define XB_SPIN(cond, bar) do { unsigned _sp = 0; while (cond) { __builtin_amdgcn_s_sleep(1); \
    if ((++_sp & 255u) == 0u) { if (xb_ld(&(bar)[XB_TMO])) break; if (_sp > XB_SPIN_CAP) { atomicAdd(&(bar)[XB_TMO], 1u); break; } } } } while (0)
struct XcdBarrier { unsigned* bar; unsigned x; volatile LAS unsigned* st; };
__device__ __forceinline__ XcdBarrier xcd_barrier_post(unsigned* bar, volatile LAS unsigned* st) {
    XcdBarrier b; b.bar = bar; b.x = xb_xcc_id(); b.st = st;
    if (threadIdx.x == 0) (void)xb_add(&bar[XB_XCNT(b.x)], 1u);
    return b;
}
__device__ __forceinline__ void xcd_barrier_complete(unsigned* bar, unsigned x, unsigned& nloc, unsigned& nx) {
    const unsigned G = gridDim.x * gridDim.y * gridDim.z;
    unsigned sum, cnt, mine, sp = 0u;
    for (;;) {
        sum = 0u; cnt = 0u;
#pragma unroll
        for (unsigned j = 0; j < 16; ++j) { const unsigned c = xb_ld(&bar[XB_XCNT(j)]); sum += c; cnt += (c > 0u) ? 1u : 0u; }
        if (sum == G) break;
        __builtin_amdgcn_s_sleep(1);
        if ((++sp & 255u) == 0u) { if (xb_ld(&bar[XB_TMO])) break; if (sp > XB_SPIN_CAP) { atomicAdd(&bar[XB_TMO], 1u); break; } }
    }
    mine = xb_ld(&bar[XB_XCNT(x)]);
    nloc = mine > 0u ? mine : 1u; nx = cnt > 0u ? cnt : 1u;
}
__device__ __forceinline__ void xcd_barrier(const XcdBarrier& b) {
    asm volatile("s_waitcnt vmcnt(0)" ::: "memory");
    __syncthreads();
    if (threadIdx.x == 0) {
        unsigned* bar = b.bar; unsigned bx_ = b.x;
        asm volatile("" : "+s"(bar), "+s"(bx_));
        __builtin_amdgcn_s_waitcnt(0);
        unsigned nloc = b.st[0], nx = b.st[1];
        if (nloc == 0u) { xcd_barrier_complete(bar, bx_, nloc, nx); b.st[0] = nloc; b.st[1] = nx; }
        const unsigned old = xb_add(&bar[XB_XSUB(bx_)], 1u);
        const unsigned gen = old / nloc;
        if (old + 1u == (gen + 1u) * nloc) {
            __builtin_amdgcn_fence(__ATOMIC_RELEASE, "agent");
            asm volatile("s_waitcnt vmcnt(0)" ::: "memory");
            const unsigned og = xb_add(&bar[XB_TOP], 1u);
            const unsigned tg = og / nx;
            if (og + 1u == (tg + 1u) * nx) xb_add(&bar[XB_TOPGEN], 1u);
            else XB_SPIN(xb_ld(&bar[XB_TOPGEN]) == tg, bar);
            __builtin_amdgcn_fence(__ATOMIC_ACQUIRE, "agent");
            xb_add(&bar[XB_XGEN(bx_)], 1u);
            asm volatile("s_waitcnt vmcnt(0)" ::: "memory");
        } else {
            XB_SPIN(xb_ld(&bar[XB_XGEN(bx_)]) == gen, bar);
            __builtin_amdgcn_fence(__ATOMIC_ACQUIRE, "agent");
            asm volatile("s_waitcnt vmcnt(0)" ::: "memory");
        }
    }
    __syncthreads();
}

constexpr int PREPQ_W = 60000;
constexpr int MOECNT_W = 16384;
constexpr int ZW = 2304;
constexpr int NWAVES = 8, NTHREADS = 512;
constexpr int RING_BYTES = 131072, LDS_BYTES = 163840, LDSCTL_OFF = LDS_BYTES - 4096, MISC_OFF = LDSCTL_OFF + 320, TAB_OFF = LDSCTL_OFF + 1024;
struct OW {
    const float* in[24];
    float* X;
    unsigned* ctl;
    bf16_t* XB;
    bf16_t* Z;
    float* SSQ;
    bf16_t *Win_t, *Wq_t, *Wkv_t, *Wo_t, *Wgu_t, *Wd_t, *Wlg_t;
    bf16_t* RWH; float* RGB;
    f32x2* ROPE;
    bf16_t *Q, *KN, *VV, *KPE;
    float *A, *DRV, *AGA, *AGB;
    bf16_t* OP; f32x2* ML;
    bf16_t* MIX; bf16_t* Y;
    int *EIDX, *HIST, *LRANK, *DEST, *ROWTOK; float* GATE;
    bf16_t *HE, *YE;
};

namespace ows {
constexpr size_t MiB = 1u << 20;
constexpr size_t CTL = 0, ROPE = 1 * MiB, SSQ = 2 * MiB, EIDX = 3 * MiB, GATE = EIDX + 131072, LRANK = GATE + 131072, DEST = LRANK + 131072, HIST = DEST + 131072, ROWTOK = HIST + 16384;
constexpr size_t AGA = 4 * MiB, AGB = AGA + 524288, ML = 5 * MiB, WLG = 6 * MiB, WIN = 7 * MiB, WQ = 12 * MiB, WKV = 14 * MiB, WO = 15 * MiB, WGU = 17 * MiB, WD = 49 * MiB;
constexpr size_t XB = 65 * MiB, Z = 97 * MiB, Y = Z, A = 169 * MiB, DRV = 201 * MiB, Q = 233 * MiB, YE = A, KN = 257 * MiB, VV = 273 * MiB, KPE = 289 * MiB, OP = 291 * MiB, HE = KN, MIX = 323 * MiB, WSET1 = 355 * MiB - WLG  , END = 414 * MiB;
static_assert(ROWTOK + 36864 * 4 <= AGA && WIN + (size_t)ZW * D * 2 <= WQ && YE + (size_t)36864 * 1024 * 2 <= KN && HE + (size_t)36864 * 512 * 2 <= OP + 32 * MiB && Z + (size_t)NT * ZW * 2 <= A, "opt workspace map");
}
__device__ __forceinline__ void tr_item(const float* W, int ldw, int k0, int n0, bf16_t* WT, int ldt, int drow0, const float* g, LAS float* scr, int lane) {
    float tv[32];
#pragma unroll
    for (int i = 0; i < 32; ++i) { const int kk = 2 * i + (lane >> 5); tv[i] = W[(size_t)(k0 + kk) * ldw + n0 + (lane & 31)]; }
    if (g) {
#pragma unroll
        for (int i = 0; i < 32; ++i) tv[i] *= g[k0 + 2 * i + (lane >> 5)]; }
#pragma unroll
    for (int i = 0; i < 32; ++i) scr[(2 * i + (lane >> 5)) * 33 + (lane & 31)] = tv[i];
    asm volatile("s_waitcnt lgkmcnt(0)" ::: "memory");
    const int c = lane & 7;
#pragma unroll
    for (int j = 0; j < 4; ++j) { const int n = (lane >> 3) + 8 * j; const LAS float* s = scr + (8 * c) * 33 + n;
        u32x4 o; o.x = pk2(s[0 * 33], s[1 * 33]); o.y = pk2(s[2 * 33], s[3 * 33]); o.z = pk2(s[4 * 33], s[5 * 33]); o.w = pk2(s[6 * 33], s[7 * 33]);
        *(u32x4*)(WT + (size_t)(drow0 + n) * ldt + k0 + 8 * c) = o; }
    asm volatile("s_waitcnt lgkmcnt(0)" ::: "memory");
}
struct PrepItem { const float* W; const float* g; bf16_t* WT; int ldw, ldt, k0, n0, drow0, ncols; };
__device__ __forceinline__ PrepItem prep_item(const OW& P, int l, int it) {
    const float* w_in = P.in[1] + (size_t)l * D * INW;
    const float* qng = P.in[9] + (size_t)l * QL;   const float* w_q = P.in[10] + (size_t)l * QL * 768;
    const float* kvng = P.in[11] + (size_t)l * KVL; const float* w_kv = P.in[12] + (size_t)l * KVL * 1024;
    const float* ong = P.in[13] + (size_t)l * 1024; const float* w_o = P.in[14] + (size_t)l * 1024 * D;
    const float* wg = P.in[19] + (size_t)l * NE * D * DE; const float* wu = P.in[20] + (size_t)l * NE * D * DE; const float* wd = P.in[21] + (size_t)l * NE * DE * D;
    constexpr int I_IN = 8 * 17, I_Q = 6 * 6, I_KV = 2 * 8, I_O = 8 * 8, I_G = 16 * 8 * 4, I_D = 16 * 4 * 8;
    PrepItem p; int r = it;
    if (r < I_IN) { const int kb = r / 17, nb = r % 17; p = PrepItem{w_in, nullptr, P.Win_t, INW, D, 128 * kb, 128 * nb, 128 * nb, nb == 16 ? 64 : 128}; return p; } r -= I_IN;
    if (r < I_Q) { const int kb = r / 6, nb = r % 6; p = PrepItem{w_q, qng, P.Wq_t, 768, QL, 128 * kb, 128 * nb, 128 * nb, 128}; return p; } r -= I_Q;
    if (r < I_KV) { const int kb = r / 8, nb = r % 8; p = PrepItem{w_kv, kvng, P.Wkv_t, 1024, KVL, 128 * kb, 128 * nb, 128 * nb, 128}; return p; } r -= I_KV;
    if (r < I_O) { const int kb = r / 8, nb = r % 8; p = PrepItem{w_o, ong, P.Wo_t, D, 1024, 128 * kb, 128 * nb, 128 * nb, 128}; return p; } r -= I_O;
    if (r < 2 * I_G) { const int up = r >= I_G; if (up) r -= I_G; const int e = r >> 5, q = r & 31, kb = q >> 2, nb = q & 3;
        p = PrepItem{(up ? wu : wg) + (size_t)e * D * DE, nullptr, P.Wgu_t + (size_t)e * 1024 * 1024, DE, 1024, 128 * kb, 128 * nb, 256 * nb + 128 * up, 128}; return p; }
    r -= 2 * I_G;
    { const int e = r >> 5, q = r & 31, kb = q >> 3, nb = q & 7; p = PrepItem{wd + (size_t)e * DE * D, nullptr, P.Wd_t + (size_t)e * 1024 * DE, D, DE, 128 * kb, 128 * nb, 128 * nb, 128}; }
    return p;
}
__device__ __forceinline__ void prep_weights(const OW& P, int l, LAS unsigned char* lds, int vcu, int G, int it0 = 0, int it1 = 1 << 30, int tail = 3) {
    const int tid = TID();
    LAS float* scr = (LAS float*)lds;
    constexpr int NITEMS = 8 * 17 + 6 * 6 + 2 * 8 + 8 * 8 + 2 * 16 * 8 * 4 + 16 * 4 * 8;
    const int lr = tid >> 5, lc = (tid & 31) * 4;
    const int tn = tid & 127, tq = tid >> 7;
    f32x4 v[8];
#define PW_LOAD(p_) do { _Pragma("unroll") for (int i = 0; i < 8; ++i) { const int kk = lr + 16 * i; v[i] = (f32x4){0.f, 0.f, 0.f, 0.f}; \
        if (lc < (p_).ncols) { v[i] = *(const f32x4*)((p_).W + (size_t)((p_).k0 + kk) * (p_).ldw + (p_).n0 + lc); if ((p_).g) v[i] = v[i] * (p_).g[(p_).k0 + kk]; } } } while (0)
    const int ITE = it1 < NITEMS ? it1 : NITEMS;
    int it = it0 + vcu;
    PrepItem cur; if (it < ITE) { cur = prep_item(P, l, it); PW_LOAD(cur); }
    for (; it < ITE; it += G) {
#pragma unroll
        for (int i = 0; i < 8; ++i) { const int kk = lr + 16 * i; scr[kk * 129 + lc] = v[i][0]; scr[kk * 129 + lc + 1] = v[i][1]; scr[kk * 129 + lc + 2] = v[i][2]; scr[kk * 129 + lc + 3] = v[i][3]; }
        const PrepItem me = cur;
        if (it + G < ITE) { cur = prep_item(P, l, it + G); PW_LOAD(cur); }
        LDS_SYNC();
        { bf16_t* dst = me.WT + (size_t)(me.drow0 + tn) * me.ldt + me.k0 + 32 * tq; const LAS float* sc = scr + (32 * tq) * 129 + tn;
#pragma unroll
          for (int c = 0; c < 4; ++c) { u32x4 o; o.x = pk2(sc[(8 * c + 0) * 129], sc[(8 * c + 1) * 129]); o.y = pk2(sc[(8 * c + 2) * 129], sc[(8 * c + 3) * 129]);
              o.z = pk2(sc[(8 * c + 4) * 129], sc[(8 * c + 5) * 129]); o.w = pk2(sc[(8 * c + 6) * 129], sc[(8 * c + 7) * 129]); *(u32x4*)(dst + 8 * c) = o; } }
        LDS_SYNC();
    }
#undef PW_LOAD
    if (tail & 1) { const int gt = vcu * NTHREADS + tid, NGT = G * NTHREADS; unsigned zz = 0u; asm volatile("" : "+v"(zz)); const u32x4 z = {zz, zz, zz, zz};
      for (int i = gt; i < 128 * 128; i += NGT) *(u32x4*)(P.Win_t + (size_t)2176 * D + (size_t)i * 8) = z; }
    if (tail & 2) { const int gt = vcu * NTHREADS + tid, NGT = G * NTHREADS;
      const float* w_r = P.in[4] + (size_t)l * 8 * 64 * 64; const float* w_i = P.in[6] + (size_t)l * 8 * 64 * 64;
      for (int i = gt; i < 8 * 128 * 64; i += NGT) { const int k = i & 63, j = (i >> 6) & 127, n = i >> 13; const int w = j >> 4, q = j & 15; const int d = 8 * w + (q & 7);
          const float v_ = (q < 8 ? w_r : w_i)[((size_t)n * 64 + k) * 64 + d]; P.Wlg_t[i] = (bf16_t)f2bf(v_); }
      const float* rw = P.in[17]; const float* g1 = P.in[15] + (size_t)l * D; const float* b1 = P.in[16] + (size_t)l * D;
      for (int i = gt; i < 16 * 1024; i += NGT) { const int k = i & 1023, e = i >> 10; const float v_ = g1[k] * rw[k * 16 + e]; const unsigned hi_ = f2bf(v_); const float rem = v_ - bf2f((unsigned short)hi_);
          P.RWH[e * 1024 + k] = (bf16_t)hi_; P.RWH[(16 + e) * 1024 + k] = (bf16_t)f2bf(rem); }
      { const int gwv = gt >> 6, ln = gt & 63;
        if (gwv < 32) { const int e = gwv & 15; const float* src = gwv < 16 ? g1 : b1; float acc = 0.f; float sa[16], sb[16];
#pragma unroll
            for (int j = 0; j < 16; ++j) { const int k = ln + 64 * j; sa[j] = src[k]; sb[j] = rw[k * 16 + e]; }
            __builtin_amdgcn_sched_barrier(0);
#pragma unroll
            for (int j = 0; j < 16; ++j) acc = fmaf(sa[j], sb[j], acc);
#pragma unroll
            for (int o = 1; o < 64; o <<= 1) acc += __shfl_xor(acc, o);
            if (ln == 0) P.RGB[gwv] = acc; } } }
}
__device__ __forceinline__ void prep_queue(const OW& P, int l, LAS unsigned char* lds, unsigned* ctr, int it0, int it1) {
    const int tid = TID();
    LAS float* scr = (LAS float*)lds;
    volatile LAS int* slot = (volatile LAS int*)(lds + MISC_OFF + 192);
    constexpr int NALL = 8 * 17 + 6 * 6 + 2 * 8 + 8 * 8 + 2 * 16 * 8 * 4 + 16 * 4 * 8; const int NITEMS = it1 < NALL ? it1 : NALL;
    const int lr = tid >> 5, lc = (tid & 31) * 4;
    const int tn = tid & 127, tq = tid >> 7;
    f32x4 v[8];
#define PW_LOAD(p_) do { _Pragma("unroll") for (int i = 0; i < 8; ++i) { const int kk = lr + 16 * i; v[i] = (f32x4){0.f, 0.f, 0.f, 0.f}; \
        if (lc < (p_).ncols) { v[i] = *(const f32x4*)((p_).W + (size_t)((p_).k0 + kk) * (p_).ldw + (p_).n0 + lc); if ((p_).g) v[i] = v[i] * (p_).g[(p_).k0 + kk]; } } } while (0)
    LDS_SYNC();
    if (tid == 0) slot[0] = it0 + (int)__hip_atomic_fetch_add(ctr, 2u, __ATOMIC_RELAXED, __HIP_MEMORY_SCOPE_AGENT);
    LDS_SYNC();
    int it = __builtin_amdgcn_readfirstlane(slot[0]); int nxt = it + 1;
    PrepItem cur; if (it < NITEMS) { cur = prep_item(P, l, it); PW_LOAD(cur); }
    while (it < NITEMS) {
        unsigned got = 0u; if (tid == 0) got = __hip_atomic_fetch_add(ctr, 1u, __ATOMIC_RELAXED, __HIP_MEMORY_SCOPE_AGENT);
#pragma unroll
        for (int i = 0; i < 8; ++i) { const int kk = lr + 16 * i; scr[kk * 129 + lc] = v[i][0]; scr[kk * 129 + lc + 1] = v[i][1]; scr[kk * 129 + lc + 2] = v[i][2]; scr[kk * 129 + lc + 3] = v[i][3]; }
        const PrepItem me = cur;
        if (nxt < NITEMS) { cur = prep_item(P, l, nxt); PW_LOAD(cur); }
        LDS_SYNC();
        { bf16_t* dst = me.WT + (size_t)(me.drow0 + tn) * me.ldt + me.k0 + 32 * tq; const LAS float* sc = scr + (32 * tq) * 129 + tn;
#pragma unroll
          for (int c = 0; c < 4; ++c) { u32x4 o; o.x = pk2(sc[(8 * c + 0) * 129], sc[(8 * c + 1) * 129]); o.y = pk2(sc[(8 * c + 2) * 129], sc[(8 * c + 3) * 129]);
              o.z = pk2(sc[(8 * c + 4) * 129], sc[(8 * c + 5) * 129]); o.w = pk2(sc[(8 * c + 6) * 129], sc[(8 * c + 7) * 129]); *(u32x4*)(dst + 8 * c) = o; } }
        if (tid == 0) slot[0] = it0 + (int)got;
        LDS_SYNC();
        it = nxt; nxt = __builtin_amdgcn_readfirstlane(slot[0]);
    }
#undef PW_LOAD
}
__device__ __forceinline__ void prep_tables(const OW& P, int vcu, int G) {
    const int gt = vcu * NTHREADS + TID(), NGT = G * NTHREADS;
    for (int i = gt; i < S * 32; i += NGT) { const int s = i >> 5, j = i & 31; const float inv = powf(10000.0f, -(float)j / 32.0f); const float ang = (float)s * inv; P.ROPE[i] = (f32x2){cosf(ang), sinf(ang)}; }
    const float* x = P.in[0];
    for (size_t i0 = gt; i0 < (size_t)NT * D / 8; i0 += (size_t)4 * NGT) { f32x4 a[4], b[4];
#pragma unroll
        for (int q = 0; q < 4; ++q) { const size_t i = i0 + (size_t)q * NGT; if (i < (size_t)NT * D / 8) { a[q] = *(const f32x4*)(x + i * 8); b[q] = *(const f32x4*)(x + i * 8 + 4); } }
#pragma unroll
        for (int q = 0; q < 4; ++q) { const size_t i = i0 + (size_t)q * NGT; if (i < (size_t)NT * D / 8) { u32x4 o; o.x = pg8::cvt_pk_bf16(a[q][0], a[q][1]); o.y = pg8::cvt_pk_bf16(a[q][2], a[q][3]); o.z = pg8::cvt_pk_bf16(b[q][0], b[q][1]); o.w = pg8::cvt_pk_bf16(b[q][2], b[q][3]); *(u32x4*)(P.XB + i * 8) = o; } } }
}

struct SchedInProj {
    static constexpr bool HOOKS = false;
    const OW* P; int G, c;
    __device__ __forceinline__ bool next(int i, pg8::UnitD& u) const {
        const int L = i * G + c; if (L >= 64 * 9) return false;
        int pm, pn; pg8::tile_order(L, 64, 9, pm, pn);
        u.A = (const char*)(P->XB + (size_t)pm * 256 * D); u.rows = nullptr; u.B = (const char*)(P->Win_t + (size_t)pn * 256 * D); u.lda = D * 2; u.ldb = D * 2; u.nt = D / 64; u.type = 0; u.pm = pm; u.pn = pn; u.aux = 0;
        return true;
    }
};
struct EpiInProj {
    bf16_t* Z; float* SSQ;
    __device__ __forceinline__ void operator()(const f32x4 (&acc)[2][2][4][2], const pg8::UnitD& u, int wr, int wc, int fr, int fq) const {
        const int row0 = u.pm * 256 + wr * 64 + fr, col0 = u.pn * 256 + wc * 32 + 8 * fq;
        const bool stats = u.pn >= 4 && u.pn < 8;
#pragma unroll
        for (int ai = 0; ai < 2; ++ai)
#pragma unroll
            for (int m = 0; m < 4; ++m) { const int row = row0 + ai * 128 + m * 16; bf16_t* rowp = Z + (size_t)row * ZW + col0; float ss = 0.f;
#pragma unroll
                for (int bj = 0; bj < 2; ++bj) { const f32x4 v0 = acc[ai][bj][m][0], v1 = acc[ai][bj][m][1];
                    ss += (v0[0] * v0[0] + v0[1] * v0[1]) + (v0[2] * v0[2] + v0[3] * v0[3]) + (v1[0] * v1[0] + v1[1] * v1[1]) + (v1[2] * v1[2] + v1[3] * v1[3]);
                    u32x4 w; w.x = pg8::cvt_pk_bf16(v0[0], v0[1]); w.y = pg8::cvt_pk_bf16(v0[2], v0[3]); w.z = pg8::cvt_pk_bf16(v1[0], v1[1]); w.w = pg8::cvt_pk_bf16(v1[2], v1[3]);
                    *(u32x4*)(rowp + bj * 128) = w; }
                if (stats) { ss += __shfl_xor(ss, 16); ss += __shfl_xor(ss, 32); if (fq == 0) SSQ[(size_t)row * 16 + (u.pn - 4) * 4 + wc] = ss; } }
    }
};
__device__ __forceinline__ void phase_inproj(const OW& P, LAS unsigned char* lds, int G) {
    SchedInProj Sd{&P, G, BID()}; EpiInProj E{P.Z, P.SSQ};
    pg8::gemm_phase<true>(lds, Sd, E);
}


struct SchedQKV {
    static constexpr bool HOOKS = false;
    const OW* P; int G, c;
    __device__ __forceinline__ bool next(int i, pg8::UnitD& u) const {
        if (G != 256) {
            const int Lq = i * G + c; if (Lq >= 448) return false;
            if (Lq < 192) { fill_q(u, Lq / 3, Lq % 3); } else { const int r = Lq - 192; fill_kv(u, r >> 2, r & 3); }
            return true;
        }
        if (c < 192) { if (i == 0) { fill_q(u, c / 3, c % 3); return true; } if (i == 1 && c % 3 == 0) { fill_kv(u, c / 3, 3); return true; } return false; }
        if (i >= 3) return false; fill_kv(u, c - 192, i); return true;
    }
    __device__ __forceinline__ void fill_q(pg8::UnitD& u, int pm, int pn) const {
        u.A = (const char*)(P->Z + (size_t)pm * 256 * ZW + 1024); u.rows = nullptr; u.B = (const char*)(P->Wq_t + (size_t)pn * 256 * QL); u.lda = ZW * 2; u.ldb = QL * 2; u.nt = QL / 64; u.type = 1; u.pm = pm; u.pn = pn; u.aux = 0; }
    __device__ __forceinline__ void fill_kv(pg8::UnitD& u, int pm, int pn) const {
        u.A = (const char*)(P->Z + (size_t)pm * 256 * ZW + 1792); u.rows = nullptr; u.B = (const char*)(P->Wkv_t + (size_t)pn * 256 * KVL); u.lda = ZW * 2; u.ldb = KVL * 2; u.nt = KVL / 64; u.type = 2; u.pm = pm; u.pn = pn; u.aux = 0; }
};
struct EpiQKV {
    const float* SSQ; bf16_t *Q, *KN, *VV;
    __device__ __forceinline__ void operator()(const f32x4 (&acc)[2][2][4][2], const pg8::UnitD& u, int wr, int wc, int fr, int fq) const {
        const int row0 = u.pm * 256 + wr * 64 + fr, cw = wc * 32 + 8 * fq;
        const bool isq = u.type == 1;
        float rs2[2];
        { const int li = fr + 16 * fq; f32x4 a[2], b[2], c[2];
#pragma unroll
          for (int ai = 0; ai < 2; ++ai) { const f32x4* sp = (const f32x4*)(SSQ + (size_t)(u.pm * 256 + wr * 64 + li + ai * 128) * 16);
              if (isq) { a[ai] = sp[0]; b[ai] = sp[1]; c[ai] = sp[2]; } else { a[ai] = sp[3]; b[ai] = (f32x4){0.f, 0.f, 0.f, 0.f}; c[ai] = b[ai]; } }
          __builtin_amdgcn_sched_barrier(0);
#pragma unroll
          for (int ai = 0; ai < 2; ++ai) { const float t = ((a[ai][0] + a[ai][1]) + (a[ai][2] + a[ai][3])) + ((b[ai][0] + b[ai][1]) + (b[ai][2] + b[ai][3])) + ((c[ai][0] + c[ai][1]) + (c[ai][2] + c[ai][3]));
              rs2[ai] = rsqrtf(t * (isq ? 1.f / QL : 1.f / KVL) + EPS); } }
#pragma unroll
        for (int ai = 0; ai < 2; ++ai)
#pragma unroll
            for (int m = 0; m < 4; ++m) { const int row = row0 + ai * 128 + m * 16;
                const float rs = __shfl(rs2[ai], 16 * m + fr);
#pragma unroll
                for (int bj = 0; bj < 2; ++bj) { const f32x4 v0 = acc[ai][bj][m][0] * rs, v1 = acc[ai][bj][m][1] * rs;
                    u32x4 w; w.x = pg8::cvt_pk_bf16(v0[0], v0[1]); w.y = pg8::cvt_pk_bf16(v0[2], v0[3]); w.z = pg8::cvt_pk_bf16(v1[0], v1[1]); w.w = pg8::cvt_pk_bf16(v1[2], v1[3]);
                    bf16_t* dst = isq ? Q + (size_t)row * QL + u.pn * 256 + bj * 128 + cw : (bj == 0 ? KN : VV) + (size_t)row * 512 + u.pn * 128 + cw;
                    *(u32x4*)dst = w; } }
    }
};
__device__ __forceinline__ float sigm(float x) { return __builtin_amdgcn_rcpf(1.f + __expf(-x)); }
__device__ __forceinline__ float one_minus_sq(float a, float x) {
    return x > -0.015625f ? -x * (1.f + 0.5f * x) : 1.f - a * a;
}
__device__ __forceinline__ void gates_tile(const OW& P, int l, LAS unsigned char* lds, int tile) {
    constexpr int URS = 1040, XRS = 144, SRS = 68;
    const int tid = TID(), lane = tid & 63, wid = __builtin_amdgcn_readfirstlane(tid >> 6), fr = lane & 15, fq = lane >> 4;
    LAS unsigned char* U = lds;
    LAS unsigned char* XC = lds + 67 * URS + 64;
    LAS float* SA = (LAS float*)(lds + 81920);
    LAS float* SD = SA + 64 * SRS;
    LAS f32x2* PP = (LAS f32x2*)(lds + 81920 + 2 * 64 * SRS * 4);
    LAS float* PAR = (LAS float*)(lds + 81920 + 2 * 64 * SRS * 4 + 4096);
    const int tok0 = tile * 64, s0 = tok0 & (S - 1);
    const float* conv_w = P.in[2] + (size_t)l * 4 * LW; const float* conv_b = P.in[3] + (size_t)l * LW;
    const float* b_r = P.in[5] + (size_t)l * LW; const float* b_i = P.in[7] + (size_t)l * LW; const float* lam = P.in[8] + (size_t)l * LW;
    const bf16_t* pZ = P.Z; const f32x2* pROPE = P.ROPE; bf16_t* pKPE = P.KPE; float* pA = P.A; float* pDRV = P.DRV; float* pAGA = P.AGA; float* pAGB = P.AGB; const bf16_t* pWlg = P.Wlg_t;
    float pv[8];
    { const int ch = tid; pv[0] = conv_w[0 * LW + ch]; pv[1] = conv_w[1 * LW + ch]; pv[2] = conv_w[2 * LW + ch]; pv[3] = conv_w[3 * LW + ch]; pv[4] = conv_b[ch]; pv[5] = b_r[ch]; pv[6] = b_i[ch]; pv[7] = lam[ch]; }
    { u32x4 uv[9]; unsigned short k1[4], k2[4]; f32x2 cs[4];
#pragma unroll
      for (int q = 0; q < 9; ++q) { const int i = tid + q * NTHREADS; const int r = i >> 6, ch = i & 63; uv[q] = (u32x4){0u, 0u, 0u, 0u};
          if (i < 67 * 64 && (r >= 3 || s0 != 0)) uv[q] = *(const u32x4*)(pZ + (size_t)(tok0 - 3 + r) * ZW + ch * 8); }
#pragma unroll
      for (int q = 0; q < 4; ++q) { const int i = tid + q * NTHREADS; const int t = i >> 5, j = i & 31; const size_t tok = (size_t)tok0 + t;
          k1[q] = pZ[tok * ZW + 2048 + j]; k2[q] = pZ[tok * ZW + 2080 + j]; cs[q] = pROPE[(s0 + t) * 32 + j]; }
#pragma unroll
      for (int q = 0; q < 9; ++q) { const int i = tid + q * NTHREADS; const int r = i >> 6, ch = i & 63; if (i < 67 * 64) *(LAS u32x4*)(U + r * URS + ch * 16) = uv[q]; }
#pragma unroll
      for (int q = 0; q < 4; ++q) { const int i = tid + q * NTHREADS; const int t = i >> 5, j = i & 31; const size_t tok = (size_t)tok0 + t; const float x1 = bf2f(k1[q]), x2 = bf2f(k2[q]);
          pKPE[tok * 64 + j] = (bf16_t)f2bf(x1 * cs[q].x - x2 * cs[q].y); pKPE[tok * 64 + 32 + j] = (bf16_t)f2bf(x1 * cs[q].y + x2 * cs[q].x); } }
    { const int ch = tid;
      PAR[0 * LW + ch] = pv[0]; PAR[1 * LW + ch] = pv[1]; PAR[2 * LW + ch] = pv[2]; PAR[3 * LW + ch] = pv[3];
      PAR[4 * LW + ch] = pv[4]; PAR[5 * LW + ch] = pv[5]; PAR[6 * LW + ch] = pv[6]; PAR[7 * LW + ch] = -8.0f * log1pf(__expf(-pv[7])); }
    LDS_SYNC();
    bf16x8 nb0, nb1; { const bf16_t* wb = pWlg + ((size_t)16 * wid + fr) * 64 + 8 * fq; nb0 = *(const bf16x8*)wb; nb1 = *(const bf16x8*)(wb + 32); }
    for (int n = 0; n < 8; ++n) {
        { const int chb = 64 * n + 8 * wid; float xc[8];
#pragma unroll
          for (int j = 0; j < 8; ++j) xc[j] = PAR[4 * LW + chb + j];
#pragma unroll
          for (int w = 0; w < 4; ++w) { const u32x4 uv = *(const LAS u32x4*)(U + (lane + w) * URS + chb * 2);
              const f32x4 c0 = *(const LAS f32x4*)(PAR + w * LW + chb), c1 = *(const LAS f32x4*)(PAR + w * LW + chb + 4);
              xc[0] = fmaf(bflo(uv.x), c0[0], xc[0]); xc[1] = fmaf(bfhi(uv.x), c0[1], xc[1]); xc[2] = fmaf(bflo(uv.y), c0[2], xc[2]); xc[3] = fmaf(bfhi(uv.y), c0[3], xc[3]);
              xc[4] = fmaf(bflo(uv.z), c1[0], xc[4]); xc[5] = fmaf(bfhi(uv.z), c1[1], xc[5]); xc[6] = fmaf(bflo(uv.w), c1[2], xc[6]); xc[7] = fmaf(bfhi(uv.w), c1[3], xc[7]); }
          u32x4 o; o.x = pk2(xc[0], xc[1]); o.y = pk2(xc[2], xc[3]); o.z = pk2(xc[4], xc[5]); o.w = pk2(xc[6], xc[7]);
          *(LAS u32x4*)(XC + lane * XRS + wid * 16) = o; }
        LDS_SYNC();
        f32x4 acc[4];
        { const bf16x8 b0 = nb0, b1 = nb1;
          if (n + 1 < 8) { const bf16_t* wb = pWlg + ((size_t)(n + 1) * 128 + 16 * wid + fr) * 64 + 8 * fq; nb0 = *(const bf16x8*)wb; nb1 = *(const bf16x8*)(wb + 32); }
#pragma unroll
          for (int m = 0; m < 4; ++m) { const bf16x8 a0 = *(const LAS bf16x8*)(XC + (16 * m + fr) * XRS + fq * 16), a1 = *(const LAS bf16x8*)(XC + (16 * m + fr) * XRS + 64 + fq * 16);
              f32x4 c = {0.f, 0.f, 0.f, 0.f};
              c = __builtin_amdgcn_mfma_f32_16x16x32_bf16(b0, a0, c, 0, 0, 0); c = __builtin_amdgcn_mfma_f32_16x16x32_bf16(b1, a1, c, 0, 0, 0); acc[m] = c; } }
        const bool lo = fq < 2;
        f32x4 rv[2], iv[2];
#pragma unroll
        for (int j = 0; j < 2; ++j) { const f32x4 snd = lo ? acc[2 + j] : acc[j]; f32x4 rc;
#pragma unroll
            for (int x = 0; x < 4; ++x) rc[x] = __shfl_xor(snd[x], 32);
            rv[j] = lo ? acc[j] : rc; iv[j] = lo ? rc : acc[2 + j]; }
        const int d0 = 8 * wid + 4 * (fq & 1), ch0 = 64 * n + d0;
        const f32x4 brv = *(const LAS f32x4*)(PAR + 5 * LW + ch0), biv = *(const LAS f32x4*)(PAR + 6 * LW + ch0), spv = *(const LAS f32x4*)(PAR + 7 * LW + ch0), cbv = *(const LAS f32x4*)(PAR + 4 * LW + ch0);
        f32x4 cw[4];
#pragma unroll
        for (int w = 0; w < 4; ++w) cw[w] = *(const LAS f32x4*)(PAR + w * LW + ch0);
#pragma unroll
        for (int j = 0; j < 2; ++j) { const int t = 16 * ((lo ? 0 : 2) + j) + fr; f32x4 av, dv;
            const u32x2 xcb = *(const LAS u32x2*)(XC + t * XRS + d0 * 2); const float xcq[4] = {bflo(xcb.x), bfhi(xcb.x), bflo(xcb.y), bfhi(xcb.y)};
#pragma unroll
            for (int x = 0; x < 4; ++x) {
                const float xcv = xcq[x];
                const float r = sigm(rv[j][x] + brv[x]), ig = sigm(iv[j][x] + biv[x]);
                const float log_a = r * spv[x];
                av[x] = __expf(log_a); dv[x] = __builtin_amdgcn_sqrtf(one_minus_sq(av[x], 2.0f * log_a)) * (ig * xcv); }
            *(LAS f32x4*)(SA + t * SRS + d0) = av; *(LAS f32x4*)(SD + t * SRS + d0) = dv; }
        LDS_SYNC();
        { float Ap = 1.f, Bp = 0.f;
#pragma unroll
          for (int j = 0; j < 8; ++j) { const int t = 8 * wid + j; const float a = SA[t * SRS + lane], dv = SD[t * SRS + lane];
              ((unsigned*)pA)[((size_t)tok0 + t) * LW + 64 * n + lane] = pg8::cvt_pk_bf16(1.f - a, dv);
              Ap *= a; Bp = fmaf(a, Bp, dv); }
          PP[wid * 64 + lane] = (f32x2){Ap, Bp}; }
        LDS_SYNC();
        if (wid == 0) { float Aa = 1.f, Bb = 0.f;
#pragma unroll
            for (int g = 0; g < 8; ++g) { const f32x2 p = PP[g * 64 + lane]; Aa *= p.x; Bb = fmaf(p.x, Bb, p.y); }
            pAGA[(size_t)tile * LW + 64 * n + lane] = Aa; pAGB[(size_t)tile * LW + 64 * n + lane] = Bb; }
    }
    LDS_SYNC();
}
__device__ __forceinline__ void phase_qkv(const OW& P, int l, LAS unsigned char* lds, int G) {
#ifndef P2SEL
#define P2SEL 3
#endif
    if (P2SEL & 1) { SchedQKV Sd{&P, G, BID()}; EpiQKV E{P.SSQ, P.Q, P.KN, P.VV};
    pg8::gemm_phase<true>(lds, Sd, E); }
    if (P2SEL & 2) for (int tile = BID(); tile < NT / 64; tile += G) gates_tile(P, l, lds, tile);
}


namespace att {
typedef short s16x4 __attribute__((ext_vector_type(4)));
typedef float f32x16 __attribute__((ext_vector_type(16)));
constexpr int KVBLK = 64, SHM_V = 16384, SHM_K = 24576, OFF_K = 3 * SHM_V, OFF_WS = OFF_K + 3 * SHM_K, OFF_QR = OFF_WS + 8 * 64 * 4, LDS_NEED = OFF_QR + 8 * 4096;
static_assert(LDS_NEED <= LDSCTL_OFF, "attention LDS");
constexpr float SCALE = 0.07216878364870322f, THR = 8.f;
#define SBAR() __builtin_amdgcn_sched_barrier(0)
__device__ __forceinline__ int v_st(int k, int c) { const int kk = (k & ~0xC) | ((k & 4) << 1) | ((k & 8) >> 1); return ((kk >> 3) * 4 + (c >> 5)) * 512 + ((kk & 7) * 32 + (c & 31)) * 2; }
__device__ __forceinline__ int v_rd_base(int lane) { return ((lane & 3) << 3) | (((lane >> 2) & 3) << 6) | (((lane >> 4) & 1) << 5) | (((lane >> 5) & 1) << 8); }
constexpr int v_rd_off(int d0, int ks, int half) { return d0 * 512 + ks * 4096 + half * 2048; }
__device__ __forceinline__ int k_off(int row, int cc) { return (cc >> 3) * 8192 + row * 128 + (((cc & 7) ^ ((row >> 1) & 7)) << 4); }
__device__ __forceinline__ int crow(int r, int hi) { return (r & 3) + 8 * (r >> 2) + 4 * hi; }
__device__ __forceinline__ unsigned cvtpk(float lo, float hi) { unsigned r; asm volatile("v_cvt_pk_bf16_f32 %0, %1, %2" : "=v"(r) : "v"(lo), "v"(hi)); return r; }
__device__ __forceinline__ void mask_tile(f32x16& p0, f32x16& p1, int dq) {
    const float NEG = -__builtin_inff();
#pragma unroll
    for (int r = 0; r < 16; ++r) { const int c = (r & 3) + 8 * (r >> 2); if (dq - c < 0) p0[r] = NEG; if (dq - c - 32 < 0) p1[r] = NEG; }
}
__device__ __forceinline__ void partialSM(f32x16& p0, f32x16& p1, float& m_reg, float& mn, float& alpha) {
    float pmax = p0[0];
#pragma unroll
    for (int r = 1; r < 16; ++r) pmax = fmaxf(pmax, p0[r]);
#pragma unroll
    for (int r = 0; r < 16; ++r) pmax = fmaxf(pmax, p1[r]);
    { auto rr = __builtin_amdgcn_permlane32_swap(__float_as_uint(pmax), __float_as_uint(pmax), false, false); pmax = fmaxf(__uint_as_float(rr[0]), __uint_as_float(rr[1])); }
    constexpr float C2 = 1.4426950408889634f * SCALE;
    if (__builtin_expect(__all((pmax - m_reg) * SCALE <= THR), 1)) { mn = m_reg; alpha = 1.f; }
    else { mn = fmaxf(m_reg, pmax); alpha = __builtin_amdgcn_exp2f((m_reg - mn) * C2); m_reg = mn; }
    const float mnL = -mn * C2;
#pragma unroll
    for (int r = 0; r < 16; ++r) p0[r] = fmaf(p0[r], C2, mnL);
#pragma unroll
    for (int r = 0; r < 16; ++r) p1[r] = fmaf(p1[r], C2, mnL);
#pragma unroll
    for (int r = 0; r < 16; ++r) p0[r] = __builtin_amdgcn_exp2f(p0[r]);
}
__device__ __forceinline__ void finishSM(f32x16& p0, f32x16& p1, float alpha, float& l_reg, bf16x8& pa0, bf16x8& pa1, bf16x8& pa2, bf16x8& pa3) {
#pragma unroll
    for (int r = 0; r < 16; ++r) p1[r] = __builtin_amdgcn_exp2f(p1[r]);
    float ps = 0;
#pragma unroll
    for (int r = 0; r < 16; ++r) ps += p0[r];
#pragma unroll
    for (int r = 0; r < 16; ++r) ps += p1[r];
    { auto rr = __builtin_amdgcn_permlane32_swap(__float_as_uint(ps), __float_as_uint(ps), false, false); ps = __uint_as_float(rr[0]) + __uint_as_float(rr[1]); }
    l_reg = l_reg * alpha + ps;
#define PK4(P, B_, OUT) do { unsigned a0 = cvtpk(P[B_+0], P[B_+1]), a1 = cvtpk(P[B_+2], P[B_+3]);                          \
        unsigned b0 = cvtpk(P[B_+4], P[B_+5]), b1 = cvtpk(P[B_+6], P[B_+7]);                                             \
        auto r0 = __builtin_amdgcn_permlane32_swap(a0, b0, false, false); auto r1 = __builtin_amdgcn_permlane32_swap(a1, b1, false, false); \
        u32x4 w = {r0[0], r1[0], r0[1], r1[1]}; OUT = *reinterpret_cast<bf16x8*>(&w); } while (0)
    PK4(p0, 0, pa0); PK4(p0, 8, pa1); PK4(p1, 0, pa2); PK4(p1, 8, pa3);
#undef PK4
}
__device__ __forceinline__ void qkt(f32x16& p0, f32x16& p1, const char* K_slot, int r32, int hi, const bf16x8* qr, const char* qrl) {
    p0 = f32x16{}; p1 = f32x16{};
    const char* kb[4];
#pragma unroll
    for (int dd = 0; dd < 4; ++dd) kb[dd] = K_slot + r32 * 128 + (((2 * dd + hi) ^ ((r32 >> 1) & 7)) << 4);
    bf16x8 a0[4], a1[4], b0[4], b1[4], qf[4];
#define QK_LOAD(X0, X1, g) do { _Pragma("unroll") for (int dd = 0; dd < 4; ++dd) { const char* a_ = kb[dd] + (g) * 8192; X0[dd] = *reinterpret_cast<const bf16x8*>(a_); X1[dd] = *reinterpret_cast<const bf16x8*>(a_ + 32 * 128); } } while (0)
#define QK_MMA(X0, X1, Q_) do { _Pragma("unroll") for (int dd = 0; dd < 4; ++dd) { p0 = __builtin_amdgcn_mfma_f32_32x32x16_bf16(X0[dd], Q_[dd], p0, 0, 0, 0); p1 = __builtin_amdgcn_mfma_f32_32x32x16_bf16(X1[dd], Q_[dd], p1, 0, 0, 0); } } while (0)
    QK_LOAD(a0, a1, 0); SBAR();
    QK_LOAD(b0, b1, 1); SBAR();
    QK_MMA(a0, a1, qr); SBAR();
    QK_LOAD(a0, a1, 2);
#pragma unroll
    for (int dd = 0; dd < 4; ++dd) qf[dd] = *reinterpret_cast<const bf16x8*>(qrl + dd * 1024);
    SBAR();
    QK_MMA(b0, b1, (qr + 4)); SBAR();
    QK_MMA(a0, a1, qf);
#undef QK_LOAD
#undef QK_MMA
}
__device__ __forceinline__ void pv_tile(f32x16* o, int vb0, bf16x8 pa0, bf16x8 pa1, bf16x8 pa2, bf16x8 pa3) {
#define TRRD(dst, off) asm volatile("ds_read_b64_tr_b16 %0, %1 offset:%2" : "=&v"(dst) : "v"(vb0), "i"(off) : "memory")
#define PV_RD(S, d0) do { constexpr int b_ = v_rd_off(d0, 0, 0); \
        TRRD(S##l0, b_); TRRD(S##h0, b_ + 2048); TRRD(S##l1, b_ + 4096); TRRD(S##h1, b_ + 6144); TRRD(S##l2, b_ + 8192); TRRD(S##h2, b_ + 10240); TRRD(S##l3, b_ + 12288); TRRD(S##h3, b_ + 14336); } while (0)
#define PV_MM(S, d0) do { \
        o[d0] = __builtin_amdgcn_mfma_f32_32x32x16_bf16(pa0, (bf16x8){S##l0[0], S##l0[1], S##l0[2], S##l0[3], S##h0[0], S##h0[1], S##h0[2], S##h0[3]}, o[d0], 0, 0, 0);   \
        o[d0] = __builtin_amdgcn_mfma_f32_32x32x16_bf16(pa1, (bf16x8){S##l1[0], S##l1[1], S##l1[2], S##l1[3], S##h1[0], S##h1[1], S##h1[2], S##h1[3]}, o[d0], 0, 0, 0);   \
        o[d0] = __builtin_amdgcn_mfma_f32_32x32x16_bf16(pa2, (bf16x8){S##l2[0], S##l2[1], S##l2[2], S##l2[3], S##h2[0], S##h2[1], S##h2[2], S##h2[3]}, o[d0], 0, 0, 0);   \
        o[d0] = __builtin_amdgcn_mfma_f32_32x32x16_bf16(pa3, (bf16x8){S##l3[0], S##l3[1], S##l3[2], S##l3[3], S##h3[0], S##h3[1], S##h3[2], S##h3[3]}, o[d0], 0, 0, 0); } while (0)
    s16x4 Al0, Al1, Al2, Al3, Ah0, Ah1, Ah2, Ah3, Bl0, Bl1, Bl2, Bl3, Bh0, Bh1, Bh2, Bh3;
    asm volatile("s_waitcnt lgkmcnt(0)" ::: "memory");
    PV_RD(A, 0);
    PV_RD(B, 1); asm volatile("s_waitcnt lgkmcnt(8)" ::: "memory"); SBAR(); PV_MM(A, 0); SBAR();
    PV_RD(A, 2); asm volatile("s_waitcnt lgkmcnt(8)" ::: "memory"); SBAR(); PV_MM(B, 1); SBAR();
    PV_RD(B, 3); asm volatile("s_waitcnt lgkmcnt(8)" ::: "memory"); SBAR(); PV_MM(A, 2); SBAR();
    asm volatile("s_waitcnt lgkmcnt(0)" ::: "memory"); SBAR(); PV_MM(B, 3);
#undef PV_RD
#undef PV_MM
#undef TRRD
}
__device__ __forceinline__ void unit(const OW& P, char* lds, int b, int h, int qb, int part) {
    const int tid = TID(), wid = __builtin_amdgcn_readfirstlane(tid >> 6), lane = tid & 63, r32 = lane & 31, hi = lane >> 5;
    const int NTall = 4 * (qb + 1), t_lo = part ? NTall / 2 : 0, NT_ = NTall / 2;
    const size_t rowbase = (size_t)b * S;
    const int q0 = qb * 256, qlo = q0 + wid * 32, qm = qlo + r32 - 4 * hi;
    char* V_lds = lds; char* K_lds = lds + OFF_K;
    float* ws = (float*)(lds + OFF_WS) + wid * 64; float* li_l = ws; float* al_l = ws + 32;
    float m_reg = -1e30f, l_reg = 0; f32x16 o[4] = {};
    const int vb0 = (int)(uintptr_t)V_lds + v_rd_base(lane);
    unsigned go_k01, go_k2, go_v0, go_v1;
    { const int row = 8 * wid + (lane >> 3), c = (lane & 7) ^ ((row >> 1) & 7);
      go_k01 = (unsigned)(row * 512 + c * 8) * 2u; go_k2 = (unsigned)(row * 64 + c * 8) * 2u;
      const int si0 = 2 * wid + (lane >> 5), si1 = si0 + 16;
      const int kk0 = (si0 >> 2) * 8 + ((lane & 31) >> 2), kk1 = (si1 >> 2) * 8 + ((lane & 31) >> 2);
      const int k0_ = (kk0 & ~0xC) | ((kk0 & 4) << 1) | ((kk0 & 8) >> 1), k1_ = (kk1 & ~0xC) | ((kk1 & 4) << 1) | ((kk1 & 8) >> 1);
      go_v0 = (unsigned)(k0_ * 512 + (si0 & 3) * 32 + (lane & 3) * 8) * 2u; go_v1 = (unsigned)(k1_ * 512 + (si1 & 3) * 32 + (lane & 3) * 8) * 2u; }
    const char* KnB = (const char*)(P.KN + rowbase * 512 + h * 128); const char* VhB = (const char*)(P.VV + rowbase * 512 + h * 128); const char* KpB = (const char*)(P.KPE + rowbase * 64);
    LAS unsigned char* ldsK = (LAS unsigned char*)(uintptr_t)(unsigned)(uintptr_t)K_lds; LAS unsigned char* ldsV = (LAS unsigned char*)(uintptr_t)(unsigned)(uintptr_t)V_lds;
#define KBASE(t) ((t_lo + (t)) * KVBLK)
#define GLDS(gp, lp) __builtin_amdgcn_global_load_lds((const unsigned*)(gp), (LAS unsigned*)(lp), 16, 0, 0)
#define STAGE(k0, ks_, vs_) do { const size_t kb_ = (size_t)(k0); \
        GLDS(KnB + kb_ * 1024 + go_k01, ldsK + (ks_) * SHM_K + wid * 1024); GLDS(KnB + kb_ * 1024 + 128 + go_k01, ldsK + (ks_) * SHM_K + 8192 + wid * 1024); \
        GLDS(KpB + kb_ * 128 + go_k2, ldsK + (ks_) * SHM_K + 16384 + wid * 1024); \
        GLDS(VhB + kb_ * 1024 + go_v0, ldsV + (vs_) * SHM_V + wid * 1024); GLDS(VhB + kb_ * 1024 + go_v1, ldsV + (vs_) * SHM_V + (wid + 8) * 1024); } while (0)
#define RESC(a) do { if (__any((a) < 1.f)) { if (hi == 0) al_l[r32] = (a); asm volatile("s_waitcnt lgkmcnt(0)" ::: "memory");              \
                     _Pragma("unroll") for (int d_ = 0; d_ < 4; ++d_) _Pragma("unroll") for (int r = 0; r < 16; ++r) o[d_][r] *= al_l[crow(r, hi)]; } } while (0)
#define MASKT(P0_, P1_, t) do { const int kb_ = KBASE(t); if (kb_ + KVBLK - 1 > qlo) mask_tile(P0_, P1_, qm - kb_); } while (0)
    STAGE(KBASE(0), 0, 0); if (NT_ > 1) { STAGE(KBASE(1), 1, 1); }
    bf16x8 qr[8]; char* qrl = lds + OFF_QR + wid * 4096 + lane * 16;
    { const bf16_t* qp = P.Q + (rowbase + qlo + r32) * QL + h * QH + hi * 8;
#pragma unroll
      for (int d0 = 0; d0 < 8; ++d0) qr[d0] = *(const bf16x8*)(qp + d0 * 16);
      const f32x2* rp = P.ROPE + (size_t)(qlo + r32) * 32 + hi * 8;
#pragma unroll
      for (int g = 0; g < 2; ++g) {
          u32x4 x1 = *(const u32x4*)(qp + (8 + g) * 16), x2 = *(const u32x4*)(qp + (10 + g) * 16); u32x4 y1, y2;
#pragma unroll
          for (int jj = 0; jj < 4; ++jj) { const f32x2 cs0 = rp[16 * g + 2 * jj], cs1 = rp[16 * g + 2 * jj + 1];
              const float a0 = bflo(x1[jj]), a1 = bfhi(x1[jj]), b0 = bflo(x2[jj]), b1 = bfhi(x2[jj]);
              y1[jj] = pk2(a0 * cs0.x - b0 * cs0.y, a1 * cs1.x - b1 * cs1.y); y2[jj] = pk2(a0 * cs0.y + b0 * cs0.x, a1 * cs1.y + b1 * cs1.x); }
          *(u32x4*)(qrl + g * 1024) = y1; *(u32x4*)(qrl + (2 + g) * 1024) = y2; } }
    f32x16 p0, p1; float mn, al; bf16x8 pa0, pa1, pa2, pa3;
    asm volatile("s_waitcnt vmcnt(0)" ::: "memory"); __syncthreads();
    int sl = 0;
    for (int t = 0; t < NT_; ++t) {
        const int s2 = sl == 0 ? 2 : sl - 1;
        if (t + 2 < NT_) { STAGE(KBASE(t + 2), s2, s2); }
        qkt(p0, p1, K_lds + sl * SHM_K, r32, hi, qr, qrl);
        MASKT(p0, p1, t); partialSM(p0, p1, m_reg, mn, al); RESC(al);
        finishSM(p0, p1, al, l_reg, pa0, pa1, pa2, pa3); SBAR();
        pv_tile(o, vb0 + sl * SHM_V, pa0, pa1, pa2, pa3);
        if (t + 2 < NT_) asm volatile("s_waitcnt vmcnt(5) lgkmcnt(0)" ::: "memory"); else asm volatile("s_waitcnt vmcnt(0) lgkmcnt(0)" ::: "memory");
        __builtin_amdgcn_s_barrier(); asm volatile("" ::: "memory");
        sl = sl == 2 ? 0 : sl + 1;
    }
    bf16_t* Ow = P.OP + ((size_t)part * NT + rowbase + qlo) * 512 + h * 128;
#pragma unroll
    for (int r = 0; r < 16; ++r) { const int orow = crow(r, hi);
#pragma unroll
        for (int d0 = 0; d0 < 4; ++d0) { const float v = o[d0][r]; const float vn = __builtin_bit_cast(float, __builtin_amdgcn_update_dpp(0, __builtin_bit_cast(int, v), 0xB1, 0xF, 0xF, false));
            if ((r32 & 1) == 0) *(unsigned*)(Ow + (size_t)orow * 512 + d0 * 32 + r32) = cvtpk(v, vn); } }
    if (hi == 0) P.ML[((size_t)part * NT + rowbase + qlo + r32) * 4 + h] = (f32x2){m_reg * (1.4426950408889634f * SCALE), l_reg};
    __syncthreads();
#undef KBASE
#undef GLDS
#undef STAGE
#undef RESC
#undef MASKT
}
#undef SBAR
}
__device__ __forceinline__ void phase_attn(const OW& P, LAS unsigned char* lds, int vcu, int G) {
    for (int v = vcu; v < 256; v += G) { const int bh = v >> 4, r = v & 15;
        att::unit(P, (char*)lds, bh >> 2, bh & 3, r, 0);
        att::unit(P, (char*)lds, bh >> 2, bh & 3, 15 - r, 1); }
}
#if MODE == 0
__global__ void shim_attn(const bf16_t* OP, const f32x2* ML, float* MIXf) {
    const size_t i = (size_t)blockIdx.x * 256 + threadIdx.x; if (i >= (size_t)NT * 512) return;
    const size_t row = i >> 9; const int c = (int)(i & 511), h = c >> 7;
    const f32x2 a = ML[row * 4 + h], b = ML[((size_t)NT + row) * 4 + h];
    const float M = fmaxf(a.x, b.x), w0 = exp2f(a.x - M), w1 = exp2f(b.x - M);
    MIXf[row * D + 512 + c] = (w0 * bf2f(OP[i]) + w1 * bf2f(OP[(size_t)NT * 512 + i])) / (w0 * a.y + w1 * b.y);
}
#endif


template <int CTRL, int ROWMASK> __device__ __forceinline__ float dppf(float v) { return __builtin_bit_cast(float, __builtin_amdgcn_update_dpp(0, __builtin_bit_cast(int, v), CTRL, ROWMASK, 0xF, false)); }
__device__ __forceinline__ float wsum(float v) {
    v += dppf<0xB1, 0xF>(v);
    v += dppf<0x4E, 0xF>(v);
    v += dppf<0x141, 0xF>(v);
    v += dppf<0x140, 0xF>(v);
    v += dppf<0x142, 0xA>(v);
    v += dppf<0x143, 0xC>(v);
    return __builtin_bit_cast(float, __builtin_amdgcn_readlane(__builtin_bit_cast(int, v), 63));
}
__device__ __forceinline__ float gelu_t(float x) { const float u = 0.7978845608028654f * (x + 0.044715f * x * x * x); const float t = 1.f - 2.f * __builtin_amdgcn_rcpf(1.f + __expf(2.f * u)); return 0.5f * x * (1.f + t); }
__device__ __forceinline__ void mix_tile(const OW& P, LAS unsigned char* lds, int tile) {
    const int tid = TID(), lane = tid & 63, wid = __builtin_amdgcn_readfirstlane(tid >> 6);
    LAS float* LR = (LAS float*)lds;
    const int tok0 = tile * 64, j = tile & 63, tile0 = tile - j;
    float h = 0.f;
    if (j > 0) {
        { float a[32], b[32];
#pragma unroll
          for (int q = 0; q < 32; ++q) { const int t_ = q < j ? tile0 + q : tile0; a[q] = P.AGA[(size_t)t_ * LW + tid]; b[q] = P.AGB[(size_t)t_ * LW + tid]; }
#pragma unroll
          for (int q = 0; q < 32; ++q) if (q < j) h = fmaf(a[q], h, b[q]); }
        if (j > 32) { float a[32], b[32];
#pragma unroll
          for (int q = 0; q < 32; ++q) { const int t_ = 32 + q < j ? tile0 + 32 + q : tile0; a[q] = P.AGA[(size_t)t_ * LW + tid]; b[q] = P.AGB[(size_t)t_ * LW + tid]; }
#pragma unroll
          for (int q = 0; q < 32; ++q) if (32 + q < j) h = fmaf(a[q], h, b[q]); }
    }
    { unsigned ad[64]; unsigned short gg[64];
#pragma unroll
      for (int q = 0; q < 64; ++q) { const size_t tok = (size_t)tok0 + q; ad[q] = ((const unsigned*)P.A)[tok * LW + tid]; gg[q] = P.Z[tok * ZW + LW + tid]; }
#pragma unroll
      for (int q = 0; q < 64; ++q) { h = fmaf(1.f - bflo(ad[q]), h, bfhi(ad[q])); LR[q * LW + tid] = h * gelu_t(bf2f(gg[q])); } }
    __syncthreads();
    { const int hh = lane >> 4;
      f32x2 nma, nmb; u32x4 noa, nob;
#define MX_LOAD(r_) do { const size_t row_ = (size_t)tok0 + (r_); nma = P.ML[row_ * 4 + hh]; nmb = P.ML[((size_t)NT + row_) * 4 + hh]; \
        noa = *(const u32x4*)(P.OP + row_ * 512 + lane * 8); nob = *(const u32x4*)(P.OP + ((size_t)NT + row_) * 512 + lane * 8); } while (0)
      MX_LOAD(wid);
      for (int r = wid; r < 64; r += NWAVES) { const size_t row = (size_t)tok0 + r;
        const f32x2 ma = nma, mb = nmb; const u32x4 oa = noa, ob = nob;
        if (r + NWAVES < 64) MX_LOAD(r + NWAVES);
        { const f32x4 v0 = *(const LAS f32x4*)(LR + r * LW + lane * 8), v1 = *(const LAS f32x4*)(LR + r * LW + lane * 8 + 4);
          float ss = (v0[0] * v0[0] + v0[1] * v0[1]) + (v0[2] * v0[2] + v0[3] * v0[3]) + (v1[0] * v1[0] + v1[1] * v1[1]) + (v1[2] * v1[2] + v1[3] * v1[3]);
          const float rs = rsqrtf(wsum(ss) * (1.f / 512.f) + EPS);
          u32x4 o; o.x = pk2(v0[0] * rs, v0[1] * rs); o.y = pk2(v0[2] * rs, v0[3] * rs); o.z = pk2(v1[0] * rs, v1[1] * rs); o.w = pk2(v1[2] * rs, v1[3] * rs);
          *(u32x4*)(P.MIX + row * D + lane * 8) = o; }
        { const float M = fmaxf(ma.x, mb.x), w0 = __builtin_amdgcn_exp2f(ma.x - M), w1 = __builtin_amdgcn_exp2f(mb.x - M), inv = 1.f / (w0 * ma.y + w1 * mb.y);
          float v[8];
#pragma unroll
          for (int q = 0; q < 4; ++q) { v[2 * q] = (w0 * bflo(oa[q]) + w1 * bflo(ob[q])) * inv; v[2 * q + 1] = (w0 * bfhi(oa[q]) + w1 * bfhi(ob[q])) * inv; }
          float ss = 0.f;
#pragma unroll
          for (int q = 0; q < 8; ++q) ss += v[q] * v[q];
          const float rs = rsqrtf(wsum(ss) * (1.f / 512.f) + EPS);
          u32x4 o; o.x = pk2(v[0] * rs, v[1] * rs); o.y = pk2(v[2] * rs, v[3] * rs); o.z = pk2(v[4] * rs, v[5] * rs); o.w = pk2(v[6] * rs, v[7] * rs);
          *(u32x4*)(P.MIX + row * D + 512 + lane * 8) = o; } }
#undef MX_LOAD
    }
    __syncthreads();
}
struct SchedOut {
    static constexpr bool HOOKS = false;
    const OW* P; int G, c;
    __device__ __forceinline__ bool next(int i, pg8::UnitD& u) const {
        const int L = i * G + c; if (L >= 256) return false;
        int pm, pn; pg8::tile_order(L, 64, 4, pm, pn);
        u.A = (const char*)(P->MIX + (size_t)pm * 256 * D); u.rows = nullptr; u.B = (const char*)(P->Wo_t + (size_t)pn * 256 * 1024); u.lda = D * 2; u.ldb = 2048; u.nt = 16; u.type = 3; u.pm = pm; u.pn = pn; u.aux = 0;
        return true;
    }
};
struct EpiOut {
    const bf16_t* xres; bf16_t* Y;
    __device__ __forceinline__ void operator()(const f32x4 (&acc)[2][2][4][2], const pg8::UnitD& u, int wr, int wc, int fr, int fq) const {
        const int row0 = u.pm * 256 + wr * 64 + fr, col0 = u.pn * 256 + wc * 32 + 8 * fq;
#pragma unroll
        for (int ai = 0; ai < 2; ++ai) { u32x4 xb[4][2];
#pragma unroll
            for (int m = 0; m < 4; ++m) { const size_t off = (size_t)(row0 + ai * 128 + m * 16) * D + col0;
#pragma unroll
                for (int bj = 0; bj < 2; ++bj) xb[m][bj] = *(const u32x4*)(xres + off + bj * 128); }
#pragma unroll
            for (int m = 0; m < 4; ++m) { const size_t off = (size_t)(row0 + ai * 128 + m * 16) * D + col0;
#pragma unroll
                for (int bj = 0; bj < 2; ++bj) { const u32x4 x_ = xb[m][bj]; const f32x4 v0 = acc[ai][bj][m][0], v1 = acc[ai][bj][m][1];
                    u32x4 w; w.x = pg8::cvt_pk_bf16(ALPHA * bflo(x_.x) + v0[0], ALPHA * bfhi(x_.x) + v0[1]); w.y = pg8::cvt_pk_bf16(ALPHA * bflo(x_.y) + v0[2], ALPHA * bfhi(x_.y) + v0[3]);
                    w.z = pg8::cvt_pk_bf16(ALPHA * bflo(x_.z) + v1[0], ALPHA * bfhi(x_.z) + v1[1]); w.w = pg8::cvt_pk_bf16(ALPHA * bflo(x_.w) + v1[2], ALPHA * bfhi(x_.w) + v1[3]);
                    *(u32x4*)(Y + off + bj * 128) = w; } } }
    }
};
__device__ __forceinline__ void ln1_router_tile(const OW& P, int l, LAS unsigned char* lds, int tile) {
    const int tid = TID(), lane = tid & 63, wid = __builtin_amdgcn_readfirstlane(tid >> 6), fr = lane & 15, fq = lane >> 4;
    LAS float* PL = (LAS float*)lds;
    LAS f32x2* ST = (LAS f32x2*)(lds + 8192);
    LAS int* EI = (LAS int*)(lds + 8192 + 512);
    const float* g1 = P.in[15] + (size_t)l * D; const float* b1 = P.in[16] + (size_t)l * D; const float* rb = P.in[18];
    const int tok0 = tile * 64;
    { const int mt = wid & 3, kh = wid >> 2;
      const bf16_t* yp = P.Y + ((size_t)tok0 + 16 * mt + fr) * D + 512 * kh + 8 * fq; const bf16_t* wp = P.RWH + (size_t)fr * 1024 + 512 * kh + 8 * fq;
      bf16x8 ya[16], bh[16], bl[16];
#pragma unroll
      for (int ks = 0; ks < 16; ++ks) { ya[ks] = *(const bf16x8*)(yp + 32 * ks); bh[ks] = *(const bf16x8*)(wp + 32 * ks); bl[ks] = *(const bf16x8*)(wp + 16 * 1024 + 32 * ks); }
      __builtin_amdgcn_sched_barrier(0);
      f32x4 acc = {0.f, 0.f, 0.f, 0.f};
#pragma unroll
      for (int ks = 0; ks < 16; ++ks) { acc = __builtin_amdgcn_mfma_f32_16x16x32_bf16(ya[ks], bh[ks], acc, 0, 0, 0); acc = __builtin_amdgcn_mfma_f32_16x16x32_bf16(ya[ks], bl[ks], acc, 0, 0, 0); }
#pragma unroll
      for (int x = 0; x < 4; ++x) PL[(kh * 64 + 16 * mt + 4 * fq + x) * 16 + fr] = acc[x]; }
    f32x4 gv[4], bv[4];
#pragma unroll
    for (int j = 0; j < 4; ++j) { gv[j] = *(const f32x4*)(g1 + lane * 16 + 4 * j); bv[j] = *(const f32x4*)(b1 + lane * 16 + 4 * j); }
    u32x4 n0 = *(const u32x4*)(P.Y + ((size_t)tok0 + wid * 8) * D + lane * 16), n1 = *(const u32x4*)(P.Y + ((size_t)tok0 + wid * 8) * D + lane * 16 + 8);
    for (int rr = 0; rr < 8; ++rr) { const int r = wid * 8 + rr; const size_t row = (size_t)tok0 + r;
        float v[16]; float s_ = 0.f;
#pragma unroll
        for (int q = 0; q < 4; ++q) { v[2 * q] = bflo(n0[q]); v[2 * q + 1] = bfhi(n0[q]); v[8 + 2 * q] = bflo(n1[q]); v[8 + 2 * q + 1] = bfhi(n1[q]); }
#pragma unroll
        for (int j = 0; j < 16; ++j) s_ += v[j];
        if (rr + 1 < 8) { n0 = *(const u32x4*)(P.Y + (row + 1) * D + lane * 16); n1 = *(const u32x4*)(P.Y + (row + 1) * D + lane * 16 + 8); }
        const float mu = wsum(s_) * (1.f / D); float q_ = 0.f;
#pragma unroll
        for (int j = 0; j < 16; ++j) { v[j] -= mu; q_ += v[j] * v[j]; }
        const float rs = rsqrtf(wsum(q_) * (1.f / D) + EPS);
#pragma unroll
        for (int j = 0; j < 16; ++j) v[j] = v[j] * rs * gv[j >> 2][j & 3] + bv[j >> 2][j & 3];
        u32x4 o0, o1;
#pragma unroll
        for (int q = 0; q < 4; ++q) { o0[q] = pk2(v[2 * q], v[2 * q + 1]); o1[q] = pk2(v[8 + 2 * q], v[8 + 2 * q + 1]); }
        *(u32x4*)(P.XB + row * D + lane * 16) = o0; *(u32x4*)(P.XB + row * D + lane * 16 + 8) = o1;
        if (lane == 0) ST[r] = (f32x2){mu, rs}; }
    __syncthreads();
    if (tid < 64) { const int r = tid; const size_t row = (size_t)tok0 + r; const f32x2 st = ST[r];
        float sg[16], ss[16];
#pragma unroll
        for (int q4 = 0; q4 < 4; ++q4) { const f32x4 pa = *(const LAS f32x4*)(PL + r * 16 + 4 * q4), pb = *(const LAS f32x4*)(PL + (64 + r) * 16 + 4 * q4);
#pragma unroll
            for (int x = 0; x < 4; ++x) { const int e = 4 * q4 + x; const float lg = st.y * ((pa[x] + pb[x]) - st.x * P.RGB[e]) + P.RGB[16 + e];
                sg[e] = __builtin_amdgcn_rcpf(1.f + __expf(-lg)); ss[e] = sg[e] + rb[e]; } }
        int best_g = 0; float best = -INFINITY;
#pragma unroll
        for (int gI = 0; gI < 4; ++gI) { float m1 = -INFINITY, m2 = -INFINITY;
#pragma unroll
            for (int k = 0; k < 4; ++k) { const float vv = ss[gI * 4 + k]; if (vv > m1) { m2 = m1; m1 = vv; } else if (vv > m2) { m2 = vv; } }
            const float gs = m1 + m2; if (gs > best) { best = gs; best_g = gI; } }
        float c0 = 0.f, c1 = 0.f, c2 = 0.f, c3 = 0.f, t0 = 0.f, t1 = 0.f, t2 = 0.f, t3 = 0.f;
#pragma unroll
        for (int gI = 0; gI < 4; ++gI) if (gI == best_g) { c0 = ss[gI * 4]; c1 = ss[gI * 4 + 1]; c2 = ss[gI * 4 + 2]; c3 = ss[gI * 4 + 3]; t0 = sg[gI * 4]; t1 = sg[gI * 4 + 1]; t2 = sg[gI * 4 + 2]; t3 = sg[gI * 4 + 3]; }
        int i1 = 0; float v1 = c0, s1 = t0;
        if (c1 > v1) { i1 = 1; v1 = c1; s1 = t1; }
        if (c2 > v1) { i1 = 2; v1 = c2; s1 = t2; }
        if (c3 > v1) { i1 = 3; v1 = c3; s1 = t3; }
        int i2 = -1; float v2 = -INFINITY, s2 = 0.f;
        if (i1 != 0 && c0 > v2) { i2 = 0; v2 = c0; s2 = t0; }
        if (i1 != 1 && c1 > v2) { i2 = 1; v2 = c1; s2 = t1; }
        if (i1 != 2 && c2 > v2) { i2 = 2; v2 = c2; s2 = t2; }
        if (i1 != 3 && c3 > v2) { i2 = 3; v2 = c3; s2 = t3; }
        const int e1 = best_g * 4 + i1, e2 = best_g * 4 + i2; const float inv = 1.f / (s1 + s2);
        P.GATE[row * 2] = s1 * inv; P.GATE[row * 2 + 1] = s2 * inv; P.EIDX[row * 2] = e1; P.EIDX[row * 2 + 1] = e2; EI[r * 2] = e1; EI[r * 2 + 1] = e2; }
    __syncthreads();
    { LAS int* C0 = EI + 128;
      int rank = 0, mye = -1, c_lo = 0;
      if (tid < 128) { mye = EI[tid];
#pragma unroll
          for (int e = 0; e < 16; ++e) { const unsigned long long m = __ballot(mye == e); if (mye == e) rank = __builtin_popcountll(m & ((1ull << lane) - 1ull)); if (tid == e) c_lo = __builtin_popcountll(m); if (tid == 64 + e) c_lo = __builtin_popcountll(m); }
          if (tid < 16) C0[tid] = c_lo; }
      __syncthreads();
      if (tid < 128) { if (tid >= 64) rank += C0[mye]; P.LRANK[(size_t)tok0 * 2 + tid] = rank; if (tid >= 64 && tid < 80) P.HIST[tile * 16 + (tid - 64)] = C0[tid - 64] + c_lo; } }
    __syncthreads();
}
__device__ __forceinline__ void moe_table(const OW& P, LAS unsigned char* lds) {
    const int tid = TID(); LAS int* HS = (LAS int*)lds; LAS int* TAB = (LAS int*)(lds + TAB_OFF);
    { int hv[8];
#pragma unroll
      for (int q = 0; q < 8; ++q) hv[q] = P.HIST[tid + q * NTHREADS];
#pragma unroll
      for (int q = 0; q < 8; ++q) HS[tid + q * NTHREADS] = hv[q]; }
    __syncthreads();
    if (tid < 64) { const int e = tid & 15, qd = tid >> 4; int tot = 0;
#pragma unroll 8
        for (int w = 0; w < 64; ++w) tot += HS[(qd * 64 + w) * 16 + e];
        tot += __shfl_xor(tot, 16); tot += __shfl_xor(tot, 32);
        if (qd == 0) TAB[32 + e] = tot; }
    __syncthreads();
    if (tid == 0) { int acc = 0; for (int e = 0; e < 16; ++e) { TAB[e] = acc; acc += (TAB[32 + e] + 255) >> 8; } TAB[16] = acc; }
    __syncthreads();
}
__device__ __forceinline__ void dest_tile(const OW& P, LAS unsigned char* lds, int tile) {
    const int tid = TID(); LAS int* HS = (LAS int*)lds; LAS int* TAB = (LAS int*)(lds + TAB_OFF); LAS int* BS = (LAS int*)(lds + 16384);
    if (tid < 64) { const int e = tid & 15, qd = tid >> 4; int b = 0;
#pragma unroll 8
        for (int w = 0; w < 64; ++w) { const int ww = qd * 64 + w; b += ww < tile ? HS[ww * 16 + e] : 0; }
        b += __shfl_xor(b, 16); b += __shfl_xor(b, 32);
        if (qd == 0) BS[e] = b; }
    __syncthreads();
    if (tid < 128) { const size_t a = (size_t)tile * 128 + tid; const int e = P.EIDX[a]; const int dst = 256 * TAB[e] + BS[e] + P.LRANK[a]; P.DEST[a] = dst; P.ROWTOK[dst] = (int)(a >> 1); }
    if (tile < 16) { const int e = tile, lo = 256 * TAB[e] + TAB[32 + e], hi = 256 * TAB[e + 1]; for (int i = lo + tid; i < hi; i += NTHREADS) P.ROWTOK[i] = 0; }
    __syncthreads();
}
struct SchedMoe {
    static constexpr bool HOOKS = false;
    const OW* P; LAS int* TAB; int G, c; bool down;
    __device__ __forceinline__ bool next(int i, pg8::UnitD& u) const {
        const int NB = __builtin_amdgcn_readfirstlane(TAB[16]); const int L = i * G + c; if (L >= NB * 4) return false;
        const int rb = L >> 2, pn = L & 3; int e = 0;
#pragma unroll
        for (int q = 1; q < 16; ++q) e += (__builtin_amdgcn_readfirstlane(TAB[q]) <= rb) ? 1 : 0;
        if (!down) { u.A = (const char*)P->XB; u.rows = P->ROWTOK + rb * 256; u.B = (const char*)(P->Wgu_t + ((size_t)e * 1024 + pn * 256) * 1024); u.lda = 2048; u.ldb = 2048; u.nt = 16; u.type = 4; }
        else { u.A = (const char*)(P->HE + (size_t)rb * 256 * DE); u.rows = nullptr; u.B = (const char*)(P->Wd_t + ((size_t)e * 1024 + pn * 256) * DE); u.lda = 1024; u.ldb = 1024; u.nt = 8; u.type = 5; }
        u.pm = rb; u.pn = pn; u.aux = e; return true;
    }
};
struct EpiMoeUp {
    bf16_t* HE;
    __device__ __forceinline__ void operator()(const f32x4 (&acc)[2][2][4][2], const pg8::UnitD& u, int wr, int wc, int fr, int fq) const {
        const int row0 = u.pm * 256 + wr * 64 + fr, col0 = u.pn * 128 + wc * 32 + 8 * fq;
#pragma unroll
        for (int ai = 0; ai < 2; ++ai)
#pragma unroll
            for (int m = 0; m < 4; ++m) { float hv[8];
#pragma unroll
                for (int n = 0; n < 2; ++n)
#pragma unroll
                    for (int x = 0; x < 4; ++x) { const float g = acc[ai][0][m][n][x], up = acc[ai][1][m][n][x]; hv[4 * n + x] = g / (1.f + __expf(-g)) * up; }
                u32x4 w; w.x = pg8::cvt_pk_bf16(hv[0], hv[1]); w.y = pg8::cvt_pk_bf16(hv[2], hv[3]); w.z = pg8::cvt_pk_bf16(hv[4], hv[5]); w.w = pg8::cvt_pk_bf16(hv[6], hv[7]);
                *(u32x4*)(HE + (size_t)(row0 + ai * 128 + m * 16) * DE + col0) = w; }
    }
};
struct EpiMoeDown {
    bf16_t* YE;
    __device__ __forceinline__ void operator()(const f32x4 (&acc)[2][2][4][2], const pg8::UnitD& u, int wr, int wc, int fr, int fq) const {
        const int row0 = u.pm * 256 + wr * 64 + fr, col0 = u.pn * 256 + wc * 32 + 8 * fq;
#pragma unroll
        for (int ai = 0; ai < 2; ++ai)
#pragma unroll
            for (int m = 0; m < 4; ++m) { bf16_t* rowp = YE + (size_t)(row0 + ai * 128 + m * 16) * D + col0;
#pragma unroll
                for (int bj = 0; bj < 2; ++bj) { const f32x4 v0 = acc[ai][bj][m][0], v1 = acc[ai][bj][m][1];
                    u32x4 w; w.x = pg8::cvt_pk_bf16(v0[0], v0[1]); w.y = pg8::cvt_pk_bf16(v0[2], v0[3]); w.z = pg8::cvt_pk_bf16(v1[0], v1[1]); w.w = pg8::cvt_pk_bf16(v1[2], v1[3]);
                    *(u32x4*)(rowp + bj * 128) = w; } }
    }
};

__device__ __forceinline__ void store16_sc1(void* p, u32x4 v) { asm volatile("global_store_dwordx4 %0, %1, off sc1\n\ts_nop 1" :: "v"(p), "v"(v) : "memory"); }
struct SchedMoe2 {
    static constexpr bool HOOKS = true;
    const OW* P; LAS int* TAB; unsigned* cnt;
    int G, c, U, nup, ndn, jA, jB;
    __device__ __forceinline__ void init(int G_, int c_) {
        G = G_; c = c_; const int NB = __builtin_amdgcn_readfirstlane(TAB[16]); U = 4 * NB;
        const int nmax = (U + G - 1) / G, nfull = U - (nmax - 1) * G;
        const bool allsame = nfull >= G; const int Lc = allsame ? 0 : G - nfull;
        nup = (c < nfull || allsame) ? nmax : nmax - 1; if (c >= U) nup = 0;
        const bool light = !allsame && c >= nfull; const int cl = c - nfull;
        const int nA = 2 * Lc < U ? 2 * Lc : U; const int R = U - nA;
        int a_cnt = 0; if (light) { a_cnt = nA - 2 * cl; a_cnt = a_cnt < 0 ? 0 : (a_cnt > 2 ? 2 : a_cnt); }
        const int o = light ? cl : Lc + c;
        const int b_cnt = o < R ? (R - o + G - 1) / G : 0;
        jA = 2 * cl; jB = nA + o; ndn = a_cnt + b_cnt; nA_mine = a_cnt;
    }
    int nA_mine;
    __device__ __forceinline__ bool next(int i, pg8::UnitD& u) const {
        if (i < nup) { const int Lq = c + i * G; fill(u, Lq >> 2, Lq & 3, false); return true; }
        const int k = i - nup; if (k >= ndn) return false;
        const int j = k < nA_mine ? jA + k : jB + (k - nA_mine) * G; fill(u, j >> 2, j & 3, true); return true;
    }
    __device__ __forceinline__ void fill(pg8::UnitD& u, int rb, int pn, bool down) const {
        int e = 0;
#pragma unroll
        for (int q = 1; q < 16; ++q) e += (__builtin_amdgcn_readfirstlane(TAB[q]) <= rb) ? 1 : 0;
        if (!down) { u.A = (const char*)P->XB; u.rows = P->ROWTOK + rb * 256; u.B = (const char*)(P->Wgu_t + ((size_t)e * 1024 + pn * 256) * 1024); u.lda = 2048; u.ldb = 2048; u.nt = 16; u.type = 4; }
        else { u.A = (const char*)(P->HE + (size_t)rb * 256 * DE); u.rows = nullptr; u.B = (const char*)(P->Wd_t + ((size_t)e * 1024 + pn * 256) * DE); u.lda = 1024; u.ldb = 1024; u.nt = 8; u.type = 5; }
        u.pm = rb; u.pn = pn; u.aux = e;
    }
    __device__ __forceinline__ void a_ready(const pg8::UnitD& u, int wid) const {
        if (u.type != 5) return;
        if (wid == 0) {
            const unsigned* w = cnt + 64 * u.pm; unsigned spins = 0;
            for (;;) { unsigned v;
                asm volatile("v_mov_b32 %0, 0\n\tglobal_load_dword %0, %0, %1 sc1\n\ts_waitcnt vmcnt(0)" : "=&v"(v) : "s"(w) : "memory");
                if ((unsigned)__builtin_amdgcn_readfirstlane((int)v) >= 32u) break;
                if (++spins > 200000u) break;
                __builtin_amdgcn_s_sleep(2); }
            __builtin_amdgcn_fence(__ATOMIC_ACQUIRE, "agent");
            asm volatile("s_waitcnt vmcnt(0)" ::: "memory");
        }
        asm volatile("" ::: "memory"); __builtin_amdgcn_s_barrier(); asm volatile("" ::: "memory");
    }
    __device__ __forceinline__ void done(const pg8::UnitD& u, int lane) const {
        if (u.type != 4) return;
        asm volatile("s_waitcnt vmcnt(0)" ::: "memory");
        if (lane == 0) __hip_atomic_fetch_add(cnt + 64 * u.pm, 1u, __ATOMIC_RELAXED, __HIP_MEMORY_SCOPE_AGENT);
    }
};
struct EpiMoe2 {
    bf16_t* HE; bf16_t* YE;
    __device__ __forceinline__ void operator()(const f32x4 (&acc)[2][2][4][2], const pg8::UnitD& u, int wr, int wc, int fr, int fq) const {
        const int row0 = u.pm * 256 + wr * 64 + fr;
        if (u.type == 4) { const int col0 = u.pn * 128 + wc * 32 + 8 * fq;
#pragma unroll
            for (int ai = 0; ai < 2; ++ai)
#pragma unroll
                for (int m = 0; m < 4; ++m) { float hv[8];
                    int rr = row0 + ai * 128 + m * 16; asm volatile("" : "+v"(rr));
#pragma unroll
                    for (int n = 0; n < 2; ++n)
#pragma unroll
                        for (int x = 0; x < 4; ++x) { const float g = acc[ai][0][m][n][x], up = acc[ai][1][m][n][x]; hv[4 * n + x] = g * __builtin_amdgcn_rcpf(1.f + __expf(-g)) * up; }
                    u32x4 w; w.x = pg8::cvt_pk_bf16(hv[0], hv[1]); w.y = pg8::cvt_pk_bf16(hv[2], hv[3]); w.z = pg8::cvt_pk_bf16(hv[4], hv[5]); w.w = pg8::cvt_pk_bf16(hv[6], hv[7]);
                    store16_sc1(HE + (size_t)rr * DE + col0, w); }
        } else { const int col0 = u.pn * 256 + wc * 32 + 8 * fq;
#pragma unroll
            for (int ai = 0; ai < 2; ++ai)
#pragma unroll
                for (int m = 0; m < 4; ++m) { int rr = row0 + ai * 128 + m * 16; asm volatile("" : "+v"(rr)); bf16_t* rowp = YE + (size_t)rr * D + col0;
#pragma unroll
                    for (int bj = 0; bj < 2; ++bj) { const f32x4 v0 = acc[ai][bj][m][0], v1 = acc[ai][bj][m][1];
                        u32x4 w; w.x = pg8::cvt_pk_bf16(v0[0], v0[1]); w.y = pg8::cvt_pk_bf16(v0[2], v0[3]); w.z = pg8::cvt_pk_bf16(v1[0], v1[1]); w.w = pg8::cvt_pk_bf16(v1[2], v1[3]);
                        *(u32x4*)(rowp + bj * 128) = w; } }
        }
    }
};
__device__ __forceinline__ void ln2_rows(const OW& P, int l, int vcu, int G, float* Xdst) {
    const int tid_ = TID(); const int lane = tid_ & 63, wid = __builtin_amdgcn_readfirstlane(tid_ >> 6);
    const float* g2 = P.in[22] + (size_t)l * D; const float* b2 = P.in[23] + (size_t)l * D;
    f32x4 gv[4], bv[4];
#pragma unroll
    for (int j = 0; j < 4; ++j) { const int c = lane * 8 + 512 * (j >> 1) + 4 * (j & 1); gv[j] = *(const f32x4*)(g2 + c); bv[j] = *(const f32x4*)(b2 + c); }
    const size_t first = (size_t)vcu * NWAVES + wid, stride = (size_t)G * NWAVES;
    for (size_t base = first; base < NT; base += 8 * stride) {
        float ga[8], gb[8]; int da[8], db[8];
#pragma unroll
        for (int k = 0; k < 8; ++k) { const size_t row = base + k * stride; const bool ok = row < NT; const size_t r_ = ok ? row : base;
            ga[k] = P.GATE[r_ * 2]; gb[k] = P.GATE[r_ * 2 + 1]; da[k] = P.DEST[r_ * 2]; db[k] = P.DEST[r_ * 2 + 1]; }
#pragma unroll
        for (int kg = 0; kg < 8; kg += 4) {
        u32x4 nx[4][2], nya[4][2], nyb[4][2];
#pragma unroll
        for (int k4 = 0; k4 < 4; ++k4) { const int k = kg + k4; const size_t row_ = base + k * stride < NT ? base + k * stride : base;
#pragma unroll
            for (int j = 0; j < 2; ++j) { nx[k4][j] = *(const u32x4*)(P.XB + row_ * D + lane * 8 + 512 * j);
                nya[k4][j] = *(const u32x4*)(P.YE + (size_t)da[k] * D + lane * 8 + 512 * j); nyb[k4][j] = *(const u32x4*)(P.YE + (size_t)db[k] * D + lane * 8 + 512 * j); } }
#pragma unroll
        for (int k4 = 0; k4 < 4; ++k4) { const int k = kg + k4; const size_t row = base + k * stride; if (row >= NT) break;
            float v[16]; float s = 0.f; const float gA = ga[k], gB = gb[k];
#pragma unroll
            for (int j = 0; j < 2; ++j)
#pragma unroll
                for (int q = 0; q < 4; ++q) { const unsigned x = nx[k4][j][q], ya = nya[k4][j][q], yb = nyb[k4][j][q];
                    v[8 * j + 2 * q] = ALPHA * bflo(x) + gA * bflo(ya) + gB * bflo(yb); v[8 * j + 2 * q + 1] = ALPHA * bfhi(x) + gA * bfhi(ya) + gB * bfhi(yb); }
#pragma unroll
            for (int i = 0; i < 16; ++i) s += v[i];
            const float mu = wsum(s) * (1.f / D); float q_ = 0.f;
#pragma unroll
            for (int i = 0; i < 16; ++i) { v[i] -= mu; q_ += v[i] * v[i]; }
            const float rs = rsqrtf(wsum(q_) * (1.f / D) + EPS);
#pragma unroll
            for (int i = 0; i < 16; ++i) v[i] = v[i] * rs * gv[i >> 2][i & 3] + bv[i >> 2][i & 3];
#pragma unroll
            for (int j = 0; j < 2; ++j) { u32x4 o;
#pragma unroll
                for (int q = 0; q < 4; ++q) o[q] = pk2(v[8 * j + 2 * q], v[8 * j + 2 * q + 1]);
                *(u32x4*)(P.XB + row * D + lane * 8 + 512 * j) = o;
                if (Xdst) { *(f32x4*)(Xdst + row * D + lane * 8 + 512 * j) = (f32x4){v[8 * j], v[8 * j + 1], v[8 * j + 2], v[8 * j + 3]}; *(f32x4*)(Xdst + row * D + lane * 8 + 512 * j + 4) = (f32x4){v[8 * j + 4], v[8 * j + 5], v[8 * j + 6], v[8 * j + 7]}; } }
        }
        }
    }
}

#if MODE == 0
__global__ void __launch_bounds__(NTHREADS, 2) opt_phase(OW P, int phase, int layer) {
    extern __shared__ __attribute__((aligned(16))) unsigned char lds_raw[];
    LAS unsigned char* lds = (LAS unsigned char*)lds_raw;
    const int G = gridDim.x, bx = blockIdx.x, vcu = (G % 8 == 0) ? (bx % 8) * (G / 8) + bx / 8 : bx;
    switch (phase) {
        case 0: if (PH(0)) { prep_tables(P, vcu, G); prep_weights(P, layer, lds, vcu, G); } break;
        case 1: if (PH(1)) phase_inproj(P, lds, G); break;
        case 2: if (PH(2)) phase_qkv(P, layer, lds, G); break;
        case 3: if (PH(3)) phase_attn(P, lds, vcu, G); break;
        case 4: if (PH(4)) { for (int tile = blockIdx.x; tile < NT / 64; tile += G) mix_tile(P, lds, tile); } break;
        case 5: if (PH(5)) { SchedOut Sd{&P, G, (int)blockIdx.x}; EpiOut E{P.XB, P.Y}; pg8::gemm_phase<true>(lds, Sd, E); } break;
        case 6: if (PH(6)) { for (int tile = blockIdx.x; tile < NT / 64; tile += G) ln1_router_tile(P, layer, lds, tile); } break;
        case 7: if (PH(7)) { moe_table(P, lds); for (int tile = blockIdx.x; tile < NT / 64; tile += G) dest_tile(P, lds, tile); } break;
        case 8: if (PH(8)) { moe_table(P, lds); SchedMoe Sd{&P, (LAS int*)(lds + TAB_OFF), G, (int)blockIdx.x, false}; EpiMoeUp E{P.HE}; pg8::gemm_phase<true>(lds, Sd, E); } break;
        case 9: if (PH(9)) { moe_table(P, lds); SchedMoe Sd{&P, (LAS int*)(lds + TAB_OFF), G, (int)blockIdx.x, true}; EpiMoeDown E{P.YE}; pg8::gemm_phase<true>(lds, Sd, E); } break;
        case 10: if (PH(10)) { ln2_rows(P, layer, vcu, G, layer == L - 1 ? P.X : nullptr); if (layer + 1 < L) prep_weights(P, layer + 1, lds, vcu, G); } break;
        default: break;
    }
}

#endif
struct MArgs { const float* in[24]; float* X; char* ws; };
constexpr int PT_OFF = LDSCTL_OFF + 2048;
__device__ __forceinline__ unsigned long long ldq(LAS unsigned char* lds, int k) {
    const LAS unsigned* p = (const LAS unsigned*)(lds + PT_OFF) + 2 * k;
    const unsigned lo = (unsigned)__builtin_amdgcn_readfirstlane((int)p[0]), hi = (unsigned)__builtin_amdgcn_readfirstlane((int)p[1]);
    return ((unsigned long long)hi << 32) | lo;
}
__device__ __forceinline__ OW load_ow(LAS unsigned char* lds_, int wsel = 0) {
    unsigned la = (unsigned)(uintptr_t)lds_; asm volatile("" : "+s"(la) :: "memory"); LAS unsigned char* lds = (LAS unsigned char*)(uintptr_t)la;
    OW P;
#pragma unroll
    for (int i = 0; i < 24; ++i) P.in[i] = (const float*)(GAS const float*)ldq(lds, i);
    P.X = (float*)(GAS float*)ldq(lds, 24); GAS char* ws = (GAS char*)ldq(lds, 25); GAS char* wsw = ws + (wsel ? ows::WSET1 : 0);
    P.ctl = (unsigned*)(GAS unsigned*)(ws + ows::CTL); P.XB = (bf16_t*)(GAS bf16_t*)(ws + ows::XB); P.Z = (bf16_t*)(GAS bf16_t*)(ws + ows::Z); P.SSQ = (float*)(GAS float*)(ws + ows::SSQ);
    P.Win_t = (bf16_t*)(GAS bf16_t*)(wsw + ows::WIN); P.Wq_t = (bf16_t*)(GAS bf16_t*)(wsw + ows::WQ); P.Wkv_t = (bf16_t*)(GAS bf16_t*)(wsw + ows::WKV); P.Wo_t = (bf16_t*)(GAS bf16_t*)(wsw + ows::WO);
    P.Wgu_t = (bf16_t*)(GAS bf16_t*)(wsw + ows::WGU); P.Wd_t = (bf16_t*)(GAS bf16_t*)(wsw + ows::WD); P.Wlg_t = (bf16_t*)(GAS bf16_t*)(wsw + ows::WLG); P.RWH = (bf16_t*)(GAS bf16_t*)(wsw + ows::WLG + 262144); P.RGB = (float*)(GAS float*)(wsw + ows::WLG + 393216);
    P.ROPE = (f32x2*)(GAS f32x2*)(ws + ows::ROPE); P.Q = (bf16_t*)(GAS bf16_t*)(ws + ows::Q); P.KN = (bf16_t*)(GAS bf16_t*)(ws + ows::KN); P.VV = (bf16_t*)(GAS bf16_t*)(ws + ows::VV); P.KPE = (bf16_t*)(GAS bf16_t*)(ws + ows::KPE);
    P.A = (float*)(GAS float*)(ws + ows::A); P.DRV = (float*)(GAS float*)(ws + ows::DRV); P.AGA = (float*)(GAS float*)(ws + ows::AGA); P.AGB = (float*)(GAS float*)(ws + ows::AGB);
    P.OP = (bf16_t*)(GAS bf16_t*)(ws + ows::OP); P.ML = (f32x2*)(GAS f32x2*)(ws + ows::ML); P.MIX = (bf16_t*)(GAS bf16_t*)(ws + ows::MIX); P.Y = (bf16_t*)(GAS bf16_t*)(ws + ows::Y);
    P.EIDX = (int*)(GAS int*)(ws + ows::EIDX); P.HIST = (int*)(GAS int*)(ws + ows::HIST); P.LRANK = (int*)(GAS int*)(ws + ows::LRANK); P.DEST = (int*)(GAS int*)(ws + ows::DEST); P.ROWTOK = (int*)(GAS int*)(ws + ows::ROWTOK); P.GATE = (float*)(GAS float*)(ws + ows::GATE);
    P.HE = (bf16_t*)(GAS bf16_t*)(ws + ows::HE); P.YE = (bf16_t*)(GAS bf16_t*)(ws + ows::YE);
    return P;
}
__global__ void __launch_bounds__(NTHREADS, 2) mega_fwd(MArgs a) {
    extern __shared__ __attribute__((aligned(16))) unsigned char lds_raw[];
    LAS unsigned char* lds = (LAS unsigned char*)lds_raw;
    for (int u = threadIdx.x; u < (LDS_BYTES - LDSCTL_OFF) / 4; u += NTHREADS) ((LAS unsigned*)(lds + LDSCTL_OFF))[u] = 0u;
    __syncthreads();
    { LAS unsigned long long* PT = (LAS unsigned long long*)(lds + PT_OFF);
#pragma unroll
      for (int i = 0; i < 24; ++i) if (threadIdx.x == i) PT[i] = (unsigned long long)a.in[i];
      if (threadIdx.x == 24) PT[24] = (unsigned long long)a.X;
      if (threadIdx.x == 25) PT[25] = (unsigned long long)a.ws; }
    __syncthreads();
    XcdBarrier bar; { const OW P = load_ow(lds); bar = xcd_barrier_post(P.ctl + 4096, (volatile LAS unsigned*)(lds + MISC_OFF) + 8); }
    LAS int* TAB = (LAS int*)(lds + TAB_OFF);
    if (PH(0)) { const OW P = load_ow(lds); const int G = GDIM(); const int b_ = BID(); const int v_ = (G % 8 == 0) ? (b_ % 8) * (G / 8) + b_ / 8 : b_; prep_tables(P, v_, G);
        if (G == 256) { prep_weights(P, 0, lds, v_, G, 0, 136, 1); prep_weights(P, 0, lds, v_, G, 1236, 1 << 30, 0); const OW P1 = load_ow(lds, 1); prep_weights(P1, 0, lds, v_, G, 0, 0, 1); }
        else { prep_weights(P, 0, lds, v_, G, 0, 1 << 30, 3); const OW P1 = load_ow(lds, 1); prep_weights(P1, 0, lds, v_, G, 0, 0, 1); } }
    xcd_barrier(bar);
    for (int l = 0; l < L; ++l) {
        constexpr int SPLIT = 900;
        for (int rep_ = 0; rep_ < (DUP(1) ? 2 : 1); ++rep_) if (PH(1)) { const OW P = load_ow(lds, l & 1); const int G = GDIM(); phase_inproj(P, lds, G); }
        if (PH(10)) {
            const int G = GDIM(), b_ = BID(); const int nmax = (576 + G - 1) / G, nfull = 576 - (nmax - 1) * G;
            if (G == 256) { const OW P = load_ow(lds, l & 1); if (b_ >= nfull) prep_weights(P, l, lds, b_ - nfull, G - nfull, l == 0 ? 136 : SPLIT, l == 0 ? 1236 : 1 << 30, 2); }
            else if (l + 1 < L) { const OW P = load_ow(lds, (l + 1) & 1); prep_weights(P, l + 1, lds, b_, G, 0, 1 << 30, 2); } }
        xcd_barrier(bar);
        for (int rep_ = 0; rep_ < (DUP(2) ? 2 : 1); ++rep_) if (PH(2)) { { const OW P = load_ow(lds, l & 1); const int G = GDIM(); SchedQKV Sd{&P, G, BID()}; EpiQKV E{P.SSQ, P.Q, P.KN, P.VV}; pg8::gemm_phase<true>(lds, Sd, E); }
                     { const OW P = load_ow(lds, l & 1); const int G = GDIM(); for (int tile = BID(); tile < NT / 64; tile += G) { gates_tile(P, l, lds, tile); if (DUP(15)) gates_tile(P, l, lds, tile); } } }
        xcd_barrier(bar);
        for (int rep_ = 0; rep_ < (DUP(3) ? 2 : 1); ++rep_) if (PH(3)) { const OW P = load_ow(lds, l & 1); const int G = GDIM(); { const int b_ = BID(); phase_attn(P, lds, (G % 8 == 0) ? (b_ % 8) * (G / 8) + b_ / 8 : b_, G); } }
        xcd_barrier(bar);
        for (int rep_ = 0; rep_ < (DUP(4) ? 2 : 1); ++rep_) if (PH(4)) { const OW P = load_ow(lds, l & 1); const int G = GDIM(); for (int tile = BID(); tile < NT / 64; tile += G) mix_tile(P, lds, tile); }
        xcd_barrier(bar);
        for (int rep_ = 0; rep_ < (DUP(5) ? 2 : 1); ++rep_) if (PH(5)) { const OW P = load_ow(lds, l & 1); const int G = GDIM(); SchedOut Sd{&P, G, BID()}; EpiOut E{P.XB, P.Y}; pg8::gemm_phase<true>(lds, Sd, E); }
        xcd_barrier(bar);
        for (int rep_ = 0; rep_ < (DUP(6) ? 2 : 1); ++rep_) if (PH(6)) { const OW P = load_ow(lds, l & 1); const int G = GDIM(); for (int tile = BID(); tile < NT / 64; tile += G) { ln1_router_tile(P, l, lds, tile); if (DUP(13)) ln1_router_tile(P, l, lds, tile); } }
        xcd_barrier(bar);
        for (int rep_ = 0; rep_ < (DUP(7) ? 2 : 1); ++rep_) if (PH(7)) { const OW P = load_ow(lds, l & 1); const int G = GDIM(); moe_table(P, lds); for (int tile = BID(); tile < NT / 64; tile += G) dest_tile(P, lds, tile); }
        xcd_barrier(bar);
        for (int rep_ = 0; rep_ < (DUP(8) ? 2 : 1); ++rep_) if (PH(8)) { const OW P = load_ow(lds, l & 1); const int G = GDIM(); SchedMoe2 Sd; Sd.P = &P; Sd.TAB = TAB; Sd.cnt = P.ctl + MOECNT_W + l * 144 * 64; Sd.init(G, BID()); EpiMoe2 E{P.HE, P.YE}; pg8::gemm_phase<true>(lds, Sd, E); }
        if (PH(10) && l + 1 < L && GDIM() == 256) { const OW P = load_ow(lds, (l + 1) & 1); prep_queue(P, l + 1, lds, P.ctl + PREPQ_W + l * 64, 0, SPLIT); }
        xcd_barrier(bar);
        if (PH(10)) { const OW P = load_ow(lds, l & 1); const int G = GDIM(); { const int b_ = BID(); const int v_ = (G % 8 == 0) ? (b_ % 8) * (G / 8) + b_ / 8 : b_; ln2_rows(P, l, v_, G, l == L - 1 ? P.X : nullptr); } }
        if (l + 1 < L) xcd_barrier(bar);
        if (DUP(12)) for (int rep_ = 0; rep_ < 10; ++rep_) xcd_barrier(bar);
    }
}
#if MODE == 0
__global__ void shim_q(const bf16_t* Qb, float* Qf) { const size_t i = (size_t)blockIdx.x * 256 + threadIdx.x; if (i < (size_t)NT * QL) Qf[i] = bf2f(Qb[i]); }
__global__ void shim_kv(const bf16_t* KN, const bf16_t* VV, float* KV) { const size_t i = (size_t)blockIdx.x * 256 + threadIdx.x; if (i < (size_t)NT * 1024) { const size_t r = i >> 10; const int c = (int)(i & 1023), h = c >> 8, d = c & 255;
    KV[i] = d < 128 ? bf2f(KN[r * 512 + h * 128 + d]) : bf2f(VV[r * 512 + h * 128 + d - 128]); } }
__global__ void shim_kpe(const bf16_t* Kb, float* Kf) { const size_t i = (size_t)blockIdx.x * 256 + threadIdx.x; if (i < (size_t)NT * 64) Kf[i] = bf2f(Kb[i]); }
__global__ void shim_z(const bf16_t* Zb, float* Zf) { const size_t i = (size_t)blockIdx.x * 256 + threadIdx.x; if (i < (size_t)NT * INW) { const size_t r = i / INW, c = i % INW; Zf[i] = bf2f(Zb[r * ZW + c]); } }


#endif
#if MODE == 0
static OW make_ow(void* const* d_in, float* out, char* ws) {
    OW P{};
    for (int i = 0; i < 24; ++i) P.in[i] = (const float*)d_in[i];
    P.X = out; P.ctl = (unsigned*)(ws + ows::CTL); P.XB = (bf16_t*)(ws + ows::XB); P.Z = (bf16_t*)(ws + ows::Z); P.SSQ = (float*)(ws + ows::SSQ);
    P.Win_t = (bf16_t*)(ws + ows::WIN); P.Wq_t = (bf16_t*)(ws + ows::WQ); P.Wkv_t = (bf16_t*)(ws + ows::WKV); P.Wo_t = (bf16_t*)(ws + ows::WO); P.Wgu_t = (bf16_t*)(ws + ows::WGU); P.Wd_t = (bf16_t*)(ws + ows::WD); P.Wlg_t = (bf16_t*)(ws + ows::WLG);
    P.ROPE = (f32x2*)(ws + ows::ROPE); P.Q = (bf16_t*)(ws + ows::Q); P.KN = (bf16_t*)(ws + ows::KN); P.VV = (bf16_t*)(ws + ows::VV); P.KPE = (bf16_t*)(ws + ows::KPE);
    P.A = (float*)(ws + ows::A); P.DRV = (float*)(ws + ows::DRV); P.AGA = (float*)(ws + ows::AGA); P.AGB = (float*)(ws + ows::AGB);
    P.OP = (bf16_t*)(ws + ows::OP); P.ML = (f32x2*)(ws + ows::ML); P.MIX = (bf16_t*)(ws + ows::MIX); P.Y = (bf16_t*)(ws + ows::Y);
    P.EIDX = (int*)(ws + ows::EIDX); P.HIST = (int*)(ws + ows::HIST); P.LRANK = (int*)(ws + ows::LRANK); P.DEST = (int*)(ws + ows::DEST); P.ROWTOK = (int*)(ws + ows::ROWTOK); P.GATE = (float*)(ws + ows::GATE);
    P.HE = (bf16_t*)(ws + ows::HE); P.YE = (bf16_t*)(ws + ows::YE); P.RWH = (bf16_t*)(ws + ows::WLG + 262144); P.RGB = (float*)(ws + ows::WLG + 393216);
    return P;
}

#endif
constexpr int ATT_LDS = (4 * S + 4 * QH) * 4, MOEUP_LDS = D * 16 * 4 + 64;
#ifndef OPT_STAGES
#define OPT_STAGES 0
#endif
#ifndef OPT_LAYERS
#define OPT_LAYERS 1
#endif
#if MODE == 0
static void hybrid_forward(void* const* d_in, float* out, float* ws, hipStream_t st) {
    const float* x0 = (const float*)d_in[0];
    float* Z = ws + rws::Z; float* YE = Z; float* A = ws + rws::AB; float* DRV = A + (size_t)NT * LW; float* HID = A;
    float* Q = ws + rws::Q; float* KV = ws + rws::KV; float* Y = KV; float* KPE = ws + rws::KPE; float* MIX = ws + rws::MIX;
    float* GATE = ws + rws::GATE; int* CNT = (int*)(ws + rws::CNT); int* LIST = (int*)(ws + rws::LIST);
    OW P{};
    for (int i = 0; i < 24; ++i) P.in[i] = (const float*)d_in[i];
    P.X = out;
    char* tailp = (char*)(ws + rws::END);
    P.ctl = (unsigned*)tailp; tailp += 65536;
    P.ROPE = (f32x2*)tailp; tailp += (size_t)S * 32 * 8;
    P.SSQ = (float*)tailp; tailp += (size_t)NT * 16 * 4;
    P.Win_t = (bf16_t*)tailp; tailp += (size_t)ZW * D * 2;
    P.Wq_t = (bf16_t*)tailp; tailp += (size_t)768 * 768 * 2;
    P.Wkv_t = (bf16_t*)tailp; tailp += (size_t)1024 * 256 * 2;
    P.Wo_t = (bf16_t*)tailp; tailp += (size_t)1024 * 1024 * 2;
    P.Wlg_t = (bf16_t*)tailp; tailp += (size_t)8 * 128 * 64 * 2;
    P.Wgu_t = (bf16_t*)tailp; tailp += (size_t)16 * 1024 * 1024 * 2;
    P.Wd_t = (bf16_t*)tailp; tailp += (size_t)16 * 1024 * 512 * 2;
    P.AGA = (float*)tailp; tailp += (size_t)256 * LW * 4;
    P.AGB = (float*)tailp; tailp += (size_t)256 * LW * 4;
    P.OP = (bf16_t*)tailp; tailp += (size_t)2 * NT * 512 * 2;
    P.ML = (f32x2*)tailp; tailp += (size_t)2 * NT * 4 * 8;
    P.A = A; P.DRV = DRV;
    { char* m = (char*)(ws + rws::MIX) ; P.Q = (bf16_t*)m; m += (size_t)NT * QL * 2; P.KN = (bf16_t*)m; m += (size_t)NT * 512 * 2; P.VV = (bf16_t*)m; m += (size_t)NT * 512 * 2; P.KPE = (bf16_t*)m; }
    P.XB = (bf16_t*)(ws + rws::MIX);
    P.Z = (bf16_t*)(ws + rws::KV);
    P.Z = (bf16_t*)(ws + rws::Q);
    const OW PF = make_ow(d_in, out, (char*)ws);
    for (int l = 0; l < L; ++l) {
        if (l < OPT_LAYERS) {
            if (l == 0) opt_phase<<<256, NTHREADS, LDS_BYTES, st>>>(PF, 0, 0);
            for (int ph = 1; ph <= 10; ++ph) opt_phase<<<256, NTHREADS, LDS_BYTES, st>>>(PF, ph, l);
            continue;
        }
        const float* xin = l == 0 ? x0 : out;
        const float* w_in = (const float*)d_in[1] + (size_t)l * D * INW;
        const float* conv_w = (const float*)d_in[2] + (size_t)l * 4 * LW;
        const float* conv_b = (const float*)d_in[3] + (size_t)l * LW;
        const float* w_r = (const float*)d_in[4] + (size_t)l * 8 * 64 * 64;
        const float* b_r = (const float*)d_in[5] + (size_t)l * LW;
        const float* w_i = (const float*)d_in[6] + (size_t)l * 8 * 64 * 64;
        const float* b_i = (const float*)d_in[7] + (size_t)l * LW;
        const float* lam = (const float*)d_in[8] + (size_t)l * LW;
        const float* qng = (const float*)d_in[9] + (size_t)l * QL;
        const float* w_qup = (const float*)d_in[10] + (size_t)l * QL * 768;
        const float* kvng = (const float*)d_in[11] + (size_t)l * KVL;
        const float* w_kvup = (const float*)d_in[12] + (size_t)l * KVL * 1024;
        const float* ong = (const float*)d_in[13] + (size_t)l * 1024;
        const float* w_out = (const float*)d_in[14] + (size_t)l * 1024 * D;
        const float* ln1g = (const float*)d_in[15] + (size_t)l * D;
        const float* ln1b = (const float*)d_in[16] + (size_t)l * D;
        const float* rw = (const float*)d_in[17];
        const float* rb = (const float*)d_in[18];
        const float* wg = (const float*)d_in[19] + (size_t)l * NE * D * DE;
        const float* wu = (const float*)d_in[20] + (size_t)l * NE * D * DE;
        const float* wd = (const float*)d_in[21] + (size_t)l * NE * DE * D;
        const float* ln2g = (const float*)d_in[22] + (size_t)l * D;
        const float* ln2b = (const float*)d_in[23] + (size_t)l * D;
        const int nopt = l == 0 ? OPT_STAGES : 0;
        if (nopt >= 1) {
            opt_phase<<<256, NTHREADS, LDS_BYTES, st>>>(P, 0, l);
            opt_phase<<<256, NTHREADS, LDS_BYTES, st>>>(P, 1, l);
            if (nopt >= 2) opt_phase<<<256, NTHREADS, LDS_BYTES, st>>>(P, 2, l);
            if (nopt >= 3) opt_phase<<<256, NTHREADS, LDS_BYTES, st>>>(P, 3, l);
            shim_z<<<(unsigned)(((size_t)NT * INW + 255) / 256), 256, 0, st>>>(P.Z, Z);
        } else {
            ref::gemm<true><<<dim3(INW / 64, NT / 64), 256, 0, st>>>(xin, D, w_in, INW, Z, INW, D);
        }
        if (nopt >= 3) {
            ref::lru_scan<<<B * LW / 256, 256, 0, st>>>(A, DRV, Z, MIX);
            shim_attn<<<(unsigned)(((size_t)NT * 512 + 255) / 256), 256, 0, st>>>(P.OP, P.ML, MIX);
        } else if (nopt >= 2) {
            shim_q<<<(unsigned)(((size_t)NT * QL + 255) / 256), 256, 0, st>>>(P.Q, Q);
            shim_kv<<<(unsigned)(((size_t)NT * 1024 + 255) / 256), 256, 0, st>>>(P.KN, P.VV, KV);
            shim_kpe<<<(unsigned)(((size_t)NT * 64 + 255) / 256), 256, 0, st>>>(P.KPE, KPE);
            ref::lru_scan<<<B * LW / 256, 256, 0, st>>>(A, DRV, Z, MIX);
            ref::q_post<<<NT * 4 * 96 / 256, 256, 0, st>>>(Q);
        } else {
            ref::lru_gates<<<NT * LW / 256, 256, 0, st>>>(Z, conv_w, conv_b, w_r, b_r, w_i, b_i, lam, A, DRV);
            ref::lru_scan<<<B * LW / 256, 256, 0, st>>>(A, DRV, Z, MIX);
            ref::rmsnorm<<<NT / 4, 256, 0, st>>>(Z, INW, 1024, QL, qng);
            ref::rmsnorm<<<NT / 4, 256, 0, st>>>(Z, INW, 1792, KVL, kvng);
            ref::gemm<true><<<dim3(768 / 64, NT / 64), 256, 0, st>>>(Z + 1024, INW, w_qup, 768, Q, QL, QL);
            ref::gemm<true><<<dim3(1024 / 64, NT / 64), 256, 0, st>>>(Z + 1792, INW, w_kvup, 1024, KV, 1024, KVL);
            ref::q_post<<<NT * 4 * 96 / 256, 256, 0, st>>>(Q);
            ref::kpe_rope<<<NT * 32 / 256, 256, 0, st>>>(Z, KPE);
        }
        if (nopt < 3) ref::attention<<<B * H * S / 4, 64, ATT_LDS, st>>>(Q, KV, KPE, MIX);
        ref::rmsnorm<<<NT / 4, 256, 0, st>>>(MIX, D, 0, 512, ong);
        ref::rmsnorm<<<NT / 4, 256, 0, st>>>(MIX, D, 512, 512, ong + 512);
        ref::gemm<false><<<dim3(D / 64, NT / 64), 256, 0, st>>>(MIX, D, w_out, D, Y, D, 1024);
        ref::ln_res<<<NT / 4, 256, 0, st>>>(xin, Y, out, ln1g, ln1b);
        (void)hipMemsetAsync(CNT, 0, 64 * sizeof(int), st);
        ref::router<<<NT / 4, 256, 0, st>>>(out, rw, rb, GATE, CNT, LIST);
        ref::moe_up<<<dim3(NT / 16, NE), 256, MOEUP_LDS, st>>>(out, wg, wu, CNT, LIST, HID);
        ref::moe_down<<<dim3(NT / 16, NE), 256, 0, st>>>(HID, wd, CNT, LIST, YE);
        ref::ln_moe<<<NT / 4, 256, 0, st>>>(out, YE, GATE, ln2g, ln2b);
    }
}

#endif
extern "C" void kernel_launch(void* const* d_in, const int* in_sizes, int n_in, void* d_out, int out_size, void* d_ws, size_t ws_size, hipStream_t stream) {
    if (n_in != 24 || out_size != NT * D || ws_size < (size_t)536870912) {
        fprintf(stderr, "kernel_launch: unexpected shapes (n_in %d, out %d, ws %zu)\n", n_in, out_size, ws_size);
        return;
    }
#if MODE == 0
    static bool attr_done = false;
    if (!attr_done) { attr_done = true;
        (void)hipFuncSetAttribute((const void*)ref::attention, hipFuncAttributeMaxDynamicSharedMemorySize, ATT_LDS);
        (void)hipFuncSetAttribute((const void*)ref::moe_up, hipFuncAttributeMaxDynamicSharedMemorySize, MOEUP_LDS);
        (void)hipFuncSetAttribute((const void*)opt_phase, hipFuncAttributeMaxDynamicSharedMemorySize, LDS_BYTES);
    }
#endif
#if MODE == 0
    hybrid_forward(d_in, (float*)d_out, (float*)d_ws, stream);
#else
    static int grid = 0;
    if (grid == 0) { int dev = 0, cus = 0; (void)hipGetDevice(&dev); if (hipDeviceGetAttribute(&cus, hipDeviceAttributeMultiprocessorCount, dev) != hipSuccess || cus <= 0) cus = 256; grid = cus;
        (void)hipFuncSetAttribute((const void*)mega_fwd, hipFuncAttributeMaxDynamicSharedMemorySize, LDS_BYTES); }
    MArgs a{};
    for (int i = 0; i < 24; ++i) a.in[i] = (const float*)d_in[i];
    a.X = (float*)d_out; a.ws = (char*)d_ws;
    (void)hipMemsetAsync((char*)d_ws + ows::CTL, 0, 262144, stream);
    hipLaunchKernelGGL(mega_fwd, dim3(grid), dim3(NTHREADS), LDS_BYTES, stream, a);
#endif
}
```

```cpp
#include <hip/hip_runtime.h>
#include <cstdint>
#include <cstdio>

namespace cfg {
constexpr int D = 1024, B = 4, S = 4096, NT = B * S, L = 4;
constexpr int LW = 512, NBLK = 8, BLK = 64;
constexpr int H = 4, QNOPE = 128, QROPE = 64, QH = 192, VH = 128, QL = 768, KVL = 256;
constexpr int INW = 2112;
constexpr int NE = 16, DE = 512;
constexpr float ALPHA = 1.681792830507429f, EPS = 1e-6f;
}
using namespace cfg;

#ifndef MODE
#define MODE 1
#endif
#if MODE == 0
namespace ref {

__device__ __forceinline__ float wave_sum(float v) {
#pragma unroll
    for (int o = 1; o < 64; o <<= 1) v += __shfl_xor(v, o);
    return v;
}
__device__ __forceinline__ float wave_max(float v) {
#pragma unroll
    for (int o = 1; o < 64; o <<= 1) v = fmaxf(v, __shfl_xor(v, o));
    return v;
}
#define BF16_EMU 1
__device__ __forceinline__ float rb(float f) {
#if BF16_EMU
    unsigned u = __float_as_uint(f); u = (u + 0x7fffu + ((u >> 16) & 1u)) & 0xffff0000u; return __uint_as_float(u);
#else
    return f;
#endif
}
__device__ __forceinline__ float sigmoidf_(float x) { return 1.f / (1.f + expf(-x)); }
__device__ __forceinline__ float gelu_tanh(float x) { return 0.5f * x * (1.f + tanhf(0.7978845608028654f * (x + 0.044715f * x * x * x))); }

template <bool RO> __global__ __launch_bounds__(256) void gemm(const float* __restrict__ A, int lda, const float* __restrict__ Bm, int ldb, float* __restrict__ C, int ldc, int K) {
    __shared__ float As[16][68];
    __shared__ float Bs[16][68];
    const int tid = threadIdx.x, tx = tid & 15, ty = tid >> 4;
    const int m0 = blockIdx.y * 64, n0 = blockIdx.x * 64;
    float acc[4][4];
#pragma unroll
    for (int i = 0; i < 4; ++i)
#pragma unroll
        for (int j = 0; j < 4; ++j) acc[i][j] = 0.f;
    for (int k0 = 0; k0 < K; k0 += 16) {
#pragma unroll
        for (int it = 0; it < 4; ++it) { const int i = tid + it * 256; const int m = i >> 4, k = i & 15; As[k][m] = rb(A[(size_t)(m0 + m) * lda + k0 + k]); }
#pragma unroll
        for (int it = 0; it < 4; ++it) { const int i = tid + it * 256; const int k = i >> 6, n = i & 63; Bs[k][n] = rb(Bm[(size_t)(k0 + k) * ldb + n0 + n]); }
        __syncthreads();
#pragma unroll
        for (int k = 0; k < 16; ++k) {
            float a[4], b[4];
#pragma unroll
            for (int i = 0; i < 4; ++i) { a[i] = As[k][ty * 4 + i]; b[i] = Bs[k][tx * 4 + i]; }
#pragma unroll
            for (int i = 0; i < 4; ++i)
#pragma unroll
                for (int j = 0; j < 4; ++j) acc[i][j] = fmaf(a[i], b[j], acc[i][j]);
        }
        __syncthreads();
    }
#pragma unroll
    for (int i = 0; i < 4; ++i)
#pragma unroll
        for (int j = 0; j < 4; ++j) C[(size_t)(m0 + ty * 4 + i) * ldc + n0 + tx * 4 + j] = RO ? rb(acc[i][j]) : acc[i][j];
}

__global__ __launch_bounds__(256) void rmsnorm(float* X, int ld, int off, int n, const float* __restrict__ g) {
    const int row = blockIdx.x * 4 + (threadIdx.x >> 6), lane = threadIdx.x & 63;
    float* x = X + (size_t)row * ld + off;
    float s = 0.f;
    for (int i = lane; i < n; i += 64) { const float v = x[i]; s += v * v; }
    s = wave_sum(s);
    const float r = rsqrtf(s / (float)n + EPS);
    for (int i = lane; i < n; i += 64) x[i] = x[i] * r * g[i];
}

__global__ __launch_bounds__(256) void lru_gates(const float* __restrict__ Z, const float* __restrict__ conv_w, const float* __restrict__ conv_b,
                                                 const float* __restrict__ wr, const float* __restrict__ br, const float* __restrict__ wi, const float* __restrict__ bi,
                                                 const float* __restrict__ lam, float* __restrict__ Aout, float* __restrict__ Dout) {
    const int idx = blockIdx.x * 256 + threadIdx.x;
    const int tok = idx >> 9, ch = idx & 511, n = ch >> 6, d = ch & 63, s = tok & (S - 1);
    float accr = br[ch], acci = bi[ch], xc_own = 0.f;
    for (int c = 0; c < 64; ++c) {
        const int cc = n * 64 + c;
        float xc = conv_b[cc];
#pragma unroll
        for (int w = 0; w < 4; ++w) { const int sp = s + w - 3; if (sp >= 0) xc = fmaf(Z[(size_t)(tok + w - 3) * INW + cc], conv_w[w * LW + cc], xc); }
        accr = fmaf(xc, wr[(size_t)cc * 64 + d], accr);
        acci = fmaf(xc, wi[(size_t)cc * 64 + d], acci);
        if (c == d) xc_own = xc;
    }
    const float r = sigmoidf_(accr), ig = sigmoidf_(acci);
    const float sp = log1pf(expf(-lam[ch]));
    const float log_a = -8.0f * r * sp;
    Aout[idx] = expf(log_a);
    Dout[idx] = sqrtf(-expm1f(2.0f * log_a)) * (ig * xc_own);
}

__global__ __launch_bounds__(256) void lru_scan(const float* __restrict__ Ain, const float* __restrict__ Din, const float* __restrict__ Z, float* __restrict__ MIX) {
    const int idx = blockIdx.x * 256 + threadIdx.x;
    const int b = idx >> 9, ch = idx & 511;
    float h = 0.f;
    for (int s0 = 0; s0 < S; s0 += 8) {
        float a[8], d[8], g[8];
#pragma unroll
        for (int j = 0; j < 8; ++j) { const size_t t = (size_t)b * S + s0 + j; a[j] = Ain[t * LW + ch]; d[j] = Din[t * LW + ch]; g[j] = Z[t * INW + LW + ch]; }
#pragma unroll
        for (int j = 0; j < 8; ++j) { h = fmaf(a[j], h, d[j]); const size_t t = (size_t)b * S + s0 + j; MIX[t * D + ch] = h * gelu_tanh(g[j]); }
    }
}

__global__ __launch_bounds__(256) void q_post(float* Q) {
    const int idx = blockIdx.x * 256 + threadIdx.x;
    const int j = idx % 96, th = idx / 96, h = th & 3, tok = th >> 2, s = tok & (S - 1);
    float* q = Q + (size_t)tok * QL + h * QH;
    const float sc = 0.07216878364870322f;
    if (j < 64) { q[j] *= sc; q[j + 64] *= sc; }
    else {
        const int i = j - 64;
        const float inv = powf(10000.0f, -(float)i / 32.0f);
        const float ang = (float)s * inv;
        const float c = cosf(ang), sn = sinf(ang);
        const float x1 = q[128 + i], x2 = q[160 + i];
        q[128 + i] = (x1 * c - x2 * sn) * sc; q[160 + i] = (x1 * sn + x2 * c) * sc;
    }
}
__global__ __launch_bounds__(256) void kpe_rope(const float* __restrict__ Z, float* __restrict__ KPE) {
    const int idx = blockIdx.x * 256 + threadIdx.x;
    const int i = idx & 31, tok = idx >> 5, s = tok & (S - 1);
    const float inv = powf(10000.0f, -(float)i / 32.0f);
    const float ang = (float)s * inv;
    const float c = cosf(ang), sn = sinf(ang);
    const float x1 = Z[(size_t)tok * INW + 2048 + i], x2 = Z[(size_t)tok * INW + 2048 + 32 + i];
    KPE[(size_t)tok * 64 + i] = x1 * c - x2 * sn; KPE[(size_t)tok * 64 + 32 + i] = x1 * sn + x2 * c;
}

__global__ __launch_bounds__(64) void attention(const float* __restrict__ Q, const float* __restrict__ KV, const float* __restrict__ KPE, float* __restrict__ MIX) {
    extern __shared__ __attribute__((aligned(16))) float dyn_lds[];
    float (*sc)[S] = (float (*)[S])dyn_lds;
    float (*qs)[QH] = (float (*)[QH])(dyn_lds + 4 * S);
    const int lane = threadIdx.x;
    const int blk = blockIdx.x;
    const int qb = blk % (S / 4), bh = blk / (S / 4), h = bh & 3, b = bh >> 2;
    const int q0 = qb * 4;
    for (int i = lane; i < 4 * QH; i += 64) { const int r = i / QH, d = i % QH; qs[r][d] = rb(Q[(size_t)(b * S + q0 + r) * QL + h * QH + d]); }
    __syncthreads();
    const int nk = q0 + 4;
    for (int j = lane; j < nk; j += 64) {
        const float* kn = KV + (size_t)(b * S + j) * 1024 + h * 256;
        const float* kp = KPE + (size_t)(b * S + j) * 64;
        float d0 = 0.f, d1 = 0.f, d2 = 0.f, d3 = 0.f;
        for (int d = 0; d < 128; d += 4) {
            float4 kv = *(const float4*)(kn + d); kv.x = rb(kv.x); kv.y = rb(kv.y); kv.z = rb(kv.z); kv.w = rb(kv.w);
            d0 += kv.x * qs[0][d] + kv.y * qs[0][d + 1] + kv.z * qs[0][d + 2] + kv.w * qs[0][d + 3];
            d1 += kv.x * qs[1][d] + kv.y * qs[1][d + 1] + kv.z * qs[1][d + 2] + kv.w * qs[1][d + 3];
            d2 += kv.x * qs[2][d] + kv.y * qs[2][d + 1] + kv.z * qs[2][d + 2] + kv.w * qs[2][d + 3];
            d3 += kv.x * qs[3][d] + kv.y * qs[3][d + 1] + kv.z * qs[3][d + 2] + kv.w * qs[3][d + 3];
        }
        for (int d = 0; d < 64; d += 4) {
            float4 kv = *(const float4*)(kp + d); kv.x = rb(kv.x); kv.y = rb(kv.y); kv.z = rb(kv.z); kv.w = rb(kv.w);
            d0 += kv.x * qs[0][128 + d] + kv.y * qs[0][129 + d] + kv.z * qs[0][130 + d] + kv.w * qs[0][131 + d];
            d1 += kv.x * qs[1][128 + d] + kv.y * qs[1][129 + d] + kv.z * qs[1][130 + d] + kv.w * qs[1][131 + d];
            d2 += kv.x * qs[2][128 + d] + kv.y * qs[2][129 + d] + kv.z * qs[2][130 + d] + kv.w * qs[2][131 + d];
            d3 += kv.x * qs[3][128 + d] + kv.y * qs[3][129 + d] + kv.z * qs[3][130 + d] + kv.w * qs[3][131 + d];
        }
        const float NEG = -INFINITY;
        sc[0][j] = (j <= q0 + 0) ? d0 : NEG; sc[1][j] = (j <= q0 + 1) ? d1 : NEG; sc[2][j] = (j <= q0 + 2) ? d2 : NEG; sc[3][j] = (j <= q0 + 3) ? d3 : NEG;
    }
    __syncthreads();
    float inv_l[4];
#pragma unroll
    for (int r = 0; r < 4; ++r) {
        float m = -INFINITY;
        for (int j = lane; j < nk; j += 64) m = fmaxf(m, sc[r][j]);
        m = wave_max(m);
        float l = 0.f;
        for (int j = lane; j < nk; j += 64) { const float p = expf(sc[r][j] - m); sc[r][j] = rb(p); l += p; }
        l = wave_sum(l);
        inv_l[r] = 1.f / l;
    }
    __syncthreads();
    float o[4][2];
#pragma unroll
    for (int r = 0; r < 4; ++r) { o[r][0] = 0.f; o[r][1] = 0.f; }
    for (int j = 0; j < nk; ++j) {
        const float* v = KV + (size_t)(b * S + j) * 1024 + h * 256 + 128;
        const float v0 = rb(v[lane]), v1 = rb(v[lane + 64]);
#pragma unroll
        for (int r = 0; r < 4; ++r) { const float p = sc[r][j]; o[r][0] = fmaf(p, v0, o[r][0]); o[r][1] = fmaf(p, v1, o[r][1]); }
    }
#pragma unroll
    for (int r = 0; r < 4; ++r) {
        float* out = MIX + (size_t)(b * S + q0 + r) * D + 512 + h * 128;
        out[lane] = o[r][0] * inv_l[r]; out[lane + 64] = o[r][1] * inv_l[r];
    }
}

__global__ __launch_bounds__(256) void ln_res(const float* Xin, const float* __restrict__ Y, float* Xout, const float* __restrict__ g, const float* __restrict__ bta) {
    const int row = blockIdx.x * 4 + (threadIdx.x >> 6), lane = threadIdx.x & 63;
    float v[16]; float s = 0.f;
#pragma unroll
    for (int j = 0; j < 16; ++j) { const int c = lane + 64 * j; v[j] = ALPHA * Xin[(size_t)row * D + c] + Y[(size_t)row * D + c]; s += v[j]; }
    const float mu = wave_sum(s) * (1.f / D);
    float q = 0.f;
#pragma unroll
    for (int j = 0; j < 16; ++j) { v[j] -= mu; q += v[j] * v[j]; }
    const float r = rsqrtf(wave_sum(q) * (1.f / D) + EPS);
#pragma unroll
    for (int j = 0; j < 16; ++j) { const int c = lane + 64 * j; Xout[(size_t)row * D + c] = v[j] * r * g[c] + bta[c]; }
}
__global__ __launch_bounds__(256) void ln_moe(float* X, const float* __restrict__ YE, const float* __restrict__ GATE, const float* __restrict__ g, const float* __restrict__ bta) {
    const int row = blockIdx.x * 4 + (threadIdx.x >> 6), lane = threadIdx.x & 63;
    const float g0 = GATE[row * 2], g1 = GATE[row * 2 + 1];
    float v[16]; float s = 0.f;
#pragma unroll
    for (int j = 0; j < 16; ++j) { const int c = lane + 64 * j; v[j] = ALPHA * X[(size_t)row * D + c] + g0 * YE[(size_t)(2 * row) * D + c] + g1 * YE[(size_t)(2 * row + 1) * D + c]; s += v[j]; }
    const float mu = wave_sum(s) * (1.f / D);
    float q = 0.f;
#pragma unroll
    for (int j = 0; j < 16; ++j) { v[j] -= mu; q += v[j] * v[j]; }
    const float r = rsqrtf(wave_sum(q) * (1.f / D) + EPS);
#pragma unroll
    for (int j = 0; j < 16; ++j) { const int c = lane + 64 * j; X[(size_t)row * D + c] = v[j] * r * g[c] + bta[c]; }
}

__global__ __launch_bounds__(256) void router(const float* __restrict__ X, const float* __restrict__ RW, const float* __restrict__ RB, float* __restrict__ GATE, int* CNT, int* LIST) {
    const int tok = blockIdx.x * 4 + (threadIdx.x >> 6), lane = threadIdx.x & 63;
    float acc[16];
#pragma unroll
    for (int e = 0; e < 16; ++e) acc[e] = 0.f;
    for (int j = 0; j < 16; ++j) {
        const int i = lane + 64 * j;
        const float x = X[(size_t)tok * D + i];
        const float4* w = (const float4*)(RW + (size_t)i * 16);
        const float4 w0 = w[0], w1 = w[1], w2 = w[2], w3 = w[3];
        acc[0] = fmaf(x, w0.x, acc[0]); acc[1] = fmaf(x, w0.y, acc[1]); acc[2] = fmaf(x, w0.z, acc[2]); acc[3] = fmaf(x, w0.w, acc[3]);
        acc[4] = fmaf(x, w1.x, acc[4]); acc[5] = fmaf(x, w1.y, acc[5]); acc[6] = fmaf(x, w1.z, acc[6]); acc[7] = fmaf(x, w1.w, acc[7]);
        acc[8] = fmaf(x, w2.x, acc[8]); acc[9] = fmaf(x, w2.y, acc[9]); acc[10] = fmaf(x, w2.z, acc[10]); acc[11] = fmaf(x, w2.w, acc[11]);
        acc[12] = fmaf(x, w3.x, acc[12]); acc[13] = fmaf(x, w3.y, acc[13]); acc[14] = fmaf(x, w3.z, acc[14]); acc[15] = fmaf(x, w3.w, acc[15]);
    }
    float sg[16], ss[16];
#pragma unroll
    for (int e = 0; e < 16; ++e) { sg[e] = sigmoidf_(wave_sum(acc[e])); ss[e] = sg[e] + RB[e]; }
    int best_g = 0; float best = -INFINITY;
#pragma unroll
    for (int gI = 0; gI < 4; ++gI) {
        float m1 = -INFINITY, m2 = -INFINITY;
#pragma unroll
        for (int k = 0; k < 4; ++k) { const float v = ss[gI * 4 + k]; if (v > m1) { m2 = m1; m1 = v; } else if (v > m2) { m2 = v; } }
        const float gs = m1 + m2;
        if (gs > best) { best = gs; best_g = gI; }
    }
    float c0 = 0.f, c1 = 0.f, c2 = 0.f, c3 = 0.f, t0 = 0.f, t1 = 0.f, t2 = 0.f, t3 = 0.f;
#pragma unroll
    for (int gI = 0; gI < 4; ++gI) if (gI == best_g) { c0 = ss[gI * 4]; c1 = ss[gI * 4 + 1]; c2 = ss[gI * 4 + 2]; c3 = ss[gI * 4 + 3]; t0 = sg[gI * 4]; t1 = sg[gI * 4 + 1]; t2 = sg[gI * 4 + 2]; t3 = sg[gI * 4 + 3]; }
    int i1 = 0; float v1 = c0, s1 = t0;
    if (c1 > v1) { i1 = 1; v1 = c1; s1 = t1; }
    if (c2 > v1) { i1 = 2; v1 = c2; s1 = t2; }
    if (c3 > v1) { i1 = 3; v1 = c3; s1 = t3; }
    int i2 = -1; float v2 = -INFINITY, s2 = 0.f;
    if (i1 != 0 && c0 > v2) { i2 = 0; v2 = c0; s2 = t0; }
    if (i1 != 1 && c1 > v2) { i2 = 1; v2 = c1; s2 = t1; }
    if (i1 != 2 && c2 > v2) { i2 = 2; v2 = c2; s2 = t2; }
    if (i1 != 3 && c3 > v2) { i2 = 3; v2 = c3; s2 = t3; }
    if (lane == 0) {
        const int e1 = best_g * 4 + i1, e2 = best_g * 4 + i2;
        const float inv = 1.f / (s1 + s2);
        GATE[tok * 2] = s1 * inv; GATE[tok * 2 + 1] = s2 * inv;
        const int p1 = atomicAdd(&CNT[e1], 1); LIST[e1 * NT + p1] = tok * 2;
        const int p2 = atomicAdd(&CNT[e2], 1); LIST[e2 * NT + p2] = tok * 2 + 1;
    }
}

__global__ __launch_bounds__(256) void moe_up(const float* __restrict__ X, const float* __restrict__ Wg, const float* __restrict__ Wu, const int* __restrict__ CNT, const int* __restrict__ LIST, float* __restrict__ HID) {
    extern __shared__ __attribute__((aligned(16))) float dyn_lds[];
    float (*xs)[16] = (float (*)[16])dyn_lds;
    int* asg_s = (int*)(dyn_lds + D * 16);
    const int e = blockIdx.y, start = blockIdx.x * 16, cnt = CNT[e];
    if (start >= cnt) return;
    const int n = min(16, cnt - start), tid = threadIdx.x;
    if (tid < 16) asg_s[tid] = tid < n ? LIST[e * NT + start + tid] : -1;
    __syncthreads();
    for (int i = tid; i < 16 * D; i += 256) { const int r = i >> 10, k = i & 1023; const int a = asg_s[r]; xs[k][r] = a >= 0 ? rb(X[(size_t)(a >> 1) * D + k]) : 0.f; }
    __syncthreads();
    float g0[16], g1[16], u0[16], u1[16];
#pragma unroll
    for (int r = 0; r < 16; ++r) { g0[r] = 0.f; g1[r] = 0.f; u0[r] = 0.f; u1[r] = 0.f; }
    const float* wg = Wg + (size_t)e * D * DE; const float* wu = Wu + (size_t)e * D * DE;
    for (int k = 0; k < D; ++k) {
        const float a0 = rb(wg[(size_t)k * DE + tid]), a1 = rb(wg[(size_t)k * DE + tid + 256]), b0 = rb(wu[(size_t)k * DE + tid]), b1 = rb(wu[(size_t)k * DE + tid + 256]);
#pragma unroll
        for (int r = 0; r < 16; ++r) { const float x = xs[k][r]; g0[r] = fmaf(x, a0, g0[r]); g1[r] = fmaf(x, a1, g1[r]); u0[r] = fmaf(x, b0, u0[r]); u1[r] = fmaf(x, b1, u1[r]); }
    }
#pragma unroll
    for (int r = 0; r < 16; ++r) { const int a = asg_s[r]; if (a >= 0) {
        HID[(size_t)a * DE + tid] = g0[r] * sigmoidf_(g0[r]) * u0[r]; HID[(size_t)a * DE + tid + 256] = g1[r] * sigmoidf_(g1[r]) * u1[r]; } }
}
__global__ __launch_bounds__(256) void moe_down(const float* __restrict__ HID, const float* __restrict__ Wd, const int* __restrict__ CNT, const int* __restrict__ LIST, float* __restrict__ YE) {
    __shared__ float hs[DE][16];
    __shared__ int asg_s[16];
    const int e = blockIdx.y, start = blockIdx.x * 16, cnt = CNT[e];
    if (start >= cnt) return;
    const int n = min(16, cnt - start), tid = threadIdx.x;
    if (tid < 16) asg_s[tid] = tid < n ? LIST[e * NT + start + tid] : -1;
    __syncthreads();
    for (int i = tid; i < 16 * DE; i += 256) { const int r = i >> 9, k = i & 511; const int a = asg_s[r]; hs[k][r] = a >= 0 ? rb(HID[(size_t)a * DE + k]) : 0.f; }
    __syncthreads();
    float y0[16], y1[16], y2[16], y3[16];
#pragma unroll
    for (int r = 0; r < 16; ++r) { y0[r] = 0.f; y1[r] = 0.f; y2[r] = 0.f; y3[r] = 0.f; }
    const float* wd = Wd + (size_t)e * DE * D;
    for (int k = 0; k < DE; ++k) {
        const float a0 = rb(wd[(size_t)k * D + tid]), a1 = rb(wd[(size_t)k * D + tid + 256]), a2 = rb(wd[(size_t)k * D + tid + 512]), a3 = rb(wd[(size_t)k * D + tid + 768]);
#pragma unroll
        for (int r = 0; r < 16; ++r) { const float x = hs[k][r]; y0[r] = fmaf(x, a0, y0[r]); y1[r] = fmaf(x, a1, y1[r]); y2[r] = fmaf(x, a2, y2[r]); y3[r] = fmaf(x, a3, y3[r]); }
    }
#pragma unroll
    for (int r = 0; r < 16; ++r) { const int a = asg_s[r]; if (a >= 0) { float* y = YE + (size_t)a * D; y[tid] = rb(y0[r]); y[tid + 256] = rb(y1[r]); y[tid + 512] = rb(y2[r]); y[tid + 768] = rb(y3[r]); } }
}

}

namespace rws {
constexpr size_t Z = 0;
constexpr size_t AB = Z + (size_t)NT * INW;
constexpr size_t Q = AB + (size_t)NT * 1024;
constexpr size_t KV = Q + (size_t)NT * QL;
constexpr size_t KPE = KV + (size_t)NT * 1024;
constexpr size_t MIX = KPE + (size_t)NT * 64;
constexpr size_t GATE = MIX + (size_t)NT * 1024;
constexpr size_t CNT = GATE + (size_t)NT * 2;
constexpr size_t LIST = CNT + 64;
constexpr size_t END = LIST + (size_t)NE * NT;
}


#endif
#ifndef MODE
#define MODE 1
#endif
#define LAS __attribute__((address_space(3)))
#ifndef PH
#define PH(k) 1
#endif
#ifndef DUP
#define DUP(k) 0
#define LDS_SYNC() do { asm volatile("s_waitcnt lgkmcnt(0)" ::: "memory"); __builtin_amdgcn_s_barrier(); asm volatile("" ::: "memory"); } while (0)
#endif
#define TID() ({ int _t = (int)threadIdx.x; asm volatile("" : "+v"(_t)); _t; })
#define BID() ({ int _b = (int)blockIdx.x; asm volatile("" : "+s"(_b)); _b; })
#define GDIM() ({ int _g = (int)gridDim.x; asm volatile("" : "+s"(_g)); _g; })
#define GAS __attribute__((address_space(1)))
typedef unsigned short bf16_t;
typedef short bf16x8 __attribute__((ext_vector_type(8)));
typedef float f32x4 __attribute__((ext_vector_type(4)));
typedef float f32x2 __attribute__((ext_vector_type(2)));
typedef unsigned u32x4 __attribute__((ext_vector_type(4)));
typedef unsigned u32x2 __attribute__((ext_vector_type(2)));

__device__ __forceinline__ unsigned f2bf(float f) { unsigned u = __builtin_bit_cast(unsigned, f); return (u + 0x7fffu + ((u >> 16) & 1u)) >> 16; }
__device__ __forceinline__ unsigned pk2(float lo, float hi) { return f2bf(lo) | (f2bf(hi) << 16); }
__device__ __forceinline__ float bf2f(unsigned short h) { return __builtin_bit_cast(float, (unsigned)h << 16); }
__device__ __forceinline__ float bflo(unsigned w) { return __builtin_bit_cast(float, w << 16); }
__device__ __forceinline__ float bfhi(unsigned w) { return __builtin_bit_cast(float, w & 0xffff0000u); }

namespace pg8 {
constexpr int BM = 256, BK = 64, HALF = 128, HTB = HALF * BK * 2, STAGE_BYTES = 8 * HTB;
__host__ __device__ __forceinline__ int lds_byte(int r, int c) { const int st = (r >> 4) * 2 + (c >> 5), rr = r & 15, cc = c & 31, ob = rr * 64 + cc * 2; return st * 1024 + (ob ^ (((ob >> 9) & 1) << 5)); }
__host__ __device__ __forceinline__ void stage_rc(int b, int& R, int& C) { const int st = b / 1024, sb = b % 1024, swz = sb ^ (((sb >> 9) & 1) << 5); R = (st >> 1) * 16 + swz / 64; C = (st & 1) * 32 + (swz % 64) / 2; }
__host__ __device__ __forceinline__ int perm32(int rho) { const int n = rho >> 4, i = rho & 15; return 8 * (i >> 2) + 4 * n + (i & 3); }

struct UnitD { const char* A; const int* rows; const char* B; unsigned lda, ldb; int nt; int type, pm, pn, aux; };

__device__ __forceinline__ unsigned cvt_pk_bf16(float lo, float hi) { unsigned r; asm volatile("v_cvt_pk_bf16_f32 %0, %1, %2" : "=v"(r) : "v"(lo), "v"(hi)); return r; }

template <bool PERM, class Sched, class Epi>
__device__ __forceinline__ void gemm_phase(LAS unsigned char* lds, const Sched& S, const Epi& E) {
    const int tid = TID(), wid = __builtin_amdgcn_readfirstlane(tid >> 6), wr = wid >> 2;
    const size_t kstep = (size_t)(BK * 2);
    const unsigned ldsw = (unsigned)wid * 1024u;
    int aoff, boff; { const int lane = tid & 63, wc = wid & 3, fr = lane & 15, fq = lane >> 4; aoff = lds_byte(wr * 64 + fr, fq * 8); boff = lds_byte(wc * 32 + fr, fq * 8); }
#define PG8_SA(b, h) (((b) * 2 + (h)) * HTB)
#define PG8_SB(b, h) ((4 + (b) * 2 + (h)) * HTB)
#define PG8_STAGE(bufoff, gbase, voff) do { _Pragma("unroll") for (int _i = 0; _i < 2; ++_i) \
        __builtin_amdgcn_global_load_lds((const unsigned*)((const char*)(gbase) + (voff)[_i]), (LAS unsigned*)(lds + (bufoff) + ldsw + _i * 8192), 16, 0, 0); } while (0)
#define PG8_LDA(dst, b, h) do { _Pragma("unroll") for (int m = 0; m < 4; ++m) _Pragma("unroll") for (int k = 0; k < 2; ++k) dst[m][k] = *(const LAS bf16x8*)(lds + PG8_SA(b, h) + aoff + m * 2048 + k * 1024); } while (0)
#define PG8_LDB(dst, b, h) do { _Pragma("unroll") for (int n = 0; n < 2; ++n) _Pragma("unroll") for (int k = 0; k < 2; ++k) dst[n][k] = *(const LAS bf16x8*)(lds + PG8_SB(b, h) + boff + n * 2048 + k * 1024); } while (0)
#define PG8_MMA(ai, bj, At, Bt) do { __builtin_amdgcn_s_setprio(1); _Pragma("unroll") for (int m = 0; m < 4; ++m) _Pragma("unroll") for (int n = 0; n < 2; ++n) _Pragma("unroll") for (int k = 0; k < 2; ++k) \
        acc[ai][bj][m][n] = __builtin_amdgcn_mfma_f32_16x16x32_bf16(Bt[n][k], At[m][k], acc[ai][bj][m][n], 0, 0, 0); __builtin_amdgcn_s_setprio(0); } while (0)
#define PG8_WAIT_V(n) asm volatile("s_waitcnt vmcnt(" #n ")" ::: "memory")
#define PG8_WAIT_L(n) asm volatile("s_waitcnt lgkmcnt(" #n ")" ::: "memory")
#define PG8_BAR __builtin_amdgcn_s_barrier()
#define PG8_SCHED __builtin_amdgcn_sched_barrier(0)
#define PG8_OFFS(u) do { int t_ = tid; asm volatile("" : "+v"(t_)); int R0, C0, R1, C1; stage_rc(t_ * 16, R0, C0); stage_rc(t_ * 16 + 8192, R1, C1); \
        const int RB0 = PERM ? ((R0 & ~31) + perm32(R0 & 31)) : R0, RB1 = PERM ? ((R1 & ~31) + perm32(R1 & 31)) : R1; const unsigned Cb = (unsigned)C0 * 2u; \
        if ((u).rows) { vA[0][0] = (unsigned)(u).rows[R0] * (u).lda + Cb; vA[0][1] = (unsigned)(u).rows[R1] * (u).lda + Cb; \
                                        vA[1][0] = (unsigned)(u).rows[128 + R0] * (u).lda + Cb; vA[1][1] = (unsigned)(u).rows[128 + R1] * (u).lda + Cb; } \
        else { vA[0][0] = (unsigned)R0 * (u).lda + Cb; vA[0][1] = (unsigned)R1 * (u).lda + Cb; vA[1][0] = (unsigned)(128 + R0) * (u).lda + Cb; vA[1][1] = (unsigned)(128 + R1) * (u).lda + Cb; } \
        vB[0] = (unsigned)RB0 * (u).ldb + Cb; vB[1] = (unsigned)RB1 * (u).ldb + Cb; hB = (size_t)128 * (u).ldb; } while (0)
#define PG8_EPI(u) do { int t_ = tid; asm volatile("" : "+v"(t_)); const int lane_ = t_ & 63; E(acc, (u), wr, wid & 3, lane_ & 15, lane_ >> 4); if (DUP(16)) E(acc, (u), wr, wid & 3, lane_ & 15, lane_ >> 4); if constexpr (Sched::HOOKS) S.done((u), lane_); } while (0)
    UnitD cur, nxt; int ui = 0;
    if (!S.next(0, cur)) return;
    f32x4 acc[2][2][4][2];
#pragma unroll
    for (int a = 0; a < 2; ++a)
#pragma unroll
        for (int b = 0; b < 2; ++b)
#pragma unroll
            for (int m = 0; m < 4; ++m)
#pragma unroll
                for (int n = 0; n < 2; ++n) acc[a][b][m][n] = (f32x4){0.f, 0.f, 0.f, 0.f};
    bf16x8 At[4][2], B0[2][2], B1[2][2];
    unsigned vA[2][2], vB[2]; size_t hB;
    if constexpr (Sched::HOOKS) S.a_ready(cur, wid);
    PG8_OFFS(cur);
    const char* cA = cur.A; const char* cB = cur.B; int nt = cur.nt;
    PG8_STAGE(PG8_SB(0, 0), cB, vB); PG8_STAGE(PG8_SB(0, 1), cB + hB, vB); PG8_STAGE(PG8_SA(0, 0), cA, vA[0]); PG8_STAGE(PG8_SA(0, 1), cA, vA[1]);
    if (wr == 1) PG8_BAR;
    PG8_WAIT_V(2); PG8_BAR;
    PG8_STAGE(PG8_SB(1, 0), cB + kstep, vB); PG8_STAGE(PG8_SA(1, 0), cA + kstep, vA[0]); PG8_STAGE(PG8_SB(1, 1), cB + hB + kstep, vB);
    PG8_WAIT_V(6); PG8_BAR;
    for (;;) {
        const bool has_next = S.next(ui + 1, nxt);
        for (int t = 0; t < nt; t += 2) {
            const bool last = (t == nt - 2);
            if constexpr (Sched::HOOKS) { if (last && has_next) S.a_ready(nxt, wid); }
            const char* a1 = cA + (size_t)(t + 1) * kstep;
            PG8_LDB(B0, 0, 0); PG8_LDB(B1, 0, 1); PG8_SCHED; PG8_LDA(At, 0, 0); PG8_STAGE(PG8_SA(1, 1), a1, vA[1]);
            PG8_WAIT_V(8); PG8_WAIT_L(0); PG8_BAR; PG8_MMA(0, 0, At, B0); PG8_MMA(0, 1, At, B1); PG8_BAR; PG8_SCHED;
            const char* a2; const char* b2;
            if (last) { if (has_next) { PG8_OFFS(nxt); a2 = nxt.A; b2 = nxt.B; } else { a2 = cA; b2 = cB; } }
            else { a2 = cA + (size_t)(t + 2) * kstep; b2 = cB + (size_t)(t + 2) * kstep; }
            const char* a3 = a2 + kstep; const char* b3 = b2 + kstep;
            PG8_LDA(At, 0, 1); PG8_STAGE(PG8_SB(0, 0), b2, vB); PG8_STAGE(PG8_SB(0, 1), b2 + hB, vB); PG8_STAGE(PG8_SA(0, 0), a2, vA[0]);
            PG8_WAIT_V(8); PG8_WAIT_L(0); PG8_BAR; PG8_MMA(1, 0, At, B0); PG8_MMA(1, 1, At, B1); PG8_BAR; PG8_SCHED;
            PG8_LDB(B0, 1, 0); PG8_LDB(B1, 1, 1); PG8_SCHED; PG8_LDA(At, 1, 0); PG8_STAGE(PG8_SA(0, 1), a2, vA[1]);
            PG8_WAIT_V(8); PG8_WAIT_L(0); PG8_BAR; PG8_MMA(0, 0, At, B0); PG8_MMA(0, 1, At, B1); PG8_BAR; PG8_SCHED;
            PG8_LDA(At, 1, 1); PG8_STAGE(PG8_SB(1, 0), b3, vB); PG8_STAGE(PG8_SB(1, 1), b3 + hB, vB); PG8_STAGE(PG8_SA(1, 0), a3, vA[0]);
            PG8_WAIT_V(8); PG8_WAIT_L(0); PG8_BAR; PG8_MMA(1, 0, At, B0); PG8_MMA(1, 1, At, B1); PG8_BAR; PG8_SCHED;
        }
        if (wr == 0) PG8_BAR;
        PG8_EPI(cur);
        if (!has_next) break;
#pragma unroll
        for (int a = 0; a < 2; ++a)
#pragma unroll
            for (int b = 0; b < 2; ++b)
#pragma unroll
                for (int m = 0; m < 4; ++m)
#pragma unroll
                    for (int n = 0; n < 2; ++n) acc[a][b][m][n] = (f32x4){0.f, 0.f, 0.f, 0.f};
        cur = nxt; cA = nxt.A; cB = nxt.B; nt = nxt.nt; ++ui;
        if (wr == 1) PG8_BAR;
    }
    PG8_WAIT_V(0);
    PG8_BAR;
#undef PG8_SA
#undef PG8_SB
#undef PG8_STAGE
#undef PG8_LDA
#undef PG8_LDB
#undef PG8_MMA
#undef PG8_WAIT_V
#undef PG8_WAIT_L
#undef PG8_BAR
#undef PG8_SCHED
#undef PG8_OFFS
#undef PG8_EPI
}
__device__ __forceinline__ void tile_order(int L, int nM, int nN, int& pm, int& pn) {
    const int nwg = nM * nN; int wgid = L;
    { const int q = nwg / 8, r = nwg % 8, xcd = wgid % 8, off = wgid / 8; wgid = (xcd < r ? xcd * (q + 1) : r * (q + 1) + (xcd - r) * q) + off; }
    const int nig = 8 * nN, gid = wgid / nig, fm = gid * 8, gsz = (nM - fm) < 8 ? (nM - fm) : 8;
    pm = fm + ((wgid % nig) % gsz); pn = (wgid % nig) / gsz;
}
}

#define XB_TMO      128
#define XB_XCNT(j)  (256  + 64 * (j))
#define XB_XSUB(j)  (1280 + 64 * (j))
#define XB_XGEN(j)  (2304 + 64 * (j))
#define XB_TOP      3328
#define XB_TOPGEN   3392
#define XCD_BAR_WORDS 3456
#define XB_SPIN_CAP (1u << 18)
__device__ __forceinline__ unsigned xb_ld(unsigned* p)              { return __hip_atomic_load(p, __ATOMIC_RELAXED, __HIP_MEMORY_SCOPE_AGENT); }
__device__ __forceinline__ unsigned xb_add(unsigned* p, unsigned v) { return __hip_atomic_fetch_add(p, v, __ATOMIC_RELAXED, __HIP_MEMORY_SCOPE_AGENT); }
__device__ __forceinline__ unsigned xb_xcc_id() { return (unsigned)__builtin_amdgcn_s_getreg((3 << 11) | 20) & 0xFu; }
#define XB_SPIN(cond, bar) do { unsigned _sp = 0; while (cond) { __builtin_amdgcn_s_sleep(1); \
    if ((++_sp & 255u) == 0u) { if (xb_ld(&(bar)[XB_TMO])) break; if (_sp > XB_SPIN_CAP) { atomicAdd(&(bar)[XB_TMO], 1u); break; } } } } while (0)
struct XcdBarrier { unsigned* bar; unsigned x; volatile LAS unsigned* st; };
__device__ __forceinline__ XcdBarrier xcd_barrier_post(unsigned* bar, volatile LAS unsigned* st) {
    XcdBarrier b; b.bar = bar; b.x = xb_xcc_id(); b.st = st;
    if (threadIdx.x == 0) (void)xb_add(&bar[XB_XCNT(b.x)], 1u);
    return b;
}
__device__ __forceinline__ void xcd_barrier_complete(unsigned* bar, unsigned x, unsigned& nloc, unsigned& nx) {
    const unsigned G = gridDim.x * gridDim.y * gridDim.z;
    unsigned sum, cnt, mine, sp = 0u;
    for (;;) {
        sum = 0u; cnt = 0u;
#pragma unroll
        for (unsigned j = 0; j < 16; ++j) { const unsigned c = xb_ld(&bar[XB_XCNT(j)]); sum += c; cnt += (c > 0u) ? 1u : 0u; }
        if (sum == G) break;
        __builtin_amdgcn_s_sleep(1);
        if ((++sp & 255u) == 0u) { if (xb_ld(&bar[XB_TMO])) break; if (sp > XB_SPIN_CAP) { atomicAdd(&bar[XB_TMO], 1u); break; } }
    }
    mine = xb_ld(&bar[XB_XCNT(x)]);
    nloc = mine > 0u ? mine : 1u; nx = cnt > 0u ? cnt : 1u;
}
__device__ __forceinline__ void xcd_barrier(const XcdBarrier& b) {
    asm volatile("s_waitcnt vmcnt(0)" ::: "memory");
    __syncthreads();
    if (threadIdx.x == 0) {
        unsigned* bar = b.bar; unsigned bx_ = b.x;
        asm volatile("" : "+s"(bar), "+s"(bx_));
        __builtin_amdgcn_s_waitcnt(0);
        unsigned nloc = b.st[0], nx = b.st[1];
        if (nloc == 0u) { xcd_barrier_complete(bar, bx_, nloc, nx); b.st[0] = nloc; b.st[1] = nx; }
        const unsigned old = xb_add(&bar[XB_XSUB(bx_)], 1u);
        const unsigned gen = old / nloc;
        if (old + 1u == (gen + 1u) * nloc) {
            __builtin_amdgcn_fence(__ATOMIC_RELEASE, "agent");
            asm volatile("s_waitcnt vmcnt(0)" ::: "memory");
            const unsigned og = xb_add(&bar[XB_TOP], 1u);
            const unsigned tg = og / nx;
            if (og + 1u == (tg + 1u) * nx) xb_add(&bar[XB_TOPGEN], 1u);
            else XB_SPIN(xb_ld(&bar[XB_TOPGEN]) == tg, bar);
            __builtin_amdgcn_fence(__ATOMIC_ACQUIRE, "agent");
            xb_add(&bar[XB_XGEN(bx_)], 1u);
            asm volatile("s_waitcnt vmcnt(0)" ::: "memory");
        } else {
            XB_SPIN(xb_ld(&bar[XB_XGEN(bx_)]) == gen, bar);
            __builtin_amdgcn_fence(__ATOMIC_ACQUIRE, "agent");
            asm volatile("s_waitcnt vmcnt(0)" ::: "memory");
        }
    }
    __syncthreads();
}

constexpr int PREPQ_W = 60000;
constexpr int MOECNT_W = 16384;
constexpr int ZW = 2304;
constexpr int NWAVES = 8, NTHREADS = 512;
constexpr int RING_BYTES = 131072, LDS_BYTES = 163840, LDSCTL_OFF = LDS_BYTES - 4096, MISC_OFF = LDSCTL_OFF + 320, TAB_OFF = LDSCTL_OFF + 1024;
struct OW {
    const float* in[24];
    float* X;
    unsigned* ctl;
    bf16_t* XB;
    bf16_t* Z;
    float* SSQ;
    bf16_t *Win_t, *Wq_t, *Wkv_t, *Wo_t, *Wgu_t, *Wd_t, *Wlg_t;
    bf16_t* RWH; float* RGB;
    f32x2* ROPE;
    bf16_t *Q, *KN, *VV, *KPE;
    float *A, *DRV, *AGA, *AGB;
    bf16_t* OP; f32x2* ML;
    bf16_t* MIX; bf16_t* Y;
    int *EIDX, *HIST, *LRANK, *DEST, *ROWTOK; float* GATE;
    bf16_t *HE, *YE;
};

namespace ows {
constexpr size_t MiB = 1u << 20;
constexpr size_t CTL = 0, ROPE = 1 * MiB, SSQ = 2 * MiB, EIDX = 3 * MiB, GATE = EIDX + 131072, LRANK = GATE + 131072, DEST = LRANK + 131072, HIST = DEST + 131072, ROWTOK = HIST + 16384;
constexpr size_t AGA = 4 * MiB, AGB = AGA + 524288, ML = 5 * MiB, WLG = 6 * MiB, WIN = 7 * MiB, WQ = 12 * MiB, WKV = 14 * MiB, WO = 15 * MiB, WGU = 17 * MiB, WD = 49 * MiB;
constexpr size_t XB = 65 * MiB, Z = 97 * MiB, Y = Z, A = 169 * MiB, DRV = 201 * MiB, Q = 233 * MiB, YE = A, KN = 257 * MiB, VV = 273 * MiB, KPE = 289 * MiB, OP = 291 * MiB, HE = KN, MIX = 323 * MiB, WSET1 = 355 * MiB - WLG  , END = 414 * MiB;
static_assert(ROWTOK + 36864 * 4 <= AGA && WIN + (size_t)ZW * D * 2 <= WQ && YE + (size_t)36864 * 1024 * 2 <= KN && HE + (size_t)36864 * 512 * 2 <= OP + 32 * MiB && Z + (size_t)NT * ZW * 2 <= A, "opt workspace map");
}
__device__ __forceinline__ void tr_item(const float* W, int ldw, int k0, int n0, bf16_t* WT, int ldt, int drow0, const float* g, LAS float* scr, int lane) {
    float tv[32];
#pragma unroll
    for (int i = 0; i < 32; ++i) { const int kk = 2 * i + (lane >> 5); tv[i] = W[(size_t)(k0 + kk) * ldw + n0 + (lane & 31)]; }
    if (g) {
#pragma unroll
        for (int i = 0; i < 32; ++i) tv[i] *= g[k0 + 2 * i + (lane >> 5)]; }
#pragma unroll
    for (int i = 0; i < 32; ++i) scr[(2 * i + (lane >> 5)) * 33 + (lane & 31)] = tv[i];
    asm volatile("s_waitcnt lgkmcnt(0)" ::: "memory");
    const int c = lane & 7;
#pragma unroll
    for (int j = 0; j < 4; ++j) { const int n = (lane >> 3) + 8 * j; const LAS float* s = scr + (8 * c) * 33 + n;
        u32x4 o; o.x = pk2(s[0 * 33], s[1 * 33]); o.y = pk2(s[2 * 33], s[3 * 33]); o.z = pk2(s[4 * 33], s[5 * 33]); o.w = pk2(s[6 * 33], s[7 * 33]);
        *(u32x4*)(WT + (size_t)(drow0 + n) * ldt + k0 + 8 * c) = o; }
    asm volatile("s_waitcnt lgkmcnt(0)" ::: "memory");
}
struct PrepItem { const float* W; const float* g; bf16_t* WT; int ldw, ldt, k0, n0, drow0, ncols; };
__device__ __forceinline__ PrepItem prep_item(const OW& P, int l, int it) {
    const float* w_in = P.in[1] + (size_t)l * D * INW;
    const float* qng = P.in[9] + (size_t)l * QL;   const float* w_q = P.in[10] + (size_t)l * QL * 768;
    const float* kvng = P.in[11] + (size_t)l * KVL; const float* w_kv = P.in[12] + (size_t)l * KVL * 1024;
    const float* ong = P.in[13] + (size_t)l * 1024; const float* w_o = P.in[14] + (size_t)l * 1024 * D;
    const float* wg = P.in[19] + (size_t)l * NE * D * DE; const float* wu = P.in[20] + (size_t)l * NE * D * DE; const float* wd = P.in[21] + (size_t)l * NE * DE * D;
    constexpr int I_IN = 8 * 17, I_Q = 6 * 6, I_KV = 2 * 8, I_O = 8 * 8, I_G = 16 * 8 * 4, I_D = 16 * 4 * 8;
    PrepItem p; int r = it;
    if (r < I_IN) { const int kb = r / 17, nb = r % 17; p = PrepItem{w_in, nullptr, P.Win_t, INW, D, 128 * kb, 128 * nb, 128 * nb, nb == 16 ? 64 : 128}; return p; } r -= I_IN;
    if (r < I_Q) { const int kb = r / 6, nb = r % 6; p = PrepItem{w_q, qng, P.Wq_t, 768, QL, 128 * kb, 128 * nb, 128 * nb, 128}; return p; } r -= I_Q;
    if (r < I_KV) { const int kb = r / 8, nb = r % 8; p = PrepItem{w_kv, kvng, P.Wkv_t, 1024, KVL, 128 * kb, 128 * nb, 128 * nb, 128}; return p; } r -= I_KV;
    if (r < I_O) { const int kb = r / 8, nb = r % 8; p = PrepItem{w_o, ong, P.Wo_t, D, 1024, 128 * kb, 128 * nb, 128 * nb, 128}; return p; } r -= I_O;
    if (r < 2 * I_G) { const int up = r >= I_G; if (up) r -= I_G; const int e = r >> 5, q = r & 31, kb = q >> 2, nb = q & 3;
        p = PrepItem{(up ? wu : wg) + (size_t)e * D * DE, nullptr, P.Wgu_t + (size_t)e * 1024 * 1024, DE, 1024, 128 * kb, 128 * nb, 256 * nb + 128 * up, 128}; return p; }
    r -= 2 * I_G;
    { const int e = r >> 5, q = r & 31, kb = q >> 3, nb = q & 7; p = PrepItem{wd + (size_t)e * DE * D, nullptr, P.Wd_t + (size_t)e * 1024 * DE, D, DE, 128 * kb, 128 * nb, 128 * nb, 128}; }
    return p;
}
__device__ __forceinline__ void prep_weights(const OW& P, int l, LAS unsigned char* lds, int vcu, int G, int it0 = 0, int it1 = 1 << 30, int tail = 3) {
    const int tid = TID();
    LAS float* scr = (LAS float*)lds;
    constexpr int NITEMS = 8 * 17 + 6 * 6 + 2 * 8 + 8 * 8 + 2 * 16 * 8 * 4 + 16 * 4 * 8;
    const int lr = tid >> 5, lc = (tid & 31) * 4;
    const int tn = tid & 127, tq = tid >> 7;
    f32x4 v[8];
#define PW_LOAD(p_) do { _Pragma("unroll") for (int i = 0; i < 8; ++i) { const int kk = lr + 16 * i; v[i] = (f32x4){0.f, 0.f, 0.f, 0.f}; \
        if (lc < (p_).ncols) { v[i] = *(const f32x4*)((p_).W + (size_t)((p_).k0 + kk) * (p_).ldw + (p_).n0 + lc); if ((p_).g) v[i] = v[i] * (p_).g[(p_).k0 + kk]; } } } while (0)
    const int ITE = it1 < NITEMS ? it1 : NITEMS;
    int it = it0 + vcu;
    PrepItem cur; if (it < ITE) { cur = prep_item(P, l, it); PW_LOAD(cur); }
    for (; it < ITE; it += G) {
#pragma unroll
        for (int i = 0; i < 8; ++i) { const int kk = lr + 16 * i; scr[kk * 129 + lc] = v[i][0]; scr[kk * 129 + lc + 1] = v[i][1]; scr[kk * 129 + lc + 2] = v[i][2]; scr[kk * 129 + lc + 3] = v[i][3]; }
        const PrepItem me = cur;
        if (it + G < ITE) { cur = prep_item(P, l, it + G); PW_LOAD(cur); }
        LDS_SYNC();
        { bf16_t* dst = me.WT + (size_t)(me.drow0 + tn) * me.ldt + me.k0 + 32 * tq; const LAS float* sc = scr + (32 * tq) * 129 + tn;
#pragma unroll
          for (int c = 0; c < 4; ++c) { u32x4 o; o.x = pk2(sc[(8 * c + 0) * 129], sc[(8 * c + 1) * 129]); o.y = pk2(sc[(8 * c + 2) * 129], sc[(8 * c + 3) * 129]);
              o.z = pk2(sc[(8 * c + 4) * 129], sc[(8 * c + 5) * 129]); o.w = pk2(sc[(8 * c + 6) * 129], sc[(8 * c + 7) * 129]); *(u32x4*)(dst + 8 * c) = o; } }
        LDS_SYNC();
    }
#undef PW_LOAD
    if (tail & 1) { const int gt = vcu * NTHREADS + tid, NGT = G * NTHREADS; unsigned zz = 0u; asm volatile("" : "+v"(zz)); const u32x4 z = {zz, zz, zz, zz};
      for (int i = gt; i < 128 * 128; i += NGT) *(u32x4*)(P.Win_t + (size_t)2176 * D + (size_t)i * 8) = z; }
    if (tail & 2) { const int gt = vcu * NTHREADS + tid, NGT = G * NTHREADS;
      const float* w_r = P.in[4] + (size_t)l * 8 * 64 * 64; const float* w_i = P.in[6] + (size_t)l * 8 * 64 * 64;
      for (int i = gt; i < 8 * 128 * 64; i += NGT) { const int k = i & 63, j = (i >> 6) & 127, n = i >> 13; const int w = j >> 4, q = j & 15; const int d = 8 * w + (q & 7);
          const float v_ = (q < 8 ? w_r : w_i)[((size_t)n * 64 + k) * 64 + d]; P.Wlg_t[i] = (bf16_t)f2bf(v_); }
      const float* rw = P.in[17]; const float* g1 = P.in[15] + (size_t)l * D; const float* b1 = P.in[16] + (size_t)l * D;
      for (int i = gt; i < 16 * 1024; i += NGT) { const int k = i & 1023, e = i >> 10; const float v_ = g1[k] * rw[k * 16 + e]; const unsigned hi_ = f2bf(v_); const float rem = v_ - bf2f((unsigned short)hi_);
          P.RWH[e * 1024 + k] = (bf16_t)hi_; P.RWH[(16 + e) * 1024 + k] = (bf16_t)f2bf(rem); }
      { const int gwv = gt >> 6, ln = gt & 63;
        if (gwv < 32) { const int e = gwv & 15; const float* src = gwv < 16 ? g1 : b1; float acc = 0.f; float sa[16], sb[16];
#pragma unroll
            for (int j = 0; j < 16; ++j) { const int k = ln + 64 * j; sa[j] = src[k]; sb[j] = rw[k * 16 + e]; }
            __builtin_amdgcn_sched_barrier(0);
#pragma unroll
            for (int j = 0; j < 16; ++j) acc = fmaf(sa[j], sb[j], acc);
#pragma unroll
            for (int o = 1; o < 64; o <<= 1) acc += __shfl_xor(acc, o);
            if (ln == 0) P.RGB[gwv] = acc; } } }
}
__device__ __forceinline__ void prep_queue(const OW& P, int l, LAS unsigned char* lds, unsigned* ctr, int it0, int it1) {
    const int tid = TID();
    LAS float* scr = (LAS float*)lds;
    volatile LAS int* slot = (volatile LAS int*)(lds + MISC_OFF + 192);
    constexpr int NALL = 8 * 17 + 6 * 6 + 2 * 8 + 8 * 8 + 2 * 16 * 8 * 4 + 16 * 4 * 8; const int NITEMS = it1 < NALL ? it1 : NALL;
    const int lr = tid >> 5, lc = (tid & 31) * 4;
    const int tn = tid & 127, tq = tid >> 7;
    f32x4 v[8];
#define PW_LOAD(p_) do { _Pragma("unroll") for (int i = 0; i < 8; ++i) { const int kk = lr + 16 * i; v[i] = (f32x4){0.f, 0.f, 0.f, 0.f}; \
        if (lc < (p_).ncols) { v[i] = *(const f32x4*)((p_).W + (size_t)((p_).k0 + kk) * (p_).ldw + (p_).n0 + lc); if ((p_).g) v[i] = v[i] * (p_).g[(p_).k0 + kk]; } } } while (0)
    LDS_SYNC();
    if (tid == 0) slot[0] = it0 + (int)__hip_atomic_fetch_add(ctr, 2u, __ATOMIC_RELAXED, __HIP_MEMORY_SCOPE_AGENT);
    LDS_SYNC();
    int it = __builtin_amdgcn_readfirstlane(slot[0]); int nxt = it + 1;
    PrepItem cur; if (it < NITEMS) { cur = prep_item(P, l, it); PW_LOAD(cur); }
    while (it < NITEMS) {
        unsigned got = 0u; if (tid == 0) got = __hip_atomic_fetch_add(ctr, 1u, __ATOMIC_RELAXED, __HIP_MEMORY_SCOPE_AGENT);
#pragma unroll
        for (int i = 0; i < 8; ++i) { const int kk = lr + 16 * i; scr[kk * 129 + lc] = v[i][0]; scr[kk * 129 + lc + 1] = v[i][1]; scr[kk * 129 + lc + 2] = v[i][2]; scr[kk * 129 + lc + 3] = v[i][3]; }
        const PrepItem me = cur;
        if (nxt < NITEMS) { cur = prep_item(P, l, nxt); PW_LOAD(cur); }
        LDS_SYNC();
        { bf16_t* dst = me.WT + (size_t)(me.drow0 + tn) * me.ldt + me.k0 + 32 * tq; const LAS float* sc = scr + (32 * tq) * 129 + tn;
#pragma unroll
          for (int c = 0; c < 4; ++c) { u32x4 o; o.x = pk2(sc[(8 * c + 0) * 129], sc[(8 * c + 1) * 129]); o.y = pk2(sc[(8 * c + 2) * 129], sc[(8 * c + 3) * 129]);
              o.z = pk2(sc[(8 * c + 4) * 129], sc[(8 * c + 5) * 129]); o.w = pk2(sc[(8 * c + 6) * 129], sc[(8 * c + 7) * 129]); *(u32x4*)(dst + 8 * c) = o; } }
        if (tid == 0) slot[0] = it0 + (int)got;
        LDS_SYNC();
        it = nxt; nxt = __builtin_amdgcn_readfirstlane(slot[0]);
    }
#undef PW_LOAD
}
__device__ __forceinline__ void prep_tables(const OW& P, int vcu, int G) {
    const int gt = vcu * NTHREADS + TID(), NGT = G * NTHREADS;
    for (int i = gt; i < S * 32; i += NGT) { const int s = i >> 5, j = i & 31; const float inv = powf(10000.0f, -(float)j / 32.0f); const float ang = (float)s * inv; P.ROPE[i] = (f32x2){cosf(ang), sinf(ang)}; }
    const float* x = P.in[0];
    for (size_t i0 = gt; i0 < (size_t)NT * D / 8; i0 += (size_t)4 * NGT) { f32x4 a[4], b[4];
#pragma unroll
        for (int q = 0; q < 4; ++q) { const size_t i = i0 + (size_t)q * NGT; if (i < (size_t)NT * D / 8) { a[q] = *(const f32x4*)(x + i * 8); b[q] = *(const f32x4*)(x + i * 8 + 4); } }
#pragma unroll
        for (int q = 0; q < 4; ++q) { const size_t i = i0 + (size_t)q * NGT; if (i < (size_t)NT * D / 8) { u32x4 o; o.x = pg8::cvt_pk_bf16(a[q][0], a[q][1]); o.y = pg8::cvt_pk_bf16(a[q][2], a[q][3]); o.z = pg8::cvt_pk_bf16(b[q][0], b[q][1]); o.w = pg8::cvt_pk_bf16(b[q][2], b[q][3]); *(u32x4*)(P.XB + i * 8) = o; } } }
}

struct SchedInProj {
    static constexpr bool HOOKS = false;
    const OW* P; int G, c;
    __device__ __forceinline__ bool next(int i, pg8::UnitD& u) const {
        const int L = i * G + c; if (L >= 64 * 9) return false;
        int pm, pn; pg8::tile_order(L, 64, 9, pm, pn);
        u.A = (const char*)(P->XB + (size_t)pm * 256 * D); u.rows = nullptr; u.B = (const char*)(P->Win_t + (size_t)pn * 256 * D); u.lda = D * 2; u.ldb = D * 2; u.nt = D / 64; u.type = 0; u.pm = pm; u.pn = pn; u.aux = 0;
        return true;
    }
};
struct EpiInProj {
    bf16_t* Z; float* SSQ;
    __device__ __forceinline__ void operator()(const f32x4 (&acc)[2][2][4][2], const pg8::UnitD& u, int wr, int wc, int fr, int fq) const {
        const int row0 = u.pm * 256 + wr * 64 + fr, col0 = u.pn * 256 + wc * 32 + 8 * fq;
        const bool stats = u.pn >= 4 && u.pn < 8;
#pragma unroll
        for (int ai = 0; ai < 2; ++ai)
#pragma unroll
            for (int m = 0; m < 4; ++m) { const int row = row0 + ai * 128 + m * 16; bf16_t* rowp = Z + (size_t)row * ZW + col0; float ss = 0.f;
#pragma unroll
                for (int bj = 0; bj < 2; ++bj) { const f32x4 v0 = acc[ai][bj][m][0], v1 = acc[ai][bj][m][1];
                    ss += (v0[0] * v0[0] + v0[1] * v0[1]) + (v0[2] * v0[2] + v0[3] * v0[3]) + (v1[0] * v1[0] + v1[1] * v1[1]) + (v1[2] * v1[2] + v1[3] * v1[3]);
                    u32x4 w; w.x = pg8::cvt_pk_bf16(v0[0], v0[1]); w.y = pg8::cvt_pk_bf16(v0[2], v0[3]); w.z = pg8::cvt_pk_bf16(v1[0], v1[1]); w.w = pg8::cvt_pk_bf16(v1[2], v1[3]);
                    *(u32x4*)(rowp + bj * 128) = w; }
                if (stats) { ss += __shfl_xor(ss, 16); ss += __shfl_xor(ss, 32); if (fq == 0) SSQ[(size_t)row * 16 + (u.pn - 4) * 4 + wc] = ss; } }
    }
};
__device__ __forceinline__ void phase_inproj(const OW& P, LAS unsigned char* lds, int G) {
    SchedInProj Sd{&P, G, BID()}; EpiInProj E{P.Z, P.SSQ};
    pg8::gemm_phase<true>(lds, Sd, E);
}


struct SchedQKV {
    static constexpr bool HOOKS = false;
    const OW* P; int G, c;
    __device__ __forceinline__ bool next(int i, pg8::UnitD& u) const {
        if (G != 256) {
            const int Lq = i * G + c; if (Lq >= 448) return false;
            if (Lq < 192) { fill_q(u, Lq / 3, Lq % 3); } else { const int r = Lq - 192; fill_kv(u, r >> 2, r & 3); }
            return true;
        }
        if (c < 192) { if (i == 0) { fill_q(u, c / 3, c % 3); return true; } if (i == 1 && c % 3 == 0) { fill_kv(u, c / 3, 3); return true; } return false; }
        if (i >= 3) return false; fill_kv(u, c - 192, i); return true;
    }
    __device__ __forceinline__ void fill_q(pg8::UnitD& u, int pm, int pn) const {
        u.A = (const char*)(P->Z + (size_t)pm * 256 * ZW + 1024); u.rows = nullptr; u.B = (const char*)(P->Wq_t + (size_t)pn * 256 * QL); u.lda = ZW * 2; u.ldb = QL * 2; u.nt = QL / 64; u.type = 1; u.pm = pm; u.pn = pn; u.aux = 0; }
    __device__ __forceinline__ void fill_kv(pg8::UnitD& u, int pm, int pn) const {
        u.A = (const char*)(P->Z + (size_t)pm * 256 * ZW + 1792); u.rows = nullptr; u.B = (const char*)(P->Wkv_t + (size_t)pn * 256 * KVL); u.lda = ZW * 2; u.ldb = KVL * 2; u.nt = KVL / 64; u.type = 2; u.pm = pm; u.pn = pn; u.aux = 0; }
};
struct EpiQKV {
    const float* SSQ; bf16_t *Q, *KN, *VV;
    __device__ __forceinline__ void operator()(const f32x4 (&acc)[2][2][4][2], const pg8::UnitD& u, int wr, int wc, int fr, int fq) const {
        const int row0 = u.pm * 256 + wr * 64 + fr, cw = wc * 32 + 8 * fq;
        const bool isq = u.type == 1;
        float rs2[2];
        { const int li = fr + 16 * fq; f32x4 a[2], b[2], c[2];
#pragma unroll
          for (int ai = 0; ai < 2; ++ai) { const f32x4* sp = (const f32x4*)(SSQ + (size_t)(u.pm * 256 + wr * 64 + li + ai * 128) * 16);
              if (isq) { a[ai] = sp[0]; b[ai] = sp[1]; c[ai] = sp[2]; } else { a[ai] = sp[3]; b[ai] = (f32x4){0.f, 0.f, 0.f, 0.f}; c[ai] = b[ai]; } }
          __builtin_amdgcn_sched_barrier(0);
#pragma unroll
          for (int ai = 0; ai < 2; ++ai) { const float t = ((a[ai][0] + a[ai][1]) + (a[ai][2] + a[ai][3])) + ((b[ai][0] + b[ai][1]) + (b[ai][2] + b[ai][3])) + ((c[ai][0] + c[ai][1]) + (c[ai][2] + c[ai][3]));
              rs2[ai] = rsqrtf(t * (isq ? 1.f / QL : 1.f / KVL) + EPS); } }
#pragma unroll
        for (int ai = 0; ai < 2; ++ai)
#pragma unroll
            for (int m = 0; m < 4; ++m) { const int row = row0 + ai * 128 + m * 16;
                const float rs = __shfl(rs2[ai], 16 * m + fr);
#pragma unroll
                for (int bj = 0; bj < 2; ++bj) { const f32x4 v0 = acc[ai][bj][m][0] * rs, v1 = acc[ai][bj][m][1] * rs;
                    u32x4 w; w.x = pg8::cvt_pk_bf16(v0[0], v0[1]); w.y = pg8::cvt_pk_bf16(v0[2], v0[3]); w.z = pg8::cvt_pk_bf16(v1[0], v1[1]); w.w = pg8::cvt_pk_bf16(v1[2], v1[3]);
                    bf16_t* dst = isq ? Q + (size_t)row * QL + u.pn * 256 + bj * 128 + cw : (bj == 0 ? KN : VV) + (size_t)row * 512 + u.pn * 128 + cw;
                    *(u32x4*)dst = w; } }
    }
};
__device__ __forceinline__ float sigm(float x) { return __builtin_amdgcn_rcpf(1.f + __expf(-x)); }
__device__ __forceinline__ float one_minus_sq(float a, float x) {
    return x > -0.015625f ? -x * (1.f + 0.5f * x) : 1.f - a * a;
}
__device__ __forceinline__ void gates_tile(const OW& P, int l, LAS unsigned char* lds, int tile) {
    constexpr int URS = 1040, XRS = 144, SRS = 68;
    const int tid = TID(), lane = tid & 63, wid = __builtin_amdgcn_readfirstlane(tid >> 6), fr = lane & 15, fq = lane >> 4;
    LAS unsigned char* U = lds;
    LAS unsigned char* XC = lds + 67 * URS + 64;
    LAS float* SA = (LAS float*)(lds + 81920);
    LAS float* SD = SA + 64 * SRS;
    LAS f32x2* PP = (LAS f32x2*)(lds + 81920 + 2 * 64 * SRS * 4);
    LAS float* PAR = (LAS float*)(lds + 81920 + 2 * 64 * SRS * 4 + 4096);
    const int tok0 = tile * 64, s0 = tok0 & (S - 1);
    const float* conv_w = P.in[2] + (size_t)l * 4 * LW; const float* conv_b = P.in[3] + (size_t)l * LW;
    const float* b_r = P.in[5] + (size_t)l * LW; const float* b_i = P.in[7] + (size_t)l * LW; const float* lam = P.in[8] + (size_t)l * LW;
    const bf16_t* pZ = P.Z; const f32x2* pROPE = P.ROPE; bf16_t* pKPE = P.KPE; float* pA = P.A; float* pDRV = P.DRV; float* pAGA = P.AGA; float* pAGB = P.AGB; const bf16_t* pWlg = P.Wlg_t;
    float pv[8];
    { const int ch = tid; pv[0] = conv_w[0 * LW + ch]; pv[1] = conv_w[1 * LW + ch]; pv[2] = conv_w[2 * LW + ch]; pv[3] = conv_w[3 * LW + ch]; pv[4] = conv_b[ch]; pv[5] = b_r[ch]; pv[6] = b_i[ch]; pv[7] = lam[ch]; }
    { u32x4 uv[9]; unsigned short k1[4], k2[4]; f32x2 cs[4];
#pragma unroll
      for (int q = 0; q < 9; ++q) { const int i = tid + q * NTHREADS; const int r = i >> 6, ch = i & 63; uv[q] = (u32x4){0u, 0u, 0u, 0u};
          if (i < 67 * 64 && (r >= 3 || s0 != 0)) uv[q] = *(const u32x4*)(pZ + (size_t)(tok0 - 3 + r) * ZW + ch * 8); }
#pragma unroll
      for (int q = 0; q < 4; ++q) { const int i = tid + q * NTHREADS; const int t = i >> 5, j = i & 31; const size_t tok = (size_t)tok0 + t;
          k1[q] = pZ[tok * ZW + 2048 + j]; k2[q] = pZ[tok * ZW + 2080 + j]; cs[q] = pROPE[(s0 + t) * 32 + j]; }
#pragma unroll
      for (int q = 0; q < 9; ++q) { const int i = tid + q * NTHREADS; const int r = i >> 6, ch = i & 63; if (i < 67 * 64) *(LAS u32x4*)(U + r * URS + ch * 16) = uv[q]; }
#pragma unroll
      for (int q = 0; q < 4; ++q) { const int i = tid + q * NTHREADS; const int t = i >> 5, j = i & 31; const size_t tok = (size_t)tok0 + t; const float x1 = bf2f(k1[q]), x2 = bf2f(k2[q]);
          pKPE[tok * 64 + j] = (bf16_t)f2bf(x1 * cs[q].x - x2 * cs[q].y); pKPE[tok * 64 + 32 + j] = (bf16_t)f2bf(x1 * cs[q].y + x2 * cs[q].x); } }
    { const int ch = tid;
      PAR[0 * LW + ch] = pv[0]; PAR[1 * LW + ch] = pv[1]; PAR[2 * LW + ch] = pv[2]; PAR[3 * LW + ch] = pv[3];
      PAR[4 * LW + ch] = pv[4]; PAR[5 * LW + ch] = pv[5]; PAR[6 * LW + ch] = pv[6]; PAR[7 * LW + ch] = -8.0f * log1pf(__expf(-pv[7])); }
    LDS_SYNC();
    bf16x8 nb0, nb1; { const bf16_t* wb = pWlg + ((size_t)16 * wid + fr) * 64 + 8 * fq; nb0 = *(const bf16x8*)wb; nb1 = *(const bf16x8*)(wb + 32); }
    for (int n = 0; n < 8; ++n) {
        { const int chb = 64 * n + 8 * wid; float xc[8];
#pragma unroll
          for (int j = 0; j < 8; ++j) xc[j] = PAR[4 * LW + chb + j];
#pragma unroll
          for (int w = 0; w < 4; ++w) { const u32x4 uv = *(const LAS u32x4*)(U + (lane + w) * URS + chb * 2);
              const f32x4 c0 = *(const LAS f32x4*)(PAR + w * LW + chb), c1 = *(const LAS f32x4*)(PAR + w * LW + chb + 4);
              xc[0] = fmaf(bflo(uv.x), c0[0], xc[0]); xc[1] = fmaf(bfhi(uv.x), c0[1], xc[1]); xc[2] = fmaf(bflo(uv.y), c0[2], xc[2]); xc[3] = fmaf(bfhi(uv.y), c0[3], xc[3]);
              xc[4] = fmaf(bflo(uv.z), c1[0], xc[4]); xc[5] = fmaf(bfhi(uv.z), c1[1], xc[5]); xc[6] = fmaf(bflo(uv.w), c1[2], xc[6]); xc[7] = fmaf(bfhi(uv.w), c1[3], xc[7]); }
          u32x4 o; o.x = pk2(xc[0], xc[1]); o.y = pk2(xc[2], xc[3]); o.z = pk2(xc[4], xc[5]); o.w = pk2(xc[6], xc[7]);
          *(LAS u32x4*)(XC + lane * XRS + wid * 16) = o; }
        LDS_SYNC();
        f32x4 acc[4];
        { const bf16x8 b0 = nb0, b1 = nb1;
          if (n + 1 < 8) { const bf16_t* wb = pWlg + ((size_t)(n + 1) * 128 + 16 * wid + fr) * 64 + 8 * fq; nb0 = *(const bf16x8*)wb; nb1 = *(const bf16x8*)(wb + 32); }
#pragma unroll
          for (int m = 0; m < 4; ++m) { const bf16x8 a0 = *(const LAS bf16x8*)(XC + (16 * m + fr) * XRS + fq * 16), a1 = *(const LAS bf16x8*)(XC + (16 * m + fr) * XRS + 64 + fq * 16);
              f32x4 c = {0.f, 0.f, 0.f, 0.f};
              c = __builtin_amdgcn_mfma_f32_16x16x32_bf16(b0, a0, c, 0, 0, 0); c = __builtin_amdgcn_mfma_f32_16x16x32_bf16(b1, a1, c, 0, 0, 0); acc[m] = c; } }
        const bool lo = fq < 2;
        f32x4 rv[2], iv[2];
#pragma unroll
        for (int j = 0; j < 2; ++j) { const f32x4 snd = lo ? acc[2 + j] : acc[j]; f32x4 rc;
#pragma unroll
            for (int x = 0; x < 4; ++x) rc[x] = __shfl_xor(snd[x], 32);
            rv[j] = lo ? acc[j] : rc; iv[j] = lo ? rc : acc[2 + j]; }
        const int d0 = 8 * wid + 4 * (fq & 1), ch0 = 64 * n + d0;
        const f32x4 brv = *(const LAS f32x4*)(PAR + 5 * LW + ch0), biv = *(const LAS f32x4*)(PAR + 6 * LW + ch0), spv = *(const LAS f32x4*)(PAR + 7 * LW + ch0), cbv = *(const LAS f32x4*)(PAR + 4 * LW + ch0);
        f32x4 cw[4];
#pragma unroll
        for (int w = 0; w < 4; ++w) cw[w] = *(const LAS f32x4*)(PAR + w * LW + ch0);
#pragma unroll
        for (int j = 0; j < 2; ++j) { const int t = 16 * ((lo ? 0 : 2) + j) + fr; f32x4 av, dv;
            const u32x2 xcb = *(const LAS u32x2*)(XC + t * XRS + d0 * 2); const float xcq[4] = {bflo(xcb.x), bfhi(xcb.x), bflo(xcb.y), bfhi(xcb.y)};
#pragma unroll
            for (int x = 0; x < 4; ++x) {
                const float xcv = xcq[x];
                const float r = sigm(rv[j][x] + brv[x]), ig = sigm(iv[j][x] + biv[x]);
                const float log_a = r * spv[x];
                av[x] = __expf(log_a); dv[x] = __builtin_amdgcn_sqrtf(one_minus_sq(av[x], 2.0f * log_a)) * (ig * xcv); }
            *(LAS f32x4*)(SA + t * SRS + d0) = av; *(LAS f32x4*)(SD + t * SRS + d0) = dv; }
        LDS_SYNC();
        { float Ap = 1.f, Bp = 0.f;
#pragma unroll
          for (int j = 0; j < 8; ++j) { const int t = 8 * wid + j; const float a = SA[t * SRS + lane], dv = SD[t * SRS + lane];
              ((unsigned*)pA)[((size_t)tok0 + t) * LW + 64 * n + lane] = pg8::cvt_pk_bf16(1.f - a, dv);
              Ap *= a; Bp = fmaf(a, Bp, dv); }
          PP[wid * 64 + lane] = (f32x2){Ap, Bp}; }
        LDS_SYNC();
        if (wid == 0) { float Aa = 1.f, Bb = 0.f;
#pragma unroll
            for (int g = 0; g < 8; ++g) { const f32x2 p = PP[g * 64 + lane]; Aa *= p.x; Bb = fmaf(p.x, Bb, p.y); }
            pAGA[(size_t)tile * LW + 64 * n + lane] = Aa; pAGB[(size_t)tile * LW + 64 * n + lane] = Bb; }
    }
    LDS_SYNC();
}
__device__ __forceinline__ void phase_qkv(const OW& P, int l, LAS unsigned char* lds, int G) {
#ifndef P2SEL
#define P2SEL 3
#endif
    if (P2SEL & 1) { SchedQKV Sd{&P, G, BID()}; EpiQKV E{P.SSQ, P.Q, P.KN, P.VV};
    pg8::gemm_phase<true>(lds, Sd, E); }
    if (P2SEL & 2) for (int tile = BID(); tile < NT / 64; tile += G) gates_tile(P, l, lds, tile);
}


namespace att {
typedef short s16x4 __attribute__((ext_vector_type(4)));
typedef float f32x16 __attribute__((ext_vector_type(16)));
constexpr int KVBLK = 64, SHM_V = 16384, SHM_K = 24576, OFF_K = 3 * SHM_V, OFF_WS = OFF_K + 3 * SHM_K, OFF_QR = OFF_WS + 8 * 64 * 4, LDS_NEED = OFF_QR + 8 * 4096;
static_assert(LDS_NEED <= LDSCTL_OFF, "attention LDS");
constexpr float SCALE = 0.07216878364870322f, THR = 8.f;
#define SBAR() __builtin_amdgcn_sched_barrier(0)
__device__ __forceinline__ int v_st(int k, int c) { const int kk = (k & ~0xC) | ((k & 4) << 1) | ((k & 8) >> 1); return ((kk >> 3) * 4 + (c >> 5)) * 512 + ((kk & 7) * 32 + (c & 31)) * 2; }
__device__ __forceinline__ int v_rd_base(int lane) { return ((lane & 3) << 3) | (((lane >> 2) & 3) << 6) | (((lane >> 4) & 1) << 5) | (((lane >> 5) & 1) << 8); }
constexpr int v_rd_off(int d0, int ks, int half) { return d0 * 512 + ks * 4096 + half * 2048; }
__device__ __forceinline__ int k_off(int row, int cc) { return (cc >> 3) * 8192 + row * 128 + (((cc & 7) ^ ((row >> 1) & 7)) << 4); }
__device__ __forceinline__ int crow(int r, int hi) { return (r & 3) + 8 * (r >> 2) + 4 * hi; }
__device__ __forceinline__ unsigned cvtpk(float lo, float hi) { unsigned r; asm volatile("v_cvt_pk_bf16_f32 %0, %1, %2" : "=v"(r) : "v"(lo), "v"(hi)); return r; }
__device__ __forceinline__ void mask_tile(f32x16& p0, f32x16& p1, int dq) {
    const float NEG = -__builtin_inff();
#pragma unroll
    for (int r = 0; r < 16; ++r) { const int c = (r & 3) + 8 * (r >> 2); if (dq - c < 0) p0[r] = NEG; if (dq - c - 32 < 0) p1[r] = NEG; }
}
__device__ __forceinline__ void partialSM(f32x16& p0, f32x16& p1, float& m_reg, float& mn, float& alpha) {
    float pmax = p0[0];
#pragma unroll
    for (int r = 1; r < 16; ++r) pmax = fmaxf(pmax, p0[r]);
#pragma unroll
    for (int r = 0; r < 16; ++r) pmax = fmaxf(pmax, p1[r]);
    { auto rr = __builtin_amdgcn_permlane32_swap(__float_as_uint(pmax), __float_as_uint(pmax), false, false); pmax = fmaxf(__uint_as_float(rr[0]), __uint_as_float(rr[1])); }
    constexpr float C2 = 1.4426950408889634f * SCALE;
    if (__builtin_expect(__all((pmax - m_reg) * SCALE <= THR), 1)) { mn = m_reg; alpha = 1.f; }
    else { mn = fmaxf(m_reg, pmax); alpha = __builtin_amdgcn_exp2f((m_reg - mn) * C2); m_reg = mn; }
    const float mnL = -mn * C2;
#pragma unroll
    for (int r = 0; r < 16; ++r) p0[r] = fmaf(p0[r], C2, mnL);
#pragma unroll
    for (int r = 0; r < 16; ++r) p1[r] = fmaf(p1[r], C2, mnL);
#pragma unroll
    for (int r = 0; r < 16; ++r) p0[r] = __builtin_amdgcn_exp2f(p0[r]);
}
__device__ __forceinline__ void finishSM(f32x16& p0, f32x16& p1, float alpha, float& l_reg, bf16x8& pa0, bf16x8& pa1, bf16x8& pa2, bf16x8& pa3) {
#pragma unroll
    for (int r = 0; r < 16; ++r) p1[r] = __builtin_amdgcn_exp2f(p1[r]);
    float ps = 0;
#pragma unroll
    for (int r = 0; r < 16; ++r) ps += p0[r];
#pragma unroll
    for (int r = 0; r < 16; ++r) ps += p1[r];
    { auto rr = __builtin_amdgcn_permlane32_swap(__float_as_uint(ps), __float_as_uint(ps), false, false); ps = __uint_as_float(rr[0]) + __uint_as_float(rr[1]); }
    l_reg = l_reg * alpha + ps;
#define PK4(P, B_, OUT) do { unsigned a0 = cvtpk(P[B_+0], P[B_+1]), a1 = cvtpk(P[B_+2], P[B_+3]);                          \
        unsigned b0 = cvtpk(P[B_+4], P[B_+5]), b1 = cvtpk(P[B_+6], P[B_+7]);                                             \
        auto r0 = __builtin_amdgcn_permlane32_swap(a0, b0, false, false); auto r1 = __builtin_amdgcn_permlane32_swap(a1, b1, false, false); \
        u32x4 w = {r0[0], r1[0], r0[1], r1[1]}; OUT = *reinterpret_cast<bf16x8*>(&w); } while (0)
    PK4(p0, 0, pa0); PK4(p0, 8, pa1); PK4(p1, 0, pa2); PK4(p1, 8, pa3);
#undef PK4
}
__device__ __forceinline__ void qkt(f32x16& p0, f32x16& p1, const char* K_slot, int r32, int hi, const bf16x8* qr, const char* qrl) {
    p0 = f32x16{}; p1 = f32x16{};
    const char* kb[4];
#pragma unroll
    for (int dd = 0; dd < 4; ++dd) kb[dd] = K_slot + r32 * 128 + (((2 * dd + hi) ^ ((r32 >> 1) & 7)) << 4);
    bf16x8 a0[4], a1[4], b0[4], b1[4], qf[4];
#define QK_LOAD(X0, X1, g) do { _Pragma("unroll") for (int dd = 0; dd < 4; ++dd) { const char* a_ = kb[dd] + (g) * 8192; X0[dd] = *reinterpret_cast<const bf16x8*>(a_); X1[dd] = *reinterpret_cast<const bf16x8*>(a_ + 32 * 128); } } while (0)
#define QK_MMA(X0, X1, Q_) do { _Pragma("unroll") for (int dd = 0; dd < 4; ++dd) { p0 = __builtin_amdgcn_mfma_f32_32x32x16_bf16(X0[dd], Q_[dd], p0, 0, 0, 0); p1 = __builtin_amdgcn_mfma_f32_32x32x16_bf16(X1[dd], Q_[dd], p1, 0, 0, 0); } } while (0)
    QK_LOAD(a0, a1, 0); SBAR();
    QK_LOAD(b0, b1, 1); SBAR();
    QK_MMA(a0, a1, qr); SBAR();
    QK_LOAD(a0, a1, 2);
#pragma unroll
    for (int dd = 0; dd < 4; ++dd) qf[dd] = *reinterpret_cast<const bf16x8*>(qrl + dd * 1024);
    SBAR();
    QK_MMA(b0, b1, (qr + 4)); SBAR();
    QK_MMA(a0, a1, qf);
#undef QK_LOAD
#undef QK_MMA
}
__device__ __forceinline__ void pv_tile(f32x16* o, int vb0, bf16x8 pa0, bf16x8 pa1, bf16x8 pa2, bf16x8 pa3) {
#define TRRD(dst, off) asm volatile("ds_read_b64_tr_b16 %0, %1 offset:%2" : "=&v"(dst) : "v"(vb0), "i"(off) : "memory")
#define PV_RD(S, d0) do { constexpr int b_ = v_rd_off(d0, 0, 0); \
        TRRD(S##l0, b_); TRRD(S##h0, b_ + 2048); TRRD(S##l1, b_ + 4096); TRRD(S##h1, b_ + 6144); TRRD(S##l2, b_ + 8192); TRRD(S##h2, b_ + 10240); TRRD(S##l3, b_ + 12288); TRRD(S##h3, b_ + 14336); } while (0)
#define PV_MM(S, d0) do { \
        o[d0] = __builtin_amdgcn_mfma_f32_32x32x16_bf16(pa0, (bf16x8){S##l0[0], S##l0[1], S##l0[2], S##l0[3], S##h0[0], S##h0[1], S##h0[2], S##h0[3]}, o[d0], 0, 0, 0);   \
        o[d0] = __builtin_amdgcn_mfma_f32_32x32x16_bf16(pa1, (bf16x8){S##l1[0], S##l1[1], S##l1[2], S##l1[3], S##h1[0], S##h1[1], S##h1[2], S##h1[3]}, o[d0], 0, 0, 0);   \
        o[d0] = __builtin_amdgcn_mfma_f32_32x32x16_bf16(pa2, (bf16x8){S##l2[0], S##l2[1], S##l2[2], S##l2[3], S##h2[0], S##h2[1], S##h2[2], S##h2[3]}, o[d0], 0, 0, 0);   \
        o[d0] = __builtin_amdgcn_mfma_f32_32x32x16_bf16(pa3, (bf16x8){S##l3[0], S##l3[1], S##l3[2], S##l3[3], S##h3[0], S##h3[1], S##h3[2], S##h3[3]}, o[d0], 0, 0, 0); } while (0)
    s16x4 Al0, Al1, Al2, Al3, Ah0, Ah1, Ah2, Ah3, Bl0, Bl1, Bl2, Bl3, Bh0, Bh1, Bh2, Bh3;
    asm volatile("s_waitcnt lgkmcnt(0)" ::: "memory");
    PV_RD(A, 0);
    PV_RD(B, 1); asm volatile("s_waitcnt lgkmcnt(8)" ::: "memory"); SBAR(); PV_MM(A, 0); SBAR();
    PV_RD(A, 2); asm volatile("s_waitcnt lgkmcnt(8)" ::: "memory"); SBAR(); PV_MM(B, 1); SBAR();
    PV_RD(B, 3); asm volatile("s_waitcnt lgkmcnt(8)" ::: "memory"); SBAR(); PV_MM(A, 2); SBAR();
    asm volatile("s_waitcnt lgkmcnt(0)" ::: "memory"); SBAR(); PV_MM(B, 3);
#undef PV_RD
#undef PV_MM
#undef TRRD
}
__device__ __forceinline__ void unit(const OW& P, char* lds, int b, int h, int qb, int part) {
    const int tid = TID(), wid = __builtin_amdgcn_readfirstlane(tid >> 6), lane = tid & 63, r32 = lane & 31, hi = lane >> 5;
    const int NTall = 4 * (qb + 1), t_lo = part ? NTall / 2 : 0, NT_ = NTall / 2;
    const size_t rowbase = (size_t)b * S;
    const int q0 = qb * 256, qlo = q0 + wid * 32, qm = qlo + r32 - 4 * hi;
    char* V_lds = lds; char* K_lds = lds + OFF_K;
    float* ws = (float*)(lds + OFF_WS) + wid * 64; float* li_l = ws; float* al_l = ws + 32;
    float m_reg = -1e30f, l_reg = 0; f32x16 o[4] = {};
    const int vb0 = (int)(uintptr_t)V_lds + v_rd_base(lane);
    unsigned go_k01, go_k2, go_v0, go_v1;
    { const int row = 8 * wid + (lane >> 3), c = (lane & 7) ^ ((row >> 1) & 7);
      go_k01 = (unsigned)(row * 512 + c * 8) * 2u; go_k2 = (unsigned)(row * 64 + c * 8) * 2u;
      const int si0 = 2 * wid + (lane >> 5), si1 = si0 + 16;
      const int kk0 = (si0 >> 2) * 8 + ((lane & 31) >> 2), kk1 = (si1 >> 2) * 8 + ((lane & 31) >> 2);
      const int k0_ = (kk0 & ~0xC) | ((kk0 & 4) << 1) | ((kk0 & 8) >> 1), k1_ = (kk1 & ~0xC) | ((kk1 & 4) << 1) | ((kk1 & 8) >> 1);
      go_v0 = (unsigned)(k0_ * 512 + (si0 & 3) * 32 + (lane & 3) * 8) * 2u; go_v1 = (unsigned)(k1_ * 512 + (si1 & 3) * 32 + (lane & 3) * 8) * 2u; }
    const char* KnB = (const char*)(P.KN + rowbase * 512 + h * 128); const char* VhB = (const char*)(P.VV + rowbase * 512 + h * 128); const char* KpB = (const char*)(P.KPE + rowbase * 64);
    LAS unsigned char* ldsK = (LAS unsigned char*)(uintptr_t)(unsigned)(uintptr_t)K_lds; LAS unsigned char* ldsV = (LAS unsigned char*)(uintptr_t)(unsigned)(uintptr_t)V_lds;
#define KBASE(t) ((t_lo + (t)) * KVBLK)
#define GLDS(gp, lp) __builtin_amdgcn_global_load_lds((const unsigned*)(gp), (LAS unsigned*)(lp), 16, 0, 0)
#define STAGE(k0, ks_, vs_) do { const size_t kb_ = (size_t)(k0); \
        GLDS(KnB + kb_ * 1024 + go_k01, ldsK + (ks_) * SHM_K + wid * 1024); GLDS(KnB + kb_ * 1024 + 128 + go_k01, ldsK + (ks_) * SHM_K + 8192 + wid * 1024); \
        GLDS(KpB + kb_ * 128 + go_k2, ldsK + (ks_) * SHM_K + 16384 + wid * 1024); \
        GLDS(VhB + kb_ * 1024 + go_v0, ldsV + (vs_) * SHM_V + wid * 1024); GLDS(VhB + kb_ * 1024 + go_v1, ldsV + (vs_) * SHM_V + (wid + 8) * 1024); } while (0)
#define RESC(a) do { if (__any((a) < 1.f)) { if (hi == 0) al_l[r32] = (a); asm volatile("s_waitcnt lgkmcnt(0)" ::: "memory");              \
                     _Pragma("unroll") for (int d_ = 0; d_ < 4; ++d_) _Pragma("unroll") for (int r = 0; r < 16; ++r) o[d_][r] *= al_l[crow(r, hi)]; } } while (0)
#define MASKT(P0_, P1_, t) do { const int kb_ = KBASE(t); if (kb_ + KVBLK - 1 > qlo) mask_tile(P0_, P1_, qm - kb_); } while (0)
    STAGE(KBASE(0), 0, 0); if (NT_ > 1) { STAGE(KBASE(1), 1, 1); }
    bf16x8 qr[8]; char* qrl = lds + OFF_QR + wid * 4096 + lane * 16;
    { const bf16_t* qp = P.Q + (rowbase + qlo + r32) * QL + h * QH + hi * 8;
#pragma unroll
      for (int d0 = 0; d0 < 8; ++d0) qr[d0] = *(const bf16x8*)(qp + d0 * 16);
      const f32x2* rp = P.ROPE + (size_t)(qlo + r32) * 32 + hi * 8;
#pragma unroll
      for (int g = 0; g < 2; ++g) {
          u32x4 x1 = *(const u32x4*)(qp + (8 + g) * 16), x2 = *(const u32x4*)(qp + (10 + g) * 16); u32x4 y1, y2;
#pragma unroll
          for (int jj = 0; jj < 4; ++jj) { const f32x2 cs0 = rp[16 * g + 2 * jj], cs1 = rp[16 * g + 2 * jj + 1];
              const float a0 = bflo(x1[jj]), a1 = bfhi(x1[jj]), b0 = bflo(x2[jj]), b1 = bfhi(x2[jj]);
              y1[jj] = pk2(a0 * cs0.x - b0 * cs0.y, a1 * cs1.x - b1 * cs1.y); y2[jj] = pk2(a0 * cs0.y + b0 * cs0.x, a1 * cs1.y + b1 * cs1.x); }
          *(u32x4*)(qrl + g * 1024) = y1; *(u32x4*)(qrl + (2 + g) * 1024) = y2; } }
    f32x16 p0, p1; float mn, al; bf16x8 pa0, pa1, pa2, pa3;
    asm volatile("s_waitcnt vmcnt(0)" ::: "memory"); __syncthreads();
    int sl = 0;
    for (int t = 0; t < NT_; ++t) {
        const int s2 = sl == 0 ? 2 : sl - 1;
        if (t + 2 < NT_) { STAGE(KBASE(t + 2), s2, s2); }
        qkt(p0, p1, K_lds + sl * SHM_K, r32, hi, qr, qrl);
        MASKT(p0, p1, t); partialSM(p0, p1, m_reg, mn, al); RESC(al);
        finishSM(p0, p1, al, l_reg, pa0, pa1, pa2, pa3); SBAR();
        pv_tile(o, vb0 + sl * SHM_V, pa0, pa1, pa2, pa3);
        if (t + 2 < NT_) asm volatile("s_waitcnt vmcnt(5) lgkmcnt(0)" ::: "memory"); else asm volatile("s_waitcnt vmcnt(0) lgkmcnt(0)" ::: "memory");
        __builtin_amdgcn_s_barrier(); asm volatile("" ::: "memory");
        sl = sl == 2 ? 0 : sl + 1;
    }
    bf16_t* Ow = P.OP + ((size_t)part * NT + rowbase + qlo) * 512 + h * 128;
#pragma unroll
    for (int r = 0; r < 16; ++r) { const int orow = crow(r, hi);
#pragma unroll
        for (int d0 = 0; d0 < 4; ++d0) { const float v = o[d0][r]; const float vn = __builtin_bit_cast(float, __builtin_amdgcn_update_dpp(0, __builtin_bit_cast(int, v), 0xB1, 0xF, 0xF, false));
            if ((r32 & 1) == 0) *(unsigned*)(Ow + (size_t)orow * 512 + d0 * 32 + r32) = cvtpk(v, vn); } }
    if (hi == 0) P.ML[((size_t)part * NT + rowbase + qlo + r32) * 4 + h] = (f32x2){m_reg * (1.4426950408889634f * SCALE), l_reg};
    __syncthreads();
#undef KBASE
#undef GLDS
#undef STAGE
#undef RESC
#undef MASKT
}
#undef SBAR
}
__device__ __forceinline__ void phase_attn(const OW& P, LAS unsigned char* lds, int vcu, int G) {
    for (int v = vcu; v < 256; v += G) { const int bh = v >> 4, r = v & 15;
        att::unit(P, (char*)lds, bh >> 2, bh & 3, r, 0);
        att::unit(P, (char*)lds, bh >> 2, bh & 3, 15 - r, 1); }
}
#if MODE == 0
__global__ void shim_attn(const bf16_t* OP, const f32x2* ML, float* MIXf) {
    const size_t i = (size_t)blockIdx.x * 256 + threadIdx.x; if (i >= (size_t)NT * 512) return;
    const size_t row = i >> 9; const int c = (int)(i & 511), h = c >> 7;
    const f32x2 a = ML[row * 4 + h], b = ML[((size_t)NT + row) * 4 + h];
    const float M = fmaxf(a.x, b.x), w0 = exp2f(a.x - M), w1 = exp2f(b.x - M);
    MIXf[row * D + 512 + c] = (w0 * bf2f(OP[i]) + w1 * bf2f(OP[(size_t)NT * 512 + i])) / (w0 * a.y + w1 * b.y);
}
#endif


template <int CTRL, int ROWMASK> __device__ __forceinline__ float dppf(float v) { return __builtin_bit_cast(float, __builtin_amdgcn_update_dpp(0, __builtin_bit_cast(int, v), CTRL, ROWMASK, 0xF, false)); }
__device__ __forceinline__ float wsum(float v) {
    v += dppf<0xB1, 0xF>(v);
    v += dppf<0x4E, 0xF>(v);
    v += dppf<0x141, 0xF>(v);
    v += dppf<0x140, 0xF>(v);
    v += dppf<0x142, 0xA>(v);
    v += dppf<0x143, 0xC>(v);
    return __builtin_bit_cast(float, __builtin_amdgcn_readlane(__builtin_bit_cast(int, v), 63));
}
__device__ __forceinline__ float gelu_t(float x) { const float u = 0.7978845608028654f * (x + 0.044715f * x * x * x); const float t = 1.f - 2.f * __builtin_amdgcn_rcpf(1.f + __expf(2.f * u)); return 0.5f * x * (1.f + t); }
__device__ __forceinline__ void mix_tile(const OW& P, LAS unsigned char* lds, int tile) {
    const int tid = TID(), lane = tid & 63, wid = __builtin_amdgcn_readfirstlane(tid >> 6);
    LAS float* LR = (LAS float*)lds;
    const int tok0 = tile * 64, j = tile & 63, tile0 = tile - j;
    float h = 0.f;
    if (j > 0) {
        { float a[32], b[32];
#pragma unroll
          for (int q = 0; q < 32; ++q) { const int t_ = q < j ? tile0 + q : tile0; a[q] = P.AGA[(size_t)t_ * LW + tid]; b[q] = P.AGB[(size_t)t_ * LW + tid]; }
#pragma unroll
          for (int q = 0; q < 32; ++q) if (q < j) h = fmaf(a[q], h, b[q]); }
        if (j > 32) { float a[32], b[32];
#pragma unroll
          for (int q = 0; q < 32; ++q) { const int t_ = 32 + q < j ? tile0 + 32 + q : tile0; a[q] = P.AGA[(size_t)t_ * LW + tid]; b[q] = P.AGB[(size_t)t_ * LW + tid]; }
#pragma unroll
          for (int q = 0; q < 32; ++q) if (32 + q < j) h = fmaf(a[q], h, b[q]); }
    }
    { unsigned ad[64]; unsigned short gg[64];
#pragma unroll
      for (int q = 0; q < 64; ++q) { const size_t tok = (size_t)tok0 + q; ad[q] = ((const unsigned*)P.A)[tok * LW + tid]; gg[q] = P.Z[tok * ZW + LW + tid]; }
#pragma unroll
      for (int q = 0; q < 64; ++q) { h = fmaf(1.f - bflo(ad[q]), h, bfhi(ad[q])); LR[q * LW + tid] = h * gelu_t(bf2f(gg[q])); } }
    __syncthreads();
    { const int hh = lane >> 4;
      f32x2 nma, nmb; u32x4 noa, nob;
#define MX_LOAD(r_) do { const size_t row_ = (size_t)tok0 + (r_); nma = P.ML[row_ * 4 + hh]; nmb = P.ML[((size_t)NT + row_) * 4 + hh]; \
        noa = *(const u32x4*)(P.OP + row_ * 512 + lane * 8); nob = *(const u32x4*)(P.OP + ((size_t)NT + row_) * 512 + lane * 8); } while (0)
      MX_LOAD(wid);
      for (int r = wid; r < 64; r += NWAVES) { const size_t row = (size_t)tok0 + r;
        const f32x2 ma = nma, mb = nmb; const u32x4 oa = noa, ob = nob;
        if (r + NWAVES < 64) MX_LOAD(r + NWAVES);
        { const f32x4 v0 = *(const LAS f32x4*)(LR + r * LW + lane * 8), v1 = *(const LAS f32x4*)(LR + r * LW + lane * 8 + 4);
          float ss = (v0[0] * v0[0] + v0[1] * v0[1]) + (v0[2] * v0[2] + v0[3] * v0[3]) + (v1[0] * v1[0] + v1[1] * v1[1]) + (v1[2] * v1[2] + v1[3] * v1[3]);
          const float rs = rsqrtf(wsum(ss) * (1.f / 512.f) + EPS);
          u32x4 o; o.x = pk2(v0[0] * rs, v0[1] * rs); o.y = pk2(v0[2] * rs, v0[3] * rs); o.z = pk2(v1[0] * rs, v1[1] * rs); o.w = pk2(v1[2] * rs, v1[3] * rs);
          *(u32x4*)(P.MIX + row * D + lane * 8) = o; }
        { const float M = fmaxf(ma.x, mb.x), w0 = __builtin_amdgcn_exp2f(ma.x - M), w1 = __builtin_amdgcn_exp2f(mb.x - M), inv = 1.f / (w0 * ma.y + w1 * mb.y);
          float v[8];
#pragma unroll
          for (int q = 0; q < 4; ++q) { v[2 * q] = (w0 * bflo(oa[q]) + w1 * bflo(ob[q])) * inv; v[2 * q + 1] = (w0 * bfhi(oa[q]) + w1 * bfhi(ob[q])) * inv; }
          float ss = 0.f;
#pragma unroll
          for (int q = 0; q < 8; ++q) ss += v[q] * v[q];
          const float rs = rsqrtf(wsum(ss) * (1.f / 512.f) + EPS);
          u32x4 o; o.x = pk2(v[0] * rs, v[1] * rs); o.y = pk2(v[2] * rs, v[3] * rs); o.z = pk2(v[4] * rs, v[5] * rs); o.w = pk2(v[6] * rs, v[7] * rs);
          *(u32x4*)(P.MIX + row * D + 512 + lane * 8) = o; } }
#undef MX_LOAD
    }
    __syncthreads();
}
struct SchedOut {
    static constexpr bool HOOKS = false;
    const OW* P; int G, c;
    __device__ __forceinline__ bool next(int i, pg8::UnitD& u) const {
        const int L = i * G + c; if (L >= 256) return false;
        int pm, pn; pg8::tile_order(L, 64, 4, pm, pn);
        u.A = (const char*)(P->MIX + (size_t)pm * 256 * D); u.rows = nullptr; u.B = (const char*)(P->Wo_t + (size_t)pn * 256 * 1024); u.lda = D * 2; u.ldb = 2048; u.nt = 16; u.type = 3; u.pm = pm; u.pn = pn; u.aux = 0;
        return true;
    }
};
struct EpiOut {
    const bf16_t* xres; bf16_t* Y;
    __device__ __forceinline__ void operator()(const f32x4 (&acc)[2][2][4][2], const pg8::UnitD& u, int wr, int wc, int fr, int fq) const {
        const int row0 = u.pm * 256 + wr * 64 + fr, col0 = u.pn * 256 + wc * 32 + 8 * fq;
#pragma unroll
        for (int ai = 0; ai < 2; ++ai) { u32x4 xb[4][2];
#pragma unroll
            for (int m = 0; m < 4; ++m) { const size_t off = (size_t)(row0 + ai * 128 + m * 16) * D + col0;
#pragma unroll
                for (int bj = 0; bj < 2; ++bj) xb[m][bj] = *(const u32x4*)(xres + off + bj * 128); }
#pragma unroll
            for (int m = 0; m < 4; ++m) { const size_t off = (size_t)(row0 + ai * 128 + m * 16) * D + col0;
#pragma unroll
                for (int bj = 0; bj < 2; ++bj) { const u32x4 x_ = xb[m][bj]; const f32x4 v0 = acc[ai][bj][m][0], v1 = acc[ai][bj][m][1];
                    u32x4 w; w.x = pg8::cvt_pk_bf16(ALPHA * bflo(x_.x) + v0[0], ALPHA * bfhi(x_.x) + v0[1]); w.y = pg8::cvt_pk_bf16(ALPHA * bflo(x_.y) + v0[2], ALPHA * bfhi(x_.y) + v0[3]);
                    w.z = pg8::cvt_pk_bf16(ALPHA * bflo(x_.z) + v1[0], ALPHA * bfhi(x_.z) + v1[1]); w.w = pg8::cvt_pk_bf16(ALPHA * bflo(x_.w) + v1[2], ALPHA * bfhi(x_.w) + v1[3]);
                    *(u32x4*)(Y + off + bj * 128) = w; } } }
    }
};
__device__ __forceinline__ void ln1_router_tile(const OW& P, int l, LAS unsigned char* lds, int tile) {
    const int tid = TID(), lane = tid & 63, wid = __builtin_amdgcn_readfirstlane(tid >> 6), fr = lane & 15, fq = lane >> 4;
    LAS float* PL = (LAS float*)lds;
    LAS f32x2* ST = (LAS f32x2*)(lds + 8192);
    LAS int* EI = (LAS int*)(lds + 8192 + 512);
    const float* g1 = P.in[15] + (size_t)l * D; const float* b1 = P.in[16] + (size_t)l * D; const float* rb = P.in[18];
    const int tok0 = tile * 64;
    { const int mt = wid & 3, kh = wid >> 2;
      const bf16_t* yp = P.Y + ((size_t)tok0 + 16 * mt + fr) * D + 512 * kh + 8 * fq; const bf16_t* wp = P.RWH + (size_t)fr * 1024 + 512 * kh + 8 * fq;
      bf16x8 ya[16], bh[16], bl[16];
#pragma unroll
      for (int ks = 0; ks < 16; ++ks) { ya[ks] = *(const bf16x8*)(yp + 32 * ks); bh[ks] = *(const bf16x8*)(wp + 32 * ks); bl[ks] = *(const bf16x8*)(wp + 16 * 1024 + 32 * ks); }
      __builtin_amdgcn_sched_barrier(0);
      f32x4 acc = {0.f, 0.f, 0.f, 0.f};
#pragma unroll
      for (int ks = 0; ks < 16; ++ks) { acc = __builtin_amdgcn_mfma_f32_16x16x32_bf16(ya[ks], bh[ks], acc, 0, 0, 0); acc = __builtin_amdgcn_mfma_f32_16x16x32_bf16(ya[ks], bl[ks], acc, 0, 0, 0); }
#pragma unroll
      for (int x = 0; x < 4; ++x) PL[(kh * 64 + 16 * mt + 4 * fq + x) * 16 + fr] = acc[x]; }
    f32x4 gv[4], bv[4];
#pragma unroll
    for (int j = 0; j < 4; ++j) { gv[j] = *(const f32x4*)(g1 + lane * 16 + 4 * j); bv[j] = *(const f32x4*)(b1 + lane * 16 + 4 * j); }
    u32x4 n0 = *(const u32x4*)(P.Y + ((size_t)tok0 + wid * 8) * D + lane * 16), n1 = *(const u32x4*)(P.Y + ((size_t)tok0 + wid * 8) * D + lane * 16 + 8);
    for (int rr = 0; rr < 8; ++rr) { const int r = wid * 8 + rr; const size_t row = (size_t)tok0 + r;
        float v[16]; float s_ = 0.f;
#pragma unroll
        for (int q = 0; q < 4; ++q) { v[2 * q] = bflo(n0[q]); v[2 * q + 1] = bfhi(n0[q]); v[8 + 2 * q] = bflo(n1[q]); v[8 + 2 * q + 1] = bfhi(n1[q]); }
#pragma unroll
        for (int j = 0; j < 16; ++j) s_ += v[j];
        if (rr + 1 < 8) { n0 = *(const u32x4*)(P.Y + (row + 1) * D + lane * 16); n1 = *(const u32x4*)(P.Y + (row + 1) * D + lane * 16 + 8); }
        const float mu = wsum(s_) * (1.f / D); float q_ = 0.f;
#pragma unroll
        for (int j = 0; j < 16; ++j) { v[j] -= mu; q_ += v[j] * v[j]; }
        const float rs = rsqrtf(wsum(q_) * (1.f / D) + EPS);
#pragma unroll
        for (int j = 0; j < 16; ++j) v[j] = v[j] * rs * gv[j >> 2][j & 3] + bv[j >> 2][j & 3];
        u32x4 o0, o1;
#pragma unroll
        for (int q = 0; q < 4; ++q) { o0[q] = pk2(v[2 * q], v[2 * q + 1]); o1[q] = pk2(v[8 + 2 * q], v[8 + 2 * q + 1]); }
        *(u32x4*)(P.XB + row * D + lane * 16) = o0; *(u32x4*)(P.XB + row * D + lane * 16 + 8) = o1;
        if (lane == 0) ST[r] = (f32x2){mu, rs}; }
    __syncthreads();
    if (tid < 64) { const int r = tid; const size_t row = (size_t)tok0 + r; const f32x2 st = ST[r];
        float sg[16], ss[16];
#pragma unroll
        for (int q4 = 0; q4 < 4; ++q4) { const f32x4 pa = *(const LAS f32x4*)(PL + r * 16 + 4 * q4), pb = *(const LAS f32x4*)(PL + (64 + r) * 16 + 4 * q4);
#pragma unroll
            for (int x = 0; x < 4; ++x) { const int e = 4 * q4 + x; const float lg = st.y * ((pa[x] + pb[x]) - st.x * P.RGB[e]) + P.RGB[16 + e];
                sg[e] = __builtin_amdgcn_rcpf(1.f + __expf(-lg)); ss[e] = sg[e] + rb[e]; } }
        int best_g = 0; float best = -INFINITY;
#pragma unroll
        for (int gI = 0; gI < 4; ++gI) { float m1 = -INFINITY, m2 = -INFINITY;
#pragma unroll
            for (int k = 0; k < 4; ++k) { const float vv = ss[gI * 4 + k]; if (vv > m1) { m2 = m1; m1 = vv; } else if (vv > m2) { m2 = vv; } }
            const float gs = m1 + m2; if (gs > best) { best = gs; best_g = gI; } }
        float c0 = 0.f, c1 = 0.f, c2 = 0.f, c3 = 0.f, t0 = 0.f, t1 = 0.f, t2 = 0.f, t3 = 0.f;
#pragma unroll
        for (int gI = 0; gI < 4; ++gI) if (gI == best_g) { c0 = ss[gI * 4]; c1 = ss[gI * 4 + 1]; c2 = ss[gI * 4 + 2]; c3 = ss[gI * 4 + 3]; t0 = sg[gI * 4]; t1 = sg[gI * 4 + 1]; t2 = sg[gI * 4 + 2]; t3 = sg[gI * 4 + 3]; }
        int i1 = 0; float v1 = c0, s1 = t0;
        if (c1 > v1) { i1 = 1; v1 = c1; s1 = t1; }
        if (c2 > v1) { i1 = 2; v1 = c2; s1 = t2; }
        if (c3 > v1) { i1 = 3; v1 = c3; s1 = t3; }
        int i2 = -1; float v2 = -INFINITY, s2 = 0.f;
        if (i1 != 0 && c0 > v2) { i2 = 0; v2 = c0; s2 = t0; }
        if (i1 != 1 && c1 > v2) { i2 = 1; v2 = c1; s2 = t1; }
        if (i1 != 2 && c2 > v2) { i2 = 2; v2 = c2; s2 = t2; }
        if (i1 != 3 && c3 > v2) { i2 = 3; v2 = c3; s2 = t3; }
        const int e1 = best_g * 4 + i1, e2 = best_g * 4 + i2; const float inv = 1.f / (s1 + s2);
        P.GATE[row * 2] = s1 * inv; P.GATE[row * 2 + 1] = s2 * inv; P.EIDX[row * 2] = e1; P.EIDX[row * 2 + 1] = e2; EI[r * 2] = e1; EI[r * 2 + 1] = e2; }
    __syncthreads();
    { LAS int* C0 = EI + 128;
      int rank = 0, mye = -1, c_lo = 0;
      if (tid < 128) { mye = EI[tid];
#pragma unroll
          for (int e = 0; e < 16; ++e) { const unsigned long long m = __ballot(mye == e); if (mye == e) rank = __builtin_popcountll(m & ((1ull << lane) - 1ull)); if (tid == e) c_lo = __builtin_popcountll(m); if (tid == 64 + e) c_lo = __builtin_popcountll(m); }
          if (tid < 16) C0[tid] = c_lo; }
      __syncthreads();
      if (tid < 128) { if (tid >= 64) rank += C0[mye]; P.LRANK[(size_t)tok0 * 2 + tid] = rank; if (tid >= 64 && tid < 80) P.HIST[tile * 16 + (tid - 64)] = C0[tid - 64] + c_lo; } }
    __syncthreads();
}
__device__ __forceinline__ void moe_table(const OW& P, LAS unsigned char* lds) {
    const int tid = TID(); LAS int* HS = (LAS int*)lds; LAS int* TAB = (LAS int*)(lds + TAB_OFF);
    { int hv[8];
#pragma unroll
      for (int q = 0; q < 8; ++q) hv[q] = P.HIST[tid + q * NTHREADS];
#pragma unroll
      for (int q = 0; q < 8; ++q) HS[tid + q * NTHREADS] = hv[q]; }
    __syncthreads();
    if (tid < 64) { const int e = tid & 15, qd = tid >> 4; int tot = 0;
#pragma unroll 8
        for (int w = 0; w < 64; ++w) tot += HS[(qd * 64 + w) * 16 + e];
        tot += __shfl_xor(tot, 16); tot += __shfl_xor(tot, 32);
        if (qd == 0) TAB[32 + e] = tot; }
    __syncthreads();
    if (tid == 0) { int acc = 0; for (int e = 0; e < 16; ++e) { TAB[e] = acc; acc += (TAB[32 + e] + 255) >> 8; } TAB[16] = acc; }
    __syncthreads();
}
__device__ __forceinline__ void dest_tile(const OW& P, LAS unsigned char* lds, int tile) {
    const int tid = TID(); LAS int* HS = (LAS int*)lds; LAS int* TAB = (LAS int*)(lds + TAB_OFF); LAS int* BS = (LAS int*)(lds + 16384);
    if (tid < 64) { const int e = tid & 15, qd = tid >> 4; int b = 0;
#pragma unroll 8
        for (int w = 0; w < 64; ++w) { const int ww = qd * 64 + w; b += ww < tile ? HS[ww * 16 + e] : 0; }
        b += __shfl_xor(b, 16); b += __shfl_xor(b, 32);
        if (qd == 0) BS[e] = b; }
    __syncthreads();
    if (tid < 128) { const size_t a = (size_t)tile * 128 + tid; const int e = P.EIDX[a]; const int dst = 256 * TAB[e] + BS[e] + P.LRANK[a]; P.DEST[a] = dst; P.ROWTOK[dst] = (int)(a >> 1); }
    if (tile < 16) { const int e = tile, lo = 256 * TAB[e] + TAB[32 + e], hi = 256 * TAB[e + 1]; for (int i = lo + tid; i < hi; i += NTHREADS) P.ROWTOK[i] = 0; }
    __syncthreads();
}
struct SchedMoe {
    static constexpr bool HOOKS = false;
    const OW* P; LAS int* TAB; int G, c; bool down;
    __device__ __forceinline__ bool next(int i, pg8::UnitD& u) const {
        const int NB = __builtin_amdgcn_readfirstlane(TAB[16]); const int L = i * G + c; if (L >= NB * 4) return false;
        const int rb = L >> 2, pn = L & 3; int e = 0;
#pragma unroll
        for (int q = 1; q < 16; ++q) e += (__builtin_amdgcn_readfirstlane(TAB[q]) <= rb) ? 1 : 0;
        if (!down) { u.A = (const char*)P->XB; u.rows = P->ROWTOK + rb * 256; u.B = (const char*)(P->Wgu_t + ((size_t)e * 1024 + pn * 256) * 1024); u.lda = 2048; u.ldb = 2048; u.nt = 16; u.type = 4; }
        else { u.A = (const char*)(P->HE + (size_t)rb * 256 * DE); u.rows = nullptr; u.B = (const char*)(P->Wd_t + ((size_t)e * 1024 + pn * 256) * DE); u.lda = 1024; u.ldb = 1024; u.nt = 8; u.type = 5; }
        u.pm = rb; u.pn = pn; u.aux = e; return true;
    }
};
struct EpiMoeUp {
    bf16_t* HE;
    __device__ __forceinline__ void operator()(const f32x4 (&acc)[2][2][4][2], const pg8::UnitD& u, int wr, int wc, int fr, int fq) const {
        const int row0 = u.pm * 256 + wr * 64 + fr, col0 = u.pn * 128 + wc * 32 + 8 * fq;
#pragma unroll
        for (int ai = 0; ai < 2; ++ai)
#pragma unroll
            for (int m = 0; m < 4; ++m) { float hv[8];
#pragma unroll
                for (int n = 0; n < 2; ++n)
#pragma unroll
                    for (int x = 0; x < 4; ++x) { const float g = acc[ai][0][m][n][x], up = acc[ai][1][m][n][x]; hv[4 * n + x] = g / (1.f + __expf(-g)) * up; }
                u32x4 w; w.x = pg8::cvt_pk_bf16(hv[0], hv[1]); w.y = pg8::cvt_pk_bf16(hv[2], hv[3]); w.z = pg8::cvt_pk_bf16(hv[4], hv[5]); w.w = pg8::cvt_pk_bf16(hv[6], hv[7]);
                *(u32x4*)(HE + (size_t)(row0 + ai * 128 + m * 16) * DE + col0) = w; }
    }
};
struct EpiMoeDown {
    bf16_t* YE;
    __device__ __forceinline__ void operator()(const f32x4 (&acc)[2][2][4][2], const pg8::UnitD& u, int wr, int wc, int fr, int fq) const {
        const int row0 = u.pm * 256 + wr * 64 + fr, col0 = u.pn * 256 + wc * 32 + 8 * fq;
#pragma unroll
        for (int ai = 0; ai < 2; ++ai)
#pragma unroll
            for (int m = 0; m < 4; ++m) { bf16_t* rowp = YE + (size_t)(row0 + ai * 128 + m * 16) * D + col0;
#pragma unroll
                for (int bj = 0; bj < 2; ++bj) { const f32x4 v0 = acc[ai][bj][m][0], v1 = acc[ai][bj][m][1];
                    u32x4 w; w.x = pg8::cvt_pk_bf16(v0[0], v0[1]); w.y = pg8::cvt_pk_bf16(v0[2], v0[3]); w.z = pg8::cvt_pk_bf16(v1[0], v1[1]); w.w = pg8::cvt_pk_bf16(v1[2], v1[3]);
                    *(u32x4*)(rowp + bj * 128) = w; } }
    }
};

__device__ __forceinline__ void store16_sc1(void* p, u32x4 v) { asm volatile("global_store_dwordx4 %0, %1, off sc1\n\ts_nop 1" :: "v"(p), "v"(v) : "memory"); }
struct SchedMoe2 {
    static constexpr bool HOOKS = true;
    const OW* P; LAS int* TAB; unsigned* cnt;
    int G, c, U, nup, ndn, jA, jB;
    __device__ __forceinline__ void init(int G_, int c_) {
        G = G_; c = c_; const int NB = __builtin_amdgcn_readfirstlane(TAB[16]); U = 4 * NB;
        const int nmax = (U + G - 1) / G, nfull = U - (nmax - 1) * G;
        const bool allsame = nfull >= G; const int Lc = allsame ? 0 : G - nfull;
        nup = (c < nfull || allsame) ? nmax : nmax - 1; if (c >= U) nup = 0;
        const bool light = !allsame && c >= nfull; const int cl = c - nfull;
        const int nA = 2 * Lc < U ? 2 * Lc : U; const int R = U - nA;
        int a_cnt = 0; if (light) { a_cnt = nA - 2 * cl; a_cnt = a_cnt < 0 ? 0 : (a_cnt > 2 ? 2 : a_cnt); }
        const int o = light ? cl : Lc + c;
        const int b_cnt = o < R ? (R - o + G - 1) / G : 0;
        jA = 2 * cl; jB = nA + o; ndn = a_cnt + b_cnt; nA_mine = a_cnt;
    }
    int nA_mine;
    __device__ __forceinline__ bool next(int i, pg8::UnitD& u) const {
        if (i < nup) { const int Lq = c + i * G; fill(u, Lq >> 2, Lq & 3, false); return true; }
        const int k = i - nup; if (k >= ndn) return false;
        const int j = k < nA_mine ? jA + k : jB + (k - nA_mine) * G; fill(u, j >> 2, j & 3, true); return true;
    }
    __device__ __forceinline__ void fill(pg8::UnitD& u, int rb, int pn, bool down) const {
        int e = 0;
#pragma unroll
        for (int q = 1; q < 16; ++q) e += (__builtin_amdgcn_readfirstlane(TAB[q]) <= rb) ? 1 : 0;
        if (!down) { u.A = (const char*)P->XB; u.rows = P->ROWTOK + rb * 256; u.B = (const char*)(P->Wgu_t + ((size_t)e * 1024 + pn * 256) * 1024); u.lda = 2048; u.ldb = 2048; u.nt = 16; u.type = 4; }
        else { u.A = (const char*)(P->HE + (size_t)rb * 256 * DE); u.rows = nullptr; u.B = (const char*)(P->Wd_t + ((size_t)e * 1024 + pn * 256) * DE); u.lda = 1024; u.ldb = 1024; u.nt = 8; u.type = 5; }
        u.pm = rb; u.pn = pn; u.aux = e;
    }
    __device__ __forceinline__ void a_ready(const pg8::UnitD& u, int wid) const {
        if (u.type != 5) return;
        if (wid == 0) {
            const unsigned* w = cnt + 64 * u.pm; unsigned spins = 0;
            for (;;) { unsigned v;
                asm volatile("v_mov_b32 %0, 0\n\tglobal_load_dword %0, %0, %1 sc1\n\ts_waitcnt vmcnt(0)" : "=&v"(v) : "s"(w) : "memory");
                if ((unsigned)__builtin_amdgcn_readfirstlane((int)v) >= 32u) break;
                if (++spins > 200000u) break;
                __builtin_amdgcn_s_sleep(2); }
            __builtin_amdgcn_fence(__ATOMIC_ACQUIRE, "agent");
            asm volatile("s_waitcnt vmcnt(0)" ::: "memory");
        }
        asm volatile("" ::: "memory"); __builtin_amdgcn_s_barrier(); asm volatile("" ::: "memory");
    }
    __device__ __forceinline__ void done(const pg8::UnitD& u, int lane) const {
        if (u.type != 4) return;
        asm volatile("s_waitcnt vmcnt(0)" ::: "memory");
        if (lane == 0) __hip_atomic_fetch_add(cnt + 64 * u.pm, 1u, __ATOMIC_RELAXED, __HIP_MEMORY_SCOPE_AGENT);
    }
};
struct EpiMoe2 {
    bf16_t* HE; bf16_t* YE;
    __device__ __forceinline__ void operator()(const f32x4 (&acc)[2][2][4][2], const pg8::UnitD& u, int wr, int wc, int fr, int fq) const {
        const int row0 = u.pm * 256 + wr * 64 + fr;
        if (u.type == 4) { const int col0 = u.pn * 128 + wc * 32 + 8 * fq;
#pragma unroll
            for (int ai = 0; ai < 2; ++ai)
#pragma unroll
                for (int m = 0; m < 4; ++m) { float hv[8];
                    int rr = row0 + ai * 128 + m * 16; asm volatile("" : "+v"(rr));
#pragma unroll
                    for (int n = 0; n < 2; ++n)
#pragma unroll
                        for (int x = 0; x < 4; ++x) { const float g = acc[ai][0][m][n][x], up = acc[ai][1][m][n][x]; hv[4 * n + x] = g * __builtin_amdgcn_rcpf(1.f + __expf(-g)) * up; }
                    u32x4 w; w.x = pg8::cvt_pk_bf16(hv[0], hv[1]); w.y = pg8::cvt_pk_bf16(hv[2], hv[3]); w.z = pg8::cvt_pk_bf16(hv[4], hv[5]); w.w = pg8::cvt_pk_bf16(hv[6], hv[7]);
                    store16_sc1(HE + (size_t)rr * DE + col0, w); }
        } else { const int col0 = u.pn * 256 + wc * 32 + 8 * fq;
#pragma unroll
            for (int ai = 0; ai < 2; ++ai)
#pragma unroll
                for (int m = 0; m < 4; ++m) { int rr = row0 + ai * 128 + m * 16; asm volatile("" : "+v"(rr)); bf16_t* rowp = YE + (size_t)rr * D + col0;
#pragma unroll
                    for (int bj = 0; bj < 2; ++bj) { const f32x4 v0 = acc[ai][bj][m][0], v1 = acc[ai][bj][m][1];
                        u32x4 w; w.x = pg8::cvt_pk_bf16(v0[0], v0[1]); w.y = pg8::cvt_pk_bf16(v0[2], v0[3]); w.z = pg8::cvt_pk_bf16(v1[0], v1[1]); w.w = pg8::cvt_pk_bf16(v1[2], v1[3]);
                        *(u32x4*)(rowp + bj * 128) = w; } }
        }
    }
};
__device__ __forceinline__ void ln2_rows(const OW& P, int l, int vcu, int G, float* Xdst) {
    const int tid_ = TID(); const int lane = tid_ & 63, wid = __builtin_amdgcn_readfirstlane(tid_ >> 6);
    const float* g2 = P.in[22] + (size_t)l * D; const float* b2 = P.in[23] + (size_t)l * D;
    f32x4 gv[4], bv[4];
#pragma unroll
    for (int j = 0; j < 4; ++j) { const int c = lane * 8 + 512 * (j >> 1) + 4 * (j & 1); gv[j] = *(const f32x4*)(g2 + c); bv[j] = *(const f32x4*)(b2 + c); }
    const size_t first = (size_t)vcu * NWAVES + wid, stride = (size_t)G * NWAVES;
    for (size_t base = first; base < NT; base += 8 * stride) {
        float ga[8], gb[8]; int da[8], db[8];
#pragma unroll
        for (int k = 0; k < 8; ++k) { const size_t row = base + k * stride; const bool ok = row < NT; const size_t r_ = ok ? row : base;
            ga[k] = P.GATE[r_ * 2]; gb[k] = P.GATE[r_ * 2 + 1]; da[k] = P.DEST[r_ * 2]; db[k] = P.DEST[r_ * 2 + 1]; }
#pragma unroll
        for (int kg = 0; kg < 8; kg += 4) {
        u32x4 nx[4][2], nya[4][2], nyb[4][2];
#pragma unroll
        for (int k4 = 0; k4 < 4; ++k4) { const int k = kg + k4; const size_t row_ = base + k * stride < NT ? base + k * stride : base;
#pragma unroll
            for (int j = 0; j < 2; ++j) { nx[k4][j] = *(const u32x4*)(P.XB + row_ * D + lane * 8 + 512 * j);
                nya[k4][j] = *(const u32x4*)(P.YE + (size_t)da[k] * D + lane * 8 + 512 * j); nyb[k4][j] = *(const u32x4*)(P.YE + (size_t)db[k] * D + lane * 8 + 512 * j); } }
#pragma unroll
        for (int k4 = 0; k4 < 4; ++k4) { const int k = kg + k4; const size_t row = base + k * stride; if (row >= NT) break;
            float v[16]; float s = 0.f; const float gA = ga[k], gB = gb[k];
#pragma unroll
            for (int j = 0; j < 2; ++j)
#pragma unroll
                for (int q = 0; q < 4; ++q) { const unsigned x = nx[k4][j][q], ya = nya[k4][j][q], yb = nyb[k4][j][q];
                    v[8 * j + 2 * q] = ALPHA * bflo(x) + gA * bflo(ya) + gB * bflo(yb); v[8 * j + 2 * q + 1] = ALPHA * bfhi(x) + gA * bfhi(ya) + gB * bfhi(yb); }
#pragma unroll
            for (int i = 0; i < 16; ++i) s += v[i];
            const float mu = wsum(s) * (1.f / D); float q_ = 0.f;
#pragma unroll
            for (int i = 0; i < 16; ++i) { v[i] -= mu; q_ += v[i] * v[i]; }
            const float rs = rsqrtf(wsum(q_) * (1.f / D) + EPS);
#pragma unroll
            for (int i = 0; i < 16; ++i) v[i] = v[i] * rs * gv[i >> 2][i & 3] + bv[i >> 2][i & 3];
#pragma unroll
            for (int j = 0; j < 2; ++j) { u32x4 o;
#pragma unroll
                for (int q = 0; q < 4; ++q) o[q] = pk2(v[8 * j + 2 * q], v[8 * j + 2 * q + 1]);
                *(u32x4*)(P.XB + row * D + lane * 8 + 512 * j) = o;
                if (Xdst) { *(f32x4*)(Xdst + row * D + lane * 8 + 512 * j) = (f32x4){v[8 * j], v[8 * j + 1], v[8 * j + 2], v[8 * j + 3]}; *(f32x4*)(Xdst + row * D + lane * 8 + 512 * j + 4) = (f32x4){v[8 * j + 4], v[8 * j + 5], v[8 * j + 6], v[8 * j + 7]}; } }
        }
        }
    }
}

#if MODE == 0
__global__ void __launch_bounds__(NTHREADS, 2) opt_phase(OW P, int phase, int layer) {
    extern __shared__ __attribute__((aligned(16))) unsigned char lds_raw[];
    LAS unsigned char* lds = (LAS unsigned char*)lds_raw;
    const int G = gridDim.x, bx = blockIdx.x, vcu = (G % 8 == 0) ? (bx % 8) * (G / 8) + bx / 8 : bx;
    switch (phase) {
        case 0: if (PH(0)) { prep_tables(P, vcu, G); prep_weights(P, layer, lds, vcu, G); } break;
        case 1: if (PH(1)) phase_inproj(P, lds, G); break;
        case 2: if (PH(2)) phase_qkv(P, layer, lds, G); break;
        case 3: if (PH(3)) phase_attn(P, lds, vcu, G); break;
        case 4: if (PH(4)) { for (int tile = blockIdx.x; tile < NT / 64; tile += G) mix_tile(P, lds, tile); } break;
        case 5: if (PH(5)) { SchedOut Sd{&P, G, (int)blockIdx.x}; EpiOut E{P.XB, P.Y}; pg8::gemm_phase<true>(lds, Sd, E); } break;
        case 6: if (PH(6)) { for (int tile = blockIdx.x; tile < NT / 64; tile += G) ln1_router_tile(P, layer, lds, tile); } break;
        case 7: if (PH(7)) { moe_table(P, lds); for (int tile = blockIdx.x; tile < NT / 64; tile += G) dest_tile(P, lds, tile); } break;
        case 8: if (PH(8)) { moe_table(P, lds); SchedMoe Sd{&P, (LAS int*)(lds + TAB_OFF), G, (int)blockIdx.x, false}; EpiMoeUp E{P.HE}; pg8::gemm_phase<true>(lds, Sd, E); } break;
        case 9: if (PH(9)) { moe_table(P, lds); SchedMoe Sd{&P, (LAS int*)(lds + TAB_OFF), G, (int)blockIdx.x, true}; EpiMoeDown E{P.YE}; pg8::gemm_phase<true>(lds, Sd, E); } break;
        case 10: if (PH(10)) { ln2_rows(P, layer, vcu, G, layer == L - 1 ? P.X : nullptr); if (layer + 1 < L) prep_weights(P, layer + 1, lds, vcu, G); } break;
        default: break;
    }
}

#endif
struct MArgs { const float* in[24]; float* X; char* ws; };
constexpr int PT_OFF = LDSCTL_OFF + 2048;
__device__ __forceinline__ unsigned long long ldq(LAS unsigned char* lds, int k) {
    const LAS unsigned* p = (const LAS unsigned*)(lds + PT_OFF) + 2 * k;
    const unsigned lo = (unsigned)__builtin_amdgcn_readfirstlane((int)p[0]), hi = (unsigned)__builtin_amdgcn_readfirstlane((int)p[1]);
    return ((unsigned long long)hi << 32) | lo;
}
__device__ __forceinline__ OW load_ow(LAS unsigned char* lds_, int wsel = 0) {
    unsigned la = (unsigned)(uintptr_t)lds_; asm volatile("" : "+s"(la) :: "memory"); LAS unsigned char* lds = (LAS unsigned char*)(uintptr_t)la;
    OW P;
#pragma unroll
    for (int i = 0; i < 24; ++i) P.in[i] = (const float*)(GAS const float*)ldq(lds, i);
    P.X = (float*)(GAS float*)ldq(lds, 24); GAS char* ws = (GAS char*)ldq(lds, 25); GAS char* wsw = ws + (wsel ? ows::WSET1 : 0);
    P.ctl = (unsigned*)(GAS unsigned*)(ws + ows::CTL); P.XB = (bf16_t*)(GAS bf16_t*)(ws + ows::XB); P.Z = (bf16_t*)(GAS bf16_t*)(ws + ows::Z); P.SSQ = (float*)(GAS float*)(ws + ows::SSQ);
    P.Win_t = (bf16_t*)(GAS bf16_t*)(wsw + ows::WIN); P.Wq_t = (bf16_t*)(GAS bf16_t*)(wsw + ows::WQ); P.Wkv_t = (bf16_t*)(GAS bf16_t*)(wsw + ows::WKV); P.Wo_t = (bf16_t*)(GAS bf16_t*)(wsw + ows::WO);
    P.Wgu_t = (bf16_t*)(GAS bf16_t*)(wsw + ows::WGU); P.Wd_t = (bf16_t*)(GAS bf16_t*)(wsw + ows::WD); P.Wlg_t = (bf16_t*)(GAS bf16_t*)(wsw + ows::WLG); P.RWH = (bf16_t*)(GAS bf16_t*)(wsw + ows::WLG + 262144); P.RGB = (float*)(GAS float*)(wsw + ows::WLG + 393216);
    P.ROPE = (f32x2*)(GAS f32x2*)(ws + ows::ROPE); P.Q = (bf16_t*)(GAS bf16_t*)(ws + ows::Q); P.KN = (bf16_t*)(GAS bf16_t*)(ws + ows::KN); P.VV = (bf16_t*)(GAS bf16_t*)(ws + ows::VV); P.KPE = (bf16_t*)(GAS bf16_t*)(ws + ows::KPE);
    P.A = (float*)(GAS float*)(ws + ows::A); P.DRV = (float*)(GAS float*)(ws + ows::DRV); P.AGA = (float*)(GAS float*)(ws + ows::AGA); P.AGB = (float*)(GAS float*)(ws + ows::AGB);
    P.OP = (bf16_t*)(GAS bf16_t*)(ws + ows::OP); P.ML = (f32x2*)(GAS f32x2*)(ws + ows::ML); P.MIX = (bf16_t*)(GAS bf16_t*)(ws + ows::MIX); P.Y = (bf16_t*)(GAS bf16_t*)(ws + ows::Y);
    P.EIDX = (int*)(GAS int*)(ws + ows::EIDX); P.HIST = (int*)(GAS int*)(ws + ows::HIST); P.LRANK = (int*)(GAS int*)(ws + ows::LRANK); P.DEST = (int*)(GAS int*)(ws + ows::DEST); P.ROWTOK = (int*)(GAS int*)(ws + ows::ROWTOK); P.GATE = (float*)(GAS float*)(ws + ows::GATE);
    P.HE = (bf16_t*)(GAS bf16_t*)(ws + ows::HE); P.YE = (bf16_t*)(GAS bf16_t*)(ws + ows::YE);
    return P;
}
__global__ void __launch_bounds__(NTHREADS, 2) mega_fwd(MArgs a) {
    extern __shared__ __attribute__((aligned(16))) unsigned char lds_raw[];
    LAS unsigned char* lds = (LAS unsigned char*)lds_raw;
    for (int u = threadIdx.x; u < (LDS_BYTES - LDSCTL_OFF) / 4; u += NTHREADS) ((LAS unsigned*)(lds + LDSCTL_OFF))[u] = 0u;
    __syncthreads();
    { LAS unsigned long long* PT = (LAS unsigned long long*)(lds + PT_OFF);
#pragma unroll
      for (int i = 0; i < 24; ++i) if (threadIdx.x == i) PT[i] = (unsigned long long)a.in[i];
      if (threadIdx.x == 24) PT[24] = (unsigned long long)a.X;
      if (threadIdx.x == 25) PT[25] = (unsigned long long)a.ws; }
    __syncthreads();
    XcdBarrier bar; { const OW P = load_ow(lds); bar = xcd_barrier_post(P.ctl + 4096, (volatile LAS unsigned*)(lds + MISC_OFF) + 8); }
    LAS int* TAB = (LAS int*)(lds + TAB_OFF);
    if (PH(0)) { const OW P = load_ow(lds); const int G = GDIM(); const int b_ = BID(); const int v_ = (G % 8 == 0) ? (b_ % 8) * (G / 8) + b_ / 8 : b_; prep_tables(P, v_, G);
        if (G == 256) { prep_weights(P, 0, lds, v_, G, 0, 136, 1); prep_weights(P, 0, lds, v_, G, 1236, 1 << 30, 0); const OW P1 = load_ow(lds, 1); prep_weights(P1, 0, lds, v_, G, 0, 0, 1); }
        else { prep_weights(P, 0, lds, v_, G, 0, 1 << 30, 3); const OW P1 = load_ow(lds, 1); prep_weights(P1, 0, lds, v_, G, 0, 0, 1); } }
    xcd_barrier(bar);
    for (int l = 0; l < L; ++l) {
        constexpr int SPLIT = 900;
        for (int rep_ = 0; rep_ < (DUP(1) ? 2 : 1); ++rep_) if (PH(1)) { const OW P = load_ow(lds, l & 1); const int G = GDIM(); phase_inproj(P, lds, G); }
        if (PH(10)) {
            const int G = GDIM(), b_ = BID(); const int nmax = (576 + G - 1) / G, nfull = 576 - (nmax - 1) * G;
            if (G == 256) { const OW P = load_ow(lds, l & 1); if (b_ >= nfull) prep_weights(P, l, lds, b_ - nfull, G - nfull, l == 0 ? 136 : SPLIT, l == 0 ? 1236 : 1 << 30, 2); }
            else if (l + 1 < L) { const OW P = load_ow(lds, (l + 1) & 1); prep_weights(P, l + 1, lds, b_, G, 0, 1 << 30, 2); } }
        xcd_barrier(bar);
        for (int rep_ = 0; rep_ < (DUP(2) ? 2 : 1); ++rep_) if (PH(2)) { { const OW P = load_ow(lds, l & 1); const int G = GDIM(); const int b_ = BID(); SchedQKV Sd{&P, G, (G % 8 == 0) ? (b_ % 8) * (G / 8) + b_ / 8 : b_};     EpiQKV E{P.SSQ, P.Q, P.KN, P.VV}; pg8::gemm_phase<true>(lds, Sd, E); }
                     { const OW P = load_ow(lds, l & 1); const int G = GDIM(); for (int tile = BID(); tile < NT / 64; tile += G) { gates_tile(P, l, lds, tile); if (DUP(15)) gates_tile(P, l, lds, tile); } } }
        xcd_barrier(bar);
        for (int rep_ = 0; rep_ < (DUP(3) ? 2 : 1); ++rep_) if (PH(3)) { const OW P = load_ow(lds, l & 1); const int G = GDIM(); { const int b_ = BID(); phase_attn(P, lds, (G % 8 == 0) ? (b_ % 8) * (G / 8) + b_ / 8 : b_, G); } }
        xcd_barrier(bar);
        for (int rep_ = 0; rep_ < (DUP(4) ? 2 : 1); ++rep_) if (PH(4)) { const OW P = load_ow(lds, l & 1); const int G = GDIM(); for (int tile = BID(); tile < NT / 64; tile += G) mix_tile(P, lds, tile); }
        xcd_barrier(bar);
        for (int rep_ = 0; rep_ < (DUP(5) ? 2 : 1); ++rep_) if (PH(5)) { const OW P = load_ow(lds, l & 1); const int G = GDIM(); SchedOut Sd{&P, G, BID()}; EpiOut E{P.XB, P.Y}; pg8::gemm_phase<true>(lds, Sd, E); }
        xcd_barrier(bar);
        for (int rep_ = 0; rep_ < (DUP(6) ? 2 : 1); ++rep_) if (PH(6)) { const OW P = load_ow(lds, l & 1); const int G = GDIM(); for (int tile = BID(); tile < NT / 64; tile += G) { ln1_router_tile(P, l, lds, tile); if (DUP(13)) ln1_router_tile(P, l, lds, tile); } }
        xcd_barrier(bar);
        for (int rep_ = 0; rep_ < (DUP(7) ? 2 : 1); ++rep_) if (PH(7)) { const OW P = load_ow(lds, l & 1); const int G = GDIM(); moe_table(P, lds); for (int tile = BID(); tile < NT / 64; tile += G) dest_tile(P, lds, tile); }
        xcd_barrier(bar);
        for (int rep_ = 0; rep_ < (DUP(8) ? 2 : 1); ++rep_) if (PH(8)) { const OW P = load_ow(lds, l & 1); const int G = GDIM(); SchedMoe2 Sd; Sd.P = &P; Sd.TAB = TAB; Sd.cnt = P.ctl + MOECNT_W + l * 144 * 64; { const int b_ = BID(); Sd.init(G, (G % 8 == 0) ? (b_ % 8) * (G / 8) + b_ / 8 : b_); } EpiMoe2 E{P.HE, P.YE}; pg8::gemm_phase<true>(lds, Sd, E); }
        if (PH(10) && l + 1 < L && GDIM() == 256) { const OW P = load_ow(lds, (l + 1) & 1); prep_queue(P, l + 1, lds, P.ctl + PREPQ_W + l * 64, 0, SPLIT); }
        xcd_barrier(bar);
        if (PH(10)) { const OW P = load_ow(lds, l & 1); const int G = GDIM(); { const int b_ = BID(); const int v_ = (G % 8 == 0) ? (b_ % 8) * (G / 8) + b_ / 8 : b_; ln2_rows(P, l, v_, G, l == L - 1 ? P.X : nullptr); } }
        if (l + 1 < L) xcd_barrier(bar);
        if (DUP(12)) for (int rep_ = 0; rep_ < 10; ++rep_) xcd_barrier(bar);
    }
}
#if MODE == 0
__global__ void shim_q(const bf16_t* Qb, float* Qf) { const size_t i = (size_t)blockIdx.x * 256 + threadIdx.x; if (i < (size_t)NT * QL) Qf[i] = bf2f(Qb[i]); }
__global__ void shim_kv(const bf16_t* KN, const bf16_t* VV, float* KV) { const size_t i = (size_t)blockIdx.x * 256 + threadIdx.x; if (i < (size_t)NT * 1024) { const size_t r = i >> 10; const int c = (int)(i & 1023), h = c >> 8, d = c & 255;
    KV[i] = d < 128 ? bf2f(KN[r * 512 + h * 128 + d]) : bf2f(VV[r * 512 + h * 128 + d - 128]); } }
__global__ void shim_kpe(const bf16_t* Kb, float* Kf) { const size_t i = (size_t)blockIdx.x * 256 + threadIdx.x; if (i < (size_t)NT * 64) Kf[i] = bf2f(Kb[i]); }
__global__ void shim_z(const bf16_t* Zb, float* Zf) { const size_t i = (size_t)blockIdx.x * 256 + threadIdx.x; if (i < (size_t)NT * INW) { const size_t r = i / INW, c = i % INW; Zf[i] = bf2f(Zb[r * ZW + c]); } }


#endif
#if MODE == 0
static OW make_ow(void* const* d_in, float* out, char* ws) {
    OW P{};
    for (int i = 0; i < 24; ++i) P.in[i] = (const float*)d_in[i];
    P.X = out; P.ctl = (unsigned*)(ws + ows::CTL); P.XB = (bf16_t*)(ws + ows::XB); P.Z = (bf16_t*)(ws + ows::Z); P.SSQ = (float*)(ws + ows::SSQ);
    P.Win_t = (bf16_t*)(ws + ows::WIN); P.Wq_t = (bf16_t*)(ws + ows::WQ); P.Wkv_t = (bf16_t*)(ws + ows::WKV); P.Wo_t = (bf16_t*)(ws + ows::WO); P.Wgu_t = (bf16_t*)(ws + ows::WGU); P.Wd_t = (bf16_t*)(ws + ows::WD); P.Wlg_t = (bf16_t*)(ws + ows::WLG);
    P.ROPE = (f32x2*)(ws + ows::ROPE); P.Q = (bf16_t*)(ws + ows::Q); P.KN = (bf16_t*)(ws + ows::KN); P.VV = (bf16_t*)(ws + ows::VV); P.KPE = (bf16_t*)(ws + ows::KPE);
    P.A = (float*)(ws + ows::A); P.DRV = (float*)(ws + ows::DRV); P.AGA = (float*)(ws + ows::AGA); P.AGB = (float*)(ws + ows::AGB);
    P.OP = (bf16_t*)(ws + ows::OP); P.ML = (f32x2*)(ws + ows::ML); P.MIX = (bf16_t*)(ws + ows::MIX); P.Y = (bf16_t*)(ws + ows::Y);
    P.EIDX = (int*)(ws + ows::EIDX); P.HIST = (int*)(ws + ows::HIST); P.LRANK = (int*)(ws + ows::LRANK); P.DEST = (int*)(ws + ows::DEST); P.ROWTOK = (int*)(ws + ows::ROWTOK); P.GATE = (float*)(ws + ows::GATE);
    P.HE = (bf16_t*)(ws + ows::HE); P.YE = (bf16_t*)(ws + ows::YE); P.RWH = (bf16_t*)(ws + ows::WLG + 262144); P.RGB = (float*)(ws + ows::WLG + 393216);
    return P;
}

#endif
constexpr int ATT_LDS = (4 * S + 4 * QH) * 4, MOEUP_LDS = D * 16 * 4 + 64;
#ifndef OPT_STAGES
#define OPT_STAGES 0
#endif
#ifndef OPT_LAYERS
#define OPT_LAYERS 1
#endif
#if MODE == 0
static void hybrid_forward(void* const* d_in, float* out, float* ws, hipStream_t st) {
    const float* x0 = (const float*)d_in[0];
    float* Z = ws + rws::Z; float* YE = Z; float* A = ws + rws::AB; float* DRV = A + (size_t)NT * LW; float* HID = A;
    float* Q = ws + rws::Q; float* KV = ws + rws::KV; float* Y = KV; float* KPE = ws + rws::KPE; float* MIX = ws + rws::MIX;
    float* GATE = ws + rws::GATE; int* CNT = (int*)(ws + rws::CNT); int* LIST = (int*)(ws + rws::LIST);
    OW P{};
    for (int i = 0; i < 24; ++i) P.in[i] = (const float*)d_in[i];
    P.X = out;
    char* tailp = (char*)(ws + rws::END);
    P.ctl = (unsigned*)tailp; tailp += 65536;
    P.ROPE = (f32x2*)tailp; tailp += (size_t)S * 32 * 8;
    P.SSQ = (float*)tailp; tailp += (size_t)NT * 16 * 4;
    P.Win_t = (bf16_t*)tailp; tailp += (size_t)ZW * D * 2;
    P.Wq_t = (bf16_t*)tailp; tailp += (size_t)768 * 768 * 2;
    P.Wkv_t = (bf16_t*)tailp; tailp += (size_t)1024 * 256 * 2;
    P.Wo_t = (bf16_t*)tailp; tailp += (size_t)1024 * 1024 * 2;
    P.Wlg_t = (bf16_t*)tailp; tailp += (size_t)8 * 128 * 64 * 2;
    P.Wgu_t = (bf16_t*)tailp; tailp += (size_t)16 * 1024 * 1024 * 2;
    P.Wd_t = (bf16_t*)tailp; tailp += (size_t)16 * 1024 * 512 * 2;
    P.AGA = (float*)tailp; tailp += (size_t)256 * LW * 4;
    P.AGB = (float*)tailp; tailp += (size_t)256 * LW * 4;
    P.OP = (bf16_t*)tailp; tailp += (size_t)2 * NT * 512 * 2;
    P.ML = (f32x2*)tailp; tailp += (size_t)2 * NT * 4 * 8;
    P.A = A; P.DRV = DRV;
    { char* m = (char*)(ws + rws::MIX) ; P.Q = (bf16_t*)m; m += (size_t)NT * QL * 2; P.KN = (bf16_t*)m; m += (size_t)NT * 512 * 2; P.VV = (bf16_t*)m; m += (size_t)NT * 512 * 2; P.KPE = (bf16_t*)m; }
    P.XB = (bf16_t*)(ws + rws::MIX);
    P.Z = (bf16_t*)(ws + rws::KV);
    P.Z = (bf16_t*)(ws + rws::Q);
    const OW PF = make_ow(d_in, out, (char*)ws);
    for (int l = 0; l < L; ++l) {
        if (l < OPT_LAYERS) {
            if (l == 0) opt_phase<<<256, NTHREADS, LDS_BYTES, st>>>(PF, 0, 0);
            for (int ph = 1; ph <= 10; ++ph) opt_phase<<<256, NTHREADS, LDS_BYTES, st>>>(PF, ph, l);
            continue;
        }
        const float* xin = l == 0 ? x0 : out;
        const float* w_in = (const float*)d_in[1] + (size_t)l * D * INW;
        const float* conv_w = (const float*)d_in[2] + (size_t)l * 4 * LW;
        const float* conv_b = (const float*)d_in[3] + (size_t)l * LW;
        const float* w_r = (const float*)d_in[4] + (size_t)l * 8 * 64 * 64;
        const float* b_r = (const float*)d_in[5] + (size_t)l * LW;
        const float* w_i = (const float*)d_in[6] + (size_t)l * 8 * 64 * 64;
        const float* b_i = (const float*)d_in[7] + (size_t)l * LW;
        const float* lam = (const float*)d_in[8] + (size_t)l * LW;
        const float* qng = (const float*)d_in[9] + (size_t)l * QL;
        const float* w_qup = (const float*)d_in[10] + (size_t)l * QL * 768;
        const float* kvng = (const float*)d_in[11] + (size_t)l * KVL;
        const float* w_kvup = (const float*)d_in[12] + (size_t)l * KVL * 1024;
        const float* ong = (const float*)d_in[13] + (size_t)l * 1024;
        const float* w_out = (const float*)d_in[14] + (size_t)l * 1024 * D;
        const float* ln1g = (const float*)d_in[15] + (size_t)l * D;
        const float* ln1b = (const float*)d_in[16] + (size_t)l * D;
        const float* rw = (const float*)d_in[17];
        const float* rb = (const float*)d_in[18];
        const float* wg = (const float*)d_in[19] + (size_t)l * NE * D * DE;
        const float* wu = (const float*)d_in[20] + (size_t)l * NE * D * DE;
        const float* wd = (const float*)d_in[21] + (size_t)l * NE * DE * D;
        const float* ln2g = (const float*)d_in[22] + (size_t)l * D;
        const float* ln2b = (const float*)d_in[23] + (size_t)l * D;
        const int nopt = l == 0 ? OPT_STAGES : 0;
        if (nopt >= 1) {
            opt_phase<<<256, NTHREADS, LDS_BYTES, st>>>(P, 0, l);
            opt_phase<<<256, NTHREADS, LDS_BYTES, st>>>(P, 1, l);
            if (nopt >= 2) opt_phase<<<256, NTHREADS, LDS_BYTES, st>>>(P, 2, l);
            if (nopt >= 3) opt_phase<<<256, NTHREADS, LDS_BYTES, st>>>(P, 3, l);
            shim_z<<<(unsigned)(((size_t)NT * INW + 255) / 256), 256, 0, st>>>(P.Z, Z);
        } else {
            ref::gemm<true><<<dim3(INW / 64, NT / 64), 256, 0, st>>>(xin, D, w_in, INW, Z, INW, D);
        }
        if (nopt >= 3) {
            ref::lru_scan<<<B * LW / 256, 256, 0, st>>>(A, DRV, Z, MIX);
            shim_attn<<<(unsigned)(((size_t)NT * 512 + 255) / 256), 256, 0, st>>>(P.OP, P.ML, MIX);
        } else if (nopt >= 2) {
            shim_q<<<(unsigned)(((size_t)NT * QL + 255) / 256), 256, 0, st>>>(P.Q, Q);
            shim_kv<<<(unsigned)(((size_t)NT * 1024 + 255) / 256), 256, 0, st>>>(P.KN, P.VV, KV);
            shim_kpe<<<(unsigned)(((size_t)NT * 64 + 255) / 256), 256, 0, st>>>(P.KPE, KPE);
            ref::lru_scan<<<B * LW / 256, 256, 0, st>>>(A, DRV, Z, MIX);
            ref::q_post<<<NT * 4 * 96 / 256, 256, 0, st>>>(Q);
        } else {
            ref::lru_gates<<<NT * LW / 256, 256, 0, st>>>(Z, conv_w, conv_b, w_r, b_r, w_i, b_i, lam, A, DRV);
            ref::lru_scan<<<B * LW / 256, 256, 0, st>>>(A, DRV, Z, MIX);
            ref::rmsnorm<<<NT / 4, 256, 0, st>>>(Z, INW, 1024, QL, qng);
            ref::rmsnorm<<<NT / 4, 256, 0, st>>>(Z, INW, 1792, KVL, kvng);
            ref::gemm<true><<<dim3(768 / 64, NT / 64), 256, 0, st>>>(Z + 1024, INW, w_qup, 768, Q, QL, QL);
            ref::gemm<true><<<dim3(1024 / 64, NT / 64), 256, 0, st>>>(Z + 1792, INW, w_kvup, 1024, KV, 1024, KVL);
            ref::q_post<<<NT * 4 * 96 / 256, 256, 0, st>>>(Q);
            ref::kpe_rope<<<NT * 32 / 256, 256, 0, st>>>(Z, KPE);
        }
        if (nopt < 3) ref::attention<<<B * H * S / 4, 64, ATT_LDS, st>>>(Q, KV, KPE, MIX);
        ref::rmsnorm<<<NT / 4, 256, 0, st>>>(MIX, D, 0, 512, ong);
        ref::rmsnorm<<<NT / 4, 256, 0, st>>>(MIX, D, 512, 512, ong + 512);
        ref::gemm<false><<<dim3(D / 64, NT / 64), 256, 0, st>>>(MIX, D, w_out, D, Y, D, 1024);
        ref::ln_res<<<NT / 4, 256, 0, st>>>(xin, Y, out, ln1g, ln1b);
        (void)hipMemsetAsync(CNT, 0, 64 * sizeof(int), st);
        ref::router<<<NT / 4, 256, 0, st>>>(out, rw, rb, GATE, CNT, LIST);
        ref::moe_up<<<dim3(NT / 16, NE), 256, MOEUP_LDS, st>>>(out, wg, wu, CNT, LIST, HID);
        ref::moe_down<<<dim3(NT / 16, NE), 256, 0, st>>>(HID, wd, CNT, LIST, YE);
        ref::ln_moe<<<NT / 4, 256, 0, st>>>(out, YE, GATE, ln2g, ln2b);
    }
}

#endif
extern "C" void kernel_launch(void* const* d_in, const int* in_sizes, int n_in, void* d_out, int out_size, void* d_ws, size_t ws_size, hipStream_t stream) {
    if (n_in != 24 || out_size != NT * D || ws_size < (size_t)536870912) {
        fprintf(stderr, "kernel_launch: unexpected shapes (n_in %d, out %d, ws %zu)\n", n_in, out_size, ws_size);
        return;
    }
#if MODE == 0
    static bool attr_done = false;
    if (!attr_done) { attr_done = true;
        (void)hipFuncSetAttribute((const void*)ref::attention, hipFuncAttributeMaxDynamicSharedMemorySize, ATT_LDS);
        (void)hipFuncSetAttribute((const void*)ref::moe_up, hipFuncAttributeMaxDynamicSharedMemorySize, MOEUP_LDS);
        (void)hipFuncSetAttribute((const void*)opt_phase, hipFuncAttributeMaxDynamicSharedMemorySize, LDS_BYTES);
    }
#endif
#if MODE == 0
    hybrid_forward(d_in, (float*)d_out, (float*)d_ws, stream);
#else
    static int grid = 0;
    if (grid == 0) { int dev = 0, cus = 0; (void)hipGetDevice(&dev); if (hipDeviceGetAttribute(&cus, hipDeviceAttributeMultiprocessorCount, dev) != hipSuccess || cus <= 0) cus = 256; grid = cus;
        (void)hipFuncSetAttribute((const void*)mega_fwd, hipFuncAttributeMaxDynamicSharedMemorySize, LDS_BYTES); }
    MArgs a{};
    for (int i = 0; i < 24; ++i) a.in[i] = (const float*)d_in[i];
    a.X = (float*)d_out; a.ws = (char*)d_ws;
    (void)hipMemsetAsync((char*)d_ws + ows::CTL, 0, 262144, stream);
    hipLaunchKernelGGL(mega_fwd, dim3(grid), dim3(NTHREADS), LDS_BYTES, stream, a);
#endif
}
```

```cpp
#include <hip/hip_runtime.h>
#include <cstdint>
#include <cstdio>

namespace cfg {
constexpr int D = 1024, B = 4, S = 4096, NT = B * S, L = 4;
constexpr int LW = 512, NBLK = 8, BLK = 64;
constexpr int H = 4, QNOPE = 128, QROPE = 64, QH = 192, VH = 128, QL = 768, KVL = 256;
constexpr int INW = 2112;
constexpr int NE = 16, DE = 512;
constexpr float ALPHA = 1.681792830507429f, EPS = 1e-6f;
}
using namespace cfg;

#ifndef MODE
#define MODE 1
#endif
#if MODE == 0
namespace ref {

__device__ __forceinline__ float wave_sum(float v) {
#pragma unroll
    for (int o = 1; o < 64; o <<= 1) v += __shfl_xor(v, o);
    return v;
}
__device__ __forceinline__ float wave_max(float v) {
#pragma unroll
    for (int o = 1; o < 64; o <<= 1) v = fmaxf(v, __shfl_xor(v, o));
    return v;
}
#define BF16_EMU 1
__device__ __forceinline__ float rb(float f) {
#if BF16_EMU
    unsigned u = __float_as_uint(f); u = (u + 0x7fffu + ((u >> 16) & 1u)) & 0xffff0000u; return __uint_as_float(u);
#else
    return f;
#endif
}
__device__ __forceinline__ float sigmoidf_(float x) { return 1.f / (1.f + expf(-x)); }
__device__ __forceinline__ float gelu_tanh(float x) { return 0.5f * x * (1.f + tanhf(0.7978845608028654f * (x + 0.044715f * x * x * x))); }

template <bool RO> __global__ __launch_bounds__(256) void gemm(const float* __restrict__ A, int lda, const float* __restrict__ Bm, int ldb, float* __restrict__ C, int ldc, int K) {
    __shared__ float As[16][68];
    __shared__ float Bs[16][68];
    const int tid = threadIdx.x, tx = tid & 15, ty = tid >> 4;
    const int m0 = blockIdx.y * 64, n0 = blockIdx.x * 64;
    float acc[4][4];
#pragma unroll
    for (int i = 0; i < 4; ++i)
#pragma unroll
        for (int j = 0; j < 4; ++j) acc[i][j] = 0.f;
    for (int k0 = 0; k0 < K; k0 += 16) {
#pragma unroll
        for (int it = 0; it < 4; ++it) { const int i = tid + it * 256; const int m = i >> 4, k = i & 15; As[k][m] = rb(A[(size_t)(m0 + m) * lda + k0 + k]); }
#pragma unroll
        for (int it = 0; it < 4; ++it) { const int i = tid + it * 256; const int k = i >> 6, n = i & 63; Bs[k][n] = rb(Bm[(size_t)(k0 + k) * ldb + n0 + n]); }
        __syncthreads();
#pragma unroll
        for (int k = 0; k < 16; ++k) {
            float a[4], b[4];
#pragma unroll
            for (int i = 0; i < 4; ++i) { a[i] = As[k][ty * 4 + i]; b[i] = Bs[k][tx * 4 + i]; }
#pragma unroll
            for (int i = 0; i < 4; ++i)
#pragma unroll
                for (int j = 0; j < 4; ++j) acc[i][j] = fmaf(a[i], b[j], acc[i][j]);
        }
        __syncthreads();
    }
#pragma unroll
    for (int i = 0; i < 4; ++i)
#pragma unroll
        for (int j = 0; j < 4; ++j) C[(size_t)(m0 + ty * 4 + i) * ldc + n0 + tx * 4 + j] = RO ? rb(acc[i][j]) : acc[i][j];
}

__global__ __launch_bounds__(256) void rmsnorm(float* X, int ld, int off, int n, const float* __restrict__ g) {
    const int row = blockIdx.x * 4 + (threadIdx.x >> 6), lane = threadIdx.x & 63;
    float* x = X + (size_t)row * ld + off;
    float s = 0.f;
    for (int i = lane; i < n; i += 64) { const float v = x[i]; s += v * v; }
    s = wave_sum(s);
    const float r = rsqrtf(s / (float)n + EPS);
    for (int i = lane; i < n; i += 64) x[i] = x[i] * r * g[i];
}

__global__ __launch_bounds__(256) void lru_gates(const float* __restrict__ Z, const float* __restrict__ conv_w, const float* __restrict__ conv_b,
                                                 const float* __restrict__ wr, const float* __restrict__ br, const float* __restrict__ wi, const float* __restrict__ bi,
                                                 const float* __restrict__ lam, float* __restrict__ Aout, float* __restrict__ Dout) {
    const int idx = blockIdx.x * 256 + threadIdx.x;
    const int tok = idx >> 9, ch = idx & 511, n = ch >> 6, d = ch & 63, s = tok & (S - 1);
    float accr = br[ch], acci = bi[ch], xc_own = 0.f;
    for (int c = 0; c < 64; ++c) {
        const int cc = n * 64 + c;
        float xc = conv_b[cc];
#pragma unroll
        for (int w = 0; w < 4; ++w) { const int sp = s + w - 3; if (sp >= 0) xc = fmaf(Z[(size_t)(tok + w - 3) * INW + cc], conv_w[w * LW + cc], xc); }
        accr = fmaf(xc, wr[(size_t)cc * 64 + d], accr);
        acci = fmaf(xc, wi[(size_t)cc * 64 + d], acci);
        if (c == d) xc_own = xc;
    }
    const float r = sigmoidf_(accr), ig = sigmoidf_(acci);
    const float sp = log1pf(expf(-lam[ch]));
    const float log_a = -8.0f * r * sp;
    Aout[idx] = expf(log_a);
    Dout[idx] = sqrtf(-expm1f(2.0f * log_a)) * (ig * xc_own);
}

__global__ __launch_bounds__(256) void lru_scan(const float* __restrict__ Ain, const float* __restrict__ Din, const float* __restrict__ Z, float* __restrict__ MIX) {
    const int idx = blockIdx.x * 256 + threadIdx.x;
    const int b = idx >> 9, ch = idx & 511;
    float h = 0.f;
    for (int s0 = 0; s0 < S; s0 += 8) {
        float a[8], d[8], g[8];
#pragma unroll
        for (int j = 0; j < 8; ++j) { const size_t t = (size_t)b * S + s0 + j; a[j] = Ain[t * LW + ch]; d[j] = Din[t * LW + ch]; g[j] = Z[t * INW + LW + ch]; }
#pragma unroll
        for (int j = 0; j < 8; ++j) { h = fmaf(a[j], h, d[j]); const size_t t = (size_t)b * S + s0 + j; MIX[t * D + ch] = h * gelu_tanh(g[j]); }
    }
}

__global__ __launch_bounds__(256) void q_post(float* Q) {
    const int idx = blockIdx.x * 256 + threadIdx.x;
    const int j = idx % 96, th = idx / 96, h = th & 3, tok = th >> 2, s = tok & (S - 1);
    float* q = Q + (size_t)tok * QL + h * QH;
    const float sc = 0.07216878364870322f;
    if (j < 64) { q[j] *= sc; q[j + 64] *= sc; }
    else {
        const int i = j - 64;
        const float inv = powf(10000.0f, -(float)i / 32.0f);
        const float ang = (float)s * inv;
        const float c = cosf(ang), sn = sinf(ang);
        const float x1 = q[128 + i], x2 = q[160 + i];
        q[128 + i] = (x1 * c - x2 * sn) * sc; q[160 + i] = (x1 * sn + x2 * c) * sc;
    }
}
__global__ __launch_bounds__(256) void kpe_rope(const float* __restrict__ Z, float* __restrict__ KPE) {
    const int idx = blockIdx.x * 256 + threadIdx.x;
    const int i = idx & 31, tok = idx >> 5, s = tok & (S - 1);
    const float inv = powf(10000.0f, -(float)i / 32.0f);
    const float ang = (float)s * inv;
    const float c = cosf(ang), sn = sinf(ang);
    const float x1 = Z[(size_t)tok * INW + 2048 + i], x2 = Z[(size_t)tok * INW + 2048 + 32 + i];
    KPE[(size_t)tok * 64 + i] = x1 * c - x2 * sn; KPE[(size_t)tok * 64 + 32 + i] = x1 * sn + x2 * c;
}

__global__ __launch_bounds__(64) void attention(const float* __restrict__ Q, const float* __restrict__ KV, const float* __restrict__ KPE, float* __restrict__ MIX) {
    extern __shared__ __attribute__((aligned(16))) float dyn_lds[];
    float (*sc)[S] = (float (*)[S])dyn_lds;
    float (*qs)[QH] = (float (*)[QH])(dyn_lds + 4 * S);
    const int lane = threadIdx.x;
    const int blk = blockIdx.x;
    const int qb = blk % (S / 4), bh = blk / (S / 4), h = bh & 3, b = bh >> 2;
    const int q0 = qb * 4;
    for (int i = lane; i < 4 * QH; i += 64) { const int r = i / QH, d = i % QH; qs[r][d] = rb(Q[(size_t)(b * S + q0 + r) * QL + h * QH + d]); }
    __syncthreads();
    const int nk = q0 + 4;
    for (int j = lane; j < nk; j += 64) {
        const float* kn = KV + (size_t)(b * S + j) * 1024 + h * 256;
        const float* kp = KPE + (size_t)(b * S + j) * 64;
        float d0 = 0.f, d1 = 0.f, d2 = 0.f, d3 = 0.f;
        for (int d = 0; d < 128; d += 4) {
            float4 kv = *(const float4*)(kn + d); kv.x = rb(kv.x); kv.y = rb(kv.y); kv.z = rb(kv.z); kv.w = rb(kv.w);
            d0 += kv.x * qs[0][d] + kv.y * qs[0][d + 1] + kv.z * qs[0][d + 2] + kv.w * qs[0][d + 3];
            d1 += kv.x * qs[1][d] + kv.y * qs[1][d + 1] + kv.z * qs[1][d + 2] + kv.w * qs[1][d + 3];
            d2 += kv.x * qs[2][d] + kv.y * qs[2][d + 1] + kv.z * qs[2][d + 2] + kv.w * qs[2][d + 3];
            d3 += kv.x * qs[3][d] + kv.y * qs[3][d + 1] + kv.z * qs[3][d + 2] + kv.w * qs[3][d + 3];
        }
        for (int d = 0; d < 64; d += 4) {
            float4 kv = *(const float4*)(kp + d); kv.x = rb(kv.x); kv.y = rb(kv.y); kv.z = rb(kv.z); kv.w = rb(kv.w);
            d0 += kv.x * qs[0][128 + d] + kv.y * qs[0][129 + d] + kv.z * qs[0][130 + d] + kv.w * qs[0][131 + d];
            d1 += kv.x * qs[1][128 + d] + kv.y * qs[1][129 + d] + kv.z * qs[1][130 + d] + kv.w * qs[1][131 + d];
            d2 += kv.x * qs[2][128 + d] + kv.y * qs[2][129 + d] + kv.z * qs[2][130 + d] + kv.w * qs[2][131 + d];
            d3 += kv.x * qs[3][128 + d] + kv.y * qs[3][129 + d] + kv.z * qs[3][130 + d] + kv.w * qs[3][131 + d];
        }
        const float NEG = -INFINITY;
        sc[0][j] = (j <= q0 + 0) ? d0 : NEG; sc[1][j] = (j <= q0 + 1) ? d1 : NEG; sc[2][j] = (j <= q0 + 2) ? d2 : NEG; sc[3][j] = (j <= q0 + 3) ? d3 : NEG;
    }
    __syncthreads();
    float inv_l[4];
#pragma unroll
    for (int r = 0; r < 4; ++r) {
        float m = -INFINITY;
        for (int j = lane; j < nk; j += 64) m = fmaxf(m, sc[r][j]);
        m = wave_max(m);
        float l = 0.f;
        for (int j = lane; j < nk; j += 64) { const float p = expf(sc[r][j] - m); sc[r][j] = rb(p); l += p; }
        l = wave_sum(l);
        inv_l[r] = 1.f / l;
    }
    __syncthreads();
    float o[4][2];
#pragma unroll
    for (int r = 0; r < 4; ++r) { o[r][0] = 0.f; o[r][1] = 0.f; }
    for (int j = 0; j < nk; ++j) {
        const float* v = KV + (size_t)(b * S + j) * 1024 + h * 256 + 128;
        const float v0 = rb(v[lane]), v1 = rb(v[lane + 64]);
#pragma unroll
        for (int r = 0; r < 4; ++r) { const float p = sc[r][j]; o[r][0] = fmaf(p, v0, o[r][0]); o[r][1] = fmaf(p, v1, o[r][1]); }
    }
#pragma unroll
    for (int r = 0; r < 4; ++r) {
        float* out = MIX + (size_t)(b * S + q0 + r) * D + 512 + h * 128;
        out[lane] = o[r][0] * inv_l[r]; out[lane + 64] = o[r][1] * inv_l[r];
    }
}

__global__ __launch_bounds__(256) void ln_res(const float* Xin, const float* __restrict__ Y, float* Xout, const float* __restrict__ g, const float* __restrict__ bta) {
    const int row = blockIdx.x * 4 + (threadIdx.x >> 6), lane = threadIdx.x & 63;
    float v[16]; float s = 0.f;
#pragma unroll
    for (int j = 0; j < 16; ++j) { const int c = lane + 64 * j; v[j] = ALPHA * Xin[(size_t)row * D + c] + Y[(size_t)row * D + c]; s += v[j]; }
    const float mu = wave_sum(s) * (1.f / D);
    float q = 0.f;
#pragma unroll
    for (int j = 0; j < 16; ++j) { v[j] -= mu; q += v[j] * v[j]; }
    const float r = rsqrtf(wave_sum(q) * (1.f / D) + EPS);
#pragma unroll
    for (int j = 0; j < 16; ++j) { const int c = lane + 64 * j; Xout[(size_t)row * D + c] = v[j] * r * g[c] + bta[c]; }
}
__global__ __launch_bounds__(256) void ln_moe(float* X, const float* __restrict__ YE, const float* __restrict__ GATE, const float* __restrict__ g, const float* __restrict__ bta) {
    const int row = blockIdx.x * 4 + (threadIdx.x >> 6), lane = threadIdx.x & 63;
    const float g0 = GATE[row * 2], g1 = GATE[row * 2 + 1];
    float v[16]; float s = 0.f;
#pragma unroll
    for (int j = 0; j < 16; ++j) { const int c = lane + 64 * j; v[j] = ALPHA * X[(size_t)row * D + c] + g0 * YE[(size_t)(2 * row) * D + c] + g1 * YE[(size_t)(2 * row + 1) * D + c]; s += v[j]; }
    const float mu = wave_sum(s) * (1.f / D);
    float q = 0.f;
#pragma unroll
    for (int j = 0; j < 16; ++j) { v[j] -= mu; q += v[j] * v[j]; }
    const float r = rsqrtf(wave_sum(q) * (1.f / D) + EPS);
#pragma unroll
    for (int j = 0; j < 16; ++j) { const int c = lane + 64 * j; X[(size_t)row * D + c] = v[j] * r * g[c] + bta[c]; }
}

__global__ __launch_bounds__(256) void router(const float* __restrict__ X, const float* __restrict__ RW, const float* __restrict__ RB, float* __restrict__ GATE, int* CNT, int* LIST) {
    const int tok = blockIdx.x * 4 + (threadIdx.x >> 6), lane = threadIdx.x & 63;
    float acc[16];
#pragma unroll
    for (int e = 0; e < 16; ++e) acc[e] = 0.f;
    for (int j = 0; j < 16; ++j) {
        const int i = lane + 64 * j;
        const float x = X[(size_t)tok * D + i];
        const float4* w = (const float4*)(RW + (size_t)i * 16);
        const float4 w0 = w[0], w1 = w[1], w2 = w[2], w3 = w[3];
        acc[0] = fmaf(x, w0.x, acc[0]); acc[1] = fmaf(x, w0.y, acc[1]); acc[2] = fmaf(x, w0.z, acc[2]); acc[3] = fmaf(x, w0.w, acc[3]);
        acc[4] = fmaf(x, w1.x, acc[4]); acc[5] = fmaf(x, w1.y, acc[5]); acc[6] = fmaf(x, w1.z, acc[6]); acc[7] = fmaf(x, w1.w, acc[7]);
        acc[8] = fmaf(x, w2.x, acc[8]); acc[9] = fmaf(x, w2.y, acc[9]); acc[10] = fmaf(x, w2.z, acc[10]); acc[11] = fmaf(x, w2.w, acc[11]);
        acc[12] = fmaf(x, w3.x, acc[12]); acc[13] = fmaf(x, w3.y, acc[13]); acc[14] = fmaf(x, w3.z, acc[14]); acc[15] = fmaf(x, w3.w, acc[15]);
    }
    float sg[16], ss[16];
#pragma unroll
    for (int e = 0; e < 16; ++e) { sg[e] = sigmoidf_(wave_sum(acc[e])); ss[e] = sg[e] + RB[e]; }
    int best_g = 0; float best = -INFINITY;
#pragma unroll
    for (int gI = 0; gI < 4; ++gI) {
        float m1 = -INFINITY, m2 = -INFINITY;
#pragma unroll
        for (int k = 0; k < 4; ++k) { const float v = ss[gI * 4 + k]; if (v > m1) { m2 = m1; m1 = v; } else if (v > m2) { m2 = v; } }
        const float gs = m1 + m2;
        if (gs > best) { best = gs; best_g = gI; }
    }
    float c0 = 0.f, c1 = 0.f, c2 = 0.f, c3 = 0.f, t0 = 0.f, t1 = 0.f, t2 = 0.f, t3 = 0.f;
#pragma unroll
    for (int gI = 0; gI < 4; ++gI) if (gI == best_g) { c0 = ss[gI * 4]; c1 = ss[gI * 4 + 1]; c2 = ss[gI * 4 + 2]; c3 = ss[gI * 4 + 3]; t0 = sg[gI * 4]; t1 = sg[gI * 4 + 1]; t2 = sg[gI * 4 + 2]; t3 = sg[gI * 4 + 3]; }
    int i1 = 0; float v1 = c0, s1 = t0;
    if (c1 > v1) { i1 = 1; v1 = c1; s1 = t1; }
    if (c2 > v1) { i1 = 2; v1 = c2; s1 = t2; }
    if (c3 > v1) { i1 = 3; v1 = c3; s1 = t3; }
    int i2 = -1; float v2 = -INFINITY, s2 = 0.f;
    if (i1 != 0 && c0 > v2) { i2 = 0; v2 = c0; s2 = t0; }
    if (i1 != 1 && c1 > v2) { i2 = 1; v2 = c1; s2 = t1; }
    if (i1 != 2 && c2 > v2) { i2 = 2; v2 = c2; s2 = t2; }
    if (i1 != 3 && c3 > v2) { i2 = 3; v2 = c3; s2 = t3; }
    if (lane == 0) {
        const int e1 = best_g * 4 + i1, e2 = best_g * 4 + i2;
        const float inv = 1.f / (s1 + s2);
        GATE[tok * 2] = s1 * inv; GATE[tok * 2 + 1] = s2 * inv;
        const int p1 = atomicAdd(&CNT[e1], 1); LIST[e1 * NT + p1] = tok * 2;
        const int p2 = atomicAdd(&CNT[e2], 1); LIST[e2 * NT + p2] = tok * 2 + 1;
    }
}

__global__ __launch_bounds__(256) void moe_up(const float* __restrict__ X, const float* __restrict__ Wg, const float* __restrict__ Wu, const int* __restrict__ CNT, const int* __restrict__ LIST, float* __restrict__ HID) {
    extern __shared__ __attribute__((aligned(16))) float dyn_lds[];
    float (*xs)[16] = (float (*)[16])dyn_lds;
    int* asg_s = (int*)(dyn_lds + D * 16);
    const int e = blockIdx.y, start = blockIdx.x * 16, cnt = CNT[e];
    if (start >= cnt) return;
    const int n = min(16, cnt - start), tid = threadIdx.x;
    if (tid < 16) asg_s[tid] = tid < n ? LIST[e * NT + start + tid] : -1;
    __syncthreads();
    for (int i = tid; i < 16 * D; i += 256) { const int r = i >> 10, k = i & 1023; const int a = asg_s[r]; xs[k][r] = a >= 0 ? rb(X[(size_t)(a >> 1) * D + k]) : 0.f; }
    __syncthreads();
    float g0[16], g1[16], u0[16], u1[16];
#pragma unroll
    for (int r = 0; r < 16; ++r) { g0[r] = 0.f; g1[r] = 0.f; u0[r] = 0.f; u1[r] = 0.f; }
    const float* wg = Wg + (size_t)e * D * DE; const float* wu = Wu + (size_t)e * D * DE;
    for (int k = 0; k < D; ++k) {
        const float a0 = rb(wg[(size_t)k * DE + tid]), a1 = rb(wg[(size_t)k * DE + tid + 256]), b0 = rb(wu[(size_t)k * DE + tid]), b1 = rb(wu[(size_t)k * DE + tid + 256]);
#pragma unroll
        for (int r = 0; r < 16; ++r) { const float x = xs[k][r]; g0[r] = fmaf(x, a0, g0[r]); g1[r] = fmaf(x, a1, g1[r]); u0[r] = fmaf(x, b0, u0[r]); u1[r] = fmaf(x, b1, u1[r]); }
    }
#pragma unroll
    for (int r = 0; r < 16; ++r) { const int a = asg_s[r]; if (a >= 0) {
        HID[(size_t)a * DE + tid] = g0[r] * sigmoidf_(g0[r]) * u0[r]; HID[(size_t)a * DE + tid + 256] = g1[r] * sigmoidf_(g1[r]) * u1[r]; } }
}
__global__ __launch_bounds__(256) void moe_down(const float* __restrict__ HID, const float* __restrict__ Wd, const int* __restrict__ CNT, const int* __restrict__ LIST, float* __restrict__ YE) {
    __shared__ float hs[DE][16];
    __shared__ int asg_s[16];
    const int e = blockIdx.y, start = blockIdx.x * 16, cnt = CNT[e];
    if (start >= cnt) return;
    const int n = min(16, cnt - start), tid = threadIdx.x;
    if (tid < 16) asg_s[tid] = tid < n ? LIST[e * NT + start + tid] : -1;
    __syncthreads();
    for (int i = tid; i < 16 * DE; i += 256) { const int r = i >> 9, k = i & 511; const int a = asg_s[r]; hs[k][r] = a >= 0 ? rb(HID[(size_t)a * DE + k]) : 0.f; }
    __syncthreads();
    float y0[16], y1[16], y2[16], y3[16];
#pragma unroll
    for (int r = 0; r < 16; ++r) { y0[r] = 0.f; y1[r] = 0.f; y2[r] = 0.f; y3[r] = 0.f; }
    const float* wd = Wd + (size_t)e * DE * D;
    for (int k = 0; k < DE; ++k) {
        const float a0 = rb(wd[(size_t)k * D + tid]), a1 = rb(wd[(size_t)k * D + tid + 256]), a2 = rb(wd[(size_t)k * D + tid + 512]), a3 = rb(wd[(size_t)k * D + tid + 768]);
#pragma unroll
        for (int r = 0; r < 16; ++r) { const float x = hs[k][r]; y0[r] = fmaf(x, a0, y0[r]); y1[r] = fmaf(x, a1, y1[r]); y2[r] = fmaf(x, a2, y2[r]); y3[r] = fmaf(x, a3, y3[r]); }
    }
#pragma unroll
    for (int r = 0; r < 16; ++r) { const int a = asg_s[r]; if (a >= 0) { float* y = YE + (size_t)a * D; y[tid] = rb(y0[r]); y[tid + 256] = rb(y1[r]); y[tid + 512] = rb(y2[r]); y[tid + 768] = rb(y3[r]); } }
}

}

namespace rws {
constexpr size_t Z = 0;
constexpr size_t AB = Z + (size_t)NT * INW;
constexpr size_t Q = AB + (size_t)NT * 1024;
constexpr size_t KV = Q + (size_t)NT * QL;
constexpr size_t KPE = KV + (size_t)NT * 1024;
constexpr size_t MIX = KPE + (size_t)NT * 64;
constexpr size_t GATE = MIX + (size_t)NT * 1024;
constexpr size_t CNT = GATE + (size_t)NT * 2;
constexpr size_t LIST = CNT + 64;
constexpr size_t END = LIST + (size_t)NE * NT;
}


#endif
#ifndef MODE
#define MODE 1
#endif
#define LAS __attribute__((address_space(3)))
#ifndef PH
#define PH(k) 1
#endif
#ifndef DUP
#define DUP(k) 0
#define LDS_SYNC() do { asm volatile("s_waitcnt lgkmcnt(0)" ::: "memory"); __builtin_amdgcn_s_barrier(); asm volatile("" ::: "memory"); } while (0)
#endif
#define TID() ({ int _t = (int)threadIdx.x; asm volatile("" : "+v"(_t)); _t; })
#define BID() ({ int _b = (int)blockIdx.x; asm volatile("" : "+s"(_b)); _b; })
#define GDIM() ({ int _g = (int)gridDim.x; asm volatile("" : "+s"(_g)); _g; })
#define GAS __attribute__((address_space(1)))
typedef unsigned short bf16_t;
typedef short bf16x8 __attribute__((ext_vector_type(8)));
typedef float f32x4 __attribute__((ext_vector_type(4)));
typedef float f32x2 __attribute__((ext_vector_type(2)));
typedef unsigned u32x4 __attribute__((ext_vector_type(4)));
typedef unsigned u32x2 __attribute__((ext_vector_type(2)));

__device__ __forceinline__ unsigned f2bf(float f) { unsigned u = __builtin_bit_cast(unsigned, f); return (u + 0x7fffu + ((u >> 16) & 1u)) >> 16; }
__device__ __forceinline__ unsigned pk2(float lo, float hi) { return f2bf(lo) | (f2bf(hi) << 16); }
__device__ __forceinline__ float bf2f(unsigned short h) { return __builtin_bit_cast(float, (unsigned)h << 16); }
__device__ __forceinline__ float bflo(unsigned w) { return __builtin_bit_cast(float, w << 16); }
__device__ __forceinline__ float bfhi(unsigned w) { return __builtin_bit_cast(float, w & 0xffff0000u); }

namespace pg8 {
constexpr int BM = 256, BK = 64, HALF = 128, HTB = HALF * BK * 2, STAGE_BYTES = 8 * HTB;
__host__ __device__ __forceinline__ int lds_byte(int r, int c) { const int st = (r >> 4) * 2 + (c >> 5), rr = r & 15, cc = c & 31, ob = rr * 64 + cc * 2; return st * 1024 + (ob ^ (((ob >> 9) & 1) << 5)); }
__host__ __device__ __forceinline__ void stage_rc(int b, int& R, int& C) { const int st = b / 1024, sb = b % 1024, swz = sb ^ (((sb >> 9) & 1) << 5); R = (st >> 1) * 16 + swz / 64; C = (st & 1) * 32 + (swz % 64) / 2; }
__host__ __device__ __forceinline__ int perm32(int rho) { const int n = rho >> 4, i = rho & 15; return 8 * (i >> 2) + 4 * n + (i & 3); }

struct UnitD { const char* A; const int* rows; const char* B; unsigned lda, ldb; int nt; int type, pm, pn, aux; };

__device__ __forceinline__ unsigned cvt_pk_bf16(float lo, float hi) { unsigned r; asm volatile("v_cvt_pk_bf16_f32 %0, %1, %2" : "=v"(r) : "v"(lo), "v"(hi)); return r; }
__device__ __forceinline__ int to_quad_src(int L) { return ((L >> 2) + 16 * (L & 3)) << 2; }
__device__ __forceinline__ int from_quad_src(int L) { return (4 * (L & 15) + (L >> 4)) << 2; }
__device__ __forceinline__ u32x4 lane_perm(u32x4 w, int src4) { u32x4 t; t.x = (unsigned)__builtin_amdgcn_ds_bpermute(src4, (int)w.x); t.y = (unsigned)__builtin_amdgcn_ds_bpermute(src4, (int)w.y);
    t.z = (unsigned)__builtin_amdgcn_ds_bpermute(src4, (int)w.z); t.w = (unsigned)__builtin_amdgcn_ds_bpermute(src4, (int)w.w); return t; }

template <bool PERM, class Sched, class Epi>
__device__ __forceinline__ void gemm_phase(LAS unsigned char* lds, const Sched& S, const Epi& E) {
    const int tid = TID(), wid = __builtin_amdgcn_readfirstlane(tid >> 6), wr = wid >> 2;
    const size_t kstep = (size_t)(BK * 2);
    const unsigned ldsw = (unsigned)wid * 1024u;
    int aoff, boff; { const int lane = tid & 63, wc = wid & 3, fr = lane & 15, fq = lane >> 4; aoff = lds_byte(wr * 64 + fr, fq * 8); boff = lds_byte(wc * 32 + fr, fq * 8); }
#define PG8_SA(b, h) (((b) * 2 + (h)) * HTB)
#define PG8_SB(b, h) ((4 + (b) * 2 + (h)) * HTB)
#define PG8_STAGE(bufoff, gbase, voff) do { _Pragma("unroll") for (int _i = 0; _i < 2; ++_i) \
        __builtin_amdgcn_global_load_lds((const unsigned*)((const char*)(gbase) + (voff)[_i]), (LAS unsigned*)(lds + (bufoff) + ldsw + _i * 8192), 16, 0, 0); } while (0)
#define PG8_LDA(dst, b, h) do { _Pragma("unroll") for (int m = 0; m < 4; ++m) _Pragma("unroll") for (int k = 0; k < 2; ++k) dst[m][k] = *(const LAS bf16x8*)(lds + PG8_SA(b, h) + aoff + m * 2048 + k * 1024); } while (0)
#define PG8_LDB(dst, b, h) do { _Pragma("unroll") for (int n = 0; n < 2; ++n) _Pragma("unroll") for (int k = 0; k < 2; ++k) dst[n][k] = *(const LAS bf16x8*)(lds + PG8_SB(b, h) + boff + n * 2048 + k * 1024); } while (0)
#define PG8_MMA(ai, bj, At, Bt) do { __builtin_amdgcn_s_setprio(1); _Pragma("unroll") for (int m = 0; m < 4; ++m) _Pragma("unroll") for (int n = 0; n < 2; ++n) _Pragma("unroll") for (int k = 0; k < 2; ++k) \
        acc[ai][bj][m][n] = __builtin_amdgcn_mfma_f32_16x16x32_bf16(Bt[n][k], At[m][k], acc[ai][bj][m][n], 0, 0, 0); __builtin_amdgcn_s_setprio(0); } while (0)
#define PG8_WAIT_V(n) asm volatile("s_waitcnt vmcnt(" #n ")" ::: "memory")
#define PG8_WAIT_L(n) asm volatile("s_waitcnt lgkmcnt(" #n ")" ::: "memory")
#define PG8_BAR __builtin_amdgcn_s_barrier()
#define PG8_SCHED __builtin_amdgcn_sched_barrier(0)
#define PG8_OFFS(u) do { int t_ = tid; asm volatile("" : "+v"(t_)); int R0, C0, R1, C1; stage_rc(t_ * 16, R0, C0); stage_rc(t_ * 16 + 8192, R1, C1); \
        const int RB0 = PERM ? ((R0 & ~31) + perm32(R0 & 31)) : R0, RB1 = PERM ? ((R1 & ~31) + perm32(R1 & 31)) : R1; const unsigned Cb = (unsigned)C0 * 2u; \
        if ((u).rows) { vA[0][0] = (unsigned)(u).rows[R0] * (u).lda + Cb; vA[0][1] = (unsigned)(u).rows[R1] * (u).lda + Cb; \
                                        vA[1][0] = (unsigned)(u).rows[128 + R0] * (u).lda + Cb; vA[1][1] = (unsigned)(u).rows[128 + R1] * (u).lda + Cb; } \
        else { vA[0][0] = (unsigned)R0 * (u).lda + Cb; vA[0][1] = (unsigned)R1 * (u).lda + Cb; vA[1][0] = (unsigned)(128 + R0) * (u).lda + Cb; vA[1][1] = (unsigned)(128 + R1) * (u).lda + Cb; } \
        vB[0] = (unsigned)RB0 * (u).ldb + Cb; vB[1] = (unsigned)RB1 * (u).ldb + Cb; hB = (size_t)128 * (u).ldb; } while (0)
#define PG8_EPI(u) do { int t_ = tid; asm volatile("" : "+v"(t_)); const int lane_ = t_ & 63; E(acc, (u), wr, wid & 3, lane_ & 15, lane_ >> 4); if (DUP(16)) E(acc, (u), wr, wid & 3, lane_ & 15, lane_ >> 4); if constexpr (Sched::HOOKS) S.done((u), lane_); } while (0)
    UnitD cur, nxt; int ui = 0;
    if (!S.next(0, cur)) return;
    f32x4 acc[2][2][4][2];
#pragma unroll
    for (int a = 0; a < 2; ++a)
#pragma unroll
        for (int b = 0; b < 2; ++b)
#pragma unroll
            for (int m = 0; m < 4; ++m)
#pragma unroll
                for (int n = 0; n < 2; ++n) acc[a][b][m][n] = (f32x4){0.f, 0.f, 0.f, 0.f};
    bf16x8 At[4][2], B0[2][2], B1[2][2];
    unsigned vA[2][2], vB[2]; size_t hB;
    if constexpr (Sched::HOOKS) S.a_ready(cur, wid);
    PG8_OFFS(cur);
    const char* cA = cur.A; const char* cB = cur.B; int nt = cur.nt;
    PG8_STAGE(PG8_SB(0, 0), cB, vB); PG8_STAGE(PG8_SB(0, 1), cB + hB, vB); PG8_STAGE(PG8_SA(0, 0), cA, vA[0]); PG8_STAGE(PG8_SA(0, 1), cA, vA[1]);
    if (wr == 1) PG8_BAR;
    PG8_WAIT_V(2); PG8_BAR;
    PG8_STAGE(PG8_SB(1, 0), cB + kstep, vB); PG8_STAGE(PG8_SA(1, 0), cA + kstep, vA[0]); PG8_STAGE(PG8_SB(1, 1), cB + hB + kstep, vB);
    PG8_WAIT_V(6); PG8_BAR;
    for (;;) {
        const bool has_next = S.next(ui + 1, nxt);
        for (int t = 0; t < nt; t += 2) {
            const bool last = (t == nt - 2);
            if constexpr (Sched::HOOKS) { if (last && has_next) S.a_ready(nxt, wid); }
            const char* a1 = cA + (size_t)(t + 1) * kstep;
            PG8_LDB(B0, 0, 0); PG8_LDB(B1, 0, 1); PG8_SCHED; PG8_LDA(At, 0, 0); PG8_STAGE(PG8_SA(1, 1), a1, vA[1]);
            PG8_WAIT_V(8); PG8_WAIT_L(0); PG8_BAR; PG8_MMA(0, 0, At, B0); PG8_MMA(0, 1, At, B1); PG8_BAR; PG8_SCHED;
            const char* a2; const char* b2;
            if (last) { if (has_next) { PG8_OFFS(nxt); a2 = nxt.A; b2 = nxt.B; } else { a2 = cA; b2 = cB; } }
            else { a2 = cA + (size_t)(t + 2) * kstep; b2 = cB + (size_t)(t + 2) * kstep; }
            const char* a3 = a2 + kstep; const char* b3 = b2 + kstep;
            PG8_LDA(At, 0, 1); PG8_STAGE(PG8_SB(0, 0), b2, vB); PG8_STAGE(PG8_SB(0, 1), b2 + hB, vB); PG8_STAGE(PG8_SA(0, 0), a2, vA[0]);
            PG8_WAIT_V(8); PG8_WAIT_L(0); PG8_BAR; PG8_MMA(1, 0, At, B0); PG8_MMA(1, 1, At, B1); PG8_BAR; PG8_SCHED;
            PG8_LDB(B0, 1, 0); PG8_LDB(B1, 1, 1); PG8_SCHED; PG8_LDA(At, 1, 0); PG8_STAGE(PG8_SA(0, 1), a2, vA[1]);
            PG8_WAIT_V(8); PG8_WAIT_L(0); PG8_BAR; PG8_MMA(0, 0, At, B0); PG8_MMA(0, 1, At, B1); PG8_BAR; PG8_SCHED;
            PG8_LDA(At, 1, 1); PG8_STAGE(PG8_SB(1, 0), b3, vB); PG8_STAGE(PG8_SB(1, 1), b3 + hB, vB); PG8_STAGE(PG8_SA(1, 0), a3, vA[0]);
            PG8_WAIT_V(8); PG8_WAIT_L(0); PG8_BAR; PG8_MMA(1, 0, At, B0); PG8_MMA(1, 1, At, B1); PG8_BAR; PG8_SCHED;
        }
        if (wr == 0) PG8_BAR;
        PG8_EPI(cur);
        if (!has_next) break;
#pragma unroll
        for (int a = 0; a < 2; ++a)
#pragma unroll
            for (int b = 0; b < 2; ++b)
#pragma unroll
                for (int m = 0; m < 4; ++m)
#pragma unroll
                    for (int n = 0; n < 2; ++n) acc[a][b][m][n] = (f32x4){0.f, 0.f, 0.f, 0.f};
        cur = nxt; cA = nxt.A; cB = nxt.B; nt = nxt.nt; ++ui;
        if (wr == 1) PG8_BAR;
    }
    PG8_WAIT_V(0);
    PG8_BAR;
#undef PG8_SA
#undef PG8_SB
#undef PG8_STAGE
#undef PG8_LDA
#undef PG8_LDB
#undef PG8_MMA
#undef PG8_WAIT_V
#undef PG8_WAIT_L
#undef PG8_BAR
#undef PG8_SCHED
#undef PG8_OFFS
#undef PG8_EPI
}
__device__ __forceinline__ void tile_order(int L, int nM, int nN, int& pm, int& pn) {
    const int nwg = nM * nN; int wgid = L;
    { const int q = nwg / 8, r = nwg % 8, xcd = wgid % 8, off = wgid / 8; wgid = (xcd < r ? xcd * (q + 1) : r * (q + 1) + (xcd - r) * q) + off; }
    const int nig = 8 * nN, gid = wgid / nig, fm = gid * 8, gsz = (nM - fm) < 8 ? (nM - fm) : 8;
    pm = fm + ((wgid % nig) % gsz); pn = (wgid % nig) / gsz;
}
}

#define XB_TMO      128
#define XB_XCNT(j)  (256  + 64 * (j))
#define XB_XSUB(j)  (1280 + 64 * (j))
#define XB_XGEN(j)  (2304 + 64 * (j))
#define XB_TOP      3328
#define XB_TOPGEN   3392
#define XCD_BAR_WORDS 3456
#define XB_SPIN_CAP (1u << 18)
__device__ __forceinline__ unsigned xb_ld(unsigned* p)              { return __hip_atomic_load(p, __ATOMIC_RELAXED, __HIP_MEMORY_SCOPE_AGENT); }
__device__ __forceinline__ unsigned xb_add(unsigned* p, unsigned v) { return __hip_atomic_fetch_add(p, v, __ATOMIC_RELAXED, __HIP_MEMORY_SCOPE_AGENT); }
__device__ __forceinline__ unsigned xb_xcc_id() { return (unsigned)__builtin_amdgcn_s_getreg((3 << 11) | 20) & 0xFu; }
#define XB_SPIN(cond, bar) do { unsigned _sp = 0; while (cond) { __builtin_amdgcn_s_sleep(1); \
    if ((++_sp & 255u) == 0u) { if (xb_ld(&(bar)[XB_TMO])) break; if (_sp > XB_SPIN_CAP) { atomicAdd(&(bar)[XB_TMO], 1u); break; } } } } while (0)
struct XcdBarrier { unsigned* bar; unsigned x; volatile LAS unsigned* st; };
__device__ __forceinline__ XcdBarrier xcd_barrier_post(unsigned* bar, volatile LAS unsigned* st) {
    XcdBarrier b; b.bar = bar; b.x = xb_xcc_id(); b.st = st;
    if (threadIdx.x == 0) (void)xb_add(&bar[XB_XCNT(b.x)], 1u);
    return b;
}
__device__ __forceinline__ void xcd_barrier_complete(unsigned* bar, unsigned x, unsigned& nloc, unsigned& nx) {
    const unsigned G = gridDim.x * gridDim.y * gridDim.z;
    unsigned sum, cnt, mine, sp = 0u;
    for (;;) {
        sum = 0u; cnt = 0u;
#pragma unroll
        for (unsigned j = 0; j < 16; ++j) { const unsigned c = xb_ld(&bar[XB_XCNT(j)]); sum += c; cnt += (c > 0u) ? 1u : 0u; }
        if (sum == G) break;
        __builtin_amdgcn_s_sleep(1);
        if ((++sp & 255u) == 0u) { if (xb_ld(&bar[XB_TMO])) break; if (sp > XB_SPIN_CAP) { atomicAdd(&bar[XB_TMO], 1u); break; } }
    }
    mine = xb_ld(&bar[XB_XCNT(x)]);
    nloc = mine > 0u ? mine : 1u; nx = cnt > 0u ? cnt : 1u;
}
__device__ __forceinline__ void xcd_barrier(const XcdBarrier& b) {
    asm volatile("s_waitcnt vmcnt(0)" ::: "memory");
    __syncthreads();
    if (threadIdx.x == 0) {
        unsigned* bar = b.bar; unsigned bx_ = b.x;
        asm volatile("" : "+s"(bar), "+s"(bx_));
        __builtin_amdgcn_s_waitcnt(0);
        unsigned nloc = b.st[0], nx = b.st[1];
        if (nloc == 0u) { xcd_barrier_complete(bar, bx_, nloc, nx); b.st[0] = nloc; b.st[1] = nx; }
        const unsigned old = xb_add(&bar[XB_XSUB(bx_)], 1u);
        const unsigned gen = old / nloc;
        if (old + 1u == (gen + 1u) * nloc) {
            __builtin_amdgcn_fence(__ATOMIC_RELEASE, "agent");
            asm volatile("s_waitcnt vmcnt(0)" ::: "memory");
            const unsigned og = xb_add(&bar[XB_TOP], 1u);
            const unsigned tg = og / nx;
            if (og + 1u == (tg + 1u) * nx) xb_add(&bar[XB_TOPGEN], 1u);
            else XB_SPIN(xb_ld(&bar[XB_TOPGEN]) == tg, bar);
            __builtin_amdgcn_fence(__ATOMIC_ACQUIRE, "agent");
            xb_add(&bar[XB_XGEN(bx_)], 1u);
            asm volatile("s_waitcnt vmcnt(0)" ::: "memory");
        } else {
            XB_SPIN(xb_ld(&bar[XB_XGEN(bx_)]) == gen, bar);
            __builtin_amdgcn_fence(__ATOMIC_ACQUIRE, "agent");
            asm volatile("s_waitcnt vmcnt(0)" ::: "memory");
        }
    }
    __syncthreads();
}

constexpr int PREPQ_W = 60000;
constexpr int MOECNT_W = 16384;
constexpr int ZW = 2304;
constexpr int NWAVES = 8, NTHREADS = 512;
constexpr int RING_BYTES = 131072, LDS_BYTES = 163840, LDSCTL_OFF = LDS_BYTES - 4096, MISC_OFF = LDSCTL_OFF + 320, TAB_OFF = LDSCTL_OFF + 1024;
struct OW {
    const float* in[24];
    float* X;
    unsigned* ctl;
    bf16_t* XB;
    bf16_t* Z;
    float* SSQ;
    bf16_t *Win_t, *Wq_t, *Wkv_t, *Wo_t, *Wgu_t, *Wd_t, *Wlg_t;
    bf16_t* RWH; float* RGB;
    f32x2* ROPE;
    bf16_t *Q, *KN, *VV, *KPE;
    float *A, *DRV, *AGA, *AGB;
    bf16_t* OP; f32x2* ML;
    bf16_t* MIX; bf16_t* Y;
    int *EIDX, *HIST, *LRANK, *DEST, *ROWTOK; float* GATE;
    bf16_t *HE, *YE;
};

namespace ows {
constexpr size_t MiB = 1u << 20;
constexpr size_t CTL = 0, ROPE = 1 * MiB, SSQ = 2 * MiB, EIDX = 3 * MiB, GATE = EIDX + 131072, LRANK = GATE + 131072, DEST = LRANK + 131072, HIST = DEST + 131072, ROWTOK = HIST + 16384;
constexpr size_t AGA = 4 * MiB, AGB = AGA + 524288, ML = 5 * MiB, WLG = 6 * MiB, WIN = 7 * MiB, WQ = 12 * MiB, WKV = 14 * MiB, WO = 15 * MiB, WGU = 17 * MiB, WD = 49 * MiB;
constexpr size_t XB = 65 * MiB, Z = 97 * MiB, Y = Z, A = 169 * MiB, DRV = 201 * MiB, Q = 233 * MiB, YE = A, KN = 257 * MiB, VV = 273 * MiB, KPE = 289 * MiB, OP = 291 * MiB, HE = KN, MIX = 323 * MiB, WSET1 = 355 * MiB - WLG  , END = 414 * MiB;
static_assert(ROWTOK + 36864 * 4 <= AGA && WIN + (size_t)ZW * D * 2 <= WQ && YE + (size_t)36864 * 1024 * 2 <= KN && HE + (size_t)36864 * 512 * 2 <= OP + 32 * MiB && Z + (size_t)NT * ZW * 2 <= A, "opt workspace map");
}
__device__ __forceinline__ void tr_item(const float* W, int ldw, int k0, int n0, bf16_t* WT, int ldt, int drow0, const float* g, LAS float* scr, int lane) {
    float tv[32];
#pragma unroll
    for (int i = 0; i < 32; ++i) { const int kk = 2 * i + (lane >> 5); tv[i] = W[(size_t)(k0 + kk) * ldw + n0 + (lane & 31)]; }
    if (g) {
#pragma unroll
        for (int i = 0; i < 32; ++i) tv[i] *= g[k0 + 2 * i + (lane >> 5)]; }
#pragma unroll
    for (int i = 0; i < 32; ++i) scr[(2 * i + (lane >> 5)) * 33 + (lane & 31)] = tv[i];
    asm volatile("s_waitcnt lgkmcnt(0)" ::: "memory");
    const int c = lane & 7;
#pragma unroll
    for (int j = 0; j < 4; ++j) { const int n = (lane >> 3) + 8 * j; const LAS float* s = scr + (8 * c) * 33 + n;
        u32x4 o; o.x = pk2(s[0 * 33], s[1 * 33]); o.y = pk2(s[2 * 33], s[3 * 33]); o.z = pk2(s[4 * 33], s[5 * 33]); o.w = pk2(s[6 * 33], s[7 * 33]);
        *(u32x4*)(WT + (size_t)(drow0 + n) * ldt + k0 + 8 * c) = o; }
    asm volatile("s_waitcnt lgkmcnt(0)" ::: "memory");
}
struct PrepItem { const float* W; const float* g; bf16_t* WT; int ldw, ldt, k0, n0, drow0, ncols; };
__device__ __forceinline__ PrepItem prep_item(const OW& P, int l, int it) {
    const float* w_in = P.in[1] + (size_t)l * D * INW;
    const float* qng = P.in[9] + (size_t)l * QL;   const float* w_q = P.in[10] + (size_t)l * QL * 768;
    const float* kvng = P.in[11] + (size_t)l * KVL; const float* w_kv = P.in[12] + (size_t)l * KVL * 1024;
    const float* ong = P.in[13] + (size_t)l * 1024; const float* w_o = P.in[14] + (size_t)l * 1024 * D;
    const float* wg = P.in[19] + (size_t)l * NE * D * DE; const float* wu = P.in[20] + (size_t)l * NE * D * DE; const float* wd = P.in[21] + (size_t)l * NE * DE * D;
    constexpr int I_IN = 8 * 17, I_Q = 6 * 6, I_KV = 2 * 8, I_O = 8 * 8, I_G = 16 * 8 * 4, I_D = 16 * 4 * 8;
    PrepItem p; int r = it;
    if (r < I_IN) { const int kb = r / 17, nb = r % 17; p = PrepItem{w_in, nullptr, P.Win_t, INW, D, 128 * kb, 128 * nb, 128 * nb, nb == 16 ? 64 : 128}; return p; } r -= I_IN;
    if (r < I_Q) { const int kb = r / 6, nb = r % 6; p = PrepItem{w_q, qng, P.Wq_t, 768, QL, 128 * kb, 128 * nb, 128 * nb, 128}; return p; } r -= I_Q;
    if (r < I_KV) { const int kb = r / 8, nb = r % 8; p = PrepItem{w_kv, kvng, P.Wkv_t, 1024, KVL, 128 * kb, 128 * nb, 128 * nb, 128}; return p; } r -= I_KV;
    if (r < I_O) { const int kb = r / 8, nb = r % 8; p = PrepItem{w_o, ong, P.Wo_t, D, 1024, 128 * kb, 128 * nb, 128 * nb, 128}; return p; } r -= I_O;
    if (r < 2 * I_G) { const int up = r >= I_G; if (up) r -= I_G; const int e = r >> 5, q = r & 31, kb = q >> 2, nb = q & 3;
        p = PrepItem{(up ? wu : wg) + (size_t)e * D * DE, nullptr, P.Wgu_t + (size_t)e * 1024 * 1024, DE, 1024, 128 * kb, 128 * nb, 256 * nb + 128 * up, 128}; return p; }
    r -= 2 * I_G;
    { const int e = r >> 5, q = r & 31, kb = q >> 3, nb = q & 7; p = PrepItem{wd + (size_t)e * DE * D, nullptr, P.Wd_t + (size_t)e * 1024 * DE, D, DE, 128 * kb, 128 * nb, 128 * nb, 128}; }
    return p;
}
__device__ __forceinline__ void prep_weights(const OW& P, int l, LAS unsigned char* lds, int vcu, int G, int it0 = 0, int it1 = 1 << 30, int tail = 3) {
    const int tid = TID();
    LAS float* scr = (LAS float*)lds;
    constexpr int NITEMS = 8 * 17 + 6 * 6 + 2 * 8 + 8 * 8 + 2 * 16 * 8 * 4 + 16 * 4 * 8;
    const int lr = tid >> 5, lc = (tid & 31) * 4;
    const int tn = tid & 127, tq = tid >> 7;
    f32x4 v[8];
#define PW_LOAD(p_) do { _Pragma("unroll") for (int i = 0; i < 8; ++i) { const int kk = lr + 16 * i; v[i] = (f32x4){0.f, 0.f, 0.f, 0.f}; \
        if (lc < (p_).ncols) { v[i] = *(const f32x4*)((p_).W + (size_t)((p_).k0 + kk) * (p_).ldw + (p_).n0 + lc); if ((p_).g) v[i] = v[i] * (p_).g[(p_).k0 + kk]; } } } while (0)
    const int ITE = it1 < NITEMS ? it1 : NITEMS;
    int it = it0 + vcu;
    PrepItem cur; if (it < ITE) { cur = prep_item(P, l, it); PW_LOAD(cur); }
    for (; it < ITE; it += G) {
#pragma unroll
        for (int i = 0; i < 8; ++i) { const int kk = lr + 16 * i; scr[kk * 129 + lc] = v[i][0]; scr[kk * 129 + lc + 1] = v[i][1]; scr[kk * 129 + lc + 2] = v[i][2]; scr[kk * 129 + lc + 3] = v[i][3]; }
        const PrepItem me = cur;
        if (it + G < ITE) { cur = prep_item(P, l, it + G); PW_LOAD(cur); }
        LDS_SYNC();
        { bf16_t* dst = me.WT + (size_t)(me.drow0 + tn) * me.ldt + me.k0 + 32 * tq; const LAS float* sc = scr + (32 * tq) * 129 + tn;
#pragma unroll
          for (int c = 0; c < 4; ++c) { u32x4 o; o.x = pk2(sc[(8 * c + 0) * 129], sc[(8 * c + 1) * 129]); o.y = pk2(sc[(8 * c + 2) * 129], sc[(8 * c + 3) * 129]);
              o.z = pk2(sc[(8 * c + 4) * 129], sc[(8 * c + 5) * 129]); o.w = pk2(sc[(8 * c + 6) * 129], sc[(8 * c + 7) * 129]); *(u32x4*)(dst + 8 * c) = o; } }
        LDS_SYNC();
    }
#undef PW_LOAD
    if (tail & 1) { const int gt = vcu * NTHREADS + tid, NGT = G * NTHREADS; unsigned zz = 0u; asm volatile("" : "+v"(zz)); const u32x4 z = {zz, zz, zz, zz};
      for (int i = gt; i < 128 * 128; i += NGT) *(u32x4*)(P.Win_t + (size_t)2176 * D + (size_t)i * 8) = z; }
    if (tail & 2) { const int gt = vcu * NTHREADS + tid, NGT = G * NTHREADS;
      const float* w_r = P.in[4] + (size_t)l * 8 * 64 * 64; const float* w_i = P.in[6] + (size_t)l * 8 * 64 * 64;
      for (int i = gt; i < 8 * 128 * 64; i += NGT) { const int k = i & 63, j = (i >> 6) & 127, n = i >> 13; const int w = j >> 4, q = j & 15; const int d = 8 * w + (q & 7);
          const float v_ = (q < 8 ? w_r : w_i)[((size_t)n * 64 + k) * 64 + d]; P.Wlg_t[i] = (bf16_t)f2bf(v_); }
      const float* rw = P.in[17]; const float* g1 = P.in[15] + (size_t)l * D; const float* b1 = P.in[16] + (size_t)l * D;
      for (int i = gt; i < 16 * 1024; i += NGT) { const int k = i & 1023, e = i >> 10; const float v_ = g1[k] * rw[k * 16 + e]; const unsigned hi_ = f2bf(v_); const float rem = v_ - bf2f((unsigned short)hi_);
          const int ix = (((k >> 5) * 64 + e + 16 * ((k >> 3) & 3)) << 3) + (k & 7);
          P.RWH[ix] = (bf16_t)hi_; P.RWH[16384 + ix] = (bf16_t)f2bf(rem); }
      { const int gwv = gt >> 6, ln = gt & 63;
        if (gwv < 32) { const int e = gwv & 15; const float* src = gwv < 16 ? g1 : b1; float acc = 0.f; float sa[16], sb[16];
#pragma unroll
            for (int j = 0; j < 16; ++j) { const int k = ln + 64 * j; sa[j] = src[k]; sb[j] = rw[k * 16 + e]; }
            __builtin_amdgcn_sched_barrier(0);
#pragma unroll
            for (int j = 0; j < 16; ++j) acc = fmaf(sa[j], sb[j], acc);
#pragma unroll
            for (int o = 1; o < 64; o <<= 1) acc += __shfl_xor(acc, o);
            if (ln == 0) P.RGB[gwv] = acc; } } }
}
__device__ __forceinline__ void prep_queue(const OW& P, int l, LAS unsigned char* lds, unsigned* ctr, int it0, int it1) {
    const int tid = TID();
    LAS float* scr = (LAS float*)lds;
    volatile LAS int* slot = (volatile LAS int*)(lds + MISC_OFF + 192);
    constexpr int NALL = 8 * 17 + 6 * 6 + 2 * 8 + 8 * 8 + 2 * 16 * 8 * 4 + 16 * 4 * 8; const int NITEMS = it1 < NALL ? it1 : NALL;
    const int lr = tid >> 5, lc = (tid & 31) * 4;
    const int tn = tid & 127, tq = tid >> 7;
    f32x4 v[8];
#define PW_LOAD(p_) do { _Pragma("unroll") for (int i = 0; i < 8; ++i) { const int kk = lr + 16 * i; v[i] = (f32x4){0.f, 0.f, 0.f, 0.f}; \
        if (lc < (p_).ncols) { v[i] = *(const f32x4*)((p_).W + (size_t)((p_).k0 + kk) * (p_).ldw + (p_).n0 + lc); if ((p_).g) v[i] = v[i] * (p_).g[(p_).k0 + kk]; } } } while (0)
    LDS_SYNC();
    if (tid == 0) slot[0] = it0 + (int)__hip_atomic_fetch_add(ctr, 2u, __ATOMIC_RELAXED, __HIP_MEMORY_SCOPE_AGENT);
    LDS_SYNC();
    int it = __builtin_amdgcn_readfirstlane(slot[0]); int nxt = it + 1;
    PrepItem cur; if (it < NITEMS) { cur = prep_item(P, l, it); PW_LOAD(cur); }
    while (it < NITEMS) {
        unsigned got = 0u; if (tid == 0) got = __hip_atomic_fetch_add(ctr, 1u, __ATOMIC_RELAXED, __HIP_MEMORY_SCOPE_AGENT);
#pragma unroll
        for (int i = 0; i < 8; ++i) { const int kk = lr + 16 * i; scr[kk * 129 + lc] = v[i][0]; scr[kk * 129 + lc + 1] = v[i][1]; scr[kk * 129 + lc + 2] = v[i][2]; scr[kk * 129 + lc + 3] = v[i][3]; }
        const PrepItem me = cur;
        if (nxt < NITEMS) { cur = prep_item(P, l, nxt); PW_LOAD(cur); }
        LDS_SYNC();
        { bf16_t* dst = me.WT + (size_t)(me.drow0 + tn) * me.ldt + me.k0 + 32 * tq; const LAS float* sc = scr + (32 * tq) * 129 + tn;
#pragma unroll
          for (int c = 0; c < 4; ++c) { u32x4 o; o.x = pk2(sc[(8 * c + 0) * 129], sc[(8 * c + 1) * 129]); o.y = pk2(sc[(8 * c + 2) * 129], sc[(8 * c + 3) * 129]);
              o.z = pk2(sc[(8 * c + 4) * 129], sc[(8 * c + 5) * 129]); o.w = pk2(sc[(8 * c + 6) * 129], sc[(8 * c + 7) * 129]); *(u32x4*)(dst + 8 * c) = o; } }
        if (tid == 0) slot[0] = it0 + (int)got;
        LDS_SYNC();
        it = nxt; nxt = __builtin_amdgcn_readfirstlane(slot[0]);
    }
#undef PW_LOAD
}
__device__ __forceinline__ void prep_tables(const OW& P, int vcu, int G) {
    const int gt = vcu * NTHREADS + TID(), NGT = G * NTHREADS;
    for (int i = gt; i < S * 32; i += NGT) { const int s = i >> 5, j = i & 31; const float inv = powf(10000.0f, -(float)j / 32.0f); const float ang = (float)s * inv; P.ROPE[i] = (f32x2){cosf(ang), sinf(ang)}; }
    const float* x = P.in[0];
    for (size_t i0 = gt; i0 < (size_t)NT * D / 8; i0 += (size_t)4 * NGT) { f32x4 a[4], b[4];
#pragma unroll
        for (int q = 0; q < 4; ++q) { const size_t i = i0 + (size_t)q * NGT; if (i < (size_t)NT * D / 8) { a[q] = *(const f32x4*)(x + i * 8); b[q] = *(const f32x4*)(x + i * 8 + 4); } }
#pragma unroll
        for (int q = 0; q < 4; ++q) { const size_t i = i0 + (size_t)q * NGT; if (i < (size_t)NT * D / 8) { u32x4 o; o.x = pg8::cvt_pk_bf16(a[q][0], a[q][1]); o.y = pg8::cvt_pk_bf16(a[q][2], a[q][3]); o.z = pg8::cvt_pk_bf16(b[q][0], b[q][1]); o.w = pg8::cvt_pk_bf16(b[q][2], b[q][3]); *(u32x4*)(P.XB + i * 8) = o; } } }
}

struct SchedInProj {
    static constexpr bool HOOKS = false;
    const OW* P; int G, c;
    __device__ __forceinline__ bool next(int i, pg8::UnitD& u) const {
        const int L = i * G + c; if (L >= 64 * 9) return false;
        int pm, pn; pg8::tile_order(L, 64, 9, pm, pn);
        u.A = (const char*)(P->XB + (size_t)pm * 256 * D); u.rows = nullptr; u.B = (const char*)(P->Win_t + (size_t)pn * 256 * D); u.lda = D * 2; u.ldb = D * 2; u.nt = D / 64; u.type = 0; u.pm = pm; u.pn = pn; u.aux = 0;
        return true;
    }
};
struct EpiInProj {
    bf16_t* Z; float* SSQ;
    __device__ __forceinline__ void operator()(const f32x4 (&acc)[2][2][4][2], const pg8::UnitD& u, int wr, int wc, int fr, int fq) const {
        const int row0 = u.pm * 256 + wr * 64 + fr;
        const bool stats = u.pn >= 4 && u.pn < 8;
        const int L = fr + 16 * fq, src4 = pg8::to_quad_src(L); const int rowq = u.pm * 256 + wr * 64 + (L >> 2), colq = u.pn * 256 + wc * 32 + 8 * (L & 3);
#pragma unroll
        for (int ai = 0; ai < 2; ++ai)
#pragma unroll
            for (int m = 0; m < 4; ++m) { const int row = row0 + ai * 128 + m * 16; bf16_t* rowp = Z + (size_t)(rowq + ai * 128 + m * 16) * ZW + colq; float ss = 0.f;
#pragma unroll
                for (int bj = 0; bj < 2; ++bj) { const f32x4 v0 = acc[ai][bj][m][0], v1 = acc[ai][bj][m][1];
                    ss += (v0[0] * v0[0] + v0[1] * v0[1]) + (v0[2] * v0[2] + v0[3] * v0[3]) + (v1[0] * v1[0] + v1[1] * v1[1]) + (v1[2] * v1[2] + v1[3] * v1[3]);
                    u32x4 w; w.x = pg8::cvt_pk_bf16(v0[0], v0[1]); w.y = pg8::cvt_pk_bf16(v0[2], v0[3]); w.z = pg8::cvt_pk_bf16(v1[0], v1[1]); w.w = pg8::cvt_pk_bf16(v1[2], v1[3]);
                    *(u32x4*)(rowp + bj * 128) = pg8::lane_perm(w, src4); }
                if (stats) { ss += __shfl_xor(ss, 16); ss += __shfl_xor(ss, 32); if (fq == 0) SSQ[(size_t)row * 16 + (u.pn - 4) * 4 + wc] = ss; } }
    }
};
__device__ __forceinline__ void phase_inproj(const OW& P, LAS unsigned char* lds, int G) {
    SchedInProj Sd{&P, G, BID()}; EpiInProj E{P.Z, P.SSQ};
    pg8::gemm_phase<true>(lds, Sd, E);
}


struct SchedQKV {
    static constexpr bool HOOKS = false;
    const OW* P; int G, c;
    __device__ __forceinline__ bool next(int i, pg8::UnitD& u) const {
        if (G != 256) {
            const int Lq = i * G + c; if (Lq >= 448) return false;
            if (Lq < 192) { fill_q(u, Lq / 3, Lq % 3); } else { const int r = Lq - 192; fill_kv(u, r >> 2, r & 3); }
            return true;
        }
        if (c < 192) { if (i == 0) { fill_q(u, c / 3, c % 3); return true; } if (i == 1 && c % 3 == 0) { fill_kv(u, c / 3, 3); return true; } return false; }
        if (i >= 3) return false; fill_kv(u, c - 192, i); return true;
    }
    __device__ __forceinline__ void fill_q(pg8::UnitD& u, int pm, int pn) const {
        u.A = (const char*)(P->Z + (size_t)pm * 256 * ZW + 1024); u.rows = nullptr; u.B = (const char*)(P->Wq_t + (size_t)pn * 256 * QL); u.lda = ZW * 2; u.ldb = QL * 2; u.nt = QL / 64; u.type = 1; u.pm = pm; u.pn = pn; u.aux = 0; }
    __device__ __forceinline__ void fill_kv(pg8::UnitD& u, int pm, int pn) const {
        u.A = (const char*)(P->Z + (size_t)pm * 256 * ZW + 1792); u.rows = nullptr; u.B = (const char*)(P->Wkv_t + (size_t)pn * 256 * KVL); u.lda = ZW * 2; u.ldb = KVL * 2; u.nt = KVL / 64; u.type = 2; u.pm = pm; u.pn = pn; u.aux = 0; }
};
struct EpiQKV {
    const float* SSQ; bf16_t *Q, *KN, *VV;
    __device__ __forceinline__ void operator()(const f32x4 (&acc)[2][2][4][2], const pg8::UnitD& u, int wr, int wc, int fr, int fq) const {
        const int row0 = u.pm * 256 + wr * 64 + fr, cw = wc * 32 + 8 * fq;
        const bool isq = u.type == 1; const int Lq = fr + 16 * fq, srcq = pg8::to_quad_src(Lq);
        float rs2[2];
        { const int li = fr + 16 * fq; f32x4 a[2], b[2], c[2];
#pragma unroll
          for (int ai = 0; ai < 2; ++ai) { const f32x4* sp = (const f32x4*)(SSQ + (size_t)(u.pm * 256 + wr * 64 + li + ai * 128) * 16);
              if (isq) { a[ai] = sp[0]; b[ai] = sp[1]; c[ai] = sp[2]; } else { a[ai] = sp[3]; b[ai] = (f32x4){0.f, 0.f, 0.f, 0.f}; c[ai] = b[ai]; } }
          __builtin_amdgcn_sched_barrier(0);
#pragma unroll
          for (int ai = 0; ai < 2; ++ai) { const float t = ((a[ai][0] + a[ai][1]) + (a[ai][2] + a[ai][3])) + ((b[ai][0] + b[ai][1]) + (b[ai][2] + b[ai][3])) + ((c[ai][0] + c[ai][1]) + (c[ai][2] + c[ai][3]));
              rs2[ai] = rsqrtf(t * (isq ? 1.f / QL : 1.f / KVL) + EPS); } }
#pragma unroll
        for (int ai = 0; ai < 2; ++ai)
#pragma unroll
            for (int m = 0; m < 4; ++m) { const int row = row0 + ai * 128 + m * 16;
                const float rs = __shfl(rs2[ai], 16 * m + fr);
#pragma unroll
                for (int bj = 0; bj < 2; ++bj) { const f32x4 v0 = acc[ai][bj][m][0] * rs, v1 = acc[ai][bj][m][1] * rs;
                    u32x4 w; w.x = pg8::cvt_pk_bf16(v0[0], v0[1]); w.y = pg8::cvt_pk_bf16(v0[2], v0[3]); w.z = pg8::cvt_pk_bf16(v1[0], v1[1]); w.w = pg8::cvt_pk_bf16(v1[2], v1[3]);
                    const int rowq = row - fr + (Lq >> 2), cwq = wc * 32 + 8 * (Lq & 3);
                    bf16_t* dst = isq ? Q + (size_t)rowq * QL + u.pn * 256 + bj * 128 + cwq : (bj == 0 ? KN : VV) + (size_t)rowq * 512 + u.pn * 128 + cwq;
                    *(u32x4*)dst = pg8::lane_perm(w, srcq); } }
    }
};
__device__ __forceinline__ float sigm(float x) { return __builtin_amdgcn_rcpf(1.f + __expf(-x)); }
__device__ __forceinline__ float one_minus_sq(float a, float x) {
    return x > -0.015625f ? -x * (1.f + 0.5f * x) : 1.f - a * a;
}
__device__ __forceinline__ void gates_tile(const OW& P, int l, LAS unsigned char* lds, int tile) {
    constexpr int URS = 1040, XRS = 144, SRS = 68;
    const int tid = TID(), lane = tid & 63, wid = __builtin_amdgcn_readfirstlane(tid >> 6), fr = lane & 15, fq = lane >> 4;
    LAS unsigned char* U = lds;
    LAS unsigned char* XC = lds + 67 * URS + 64;
    LAS float* SA = (LAS float*)(lds + 81920);
    LAS float* SD = SA + 64 * SRS;
    LAS f32x2* PP = (LAS f32x2*)(lds + 81920 + 2 * 64 * SRS * 4);
    LAS float* PAR = (LAS float*)(lds + 81920 + 2 * 64 * SRS * 4 + 4096);
    const int tok0 = tile * 64, s0 = tok0 & (S - 1);
    const float* conv_w = P.in[2] + (size_t)l * 4 * LW; const float* conv_b = P.in[3] + (size_t)l * LW;
    const float* b_r = P.in[5] + (size_t)l * LW; const float* b_i = P.in[7] + (size_t)l * LW; const float* lam = P.in[8] + (size_t)l * LW;
    const bf16_t* pZ = P.Z; const f32x2* pROPE = P.ROPE; bf16_t* pKPE = P.KPE; float* pA = P.A; float* pDRV = P.DRV; float* pAGA = P.AGA; float* pAGB = P.AGB; const bf16_t* pWlg = P.Wlg_t;
    float pv[8];
    { const int ch = tid; pv[0] = conv_w[0 * LW + ch]; pv[1] = conv_w[1 * LW + ch]; pv[2] = conv_w[2 * LW + ch]; pv[3] = conv_w[3 * LW + ch]; pv[4] = conv_b[ch]; pv[5] = b_r[ch]; pv[6] = b_i[ch]; pv[7] = lam[ch]; }
    { u32x4 uv[9]; unsigned short k1[4], k2[4]; f32x2 cs[4];
#pragma unroll
      for (int q = 0; q < 9; ++q) { const int i = tid + q * NTHREADS; const int r = i >> 6, ch = i & 63; uv[q] = (u32x4){0u, 0u, 0u, 0u};
          if (i < 67 * 64 && (r >= 3 || s0 != 0)) uv[q] = *(const u32x4*)(pZ + (size_t)(tok0 - 3 + r) * ZW + ch * 8); }
#pragma unroll
      for (int q = 0; q < 4; ++q) { const int i = tid + q * NTHREADS; const int t = i >> 5, j = i & 31; const size_t tok = (size_t)tok0 + t;
          k1[q] = pZ[tok * ZW + 2048 + j]; k2[q] = pZ[tok * ZW + 2080 + j]; cs[q] = pROPE[(s0 + t) * 32 + j]; }
#pragma unroll
      for (int q = 0; q < 9; ++q) { const int i = tid + q * NTHREADS; const int r = i >> 6, ch = i & 63; if (i < 67 * 64) *(LAS u32x4*)(U + r * URS + ch * 16) = uv[q]; }
#pragma unroll
      for (int q = 0; q < 4; ++q) { const int i = tid + q * NTHREADS; const int t = i >> 5, j = i & 31; const size_t tok = (size_t)tok0 + t; const float x1 = bf2f(k1[q]), x2 = bf2f(k2[q]);
          pKPE[tok * 64 + j] = (bf16_t)f2bf(x1 * cs[q].x - x2 * cs[q].y); pKPE[tok * 64 + 32 + j] = (bf16_t)f2bf(x1 * cs[q].y + x2 * cs[q].x); } }
    { const int ch = tid;
      PAR[0 * LW + ch] = pv[0]; PAR[1 * LW + ch] = pv[1]; PAR[2 * LW + ch] = pv[2]; PAR[3 * LW + ch] = pv[3];
      PAR[4 * LW + ch] = pv[4]; PAR[5 * LW + ch] = pv[5]; PAR[6 * LW + ch] = pv[6]; PAR[7 * LW + ch] = -8.0f * log1pf(__expf(-pv[7])); }
    LDS_SYNC();
    bf16x8 nb0, nb1; { const bf16_t* wb = pWlg + ((size_t)16 * wid + fr) * 64 + 8 * fq; nb0 = *(const bf16x8*)wb; nb1 = *(const bf16x8*)(wb + 32); }
    for (int n = 0; n < 8; ++n) {
        { const int chb = 64 * n + 8 * wid; float xc[8];
#pragma unroll
          for (int j = 0; j < 8; ++j) xc[j] = PAR[4 * LW + chb + j];
#pragma unroll
          for (int w = 0; w < 4; ++w) { const u32x4 uv = *(const LAS u32x4*)(U + (lane + w) * URS + chb * 2);
              const f32x4 c0 = *(const LAS f32x4*)(PAR + w * LW + chb), c1 = *(const LAS f32x4*)(PAR + w * LW + chb + 4);
              xc[0] = fmaf(bflo(uv.x), c0[0], xc[0]); xc[1] = fmaf(bfhi(uv.x), c0[1], xc[1]); xc[2] = fmaf(bflo(uv.y), c0[2], xc[2]); xc[3] = fmaf(bfhi(uv.y), c0[3], xc[3]);
              xc[4] = fmaf(bflo(uv.z), c1[0], xc[4]); xc[5] = fmaf(bfhi(uv.z), c1[1], xc[5]); xc[6] = fmaf(bflo(uv.w), c1[2], xc[6]); xc[7] = fmaf(bfhi(uv.w), c1[3], xc[7]); }
          u32x4 o; o.x = pk2(xc[0], xc[1]); o.y = pk2(xc[2], xc[3]); o.z = pk2(xc[4], xc[5]); o.w = pk2(xc[6], xc[7]);
          *(LAS u32x4*)(XC + lane * XRS + wid * 16) = o; }
        LDS_SYNC();
        f32x4 acc[4];
        { const bf16x8 b0 = nb0, b1 = nb1;
          if (n + 1 < 8) { const bf16_t* wb = pWlg + ((size_t)(n + 1) * 128 + 16 * wid + fr) * 64 + 8 * fq; nb0 = *(const bf16x8*)wb; nb1 = *(const bf16x8*)(wb + 32); }
#pragma unroll
          for (int m = 0; m < 4; ++m) { const bf16x8 a0 = *(const LAS bf16x8*)(XC + (16 * m + fr) * XRS + fq * 16), a1 = *(const LAS bf16x8*)(XC + (16 * m + fr) * XRS + 64 + fq * 16);
              f32x4 c = {0.f, 0.f, 0.f, 0.f};
              c = __builtin_amdgcn_mfma_f32_16x16x32_bf16(b0, a0, c, 0, 0, 0); c = __builtin_amdgcn_mfma_f32_16x16x32_bf16(b1, a1, c, 0, 0, 0); acc[m] = c; } }
        const bool lo = fq < 2;
        f32x4 rv[2], iv[2];
#pragma unroll
        for (int j = 0; j < 2; ++j) { const f32x4 snd = lo ? acc[2 + j] : acc[j]; f32x4 rc;
#pragma unroll
            for (int x = 0; x < 4; ++x) rc[x] = __shfl_xor(snd[x], 32);
            rv[j] = lo ? acc[j] : rc; iv[j] = lo ? rc : acc[2 + j]; }
        const int d0 = 8 * wid + 4 * (fq & 1), ch0 = 64 * n + d0;
        const f32x4 brv = *(const LAS f32x4*)(PAR + 5 * LW + ch0), biv = *(const LAS f32x4*)(PAR + 6 * LW + ch0), spv = *(const LAS f32x4*)(PAR + 7 * LW + ch0), cbv = *(const LAS f32x4*)(PAR + 4 * LW + ch0);
        f32x4 cw[4];
#pragma unroll
        for (int w = 0; w < 4; ++w) cw[w] = *(const LAS f32x4*)(PAR + w * LW + ch0);
#pragma unroll
        for (int j = 0; j < 2; ++j) { const int t = 16 * ((lo ? 0 : 2) + j) + fr; f32x4 av, dv;
            const u32x2 xcb = *(const LAS u32x2*)(XC + t * XRS + d0 * 2); const float xcq[4] = {bflo(xcb.x), bfhi(xcb.x), bflo(xcb.y), bfhi(xcb.y)};
#pragma unroll
            for (int x = 0; x < 4; ++x) {
                const float xcv = xcq[x];
                const float r = sigm(rv[j][x] + brv[x]), ig = sigm(iv[j][x] + biv[x]);
                const float log_a = r * spv[x];
                av[x] = __expf(log_a); dv[x] = __builtin_amdgcn_sqrtf(one_minus_sq(av[x], 2.0f * log_a)) * (ig * xcv); }
            *(LAS f32x4*)(SA + t * SRS + d0) = av; *(LAS f32x4*)(SD + t * SRS + d0) = dv; }
        LDS_SYNC();
        { float Ap = 1.f, Bp = 0.f;
#pragma unroll
          for (int j = 0; j < 8; ++j) { const int t = 8 * wid + j; const float a = SA[t * SRS + lane], dv = SD[t * SRS + lane];
              ((unsigned*)pA)[((size_t)tok0 + t) * LW + 64 * n + lane] = pg8::cvt_pk_bf16(1.f - a, dv);
              Ap *= a; Bp = fmaf(a, Bp, dv); }
          PP[wid * 64 + lane] = (f32x2){Ap, Bp}; }
        LDS_SYNC();
        if (wid == 0) { float Aa = 1.f, Bb = 0.f;
#pragma unroll
            for (int g = 0; g < 8; ++g) { const f32x2 p = PP[g * 64 + lane]; Aa *= p.x; Bb = fmaf(p.x, Bb, p.y); }
            pAGA[(size_t)tile * LW + 64 * n + lane] = Aa; pAGB[(size_t)tile * LW + 64 * n + lane] = Bb; }
    }
    LDS_SYNC();
}
__device__ __forceinline__ void phase_qkv(const OW& P, int l, LAS unsigned char* lds, int G) {
#ifndef P2SEL
#define P2SEL 3
#endif
    if (P2SEL & 1) { SchedQKV Sd{&P, G, BID()}; EpiQKV E{P.SSQ, P.Q, P.KN, P.VV};
    pg8::gemm_phase<true>(lds, Sd, E); }
    if (P2SEL & 2) for (int tile = BID(); tile < NT / 64; tile += G) gates_tile(P, l, lds, tile);
}


namespace att {
typedef short s16x4 __attribute__((ext_vector_type(4)));
typedef float f32x16 __attribute__((ext_vector_type(16)));
constexpr int KVBLK = 64, SHM_V = 16384, SHM_K = 24576, OFF_K = 3 * SHM_V, OFF_WS = OFF_K + 3 * SHM_K, OFF_QR = OFF_WS + 8 * 64 * 4, LDS_NEED = OFF_QR + 8 * 4096;
static_assert(LDS_NEED <= LDSCTL_OFF, "attention LDS");
constexpr float SCALE = 0.07216878364870322f, THR = 8.f;
#define SBAR() __builtin_amdgcn_sched_barrier(0)
__device__ __forceinline__ int v_st(int k, int c) { const int kk = (k & ~0xC) | ((k & 4) << 1) | ((k & 8) >> 1); return ((kk >> 3) * 4 + (c >> 5)) * 512 + ((kk & 7) * 32 + (c & 31)) * 2; }
__device__ __forceinline__ int v_rd_base(int lane) { return ((lane & 3) << 3) | (((lane >> 2) & 3) << 6) | (((lane >> 4) & 1) << 5) | (((lane >> 5) & 1) << 8); }
constexpr int v_rd_off(int d0, int ks, int half) { return d0 * 512 + ks * 4096 + half * 2048; }
__device__ __forceinline__ int k_off(int row, int cc) { return (cc >> 3) * 8192 + row * 128 + (((cc & 7) ^ ((row >> 1) & 7)) << 4); }
__device__ __forceinline__ int crow(int r, int hi) { return (r & 3) + 8 * (r >> 2) + 4 * hi; }
__device__ __forceinline__ unsigned cvtpk(float lo, float hi) { unsigned r; asm volatile("v_cvt_pk_bf16_f32 %0, %1, %2" : "=v"(r) : "v"(lo), "v"(hi)); return r; }
__device__ __forceinline__ void mask_tile(f32x16& p0, f32x16& p1, int dq) {
    const float NEG = -__builtin_inff();
#pragma unroll
    for (int r = 0; r < 16; ++r) { const int c = (r & 3) + 8 * (r >> 2); if (dq - c < 0) p0[r] = NEG; if (dq - c - 32 < 0) p1[r] = NEG; }
}
__device__ __forceinline__ void partialSM(f32x16& p0, f32x16& p1, float& m_reg, float& mn, float& alpha) {
    float pmax = p0[0];
#pragma unroll
    for (int r = 1; r < 16; ++r) pmax = fmaxf(pmax, p0[r]);
#pragma unroll
    for (int r = 0; r < 16; ++r) pmax = fmaxf(pmax, p1[r]);
    { auto rr = __builtin_amdgcn_permlane32_swap(__float_as_uint(pmax), __float_as_uint(pmax), false, false); pmax = fmaxf(__uint_as_float(rr[0]), __uint_as_float(rr[1])); }
    constexpr float C2 = 1.4426950408889634f * SCALE;
    if (__builtin_expect(__all((pmax - m_reg) * SCALE <= THR), 1)) { mn = m_reg; alpha = 1.f; }
    else { mn = fmaxf(m_reg, pmax); alpha = __builtin_amdgcn_exp2f((m_reg - mn) * C2); m_reg = mn; }
    const float mnL = -mn * C2;
#pragma unroll
    for (int r = 0; r < 16; ++r) p0[r] = fmaf(p0[r], C2, mnL);
#pragma unroll
    for (int r = 0; r < 16; ++r) p1[r] = fmaf(p1[r], C2, mnL);
#pragma unroll
    for (int r = 0; r < 16; ++r) p0[r] = __builtin_amdgcn_exp2f(p0[r]);
}
__device__ __forceinline__ void finishSM(f32x16& p0, f32x16& p1, float alpha, float& l_reg, bf16x8& pa0, bf16x8& pa1, bf16x8& pa2, bf16x8& pa3) {
#pragma unroll
    for (int r = 0; r < 16; ++r) p1[r] = __builtin_amdgcn_exp2f(p1[r]);
    float ps = 0;
#pragma unroll
    for (int r = 0; r < 16; ++r) ps += p0[r];
#pragma unroll
    for (int r = 0; r < 16; ++r) ps += p1[r];
    { auto rr = __builtin_amdgcn_permlane32_swap(__float_as_uint(ps), __float_as_uint(ps), false, false); ps = __uint_as_float(rr[0]) + __uint_as_float(rr[1]); }
    l_reg = l_reg * alpha + ps;
#define PK4(P, B_, OUT) do { unsigned a0 = cvtpk(P[B_+0], P[B_+1]), a1 = cvtpk(P[B_+2], P[B_+3]);                          \
        unsigned b0 = cvtpk(P[B_+4], P[B_+5]), b1 = cvtpk(P[B_+6], P[B_+7]);                                             \
        auto r0 = __builtin_amdgcn_permlane32_swap(a0, b0, false, false); auto r1 = __builtin_amdgcn_permlane32_swap(a1, b1, false, false); \
        u32x4 w = {r0[0], r1[0], r0[1], r1[1]}; OUT = *reinterpret_cast<bf16x8*>(&w); } while (0)
    PK4(p0, 0, pa0); PK4(p0, 8, pa1); PK4(p1, 0, pa2); PK4(p1, 8, pa3);
#undef PK4
}
__device__ __forceinline__ void qkt(f32x16& p0, f32x16& p1, const char* K_slot, int r32, int hi, const bf16x8* qr, const char* qrl) {
    p0 = f32x16{}; p1 = f32x16{};
    const char* kb[4];
#pragma unroll
    for (int dd = 0; dd < 4; ++dd) kb[dd] = K_slot + r32 * 128 + (((2 * dd + hi) ^ ((r32 >> 1) & 7)) << 4);
    bf16x8 a0[4], a1[4], b0[4], b1[4], qf[4];
#define QK_LOAD(X0, X1, g) do { _Pragma("unroll") for (int dd = 0; dd < 4; ++dd) { const char* a_ = kb[dd] + (g) * 8192; X0[dd] = *reinterpret_cast<const bf16x8*>(a_); X1[dd] = *reinterpret_cast<const bf16x8*>(a_ + 32 * 128); } } while (0)
#define QK_MMA(X0, X1, Q_) do { _Pragma("unroll") for (int dd = 0; dd < 4; ++dd) { p0 = __builtin_amdgcn_mfma_f32_32x32x16_bf16(X0[dd], Q_[dd], p0, 0, 0, 0); p1 = __builtin_amdgcn_mfma_f32_32x32x16_bf16(X1[dd], Q_[dd], p1, 0, 0, 0); } } while (0)
    QK_LOAD(a0, a1, 0); SBAR();
    QK_LOAD(b0, b1, 1); SBAR();
    QK_MMA(a0, a1, qr); SBAR();
    QK_LOAD(a0, a1, 2);
#pragma unroll
    for (int dd = 0; dd < 4; ++dd) qf[dd] = *reinterpret_cast<const bf16x8*>(qrl + dd * 1024);
    SBAR();
    QK_MMA(b0, b1, (qr + 4)); SBAR();
    QK_MMA(a0, a1, qf);
#undef QK_LOAD
#undef QK_MMA
}
__device__ __forceinline__ void pv_tile(f32x16* o, int vb0, bf16x8 pa0, bf16x8 pa1, bf16x8 pa2, bf16x8 pa3) {
#define TRRD(dst, off) asm volatile("ds_read_b64_tr_b16 %0, %1 offset:%2" : "=&v"(dst) : "v"(vb0), "i"(off) : "memory")
#define PV_RD(S, d0) do { constexpr int b_ = v_rd_off(d0, 0, 0); \
        TRRD(S##l0, b_); TRRD(S##h0, b_ + 2048); TRRD(S##l1, b_ + 4096); TRRD(S##h1, b_ + 6144); TRRD(S##l2, b_ + 8192); TRRD(S##h2, b_ + 10240); TRRD(S##l3, b_ + 12288); TRRD(S##h3, b_ + 14336); } while (0)
#define PV_MM(S, d0) do { \
        o[d0] = __builtin_amdgcn_mfma_f32_32x32x16_bf16(pa0, (bf16x8){S##l0[0], S##l0[1], S##l0[2], S##l0[3], S##h0[0], S##h0[1], S##h0[2], S##h0[3]}, o[d0], 0, 0, 0);   \
        o[d0] = __builtin_amdgcn_mfma_f32_32x32x16_bf16(pa1, (bf16x8){S##l1[0], S##l1[1], S##l1[2], S##l1[3], S##h1[0], S##h1[1], S##h1[2], S##h1[3]}, o[d0], 0, 0, 0);   \
        o[d0] = __builtin_amdgcn_mfma_f32_32x32x16_bf16(pa2, (bf16x8){S##l2[0], S##l2[1], S##l2[2], S##l2[3], S##h2[0], S##h2[1], S##h2[2], S##h2[3]}, o[d0], 0, 0, 0);   \
        o[d0] = __builtin_amdgcn_mfma_f32_32x32x16_bf16(pa3, (bf16x8){S##l3[0], S##l3[1], S##l3[2], S##l3[3], S##h3[0], S##h3[1], S##h3[2], S##h3[3]}, o[d0], 0, 0, 0); } while (0)
    s16x4 Al0, Al1, Al2, Al3, Ah0, Ah1, Ah2, Ah3, Bl0, Bl1, Bl2, Bl3, Bh0, Bh1, Bh2, Bh3;
    asm volatile("s_waitcnt lgkmcnt(0)" ::: "memory");
    PV_RD(A, 0);
    PV_RD(B, 1); asm volatile("s_waitcnt lgkmcnt(8)" ::: "memory"); SBAR(); PV_MM(A, 0); SBAR();
    PV_RD(A, 2); asm volatile("s_waitcnt lgkmcnt(8)" ::: "memory"); SBAR(); PV_MM(B, 1); SBAR();
    PV_RD(B, 3); asm volatile("s_waitcnt lgkmcnt(8)" ::: "memory"); SBAR(); PV_MM(A, 2); SBAR();
    asm volatile("s_waitcnt lgkmcnt(0)" ::: "memory"); SBAR(); PV_MM(B, 3);
#undef PV_RD
#undef PV_MM
#undef TRRD
}
__device__ __forceinline__ void unit(const OW& P, char* lds, int b, int h, int qb, int part) {
    const int tid = TID(), wid = __builtin_amdgcn_readfirstlane(tid >> 6), lane = tid & 63, r32 = lane & 31, hi = lane >> 5;
    const int NTall = 4 * (qb + 1), t_lo = part ? NTall / 2 : 0, NT_ = NTall / 2;
    const size_t rowbase = (size_t)b * S;
    const int q0 = qb * 256, qlo = q0 + wid * 32, qm = qlo + r32 - 4 * hi;
    char* V_lds = lds; char* K_lds = lds + OFF_K;
    float* ws = (float*)(lds + OFF_WS) + wid * 64; float* li_l = ws; float* al_l = ws + 32;
    float m_reg = -1e30f, l_reg = 0; f32x16 o[4] = {};
    const int vb0 = (int)(uintptr_t)V_lds + v_rd_base(lane);
    unsigned go_k01, go_k2, go_v0, go_v1;
    { const int row = 8 * wid + (lane >> 3), c = (lane & 7) ^ ((row >> 1) & 7);
      go_k01 = (unsigned)(row * 512 + c * 8) * 2u; go_k2 = (unsigned)(row * 64 + c * 8) * 2u;
      const int si0 = 2 * wid + (lane >> 5), si1 = si0 + 16;
      const int kk0 = (si0 >> 2) * 8 + ((lane & 31) >> 2), kk1 = (si1 >> 2) * 8 + ((lane & 31) >> 2);
      const int k0_ = (kk0 & ~0xC) | ((kk0 & 4) << 1) | ((kk0 & 8) >> 1), k1_ = (kk1 & ~0xC) | ((kk1 & 4) << 1) | ((kk1 & 8) >> 1);
      go_v0 = (unsigned)(k0_ * 512 + (si0 & 3) * 32 + (lane & 3) * 8) * 2u; go_v1 = (unsigned)(k1_ * 512 + (si1 & 3) * 32 + (lane & 3) * 8) * 2u; }
    const char* KnB = (const char*)(P.KN + rowbase * 512 + h * 128); const char* VhB = (const char*)(P.VV + rowbase * 512 + h * 128); const char* KpB = (const char*)(P.KPE + rowbase * 64);
    LAS unsigned char* ldsK = (LAS unsigned char*)(uintptr_t)(unsigned)(uintptr_t)K_lds; LAS unsigned char* ldsV = (LAS unsigned char*)(uintptr_t)(unsigned)(uintptr_t)V_lds;
#define KBASE(t) ((t_lo + (t)) * KVBLK)
#define GLDS(gp, lp) __builtin_amdgcn_global_load_lds((const unsigned*)(gp), (LAS unsigned*)(lp), 16, 0, 0)
#define STAGE(k0, ks_, vs_) do { const size_t kb_ = (size_t)(k0); \
        GLDS(KnB + kb_ * 1024 + go_k01, ldsK + (ks_) * SHM_K + wid * 1024); GLDS(KnB + kb_ * 1024 + 128 + go_k01, ldsK + (ks_) * SHM_K + 8192 + wid * 1024); \
        GLDS(KpB + kb_ * 128 + go_k2, ldsK + (ks_) * SHM_K + 16384 + wid * 1024); \
        GLDS(VhB + kb_ * 1024 + go_v0, ldsV + (vs_) * SHM_V + wid * 1024); GLDS(VhB + kb_ * 1024 + go_v1, ldsV + (vs_) * SHM_V + (wid + 8) * 1024); } while (0)
#define RESC(a) do { if (__any((a) < 1.f)) { if (hi == 0) al_l[r32] = (a); asm volatile("s_waitcnt lgkmcnt(0)" ::: "memory");              \
                     _Pragma("unroll") for (int d_ = 0; d_ < 4; ++d_) _Pragma("unroll") for (int r = 0; r < 16; ++r) o[d_][r] *= al_l[crow(r, hi)]; } } while (0)
#define MASKT(P0_, P1_, t) do { const int kb_ = KBASE(t); if (kb_ + KVBLK - 1 > qlo) mask_tile(P0_, P1_, qm - kb_); } while (0)
    STAGE(KBASE(0), 0, 0); if (NT_ > 1) { STAGE(KBASE(1), 1, 1); }
    bf16x8 qr[8]; char* qrl = lds + OFF_QR + wid * 4096 + lane * 16;
    { const bf16_t* qp = P.Q + (rowbase + qlo + r32) * QL + h * QH + hi * 8;
#pragma unroll
      for (int d0 = 0; d0 < 8; ++d0) qr[d0] = *(const bf16x8*)(qp + d0 * 16);
      const f32x2* rp = P.ROPE + (size_t)(qlo + r32) * 32 + hi * 8;
#pragma unroll
      for (int g = 0; g < 2; ++g) {
          u32x4 x1 = *(const u32x4*)(qp + (8 + g) * 16), x2 = *(const u32x4*)(qp + (10 + g) * 16); u32x4 y1, y2;
#pragma unroll
          for (int jj = 0; jj < 4; ++jj) { const f32x2 cs0 = rp[16 * g + 2 * jj], cs1 = rp[16 * g + 2 * jj + 1];
              const float a0 = bflo(x1[jj]), a1 = bfhi(x1[jj]), b0 = bflo(x2[jj]), b1 = bfhi(x2[jj]);
              y1[jj] = pk2(a0 * cs0.x - b0 * cs0.y, a1 * cs1.x - b1 * cs1.y); y2[jj] = pk2(a0 * cs0.y + b0 * cs0.x, a1 * cs1.y + b1 * cs1.x); }
          *(u32x4*)(qrl + g * 1024) = y1; *(u32x4*)(qrl + (2 + g) * 1024) = y2; } }
    f32x16 p0, p1; float mn, al; bf16x8 pa0, pa1, pa2, pa3;
    asm volatile("s_waitcnt vmcnt(0)" ::: "memory"); __syncthreads();
    int sl = 0;
    for (int t = 0; t < NT_; ++t) {
        const int s2 = sl == 0 ? 2 : sl - 1;
        if (t + 2 < NT_) { STAGE(KBASE(t + 2), s2, s2); }
        qkt(p0, p1, K_lds + sl * SHM_K, r32, hi, qr, qrl);
        MASKT(p0, p1, t); partialSM(p0, p1, m_reg, mn, al); RESC(al);
        finishSM(p0, p1, al, l_reg, pa0, pa1, pa2, pa3); SBAR();
        pv_tile(o, vb0 + sl * SHM_V, pa0, pa1, pa2, pa3);
        if (t + 2 < NT_) asm volatile("s_waitcnt vmcnt(5) lgkmcnt(0)" ::: "memory"); else asm volatile("s_waitcnt vmcnt(0) lgkmcnt(0)" ::: "memory");
        __builtin_amdgcn_s_barrier(); asm volatile("" ::: "memory");
        sl = sl == 2 ? 0 : sl + 1;
    }
    bf16_t* Ow = P.OP + ((size_t)part * NT + rowbase + qlo) * 512 + h * 128;
#pragma unroll
    for (int r = 0; r < 16; ++r) { const int orow = crow(r, hi);
#pragma unroll
        for (int d0 = 0; d0 < 4; ++d0) { const float v = o[d0][r]; const float vn = __builtin_bit_cast(float, __builtin_amdgcn_update_dpp(0, __builtin_bit_cast(int, v), 0xB1, 0xF, 0xF, false));
            if ((r32 & 1) == 0) *(unsigned*)(Ow + (size_t)orow * 512 + d0 * 32 + r32) = cvtpk(v, vn); } }
    if (hi == 0) P.ML[((size_t)part * NT + rowbase + qlo + r32) * 4 + h] = (f32x2){m_reg * (1.4426950408889634f * SCALE), l_reg};
    __syncthreads();
#undef KBASE
#undef GLDS
#undef STAGE
#undef RESC
#undef MASKT
}
#undef SBAR
}
__device__ __forceinline__ void phase_attn(const OW& P, LAS unsigned char* lds, int vcu, int G) {
    for (int v = vcu; v < 256; v += G) { const int bh = v >> 4, r = v & 15;
        att::unit(P, (char*)lds, bh >> 2, bh & 3, r, 0);
        att::unit(P, (char*)lds, bh >> 2, bh & 3, 15 - r, 1); }
}
#if MODE == 0
__global__ void shim_attn(const bf16_t* OP, const f32x2* ML, float* MIXf) {
    const size_t i = (size_t)blockIdx.x * 256 + threadIdx.x; if (i >= (size_t)NT * 512) return;
    const size_t row = i >> 9; const int c = (int)(i & 511), h = c >> 7;
    const f32x2 a = ML[row * 4 + h], b = ML[((size_t)NT + row) * 4 + h];
    const float M = fmaxf(a.x, b.x), w0 = exp2f(a.x - M), w1 = exp2f(b.x - M);
    MIXf[row * D + 512 + c] = (w0 * bf2f(OP[i]) + w1 * bf2f(OP[(size_t)NT * 512 + i])) / (w0 * a.y + w1 * b.y);
}
#endif


template <int CTRL, int ROWMASK> __device__ __forceinline__ float dppf(float v) { return __builtin_bit_cast(float, __builtin_amdgcn_update_dpp(0, __builtin_bit_cast(int, v), CTRL, ROWMASK, 0xF, false)); }
__device__ __forceinline__ float wsum(float v) {
    v += dppf<0xB1, 0xF>(v);
    v += dppf<0x4E, 0xF>(v);
    v += dppf<0x141, 0xF>(v);
    v += dppf<0x140, 0xF>(v);
    v += dppf<0x142, 0xA>(v);
    v += dppf<0x143, 0xC>(v);
    return __builtin_bit_cast(float, __builtin_amdgcn_readlane(__builtin_bit_cast(int, v), 63));
}
__device__ __forceinline__ float gelu_t(float x) { const float u = 0.7978845608028654f * (x + 0.044715f * x * x * x); const float t = 1.f - 2.f * __builtin_amdgcn_rcpf(1.f + __expf(2.f * u)); return 0.5f * x * (1.f + t); }
__device__ __forceinline__ void mix_tile(const OW& P, LAS unsigned char* lds, int tile) {
    const int tid = TID(), lane = tid & 63, wid = __builtin_amdgcn_readfirstlane(tid >> 6);
    LAS float* LR = (LAS float*)lds;
    const int tok0 = tile * 64, j = tile & 63, tile0 = tile - j;
    float h = 0.f;
    if (j > 0) {
        { float a[32], b[32];
#pragma unroll
          for (int q = 0; q < 32; ++q) { const int t_ = q < j ? tile0 + q : tile0; a[q] = P.AGA[(size_t)t_ * LW + tid]; b[q] = P.AGB[(size_t)t_ * LW + tid]; }
#pragma unroll
          for (int q = 0; q < 32; ++q) if (q < j) h = fmaf(a[q], h, b[q]); }
        if (j > 32) { float a[32], b[32];
#pragma unroll
          for (int q = 0; q < 32; ++q) { const int t_ = 32 + q < j ? tile0 + 32 + q : tile0; a[q] = P.AGA[(size_t)t_ * LW + tid]; b[q] = P.AGB[(size_t)t_ * LW + tid]; }
#pragma unroll
          for (int q = 0; q < 32; ++q) if (32 + q < j) h = fmaf(a[q], h, b[q]); }
    }
    { unsigned ad[64]; unsigned short gg[64];
#pragma unroll
      for (int q = 0; q < 64; ++q) { const size_t tok = (size_t)tok0 + q; ad[q] = ((const unsigned*)P.A)[tok * LW + tid]; gg[q] = P.Z[tok * ZW + LW + tid]; }
#pragma unroll
      for (int q = 0; q < 64; ++q) { h = fmaf(1.f - bflo(ad[q]), h, bfhi(ad[q])); LR[q * LW + tid] = h * gelu_t(bf2f(gg[q])); } }
    __syncthreads();
    { const int hh = lane >> 4;
      f32x2 nma, nmb; u32x4 noa, nob;
#define MX_LOAD(r_) do { const size_t row_ = (size_t)tok0 + (r_); nma = P.ML[row_ * 4 + hh]; nmb = P.ML[((size_t)NT + row_) * 4 + hh]; \
        noa = *(const u32x4*)(P.OP + row_ * 512 + lane * 8); nob = *(const u32x4*)(P.OP + ((size_t)NT + row_) * 512 + lane * 8); } while (0)
      MX_LOAD(wid);
      for (int r = wid; r < 64; r += NWAVES) { const size_t row = (size_t)tok0 + r;
        const f32x2 ma = nma, mb = nmb; const u32x4 oa = noa, ob = nob;
        if (r + NWAVES < 64) MX_LOAD(r + NWAVES);
        { const f32x4 v0 = *(const LAS f32x4*)(LR + r * LW + lane * 8), v1 = *(const LAS f32x4*)(LR + r * LW + lane * 8 + 4);
          float ss = (v0[0] * v0[0] + v0[1] * v0[1]) + (v0[2] * v0[2] + v0[3] * v0[3]) + (v1[0] * v1[0] + v1[1] * v1[1]) + (v1[2] * v1[2] + v1[3] * v1[3]);
          const float rs = rsqrtf(wsum(ss) * (1.f / 512.f) + EPS);
          u32x4 o; o.x = pk2(v0[0] * rs, v0[1] * rs); o.y = pk2(v0[2] * rs, v0[3] * rs); o.z = pk2(v1[0] * rs, v1[1] * rs); o.w = pk2(v1[2] * rs, v1[3] * rs);
          *(u32x4*)(P.MIX + row * D + lane * 8) = o; }
        { const float M = fmaxf(ma.x, mb.x), w0 = __builtin_amdgcn_exp2f(ma.x - M), w1 = __builtin_amdgcn_exp2f(mb.x - M), inv = 1.f / (w0 * ma.y + w1 * mb.y);
          float v[8];
#pragma unroll
          for (int q = 0; q < 4; ++q) { v[2 * q] = (w0 * bflo(oa[q]) + w1 * bflo(ob[q])) * inv; v[2 * q + 1] = (w0 * bfhi(oa[q]) + w1 * bfhi(ob[q])) * inv; }
          float ss = 0.f;
#pragma unroll
          for (int q = 0; q < 8; ++q) ss += v[q] * v[q];
          const float rs = rsqrtf(wsum(ss) * (1.f / 512.f) + EPS);
          u32x4 o; o.x = pk2(v[0] * rs, v[1] * rs); o.y = pk2(v[2] * rs, v[3] * rs); o.z = pk2(v[4] * rs, v[5] * rs); o.w = pk2(v[6] * rs, v[7] * rs);
          *(u32x4*)(P.MIX + row * D + 512 + lane * 8) = o; } }
#undef MX_LOAD
    }
    __syncthreads();
}
struct SchedOut {
    static constexpr bool HOOKS = false;
    const OW* P; int G, c;
    __device__ __forceinline__ bool next(int i, pg8::UnitD& u) const {
        const int L = i * G + c; if (L >= 256) return false;
        int pm, pn; pg8::tile_order(L, 64, 4, pm, pn);
        u.A = (const char*)(P->MIX + (size_t)pm * 256 * D); u.rows = nullptr; u.B = (const char*)(P->Wo_t + (size_t)pn * 256 * 1024); u.lda = D * 2; u.ldb = 2048; u.nt = 16; u.type = 3; u.pm = pm; u.pn = pn; u.aux = 0;
        return true;
    }
};
struct EpiOut {
    const bf16_t* xres; bf16_t* Y;
    __device__ __forceinline__ void operator()(const f32x4 (&acc)[2][2][4][2], const pg8::UnitD& u, int wr, int wc, int fr, int fq) const {
        const int L = fr + 16 * fq, sq = pg8::to_quad_src(L), sf = pg8::from_quad_src(L);
        const int row0 = u.pm * 256 + wr * 64 + (L >> 2), col0 = u.pn * 256 + wc * 32 + 8 * (L & 3);
#pragma unroll
        for (int ai = 0; ai < 2; ++ai) { u32x4 xb[4][2];
#pragma unroll
            for (int m = 0; m < 4; ++m) { const size_t off = (size_t)(row0 + ai * 128 + m * 16) * D + col0;
#pragma unroll
                for (int bj = 0; bj < 2; ++bj) xb[m][bj] = *(const u32x4*)(xres + off + bj * 128); }
#pragma unroll
            for (int m = 0; m < 4; ++m) { const size_t off = (size_t)(row0 + ai * 128 + m * 16) * D + col0;
#pragma unroll
                for (int bj = 0; bj < 2; ++bj) { const u32x4 x_ = pg8::lane_perm(xb[m][bj], sf); const f32x4 v0 = acc[ai][bj][m][0], v1 = acc[ai][bj][m][1];
                    u32x4 w; w.x = pg8::cvt_pk_bf16(ALPHA * bflo(x_.x) + v0[0], ALPHA * bfhi(x_.x) + v0[1]); w.y = pg8::cvt_pk_bf16(ALPHA * bflo(x_.y) + v0[2], ALPHA * bfhi(x_.y) + v0[3]);
                    w.z = pg8::cvt_pk_bf16(ALPHA * bflo(x_.z) + v1[0], ALPHA * bfhi(x_.z) + v1[1]); w.w = pg8::cvt_pk_bf16(ALPHA * bflo(x_.w) + v1[2], ALPHA * bfhi(x_.w) + v1[3]);
                    *(u32x4*)(Y + off + bj * 128) = pg8::lane_perm(w, sq); } } }
    }
};
__device__ __forceinline__ void ln1_router_tile(const OW& P, int l, LAS unsigned char* lds, int tile) {
    const int tid = TID(), lane = tid & 63, wid = __builtin_amdgcn_readfirstlane(tid >> 6), fr = lane & 15, fq = lane >> 4;
    LAS float* PL = (LAS float*)lds;
    LAS f32x2* ST = (LAS f32x2*)(lds + 8192);
    LAS int* EI = (LAS int*)(lds + 8192 + 512);
    const float* g1 = P.in[15] + (size_t)l * D; const float* b1 = P.in[16] + (size_t)l * D; const float* rb = P.in[18];
    const int tok0 = tile * 64;
    constexpr int YRS = 2064;
    LAS unsigned char* YT = lds + 16384;
    { f32x4 gv[4], bv[4];
#pragma unroll
      for (int j = 0; j < 4; ++j) { const int c = lane * 8 + 512 * (j >> 1) + 4 * (j & 1); gv[j] = *(const f32x4*)(g1 + c); bv[j] = *(const f32x4*)(b1 + c); }
#pragma unroll
      for (int kg = 0; kg < 8; kg += 4) {
        u32x4 ny[4][2];
#pragma unroll
        for (int k4 = 0; k4 < 4; ++k4)
#pragma unroll
            for (int j = 0; j < 2; ++j) ny[k4][j] = *(const u32x4*)(P.Y + ((size_t)tok0 + wid * 8 + kg + k4) * D + lane * 8 + 512 * j);
        __builtin_amdgcn_sched_barrier(0);
#pragma unroll
        for (int k4 = 0; k4 < 4; ++k4) { const int r = wid * 8 + kg + k4; const size_t row = (size_t)tok0 + r;
            *(LAS u32x4*)(YT + r * YRS + lane * 16) = ny[k4][0]; *(LAS u32x4*)(YT + r * YRS + 1024 + lane * 16) = ny[k4][1];
            float v[16]; float s_ = 0.f;
#pragma unroll
            for (int j = 0; j < 2; ++j)
#pragma unroll
                for (int q = 0; q < 4; ++q) { v[8 * j + 2 * q] = bflo(ny[k4][j][q]); v[8 * j + 2 * q + 1] = bfhi(ny[k4][j][q]); }
#pragma unroll
            for (int j = 0; j < 16; ++j) s_ += v[j];
            const float mu = wsum(s_) * (1.f / D); float q_ = 0.f;
#pragma unroll
            for (int j = 0; j < 16; ++j) { v[j] -= mu; q_ += v[j] * v[j]; }
            const float rs = rsqrtf(wsum(q_) * (1.f / D) + EPS);
#pragma unroll
            for (int j = 0; j < 16; ++j) v[j] = v[j] * rs * gv[j >> 2][j & 3] + bv[j >> 2][j & 3];
#pragma unroll
            for (int j = 0; j < 2; ++j) { u32x4 o;
#pragma unroll
                for (int q = 0; q < 4; ++q) o[q] = pk2(v[8 * j + 2 * q], v[8 * j + 2 * q + 1]);
                *(u32x4*)(P.XB + row * D + lane * 8 + 512 * j) = o; }
            if (lane == 0) ST[r] = (f32x2){mu, rs}; } } }
    LDS_SYNC();
    { const int mt = wid & 3, kh = wid >> 2;
      bf16x8 ya[16], bh[16], bl[16];
#pragma unroll
      for (int ks = 0; ks < 16; ++ks) { const bf16_t* wp = P.RWH + ((size_t)((16 * kh + ks) * 64 + lane) << 3); bh[ks] = *(const bf16x8*)wp; bl[ks] = *(const bf16x8*)(wp + 16384); }
#pragma unroll
      for (int ks = 0; ks < 16; ++ks) ya[ks] = *(const LAS bf16x8*)(YT + (16 * mt + fr) * YRS + (512 * kh + 32 * ks + 8 * fq) * 2);
      __builtin_amdgcn_sched_barrier(0);
      f32x4 acc = {0.f, 0.f, 0.f, 0.f};
#pragma unroll
      for (int ks = 0; ks < 16; ++ks) { acc = __builtin_amdgcn_mfma_f32_16x16x32_bf16(ya[ks], bh[ks], acc, 0, 0, 0); acc = __builtin_amdgcn_mfma_f32_16x16x32_bf16(ya[ks], bl[ks], acc, 0, 0, 0); }
#pragma unroll
      for (int x = 0; x < 4; ++x) PL[(kh * 64 + 16 * mt + 4 * fq + x) * 16 + fr] = acc[x]; }
    __syncthreads();
    if (tid < 64) { const int r = tid; const size_t row = (size_t)tok0 + r; const f32x2 st = ST[r];
        float sg[16], ss[16];
#pragma unroll
        for (int q4 = 0; q4 < 4; ++q4) { const f32x4 pa = *(const LAS f32x4*)(PL + r * 16 + 4 * q4), pb = *(const LAS f32x4*)(PL + (64 + r) * 16 + 4 * q4);
#pragma unroll
            for (int x = 0; x < 4; ++x) { const int e = 4 * q4 + x; const float lg = st.y * ((pa[x] + pb[x]) - st.x * P.RGB[e]) + P.RGB[16 + e];
                sg[e] = __builtin_amdgcn_rcpf(1.f + __expf(-lg)); ss[e] = sg[e] + rb[e]; } }
        int best_g = 0; float best = -INFINITY;
#pragma unroll
        for (int gI = 0; gI < 4; ++gI) { float m1 = -INFINITY, m2 = -INFINITY;
#pragma unroll
            for (int k = 0; k < 4; ++k) { const float vv = ss[gI * 4 + k]; if (vv > m1) { m2 = m1; m1 = vv; } else if (vv > m2) { m2 = vv; } }
            const float gs = m1 + m2; if (gs > best) { best = gs; best_g = gI; } }
        float c0 = 0.f, c1 = 0.f, c2 = 0.f, c3 = 0.f, t0 = 0.f, t1 = 0.f, t2 = 0.f, t3 = 0.f;
#pragma unroll
        for (int gI = 0; gI < 4; ++gI) if (gI == best_g) { c0 = ss[gI * 4]; c1 = ss[gI * 4 + 1]; c2 = ss[gI * 4 + 2]; c3 = ss[gI * 4 + 3]; t0 = sg[gI * 4]; t1 = sg[gI * 4 + 1]; t2 = sg[gI * 4 + 2]; t3 = sg[gI * 4 + 3]; }
        int i1 = 0; float v1 = c0, s1 = t0;
        if (c1 > v1) { i1 = 1; v1 = c1; s1 = t1; }
        if (c2 > v1) { i1 = 2; v1 = c2; s1 = t2; }
        if (c3 > v1) { i1 = 3; v1 = c3; s1 = t3; }
        int i2 = -1; float v2 = -INFINITY, s2 = 0.f;
        if (i1 != 0 && c0 > v2) { i2 = 0; v2 = c0; s2 = t0; }
        if (i1 != 1 && c1 > v2) { i2 = 1; v2 = c1; s2 = t1; }
        if (i1 != 2 && c2 > v2) { i2 = 2; v2 = c2; s2 = t2; }
        if (i1 != 3 && c3 > v2) { i2 = 3; v2 = c3; s2 = t3; }
        const int e1 = best_g * 4 + i1, e2 = best_g * 4 + i2; const float inv = 1.f / (s1 + s2);
        P.GATE[row * 2] = s1 * inv; P.GATE[row * 2 + 1] = s2 * inv; P.EIDX[row * 2] = e1; P.EIDX[row * 2 + 1] = e2; EI[r * 2] = e1; EI[r * 2 + 1] = e2; }
    __syncthreads();
    { LAS int* C0 = EI + 128;
      int rank = 0, mye = -1, c_lo = 0;
      if (tid < 128) { mye = EI[tid];
#pragma unroll
          for (int e = 0; e < 16; ++e) { const unsigned long long m = __ballot(mye == e); if (mye == e) rank = __builtin_popcountll(m & ((1ull << lane) - 1ull)); if (tid == e) c_lo = __builtin_popcountll(m); if (tid == 64 + e) c_lo = __builtin_popcountll(m); }
          if (tid < 16) C0[tid] = c_lo; }
      __syncthreads();
      if (tid < 128) { if (tid >= 64) rank += C0[mye]; P.LRANK[(size_t)tok0 * 2 + tid] = rank; if (tid >= 64 && tid < 80) P.HIST[tile * 16 + (tid - 64)] = C0[tid - 64] + c_lo; } }
    __syncthreads();
}
__device__ __forceinline__ void moe_table(const OW& P, LAS unsigned char* lds) {
    const int tid = TID(); LAS int* HS = (LAS int*)lds; LAS int* TAB = (LAS int*)(lds + TAB_OFF);
    { int hv[8];
#pragma unroll
      for (int q = 0; q < 8; ++q) hv[q] = P.HIST[tid + q * NTHREADS];
#pragma unroll
      for (int q = 0; q < 8; ++q) HS[tid + q * NTHREADS] = hv[q]; }
    __syncthreads();
    if (tid < 64) { const int e = tid & 15, qd = tid >> 4; int tot = 0;
#pragma unroll 8
        for (int w = 0; w < 64; ++w) tot += HS[(qd * 64 + w) * 16 + e];
        tot += __shfl_xor(tot, 16); tot += __shfl_xor(tot, 32);
        if (qd == 0) TAB[32 + e] = tot; }
    __syncthreads();
    if (tid == 0) { int acc = 0; for (int e = 0; e < 16; ++e) { TAB[e] = acc; acc += (TAB[32 + e] + 255) >> 8; } TAB[16] = acc; }
    __syncthreads();
}
__device__ __forceinline__ void dest_tile(const OW& P, LAS unsigned char* lds, int tile) {
    const int tid = TID(); LAS int* HS = (LAS int*)lds; LAS int* TAB = (LAS int*)(lds + TAB_OFF); LAS int* BS = (LAS int*)(lds + 16384);
    if (tid < 64) { const int e = tid & 15, qd = tid >> 4; int b = 0;
#pragma unroll 8
        for (int w = 0; w < 64; ++w) { const int ww = qd * 64 + w; b += ww < tile ? HS[ww * 16 + e] : 0; }
        b += __shfl_xor(b, 16); b += __shfl_xor(b, 32);
        if (qd == 0) BS[e] = b; }
    __syncthreads();
    if (tid < 128) { const size_t a = (size_t)tile * 128 + tid; const int e = P.EIDX[a]; const int dst = 256 * TAB[e] + BS[e] + P.LRANK[a]; P.DEST[a] = dst; P.ROWTOK[dst] = (int)(a >> 1); }
    if (tile < 16) { const int e = tile, lo = 256 * TAB[e] + TAB[32 + e], hi = 256 * TAB[e + 1]; for (int i = lo + tid; i < hi; i += NTHREADS) P.ROWTOK[i] = 0; }
    __syncthreads();
}
struct SchedMoe {
    static constexpr bool HOOKS = false;
    const OW* P; LAS int* TAB; int G, c; bool down;
    __device__ __forceinline__ bool next(int i, pg8::UnitD& u) const {
        const int NB = __builtin_amdgcn_readfirstlane(TAB[16]); const int L = i * G + c; if (L >= NB * 4) return false;
        const int rb = L >> 2, pn = L & 3; int e = 0;
#pragma unroll
        for (int q = 1; q < 16; ++q) e += (__builtin_amdgcn_readfirstlane(TAB[q]) <= rb) ? 1 : 0;
        if (!down) { u.A = (const char*)P->XB; u.rows = P->ROWTOK + rb * 256; u.B = (const char*)(P->Wgu_t + ((size_t)e * 1024 + pn * 256) * 1024); u.lda = 2048; u.ldb = 2048; u.nt = 16; u.type = 4; }
        else { u.A = (const char*)(P->HE + (size_t)rb * 256 * DE); u.rows = nullptr; u.B = (const char*)(P->Wd_t + ((size_t)e * 1024 + pn * 256) * DE); u.lda = 1024; u.ldb = 1024; u.nt = 8; u.type = 5; }
        u.pm = rb; u.pn = pn; u.aux = e; return true;
    }
};
struct EpiMoeUp {
    bf16_t* HE;
    __device__ __forceinline__ void operator()(const f32x4 (&acc)[2][2][4][2], const pg8::UnitD& u, int wr, int wc, int fr, int fq) const {
        const int row0 = u.pm * 256 + wr * 64 + fr, col0 = u.pn * 128 + wc * 32 + 8 * fq;
#pragma unroll
        for (int ai = 0; ai < 2; ++ai)
#pragma unroll
            for (int m = 0; m < 4; ++m) { float hv[8];
#pragma unroll
                for (int n = 0; n < 2; ++n)
#pragma unroll
                    for (int x = 0; x < 4; ++x) { const float g = acc[ai][0][m][n][x], up = acc[ai][1][m][n][x]; hv[4 * n + x] = g / (1.f + __expf(-g)) * up; }
                u32x4 w; w.x = pg8::cvt_pk_bf16(hv[0], hv[1]); w.y = pg8::cvt_pk_bf16(hv[2], hv[3]); w.z = pg8::cvt_pk_bf16(hv[4], hv[5]); w.w = pg8::cvt_pk_bf16(hv[6], hv[7]);
                *(u32x4*)(HE + (size_t)(row0 + ai * 128 + m * 16) * DE + col0) = w; }
    }
};
struct EpiMoeDown {
    bf16_t* YE;
    __device__ __forceinline__ void operator()(const f32x4 (&acc)[2][2][4][2], const pg8::UnitD& u, int wr, int wc, int fr, int fq) const {
        const int row0 = u.pm * 256 + wr * 64 + fr, col0 = u.pn * 256 + wc * 32 + 8 * fq;
#pragma unroll
        for (int ai = 0; ai < 2; ++ai)
#pragma unroll
            for (int m = 0; m < 4; ++m) { bf16_t* rowp = YE + (size_t)(row0 + ai * 128 + m * 16) * D + col0;
#pragma unroll
                for (int bj = 0; bj < 2; ++bj) { const f32x4 v0 = acc[ai][bj][m][0], v1 = acc[ai][bj][m][1];
                    u32x4 w; w.x = pg8::cvt_pk_bf16(v0[0], v0[1]); w.y = pg8::cvt_pk_bf16(v0[2], v0[3]); w.z = pg8::cvt_pk_bf16(v1[0], v1[1]); w.w = pg8::cvt_pk_bf16(v1[2], v1[3]);
                    *(u32x4*)(rowp + bj * 128) = w; } }
    }
};

__device__ __forceinline__ void store16_sc1(void* p, u32x4 v) { asm volatile("global_store_dwordx4 %0, %1, off sc1\n\ts_nop 1" :: "v"(p), "v"(v) : "memory"); }
struct SchedMoe2 {
    static constexpr bool HOOKS = true;
    const OW* P; LAS int* TAB; unsigned* cnt;
    int G, c, U, nup, ndn, jA, jB;
    __device__ __forceinline__ void init(int G_, int c_) {
        G = G_; c = c_; const int NB = __builtin_amdgcn_readfirstlane(TAB[16]); U = 4 * NB;
        const int nmax = (U + G - 1) / G, nfull = U - (nmax - 1) * G;
        const bool allsame = nfull >= G; const int Lc = allsame ? 0 : G - nfull;
        nup = (c < nfull || allsame) ? nmax : nmax - 1; if (c >= U) nup = 0;
        const bool light = !allsame && c >= nfull; const int cl = c - nfull;
        const int nA = 2 * Lc < U ? 2 * Lc : U; const int R = U - nA;
        int a_cnt = 0; if (light) { a_cnt = nA - 2 * cl; a_cnt = a_cnt < 0 ? 0 : (a_cnt > 2 ? 2 : a_cnt); }
        const int o = light ? cl : Lc + c;
        const int b_cnt = o < R ? (R - o + G - 1) / G : 0;
        jA = 2 * cl; jB = nA + o; ndn = a_cnt + b_cnt; nA_mine = a_cnt;
    }
    int nA_mine;
    __device__ __forceinline__ bool next(int i, pg8::UnitD& u) const {
        if (i < nup) { const int Lq = c + i * G; fill(u, Lq >> 2, Lq & 3, false); return true; }
        const int k = i - nup; if (k >= ndn) return false;
        const int j = k < nA_mine ? jA + k : jB + (k - nA_mine) * G; fill(u, j >> 2, j & 3, true); return true;
    }
    __device__ __forceinline__ void fill(pg8::UnitD& u, int rb, int pn, bool down) const {
        int e = 0;
#pragma unroll
        for (int q = 1; q < 16; ++q) e += (__builtin_amdgcn_readfirstlane(TAB[q]) <= rb) ? 1 : 0;
        if (!down) { u.A = (const char*)P->XB; u.rows = P->ROWTOK + rb * 256; u.B = (const char*)(P->Wgu_t + ((size_t)e * 1024 + pn * 256) * 1024); u.lda = 2048; u.ldb = 2048; u.nt = 16; u.type = 4; }
        else { u.A = (const char*)(P->HE + (size_t)rb * 256 * DE); u.rows = nullptr; u.B = (const char*)(P->Wd_t + ((size_t)e * 1024 + pn * 256) * DE); u.lda = 1024; u.ldb = 1024; u.nt = 8; u.type = 5; }
        u.pm = rb; u.pn = pn; u.aux = e;
    }
    __device__ __forceinline__ void a_ready(const pg8::UnitD& u, int wid) const {
        if (u.type != 5) return;
        if (wid == 0) {
            const unsigned* w = cnt + 64 * u.pm; unsigned spins = 0;
            for (;;) { unsigned v;
                asm volatile("v_mov_b32 %0, 0\n\tglobal_load_dword %0, %0, %1 sc1\n\ts_waitcnt vmcnt(0)" : "=&v"(v) : "s"(w) : "memory");
                if ((unsigned)__builtin_amdgcn_readfirstlane((int)v) >= 32u) break;
                if (++spins > 200000u) break;
                __builtin_amdgcn_s_sleep(2); }
            __builtin_amdgcn_fence(__ATOMIC_ACQUIRE, "agent");
            asm volatile("s_waitcnt vmcnt(0)" ::: "memory");
        }
        asm volatile("" ::: "memory"); __builtin_amdgcn_s_barrier(); asm volatile("" ::: "memory");
    }
    __device__ __forceinline__ void done(const pg8::UnitD& u, int lane) const {
        if (u.type != 4) return;
        asm volatile("s_waitcnt vmcnt(0)" ::: "memory");
        if (lane == 0) __hip_atomic_fetch_add(cnt + 64 * u.pm, 1u, __ATOMIC_RELAXED, __HIP_MEMORY_SCOPE_AGENT);
    }
};
struct EpiMoe2 {
    bf16_t* HE; bf16_t* YE;
    __device__ __forceinline__ void operator()(const f32x4 (&acc)[2][2][4][2], const pg8::UnitD& u, int wr, int wc, int fr, int fq) const {
        const int L = fr + 16 * fq, sq = pg8::to_quad_src(L);
        const int row0 = u.pm * 256 + wr * 64 + (L >> 2);
        if (u.type == 4) { const int col0 = u.pn * 128 + wc * 32 + 8 * (L & 3);
#pragma unroll
            for (int ai = 0; ai < 2; ++ai)
#pragma unroll
                for (int m = 0; m < 4; ++m) { float hv[8];
                    int rr = row0 + ai * 128 + m * 16; asm volatile("" : "+v"(rr));
#pragma unroll
                    for (int n = 0; n < 2; ++n)
#pragma unroll
                        for (int x = 0; x < 4; ++x) { const float g = acc[ai][0][m][n][x], up = acc[ai][1][m][n][x]; hv[4 * n + x] = g * __builtin_amdgcn_rcpf(1.f + __expf(-g)) * up; }
                    u32x4 w; w.x = pg8::cvt_pk_bf16(hv[0], hv[1]); w.y = pg8::cvt_pk_bf16(hv[2], hv[3]); w.z = pg8::cvt_pk_bf16(hv[4], hv[5]); w.w = pg8::cvt_pk_bf16(hv[6], hv[7]);
                    store16_sc1(HE + (size_t)rr * DE + col0, pg8::lane_perm(w, sq)); }
        } else { const int col0 = u.pn * 256 + wc * 32 + 8 * (L & 3);
#pragma unroll
            for (int ai = 0; ai < 2; ++ai)
#pragma unroll
                for (int m = 0; m < 4; ++m) { int rr = row0 + ai * 128 + m * 16; asm volatile("" : "+v"(rr)); bf16_t* rowp = YE + (size_t)rr * D + col0;
#pragma unroll
                    for (int bj = 0; bj < 2; ++bj) { const f32x4 v0 = acc[ai][bj][m][0], v1 = acc[ai][bj][m][1];
                        u32x4 w; w.x = pg8::cvt_pk_bf16(v0[0], v0[1]); w.y = pg8::cvt_pk_bf16(v0[2], v0[3]); w.z = pg8::cvt_pk_bf16(v1[0], v1[1]); w.w = pg8::cvt_pk_bf16(v1[2], v1[3]);
                        *(u32x4*)(rowp + bj * 128) = pg8::lane_perm(w, sq); } }
        }
    }
};
__device__ __forceinline__ void ln2_rows(const OW& P, int l, int vcu, int G, float* Xdst) {
    const int tid_ = TID(); const int lane = tid_ & 63, wid = __builtin_amdgcn_readfirstlane(tid_ >> 6);
    const float* g2 = P.in[22] + (size_t)l * D; const float* b2 = P.in[23] + (size_t)l * D;
    f32x4 gv[4], bv[4];
#pragma unroll
    for (int j = 0; j < 4; ++j) { const int c = lane * 8 + 512 * (j >> 1) + 4 * (j & 1); gv[j] = *(const f32x4*)(g2 + c); bv[j] = *(const f32x4*)(b2 + c); }
    const size_t first = (size_t)vcu * NWAVES + wid, stride = (size_t)G * NWAVES;
    for (size_t base = first; base < NT; base += 8 * stride) {
        float ga[8], gb[8]; int da[8], db[8];
#pragma unroll
        for (int k = 0; k < 8; ++k) { const size_t row = base + k * stride; const bool ok = row < NT; const size_t r_ = ok ? row : base;
            ga[k] = P.GATE[r_ * 2]; gb[k] = P.GATE[r_ * 2 + 1]; da[k] = P.DEST[r_ * 2]; db[k] = P.DEST[r_ * 2 + 1]; }
#pragma unroll
        for (int kg = 0; kg < 8; kg += 4) {
        u32x4 nx[4][2], nya[4][2], nyb[4][2];
#pragma unroll
        for (int k4 = 0; k4 < 4; ++k4) { const int k = kg + k4; const size_t row_ = base + k * stride < NT ? base + k * stride : base;
#pragma unroll
            for (int j = 0; j < 2; ++j) { nx[k4][j] = *(const u32x4*)(P.XB + row_ * D + lane * 8 + 512 * j);
                nya[k4][j] = *(const u32x4*)(P.YE + (size_t)da[k] * D + lane * 8 + 512 * j); nyb[k4][j] = *(const u32x4*)(P.YE + (size_t)db[k] * D + lane * 8 + 512 * j); } }
#pragma unroll
        for (int k4 = 0; k4 < 4; ++k4) { const int k = kg + k4; const size_t row = base + k * stride; if (row >= NT) break;
            float v[16]; float s = 0.f; const float gA = ga[k], gB = gb[k];
#pragma unroll
            for (int j = 0; j < 2; ++j)
#pragma unroll
                for (int q = 0; q < 4; ++q) { const unsigned x = nx[k4][j][q], ya = nya[k4][j][q], yb = nyb[k4][j][q];
                    v[8 * j + 2 * q] = ALPHA * bflo(x) + gA * bflo(ya) + gB * bflo(yb); v[8 * j + 2 * q + 1] = ALPHA * bfhi(x) + gA * bfhi(ya) + gB * bfhi(yb); }
#pragma unroll
            for (int i = 0; i < 16; ++i) s += v[i];
            const float mu = wsum(s) * (1.f / D); float q_ = 0.f;
#pragma unroll
            for (int i = 0; i < 16; ++i) { v[i] -= mu; q_ += v[i] * v[i]; }
            const float rs = rsqrtf(wsum(q_) * (1.f / D) + EPS);
#pragma unroll
            for (int i = 0; i < 16; ++i) v[i] = v[i] * rs * gv[i >> 2][i & 3] + bv[i >> 2][i & 3];
#pragma unroll
            for (int j = 0; j < 2; ++j) { u32x4 o;
#pragma unroll
                for (int q = 0; q < 4; ++q) o[q] = pk2(v[8 * j + 2 * q], v[8 * j + 2 * q + 1]);
                *(u32x4*)(P.XB + row * D + lane * 8 + 512 * j) = o;
                if (Xdst) { *(f32x4*)(Xdst + row * D + lane * 8 + 512 * j) = (f32x4){v[8 * j], v[8 * j + 1], v[8 * j + 2], v[8 * j + 3]}; *(f32x4*)(Xdst + row * D + lane * 8 + 512 * j + 4) = (f32x4){v[8 * j + 4], v[8 * j + 5], v[8 * j + 6], v[8 * j + 7]}; } }
        }
        }
    }
}

#if MODE == 0
__global__ void __launch_bounds__(NTHREADS, 2) opt_phase(OW P, int phase, int layer) {
    extern __shared__ __attribute__((aligned(16))) unsigned char lds_raw[];
    LAS unsigned char* lds = (LAS unsigned char*)lds_raw;
    const int G = gridDim.x, bx = blockIdx.x, vcu = (G % 8 == 0) ? (bx % 8) * (G / 8) + bx / 8 : bx;
    switch (phase) {
        case 0: if (PH(0)) { prep_tables(P, vcu, G); prep_weights(P, layer, lds, vcu, G); } break;
        case 1: if (PH(1)) phase_inproj(P, lds, G); break;
        case 2: if (PH(2)) phase_qkv(P, layer, lds, G); break;
        case 3: if (PH(3)) phase_attn(P, lds, vcu, G); break;
        case 4: if (PH(4)) { for (int tile = blockIdx.x; tile < NT / 64; tile += G) mix_tile(P, lds, tile); } break;
        case 5: if (PH(5)) { SchedOut Sd{&P, G, (int)blockIdx.x}; EpiOut E{P.XB, P.Y}; pg8::gemm_phase<true>(lds, Sd, E); } break;
        case 6: if (PH(6)) { for (int tile = blockIdx.x; tile < NT / 64; tile += G) ln1_router_tile(P, layer, lds, tile); } break;
        case 7: if (PH(7)) { moe_table(P, lds); for (int tile = blockIdx.x; tile < NT / 64; tile += G) dest_tile(P, lds, tile); } break;
        case 8: if (PH(8)) { moe_table(P, lds); SchedMoe Sd{&P, (LAS int*)(lds + TAB_OFF), G, (int)blockIdx.x, false}; EpiMoeUp E{P.HE}; pg8::gemm_phase<true>(lds, Sd, E); } break;
        case 9: if (PH(9)) { moe_table(P, lds); SchedMoe Sd{&P, (LAS int*)(lds + TAB_OFF), G, (int)blockIdx.x, true}; EpiMoeDown E{P.YE}; pg8::gemm_phase<true>(lds, Sd, E); } break;
        case 10: if (PH(10)) { ln2_rows(P, layer, vcu, G, layer == L - 1 ? P.X : nullptr); if (layer + 1 < L) prep_weights(P, layer + 1, lds, vcu, G); } break;
        default: break;
    }
}

#endif
struct MArgs { const float* in[24]; float* X; char* ws; };
constexpr int PT_OFF = LDSCTL_OFF + 2048;
__device__ __forceinline__ unsigned long long ldq(LAS unsigned char* lds, int k) {
    const LAS unsigned* p = (const LAS unsigned*)(lds + PT_OFF) + 2 * k;
    const unsigned lo = (unsigned)__builtin_amdgcn_readfirstlane((int)p[0]), hi = (unsigned)__builtin_amdgcn_readfirstlane((int)p[1]);
    return ((unsigned long long)hi << 32) | lo;
}
__device__ __forceinline__ OW load_ow(LAS unsigned char* lds_, int wsel = 0) {
    unsigned la = (unsigned)(uintptr_t)lds_; asm volatile("" : "+s"(la) :: "memory"); LAS unsigned char* lds = (LAS unsigned char*)(uintptr_t)la;
    OW P;
#pragma unroll
    for (int i = 0; i < 24; ++i) P.in[i] = (const float*)(GAS const float*)ldq(lds, i);
    P.X = (float*)(GAS float*)ldq(lds, 24); GAS char* ws = (GAS char*)ldq(lds, 25); GAS char* wsw = ws + (wsel ? ows::WSET1 : 0);
    P.ctl = (unsigned*)(GAS unsigned*)(ws + ows::CTL); P.XB = (bf16_t*)(GAS bf16_t*)(ws + ows::XB); P.Z = (bf16_t*)(GAS bf16_t*)(ws + ows::Z); P.SSQ = (float*)(GAS float*)(ws + ows::SSQ);
    P.Win_t = (bf16_t*)(GAS bf16_t*)(wsw + ows::WIN); P.Wq_t = (bf16_t*)(GAS bf16_t*)(wsw + ows::WQ); P.Wkv_t = (bf16_t*)(GAS bf16_t*)(wsw + ows::WKV); P.Wo_t = (bf16_t*)(GAS bf16_t*)(wsw + ows::WO);
    P.Wgu_t = (bf16_t*)(GAS bf16_t*)(wsw + ows::WGU); P.Wd_t = (bf16_t*)(GAS bf16_t*)(wsw + ows::WD); P.Wlg_t = (bf16_t*)(GAS bf16_t*)(wsw + ows::WLG); P.RWH = (bf16_t*)(GAS bf16_t*)(wsw + ows::WLG + 262144); P.RGB = (float*)(GAS float*)(wsw + ows::WLG + 393216);
    P.ROPE = (f32x2*)(GAS f32x2*)(ws + ows::ROPE); P.Q = (bf16_t*)(GAS bf16_t*)(ws + ows::Q); P.KN = (bf16_t*)(GAS bf16_t*)(ws + ows::KN); P.VV = (bf16_t*)(GAS bf16_t*)(ws + ows::VV); P.KPE = (bf16_t*)(GAS bf16_t*)(ws + ows::KPE);
    P.A = (float*)(GAS float*)(ws + ows::A); P.DRV = (float*)(GAS float*)(ws + ows::DRV); P.AGA = (float*)(GAS float*)(ws + ows::AGA); P.AGB = (float*)(GAS float*)(ws + ows::AGB);
    P.OP = (bf16_t*)(GAS bf16_t*)(ws + ows::OP); P.ML = (f32x2*)(GAS f32x2*)(ws + ows::ML); P.MIX = (bf16_t*)(GAS bf16_t*)(ws + ows::MIX); P.Y = (bf16_t*)(GAS bf16_t*)(ws + ows::Y);
    P.EIDX = (int*)(GAS int*)(ws + ows::EIDX); P.HIST = (int*)(GAS int*)(ws + ows::HIST); P.LRANK = (int*)(GAS int*)(ws + ows::LRANK); P.DEST = (int*)(GAS int*)(ws + ows::DEST); P.ROWTOK = (int*)(GAS int*)(ws + ows::ROWTOK); P.GATE = (float*)(GAS float*)(ws + ows::GATE);
    P.HE = (bf16_t*)(GAS bf16_t*)(ws + ows::HE); P.YE = (bf16_t*)(GAS bf16_t*)(ws + ows::YE);
    return P;
}
__global__ void __launch_bounds__(NTHREADS, 2) mega_fwd(MArgs a) {
    extern __shared__ __attribute__((aligned(16))) unsigned char lds_raw[];
    LAS unsigned char* lds = (LAS unsigned char*)lds_raw;
    for (int u = threadIdx.x; u < (LDS_BYTES - LDSCTL_OFF) / 4; u += NTHREADS) ((LAS unsigned*)(lds + LDSCTL_OFF))[u] = 0u;
    __syncthreads();
    { LAS unsigned long long* PT = (LAS unsigned long long*)(lds + PT_OFF);
#pragma unroll
      for (int i = 0; i < 24; ++i) if (threadIdx.x == i) PT[i] = (unsigned long long)a.in[i];
      if (threadIdx.x == 24) PT[24] = (unsigned long long)a.X;
      if (threadIdx.x == 25) PT[25] = (unsigned long long)a.ws; }
    __syncthreads();
    XcdBarrier bar; { const OW P = load_ow(lds); bar = xcd_barrier_post(P.ctl + 4096, (volatile LAS unsigned*)(lds + MISC_OFF) + 8); }
    LAS int* TAB = (LAS int*)(lds + TAB_OFF);
    if (PH(0)) { const OW P = load_ow(lds); const int G = GDIM(); const int b_ = BID(); const int v_ = (G % 8 == 0) ? (b_ % 8) * (G / 8) + b_ / 8 : b_; prep_tables(P, v_, G);
        if (G == 256) { prep_weights(P, 0, lds, v_, G, 0, 136, 1); prep_weights(P, 0, lds, v_, G, 1236, 1 << 30, 0); const OW P1 = load_ow(lds, 1); prep_weights(P1, 0, lds, v_, G, 0, 0, 1); }
        else { prep_weights(P, 0, lds, v_, G, 0, 1 << 30, 3); const OW P1 = load_ow(lds, 1); prep_weights(P1, 0, lds, v_, G, 0, 0, 1); } }
    xcd_barrier(bar);
    for (int l = 0; l < L; ++l) {
        constexpr int SPLIT = 900;
        for (int rep_ = 0; rep_ < (DUP(1) ? 2 : 1); ++rep_) if (PH(1)) { const OW P = load_ow(lds, l & 1); const int G = GDIM(); phase_inproj(P, lds, G); }
        if (PH(10)) {
            const int G = GDIM(), b_ = BID(); const int nmax = (576 + G - 1) / G, nfull = 576 - (nmax - 1) * G;
            if (G == 256) { const OW P = load_ow(lds, l & 1); if (b_ >= nfull) prep_weights(P, l, lds, b_ - nfull, G - nfull, l == 0 ? 136 : SPLIT, l == 0 ? 1236 : 1 << 30, 2); }
            else if (l + 1 < L) { const OW P = load_ow(lds, (l + 1) & 1); prep_weights(P, l + 1, lds, b_, G, 0, 1 << 30, 2); } }
        xcd_barrier(bar);
        for (int rep_ = 0; rep_ < (DUP(2) ? 2 : 1); ++rep_) if (PH(2)) { { const OW P = load_ow(lds, l & 1); const int G = GDIM(); const int b_ = BID(); SchedQKV Sd{&P, G, (G % 8 == 0) ? (b_ % 8) * (G / 8) + b_ / 8 : b_};     EpiQKV E{P.SSQ, P.Q, P.KN, P.VV}; pg8::gemm_phase<true>(lds, Sd, E); }
                     { const OW P = load_ow(lds, l & 1); const int G = GDIM(); for (int tile = BID(); tile < NT / 64; tile += G) { gates_tile(P, l, lds, tile); if (DUP(15)) gates_tile(P, l, lds, tile); } } }
        xcd_barrier(bar);
        for (int rep_ = 0; rep_ < (DUP(3) ? 2 : 1); ++rep_) if (PH(3)) { const OW P = load_ow(lds, l & 1); const int G = GDIM(); { const int b_ = BID(); phase_attn(P, lds, (G % 8 == 0) ? (b_ % 8) * (G / 8) + b_ / 8 : b_, G); } }
        xcd_barrier(bar);
        for (int rep_ = 0; rep_ < (DUP(4) ? 2 : 1); ++rep_) if (PH(4)) { const OW P = load_ow(lds, l & 1); const int G = GDIM(); for (int tile = BID(); tile < NT / 64; tile += G) mix_tile(P, lds, tile); }
        xcd_barrier(bar);
        for (int rep_ = 0; rep_ < (DUP(5) ? 2 : 1); ++rep_) if (PH(5)) { const OW P = load_ow(lds, l & 1); const int G = GDIM(); SchedOut Sd{&P, G, BID()}; EpiOut E{P.XB, P.Y}; pg8::gemm_phase<true>(lds, Sd, E); }
        xcd_barrier(bar);
        for (int rep_ = 0; rep_ < (DUP(6) ? 2 : 1); ++rep_) if (PH(6)) { const OW P = load_ow(lds, l & 1); const int G = GDIM(); for (int tile = BID(); tile < NT / 64; tile += G) { ln1_router_tile(P, l, lds, tile); if (DUP(13)) ln1_router_tile(P, l, lds, tile); } }
        xcd_barrier(bar);
        for (int rep_ = 0; rep_ < (DUP(7) ? 2 : 1); ++rep_) if (PH(7)) { const OW P = load_ow(lds, l & 1); const int G = GDIM(); moe_table(P, lds); for (int tile = BID(); tile < NT / 64; tile += G) dest_tile(P, lds, tile); }
        xcd_barrier(bar);
        for (int rep_ = 0; rep_ < (DUP(8) ? 2 : 1); ++rep_) if (PH(8)) { const OW P = load_ow(lds, l & 1); const int G = GDIM(); SchedMoe2 Sd; Sd.P = &P; Sd.TAB = TAB; Sd.cnt = P.ctl + MOECNT_W + l * 144 * 64; { const int b_ = BID(); Sd.init(G, (G % 8 == 0) ? (b_ % 8) * (G / 8) + b_ / 8 : b_); } EpiMoe2 E{P.HE, P.YE}; pg8::gemm_phase<true>(lds, Sd, E); }
        if (PH(10) && l + 1 < L && GDIM() == 256) { const OW P = load_ow(lds, (l + 1) & 1); prep_queue(P, l + 1, lds, P.ctl + PREPQ_W + l * 64, 0, SPLIT); }
        xcd_barrier(bar);
        if (PH(10)) { const OW P = load_ow(lds, l & 1); const int G = GDIM(); { const int b_ = BID(); const int v_ = (G % 8 == 0) ? (b_ % 8) * (G / 8) + b_ / 8 : b_; ln2_rows(P, l, v_, G, l == L - 1 ? P.X : nullptr); } }
        if (l + 1 < L) xcd_barrier(bar);
        if (DUP(12)) for (int rep_ = 0; rep_ < 10; ++rep_) xcd_barrier(bar);
    }
}
#if MODE == 0
__global__ void shim_q(const bf16_t* Qb, float* Qf) { const size_t i = (size_t)blockIdx.x * 256 + threadIdx.x; if (i < (size_t)NT * QL) Qf[i] = bf2f(Qb[i]); }
__global__ void shim_kv(const bf16_t* KN, const bf16_t* VV, float* KV) { const size_t i = (size_t)blockIdx.x * 256 + threadIdx.x; if (i < (size_t)NT * 1024) { const size_t r = i >> 10; const int c = (int)(i & 1023), h = c >> 8, d = c & 255;
    KV[i] = d < 128 ? bf2f(KN[r * 512 + h * 128 + d]) : bf2f(VV[r * 512 + h * 128 + d - 128]); } }
__global__ void shim_kpe(const bf16_t* Kb, float* Kf) { const size_t i = (size_t)blockIdx.x * 256 + threadIdx.x; if (i < (size_t)NT * 64) Kf[i] = bf2f(Kb[i]); }
__global__ void shim_z(const bf16_t* Zb, float* Zf) { const size_t i = (size_t)blockIdx.x * 256 + threadIdx.x; if (i < (size_t)NT * INW) { const size_t r = i / INW, c = i % INW; Zf[i] = bf2f(Zb[r * ZW + c]); } }


#endif
#if MODE == 0
static OW make_ow(void* const* d_in, float* out, char* ws) {
    OW P{};
    for (int i = 0; i < 24; ++i) P.in[i] = (const float*)d_in[i];
    P.X = out; P.ctl = (unsigned*)(ws + ows::CTL); P.XB = (bf16_t*)(ws + ows::XB); P.Z = (bf16_t*)(ws + ows::Z); P.SSQ = (float*)(ws + ows::SSQ);
    P.Win_t = (bf16_t*)(ws + ows::WIN); P.Wq_t = (bf16_t*)(ws + ows::WQ); P.Wkv_t = (bf16_t*)(ws + ows::WKV); P.Wo_t = (bf16_t*)(ws + ows::WO); P.Wgu_t = (bf16_t*)(ws + ows::WGU); P.Wd_t = (bf16_t*)(ws + ows::WD); P.Wlg_t = (bf16_t*)(ws + ows::WLG);
    P.ROPE = (f32x2*)(ws + ows::ROPE); P.Q = (bf16_t*)(ws + ows::Q); P.KN = (bf16_t*)(ws + ows::KN); P.VV = (bf16_t*)(ws + ows::VV); P.KPE = (bf16_t*)(ws + ows::KPE);
    P.A = (float*)(ws + ows::A); P.DRV = (float*)(ws + ows::DRV); P.AGA = (float*)(ws + ows::AGA); P.AGB = (float*)(ws + ows::AGB);
    P.OP = (bf16_t*)(ws + ows::OP); P.ML = (f32x2*)(ws + ows::ML); P.MIX = (bf16_t*)(ws + ows::MIX); P.Y = (bf16_t*)(ws + ows::Y);
    P.EIDX = (int*)(ws + ows::EIDX); P.HIST = (int*)(ws + ows::HIST); P.LRANK = (int*)(ws + ows::LRANK); P.DEST = (int*)(ws + ows::DEST); P.ROWTOK = (int*)(ws + ows::ROWTOK); P.GATE = (float*)(ws + ows::GATE);
    P.HE = (bf16_t*)(ws + ows::HE); P.YE = (bf16_t*)(ws + ows::YE); P.RWH = (bf16_t*)(ws + ows::WLG + 262144); P.RGB = (float*)(ws + ows::WLG + 393216);
    return P;
}

#endif
constexpr int ATT_LDS = (4 * S + 4 * QH) * 4, MOEUP_LDS = D * 16 * 4 + 64;
#ifndef OPT_STAGES
#define OPT_STAGES 0
#endif
#ifndef OPT_LAYERS
#define OPT_LAYERS 1
#endif
#if MODE == 0
static void hybrid_forward(void* const* d_in, float* out, float* ws, hipStream_t st) {
    const float* x0 = (const float*)d_in[0];
    float* Z = ws + rws::Z; float* YE = Z; float* A = ws + rws::AB; float* DRV = A + (size_t)NT * LW; float* HID = A;
    float* Q = ws + rws::Q; float* KV = ws + rws::KV; float* Y = KV; float* KPE = ws + rws::KPE; float* MIX = ws + rws::MIX;
    float* GATE = ws + rws::GATE; int* CNT = (int*)(ws + rws::CNT); int* LIST = (int*)(ws + rws::LIST);
    OW P{};
    for (int i = 0; i < 24; ++i) P.in[i] = (const float*)d_in[i];
    P.X = out;
    char* tailp = (char*)(ws + rws::END);
    P.ctl = (unsigned*)tailp; tailp += 65536;
    P.ROPE = (f32x2*)tailp; tailp += (size_t)S * 32 * 8;
    P.SSQ = (float*)tailp; tailp += (size_t)NT * 16 * 4;
    P.Win_t = (bf16_t*)tailp; tailp += (size_t)ZW * D * 2;
    P.Wq_t = (bf16_t*)tailp; tailp += (size_t)768 * 768 * 2;
    P.Wkv_t = (bf16_t*)tailp; tailp += (size_t)1024 * 256 * 2;
    P.Wo_t = (bf16_t*)tailp; tailp += (size_t)1024 * 1024 * 2;
    P.Wlg_t = (bf16_t*)tailp; tailp += (size_t)8 * 128 * 64 * 2;
    P.Wgu_t = (bf16_t*)tailp; tailp += (size_t)16 * 1024 * 1024 * 2;
    P.Wd_t = (bf16_t*)tailp; tailp += (size_t)16 * 1024 * 512 * 2;
    P.AGA = (float*)tailp; tailp += (size_t)256 * LW * 4;
    P.AGB = (float*)tailp; tailp += (size_t)256 * LW * 4;
    P.OP = (bf16_t*)tailp; tailp += (size_t)2 * NT * 512 * 2;
    P.ML = (f32x2*)tailp; tailp += (size_t)2 * NT * 4 * 8;
    P.A = A; P.DRV = DRV;
    { char* m = (char*)(ws + rws::MIX) ; P.Q = (bf16_t*)m; m += (size_t)NT * QL * 2; P.KN = (bf16_t*)m; m += (size_t)NT * 512 * 2; P.VV = (bf16_t*)m; m += (size_t)NT * 512 * 2; P.KPE = (bf16_t*)m; }
    P.XB = (bf16_t*)(ws + rws::MIX);
    P.Z = (bf16_t*)(ws + rws::KV);
    P.Z = (bf16_t*)(ws + rws::Q);
    const OW PF = make_ow(d_in, out, (char*)ws);
    for (int l = 0; l < L; ++l) {
        if (l < OPT_LAYERS) {
            if (l == 0) opt_phase<<<256, NTHREADS, LDS_BYTES, st>>>(PF, 0, 0);
            for (int ph = 1; ph <= 10; ++ph) opt_phase<<<256, NTHREADS, LDS_BYTES, st>>>(PF, ph, l);
            continue;
        }
        const float* xin = l == 0 ? x0 : out;
        const float* w_in = (const float*)d_in[1] + (size_t)l * D * INW;
        const float* conv_w = (const float*)d_in[2] + (size_t)l * 4 * LW;
        const float* conv_b = (const float*)d_in[3] + (size_t)l * LW;
        const float* w_r = (const float*)d_in[4] + (size_t)l * 8 * 64 * 64;
        const float* b_r = (const float*)d_in[5] + (size_t)l * LW;
        const float* w_i = (const float*)d_in[6] + (size_t)l * 8 * 64 * 64;
        const float* b_i = (const float*)d_in[7] + (size_t)l * LW;
        const float* lam = (const float*)d_in[8] + (size_t)l * LW;
        const float* qng = (const float*)d_in[9] + (size_t)l * QL;
        const float* w_qup = (const float*)d_in[10] + (size_t)l * QL * 768;
        const float* kvng = (const float*)d_in[11] + (size_t)l * KVL;
        const float* w_kvup = (const float*)d_in[12] + (size_t)l * KVL * 1024;
        const float* ong = (const float*)d_in[13] + (size_t)l * 1024;
        const float* w_out = (const float*)d_in[14] + (size_t)l * 1024 * D;
        const float* ln1g = (const float*)d_in[15] + (size_t)l * D;
        const float* ln1b = (const float*)d_in[16] + (size_t)l * D;
        const float* rw = (const float*)d_in[17];
        const float* rb = (const float*)d_in[18];
        const float* wg = (const float*)d_in[19] + (size_t)l * NE * D * DE;
        const float* wu = (const float*)d_in[20] + (size_t)l * NE * D * DE;
        const float* wd = (const float*)d_in[21] + (size_t)l * NE * DE * D;
        const float* ln2g = (const float*)d_in[22] + (size_t)l * D;
        const float* ln2b = (const float*)d_in[23] + (size_t)l * D;
        const int nopt = l == 0 ? OPT_STAGES : 0;
        if (nopt >= 1) {
            opt_phase<<<256, NTHREADS, LDS_BYTES, st>>>(P, 0, l);
            opt_phase<<<256, NTHREADS, LDS_BYTES, st>>>(P, 1, l);
            if (nopt >= 2) opt_phase<<<256, NTHREADS, LDS_BYTES, st>>>(P, 2, l);
            if (nopt >= 3) opt_phase<<<256, NTHREADS, LDS_BYTES, st>>>(P, 3, l);
            shim_z<<<(unsigned)(((size_t)NT * INW + 255) / 256), 256, 0, st>>>(P.Z, Z);
        } else {
            ref::gemm<true><<<dim3(INW / 64, NT / 64), 256, 0, st>>>(xin, D, w_in, INW, Z, INW, D);
        }
        if (nopt >= 3) {
            ref::lru_scan<<<B * LW / 256, 256, 0, st>>>(A, DRV, Z, MIX);
            shim_attn<<<(unsigned)(((size_t)NT * 512 + 255) / 256), 256, 0, st>>>(P.OP, P.ML, MIX);
        } else if (nopt >= 2) {
            shim_q<<<(unsigned)(((size_t)NT * QL + 255) / 256), 256, 0, st>>>(P.Q, Q);
            shim_kv<<<(unsigned)(((size_t)NT * 1024 + 255) / 256), 256, 0, st>>>(P.KN, P.VV, KV);
            shim_kpe<<<(unsigned)(((size_t)NT * 64 + 255) / 256), 256, 0, st>>>(P.KPE, KPE);
            ref::lru_scan<<<B * LW / 256, 256, 0, st>>>(A, DRV, Z, MIX);
            ref::q_post<<<NT * 4 * 96 / 256, 256, 0, st>>>(Q);
        } else {
            ref::lru_gates<<<NT * LW / 256, 256, 0, st>>>(Z, conv_w, conv_b, w_r, b_r, w_i, b_i, lam, A, DRV);
            ref::lru_scan<<<B * LW / 256, 256, 0, st>>>(A, DRV, Z, MIX);
            ref::rmsnorm<<<NT / 4, 256, 0, st>>>(Z, INW, 1024, QL, qng);
            ref::rmsnorm<<<NT / 4, 256, 0, st>>>(Z, INW, 1792, KVL, kvng);
            ref::gemm<true><<<dim3(768 / 64, NT / 64), 256, 0, st>>>(Z + 1024, INW, w_qup, 768, Q, QL, QL);
            ref::gemm<true><<<dim3(1024 / 64, NT / 64), 256, 0, st>>>(Z + 1792, INW, w_kvup, 1024, KV, 1024, KVL);
            ref::q_post<<<NT * 4 * 96 / 256, 256, 0, st>>>(Q);
            ref::kpe_rope<<<NT * 32 / 256, 256, 0, st>>>(Z, KPE);
        }
        if (nopt < 3) ref::attention<<<B * H * S / 4, 64, ATT_LDS, st>>>(Q, KV, KPE, MIX);
        ref::rmsnorm<<<NT / 4, 256, 0, st>>>(MIX, D, 0, 512, ong);
        ref::rmsnorm<<<NT / 4, 256, 0, st>>>(MIX, D, 512, 512, ong + 512);
        ref::gemm<false><<<dim3(D / 64, NT / 64), 256, 0, st>>>(MIX, D, w_out, D, Y, D, 1024);
        ref::ln_res<<<NT / 4, 256, 0, st>>>(xin, Y, out, ln1g, ln1b);
        (void)hipMemsetAsync(CNT, 0, 64 * sizeof(int), st);
        ref::router<<<NT / 4, 256, 0, st>>>(out, rw, rb, GATE, CNT, LIST);
        ref::moe_up<<<dim3(NT / 16, NE), 256, MOEUP_LDS, st>>>(out, wg, wu, CNT, LIST, HID);
        ref::moe_down<<<dim3(NT / 16, NE), 256, 0, st>>>(HID, wd, CNT, LIST, YE);
        ref::ln_moe<<<NT / 4, 256, 0, st>>>(out, YE, GATE, ln2g, ln2b);
    }
}

#endif
extern "C" void kernel_launch(void* const* d_in, const int* in_sizes, int n_in, void* d_out, int out_size, void* d_ws, size_t ws_size, hipStream_t stream) {
    if (n_in != 24 || out_size != NT * D || ws_size < (size_t)536870912) {
        fprintf(stderr, "kernel_launch: unexpected shapes (n_in %d, out %d, ws %zu)\n", n_in, out_size, ws_size);
        return;
    }
#if MODE == 0
    static bool attr_done = false;
    if (!attr_done) { attr_done = true;
        (void)hipFuncSetAttribute((const void*)ref::attention, hipFuncAttributeMaxDynamicSharedMemorySize, ATT_LDS);
        (void)hipFuncSetAttribute((const void*)ref::moe_up, hipFuncAttributeMaxDynamicSharedMemorySize, MOEUP_LDS);
        (void)hipFuncSetAttribute((const void*)opt_phase, hipFuncAttributeMaxDynamicSharedMemorySize, LDS_BYTES);
    }
#endif
#if MODE == 0
    hybrid_forward(d_in, (float*)d_out, (float*)d_ws, stream);
#else
    static int grid = 0;
    if (grid == 0) { int dev = 0, cus = 0; (void)hipGetDevice(&dev); if (hipDeviceGetAttribute(&cus, hipDeviceAttributeMultiprocessorCount, dev) != hipSuccess || cus <= 0) cus = 256; grid = cus;
        (void)hipFuncSetAttribute((const void*)mega_fwd, hipFuncAttributeMaxDynamicSharedMemorySize, LDS_BYTES); }
    MArgs a{};
    for (int i = 0; i < 24; ++i) a.in[i] = (const float*)d_in[i];
    a.X = (float*)d_out; a.ws = (char*)d_ws;
    (void)hipMemsetAsync((char*)d_ws + ows::CTL, 0, 262144, stream);
    hipLaunchKernelGGL(mega_fwd, dim3(grid), dim3(NTHREADS), LDS_BYTES, stream, a);
#endif
}
```
